# Optimizing an MI355X kernel written in HIP

```python
import math
import jax, jax.numpy as jnp
from jax import lax
import numpy as np

D_MODEL = 1024
BATCH = 8
SEQ = 2048
DEPTH = 1

ATT_HEADS = 8
ATT_HEAD_DIM = 64
KV_RANK = 128
IDX_HEADS = 8
IDX_DIM = 32
TOPK_MAX = 256
Q_BLOCK = 128
N_BUCKETS = 32
MAX_DISTANCE = 128
DN_HEADS = 4
DN_HEAD_DIM = 128
CONV_WIDTH = 4
CHUNK = 64
ATT_W = ATT_HEADS * ATT_HEAD_DIM
DN_W = DN_HEADS * DN_HEAD_DIM
MIX_WIDTH = ATT_W + DN_W
IN_SIZES = (ATT_W, KV_RANK, IDX_HEADS * IDX_DIM, IDX_DIM, IDX_HEADS, 3 * DN_W, DN_W, DN_HEADS, DN_HEADS)
IN_WIDTH = sum(IN_SIZES)
N_GROUPS = 4
EXPERTS_PER_GROUP = 8
N_EXPERTS = N_GROUPS * EXPERTS_PER_GROUP
TOP_K_IN_GROUP = 2
EXPERT_FF = D_MODEL // 2
EPS = 1e-6

kernel_name = "hybrid_dsa_gdn_hmoe_adaln"


def rms_norm(x, g):
    xf = x.astype(jnp.float32)
    y = xf * lax.rsqrt(jnp.mean(xf * xf, axis=-1, keepdims=True) + EPS)
    return (y * g.astype(jnp.float32)).astype(x.dtype)


def l2_norm(x):
    return x * lax.rsqrt(jnp.sum(x * x, axis=-1, keepdims=True) + EPS)


def t5_bucket(dist):
    n = jnp.maximum(dist, 0)
    max_exact = N_BUCKETS // 2
    nf = jnp.maximum(n, 1).astype(jnp.float32)
    large = max_exact + (jnp.log(nf / max_exact) / math.log(MAX_DISTANCE / max_exact)
                         * (N_BUCKETS - max_exact)).astype(jnp.int32)
    large = jnp.minimum(large, N_BUCKETS - 1)
    return jnp.where(n < max_exact, n, large)


def dsa_attention(q, k, v, q_idx, k_idx, w_idx, positions, rel_bias):
    B, T = q.shape[0], q.shape[1]
    n_sel = min(TOPK_MAX, T // 4)
    nb = T // Q_BLOCK

    def to_blocks(a):
        return jnp.moveaxis(a.reshape((B, nb, Q_BLOCK) + a.shape[2:]), 1, 0)

    t_ids = jnp.arange(T, dtype=jnp.int32).reshape(nb, Q_BLOCK)
    key_ids = jnp.arange(T, dtype=jnp.int32)
    scale = ATT_HEAD_DIM ** -0.5
    idx_scale = IDX_DIM ** -0.5
    k_idx_f = k_idx.astype(jnp.float32)
    gather = jax.vmap(lambda a, i: a[i])

    def block(args):
        qb, qib, wb, pb, tb = args
        s_idx = jnp.einsum('bqhd,bsd->bqhs', qib.astype(jnp.float32), k_idx_f) * idx_scale
        score = jnp.einsum('bqh,bqhs->bqs', wb.astype(jnp.float32), jax.nn.relu(s_idx))
        causal = key_ids[None, :] <= tb[:, None]
        score = jnp.where(causal[None], score, -jnp.inf)
        _, sel = lax.top_k(score, n_sel)
        valid = sel <= tb[None, :, None]
        k_sel = gather(k, sel)
        v_sel = gather(v, sel)
        p_sel = gather(positions, sel)
        bias = rel_bias[t5_bucket(pb[:, :, None] - p_sel)]
        logits = (jnp.einsum('bqhd,bqkd->bqhk', qb, k_sel).astype(jnp.float32) * scale
                  + jnp.moveaxis(bias.astype(jnp.float32), -1, 2))
        logits = jnp.where(valid[:, :, None, :], logits, -jnp.inf)
        probs = jax.nn.softmax(logits, axis=-1).astype(v.dtype)
        return jnp.einsum('bqhk,bqkd->bqhd', probs, v_sel)

    out = lax.map(block, (to_blocks(q), to_blocks(q_idx), to_blocks(w_idx), to_blocks(positions), t_ids))
    return jnp.moveaxis(out, 0, 1).reshape(B, T, ATT_W)


def gated_deltanet(qkv, z, beta_in, a_in, conv_w, a_log, dt_bias, norm_g):
    B, T = qkv.shape[0], qkv.shape[1]
    qkv = lax.conv_general_dilated(qkv, conv_w[:, None, :], window_strides=(1,),
                                   padding=((CONV_WIDTH - 1, 0),),
                                   dimension_numbers=('NWC', 'WIO', 'NWC'),
                                   feature_group_count=qkv.shape[-1])
    qkv = jax.nn.silu(qkv.astype(jnp.float32))
    q, k, v = jnp.split(qkv, 3, axis=-1)
    heads = lambda a: a.reshape(B, T, DN_HEADS, DN_HEAD_DIM)
    q = l2_norm(heads(q)) * DN_HEAD_DIM ** -0.5
    k = l2_norm(heads(k))
    v = heads(v)
    beta = jax.nn.sigmoid(beta_in.astype(jnp.float32))
    g = -jnp.exp(a_log.astype(jnp.float32)) * jax.nn.softplus(a_in.astype(jnp.float32) + dt_bias.astype(jnp.float32))
    nc = T // CHUNK

    def chunks(a):
        a = jnp.moveaxis(a, 2, 1)
        return a.reshape((B, DN_HEADS, nc, CHUNK) + a.shape[3:])

    q, k, v, beta, g = [chunks(a) for a in (q, k, v, beta, g)]
    G = jnp.cumsum(g, axis=-1)
    diff = G[..., :, None] - G[..., None, :]
    incl = jnp.tril(jnp.ones((CHUNK, CHUNK), dtype=bool))
    strict = jnp.tril(jnp.ones((CHUNK, CHUNK), dtype=bool), -1)
    decay_incl = jnp.exp(jnp.where(incl, diff, -jnp.inf))
    decay_strict = jnp.where(strict, decay_incl, 0.0)
    kk = jnp.einsum('bhncd,bhnsd->bhncs', k, k)
    a_mat = beta[..., None] * kk * decay_strict + jnp.eye(CHUNK, dtype=jnp.float32)
    rhs = jnp.concatenate([beta[..., None] * v, (beta * jnp.exp(G))[..., None] * k], axis=-1)
    sol = lax.linalg.triangular_solve(a_mat, rhs, left_side=True, lower=True, unit_diagonal=True)
    u, w = sol[..., :DN_HEAD_DIM], sol[..., DN_HEAD_DIM:]
    p = jnp.einsum('bhncd,bhnsd->bhncs', q, k) * decay_incl
    qg = q * jnp.exp(G)[..., None]
    g_last = G[..., -1]
    kd = k * jnp.exp(g_last[..., None] - G)[..., None]
    gc = jnp.exp(g_last)

    def step(S, xs):
        u_c, w_c, p_c, qg_c, kd_c, gc_c = xs
        delta = u_c - jnp.einsum('bhcd,bhde->bhce', w_c, S)
        o = jnp.einsum('bhcd,bhde->bhce', qg_c, S) + jnp.einsum('bhcs,bhse->bhce', p_c, delta)
        S = gc_c[..., None, None] * S + jnp.einsum('bhcd,bhce->bhde', kd_c, delta)
        return S, o

    S0 = jnp.zeros((B, DN_HEADS, DN_HEAD_DIM, DN_HEAD_DIM), jnp.float32)
    xs = tuple(jnp.moveaxis(a, 2, 0) for a in (u, w, p, qg, kd, gc))
    _, o = lax.scan(step, S0, xs)
    o = jnp.moveaxis(o, 0, 2).reshape(B, DN_HEADS, T, DN_HEAD_DIM).transpose(0, 2, 1, 3)
    zf = z.astype(jnp.float32).reshape(B, T, DN_HEADS, DN_HEAD_DIM)
    o = rms_norm(o, norm_g) * jax.nn.silu(zf)
    return o.reshape(B, T, DN_W)


def hier_moe(h, rg_w, rg_b, re_w, re_b, w1, w3, w2):
    B, T, D = h.shape
    hf = h.reshape(-1, D)
    g_prob = jax.nn.softmax((hf @ rg_w + rg_b).astype(jnp.float32), axis=-1)
    g_top, g_sel = lax.top_k(g_prob, 1)
    e_logits = (hf @ re_w + re_b).astype(jnp.float32).reshape(-1, N_GROUPS, EXPERTS_PER_GROUP)
    e_in_group = jnp.einsum('ng,nge->ne', jax.nn.one_hot(g_sel[:, 0], N_GROUPS, dtype=jnp.float32), e_logits)
    e_prob = jax.nn.softmax(e_in_group, axis=-1)
    e_top, e_sel = lax.top_k(e_prob, TOP_K_IN_GROUP)
    e_top = e_top / jnp.sum(e_top, axis=-1, keepdims=True)
    weights = g_top * e_top
    expert_id = g_sel * EXPERTS_PER_GROUP + e_sel
    gates = jnp.sum(jax.nn.one_hot(expert_id, N_EXPERTS, dtype=jnp.float32) * weights[..., None], axis=1)
    gates = gates.astype(h.dtype)
    y = jnp.zeros_like(hf)
    for e in range(N_EXPERTS):
        act = jax.nn.silu(hf @ w1[e]) * (hf @ w3[e])
        y = y + gates[:, e:e + 1] * (act @ w2[e])
    return y.reshape(B, T, D)


def setup_inputs(seed: int = 0) -> dict:
    key = jax.random.key(seed)
    ks = jax.random.split(key, 32)
    f32 = jnp.float32
    L = DEPTH
    nrm = lambda k, shape, s: jax.random.normal(k, shape, f32) * s
    gain = lambda k, n: 1.0 + 0.02 * jax.random.normal(k, (L, n), f32)
    dt = jnp.exp(jax.random.uniform(ks[15], (L, DN_HEADS), f32, math.log(1e-3), math.log(1e-1)))
    return {
        "x": nrm(ks[0], (BATCH, SEQ, D_MODEL), 1.0),
        "c": nrm(ks[1], (BATCH, D_MODEL), 1.0),
        "positions": jnp.broadcast_to(jnp.arange(SEQ, dtype=jnp.int32), (BATCH, SEQ)),
        "ada_w": nrm(ks[2], (L, D_MODEL, 6 * D_MODEL), 0.5 * D_MODEL ** -0.5),
        "ada_b": nrm(ks[3], (L, 6 * D_MODEL), 0.02),
        "norm1_g": gain(ks[4], D_MODEL),
        "norm2_g": gain(ks[5], D_MODEL),
        "w_in": nrm(ks[6], (L, D_MODEL, IN_WIDTH), D_MODEL ** -0.5),
        "q_norm_g": gain(ks[7], ATT_HEAD_DIM),
        "k_norm_g": gain(ks[8], ATT_HEAD_DIM),
        "kv_norm_g": gain(ks[9], KV_RANK),
        "w_kv_up": nrm(ks[10], (L, KV_RANK, 2 * ATT_HEAD_DIM), KV_RANK ** -0.5),
        "idx_k_norm_g": gain(ks[11], IDX_DIM),
        "rel_bias": nrm(ks[12], (N_BUCKETS, ATT_HEADS), 0.5),
        "conv_w": nrm(ks[13], (L, CONV_WIDTH, 3 * DN_W), CONV_WIDTH ** -0.5),
        "a_log": jnp.log(jax.random.uniform(ks[14], (L, DN_HEADS), f32, 1.0, 16.0)),
        "dt_bias": dt + jnp.log(-jnp.expm1(-dt)),
        "dn_norm_g": gain(ks[16], DN_HEAD_DIM),
        "w_out": nrm(ks[17], (L, MIX_WIDTH, D_MODEL), MIX_WIDTH ** -0.5),
        "router_g_w": nrm(ks[18], (L, D_MODEL, N_GROUPS), D_MODEL ** -0.5),
        "router_g_b": nrm(ks[19], (L, N_GROUPS), 0.01),
        "router_e_w": nrm(ks[20], (L, D_MODEL, N_EXPERTS), D_MODEL ** -0.5),
        "router_e_b": nrm(ks[21], (L, N_EXPERTS), 0.01),
        "w1": nrm(ks[22], (L, N_EXPERTS, D_MODEL, EXPERT_FF), D_MODEL ** -0.5),
        "w3": nrm(ks[23], (L, N_EXPERTS, D_MODEL, EXPERT_FF), D_MODEL ** -0.5),
        "w2": nrm(ks[24], (L, N_EXPERTS, EXPERT_FF, D_MODEL), EXPERT_FF ** -0.5),
    }


def reference(x, c, positions, ada_w, ada_b, norm1_g, norm2_g, w_in, q_norm_g, k_norm_g,
              kv_norm_g, w_kv_up, idx_k_norm_g, rel_bias, conv_w, a_log, dt_bias, dn_norm_g,
              w_out, router_g_w, router_g_b, router_e_w, router_e_b, w1, w3, w2):
    B, T, D = x.shape
    split_pts = np.cumsum(IN_SIZES)[:-1].tolist()
    for l in range(DEPTH):
        mod = jax.nn.silu(c) @ ada_w[l] + ada_b[l]
        shift1, scale1, gate1, shift2, scale2, gate2 = [m[:, None, :] for m in jnp.split(mod, 6, axis=-1)]

        h = rms_norm(x, norm1_g[l]) * (1.0 + scale1) + shift1
        proj = h @ w_in[l]
        q_att, kv_lat, q_idx, k_idx, w_idx, dn_qkv, dn_z, dn_beta, dn_a = jnp.split(proj, split_pts, axis=-1)
        q = rms_norm(q_att.reshape(B, T, ATT_HEADS, ATT_HEAD_DIM), q_norm_g[l])
        kv = rms_norm(kv_lat, kv_norm_g[l]) @ w_kv_up[l]
        k = rms_norm(kv[..., :ATT_HEAD_DIM], k_norm_g[l])
        v = kv[..., ATT_HEAD_DIM:]
        qi = q_idx.reshape(B, T, IDX_HEADS, IDX_DIM)
        ki = rms_norm(k_idx, idx_k_norm_g[l])
        wi = w_idx * IDX_HEADS ** -0.5
        att = dsa_attention(q, k, v, qi, ki, wi, positions, rel_bias)
        dn = gated_deltanet(dn_qkv, dn_z, dn_beta, dn_a, conv_w[l], a_log[l], dt_bias[l], dn_norm_g[l])
        mixed = jnp.concatenate([att.astype(x.dtype), dn.astype(x.dtype)], axis=-1) @ w_out[l]
        x = x + gate1 * mixed

        h2 = rms_norm(x, norm2_g[l]) * (1.0 + scale2) + shift2
        x = x + gate2 * hier_moe(h2, router_g_w[l], router_g_b[l], router_e_w[l], router_e_b[l],
                                 w1[l], w3[l], w2[l])
    return x
```

```cpp
#include <hip/hip_runtime.h>
#include <cstdio>
#include <cstdint>

typedef unsigned short bf16_t;
typedef short bf16x8 __attribute__((ext_vector_type(8)));
typedef float f32x16 __attribute__((ext_vector_type(16)));
typedef float f32x4 __attribute__((ext_vector_type(4)));

constexpr int NB = 8, NT = 2048, ND = 1024, NTOK = NB * NT;
constexpr int NPROJ = 3072;
constexpr int PC_QATT = 0, PC_KVLAT = 512, PC_QIDX = 640, PC_DNQKV = 896, PC_DNZ = 2432, PC_KIDX = 2944, PC_WIDX = 2976, PC_BETA = 2984, PC_A = 2988;
constexpr int W_IN_SRC = 2992;
constexpr int NE = 32, EFF = 512;
constexpr int KSPLIT = 16;
constexpr int NTHREADS = 512, NWAVES = 8;
constexpr float EPS = 1e-6f;

constexpr size_t MiB = 1ull << 20;
constexpr size_t WS_CTL = 0;
constexpr size_t WS_MODP = WS_CTL + 1 * MiB;
constexpr size_t WS_WIN = WS_MODP + 3 * MiB;
constexpr size_t WS_WOUT = WS_WIN + 6 * MiB;
constexpr size_t WS_W13 = WS_WOUT + 2 * MiB;
constexpr size_t WS_W2 = WS_W13 + 64 * MiB;
constexpr size_t WS_PROJ = WS_W2 + 32 * MiB;
constexpr size_t WS_ACT = WS_PROJ;
constexpr size_t WS_YBUF = WS_PROJ + 32 * MiB;
constexpr size_t WS_QN = WS_PROJ + 96 * MiB;
constexpr size_t WS_K = WS_QN + 16 * MiB;
constexpr size_t WS_V = WS_K + 2 * MiB;
constexpr size_t WS_KI = WS_V + 2 * MiB;
constexpr size_t WS_WI = WS_KI + 1 * MiB;
constexpr size_t WS_DBG = WS_WI + 512 * 1024;
constexpr size_t WS_DQ = WS_DBG + 512 * 1024;
constexpr size_t WS_DK = WS_DQ + 16 * MiB;
constexpr size_t WS_DV = WS_DK + 16 * MiB;
constexpr size_t WS_H2 = WS_DK;
constexpr size_t WS_LIST = WS_DV + 16 * MiB;
constexpr size_t WS_TOKINFO = WS_LIST + 2 * MiB;
constexpr size_t WS_END = WS_TOKINFO + 512 * 1024;

struct P {
    const float* x; const float* c; const int* pos; const float* ada_w; const float* ada_b; const float* norm1_g; const float* norm2_g;
    const float* w_in; const float* q_norm_g; const float* k_norm_g; const float* kv_norm_g; const float* w_kv_up; const float* idx_k_norm_g;
    const float* rel_bias; const float* conv_w; const float* a_log; const float* dt_bias; const float* dn_norm_g; const float* w_out;
    const float* rg_w; const float* rg_b; const float* re_w; const float* re_b; const float* w1; const float* w3; const float* w2;
    float* out; unsigned char* ws;
};

__device__ __forceinline__ float bf2f(bf16_t h) { return __uint_as_float(((unsigned)h) << 16); }
__device__ __forceinline__ bf16_t f2bf(float f) { unsigned u = __float_as_uint(f); u += 0x7fffu + ((u >> 16) & 1u); return (bf16_t)(u >> 16); }
__device__ __forceinline__ unsigned pack2(float a, float b) { return (unsigned)f2bf(a) | ((unsigned)f2bf(b) << 16); }
__device__ __forceinline__ float wave_sum(float v) {
#pragma unroll
    for (int o = 32; o >= 1; o >>= 1) v += __shfl_xor(v, o);
    return v;
}
__device__ __forceinline__ float wave_max(float v) {
#pragma unroll
    for (int o = 32; o >= 1; o >>= 1) v = fmaxf(v, __shfl_xor(v, o));
    return v;
}
__device__ __forceinline__ int wave_isum(int v) {
#pragma unroll
    for (int o = 32; o >= 1; o >>= 1) v += __shfl_xor(v, o);
    return v;
}
__device__ __forceinline__ float silu_f(float x) { return x / (1.f + __expf(-x)); }
__device__ __forceinline__ float sigmoid_f(float x) { return 1.f / (1.f + __expf(-x)); }
__device__ __forceinline__ float mod_val(const P& p, int b, int which, int d) {
    const float* mp = (const float*)(p.ws + WS_MODP);
    const int col = which * ND + d;
    float s = p.ada_b[col];
#pragma unroll
    for (int ks = 0; ks < KSPLIT; ++ks) s += mp[(size_t)(ks * NB + b) * (6 * ND) + col];
    return s;
}

__device__ void ph_mod_partial(const P& p) {
    const int lane = threadIdx.x & 63, wave = threadIdx.x >> 6;
    float* mp = (float*)(p.ws + WS_MODP);
    const int nitem = 96 * KSPLIT;
    for (int it = blockIdx.x * NWAVES + wave; it < nitem; it += gridDim.x * NWAVES) {
        const int cg = it % 96, ks = it / 96;
        const int col = cg * 64 + lane;
        float acc[NB];
#pragma unroll
        for (int b = 0; b < NB; ++b) acc[b] = 0.f;
        for (int kk = 0; kk < ND / KSPLIT; ++kk) {
            const int k = ks * (ND / KSPLIT) + kk;
            const float w = p.ada_w[(size_t)k * (6 * ND) + col];
#pragma unroll
            for (int b = 0; b < NB; ++b) acc[b] += silu_f(p.c[b * ND + k]) * w;
        }
#pragma unroll
        for (int b = 0; b < NB; ++b) mp[(size_t)(ks * NB + b) * (6 * ND) + col] = acc[b];
    }
}

__device__ __forceinline__ int win_src_col(int n) {
    if (n < 896) return n;
    if (n < 2944) return n + 40;
    if (n < 2976) return n - 2944 + 896;
    if (n < 2984) return n - 2976 + 928;
    if (n < 2992) return n;
    return -1;
}
__device__ void conv_tile(float* tile  , const float* src0, const float* src1, int nsrc, int mode, int n0, int k0, bf16_t* dst, int K, int qcol) {
    const int tid = threadIdx.x;
    {
        const int n = tid & 63, r = tid >> 6;
        int col; const float* src = src0;
        if (mode == 0) col = n0 + n;
        else if (mode == 1) col = win_src_col(n0 + n);
        else { col = qcol + (n & 31); if (n >= 32) src = src1; }
#pragma unroll
        for (int i = 0; i < 8; ++i) {
            const int k = r + 8 * i;
            tile[k * 65 + n] = (col >= 0) ? src[(size_t)(k0 + k) * nsrc + col] : 0.f;
        }
    }
    __syncthreads();
    {
        const int n = tid >> 3, kc = tid & 7;
        unsigned w[4];
#pragma unroll
        for (int j = 0; j < 4; ++j) w[j] = pack2(tile[(kc * 8 + 2 * j) * 65 + n], tile[(kc * 8 + 2 * j + 1) * 65 + n]);
        *(uint4*)(dst + (size_t)(n0 + n) * K + k0 + kc * 8) = make_uint4(w[0], w[1], w[2], w[3]);
    }
    __syncthreads();
}
__device__ void ph_convert(const P& p, char* smem) {
    float* tile = (float*)smem;
    bf16_t* Wt_in = (bf16_t*)(p.ws + WS_WIN); bf16_t* Wt_out = (bf16_t*)(p.ws + WS_WOUT);
    bf16_t* Wt13 = (bf16_t*)(p.ws + WS_W13); bf16_t* Wt2 = (bf16_t*)(p.ws + WS_W2);
    const int T0 = 48 * 16, T1 = 16 * 16, T2 = NE * 256, T3 = NE * 128;
    const int total = T0 + T1 + T2 + T3;
    for (int t = blockIdx.x; t < total; t += gridDim.x) {
        if (t < T0) { const int nt = t / 16, kt = t % 16; conv_tile(tile, p.w_in, nullptr, W_IN_SRC, 1, nt * 64, kt * 64, Wt_in, ND, 0); }
        else if (t < T0 + T1) { const int u = t - T0; const int nt = u / 16, kt = u % 16; conv_tile(tile, p.w_out, nullptr, ND, 0, nt * 64, kt * 64, Wt_out, ND, 0); }
        else if (t < T0 + T1 + T2) { const int u = t - T0 - T1; const int e = u / 256, v = u % 256; const int nt = v / 16, kt = v % 16;
            conv_tile(tile, p.w1 + (size_t)e * ND * EFF, p.w3 + (size_t)e * ND * EFF, EFF, 2, nt * 64, kt * 64, Wt13 + (size_t)e * 1024 * ND, ND, nt * 32); }
        else { const int u = t - T0 - T1 - T2; const int e = u / 128, v = u % 128; const int nt = v / 8, kt = v % 8;
            conv_tile(tile, p.w2 + (size_t)e * EFF * ND, nullptr, ND, 0, nt * 64, kt * 64, Wt2 + (size_t)e * ND * EFF, EFF, 0); }
    }
}

__device__ void ph_norm1(const P& p, char* smem) {
    float* sA = (float*)smem; float* sB = sA + ND;
    const int lane = threadIdx.x & 63, wave = threadIdx.x >> 6;
    bf16_t* h = (bf16_t*)p.out;
    int curb = -1;
    for (int tile = blockIdx.x; tile < NTOK / 64; tile += gridDim.x) {
        const int b = tile / (NT / 64);
        if (b != curb) {
            __syncthreads();
            for (int d = threadIdx.x; d < ND; d += NTHREADS) { sA[d] = p.norm1_g[d] * (1.f + mod_val(p, b, 1, d)); sB[d] = mod_val(p, b, 0, d); }
            __syncthreads();
            curb = b;
        }
        for (int i = 0; i < 8; ++i) {
            const int tok = tile * 64 + wave * 8 + i;
            const float* xr = p.x + (size_t)tok * ND;
            f32x4 v[4]; float ss = 0.f;
#pragma unroll
            for (int j = 0; j < 4; ++j) { v[j] = *(const f32x4*)(xr + j * 256 + lane * 4); ss += v[j][0] * v[j][0] + v[j][1] * v[j][1] + v[j][2] * v[j][2] + v[j][3] * v[j][3]; }
            ss = wave_sum(ss);
            const float rstd = rsqrtf(ss * (1.f / ND) + EPS);
#pragma unroll
            for (int j = 0; j < 4; ++j) {
                const int d = j * 256 + lane * 4;
                const float o0 = v[j][0] * rstd * sA[d] + sB[d], o1 = v[j][1] * rstd * sA[d + 1] + sB[d + 1], o2 = v[j][2] * rstd * sA[d + 2] + sB[d + 2], o3 = v[j][3] * rstd * sA[d + 3] + sB[d + 3];
                *(uint2*)(h + (size_t)tok * ND + d) = make_uint2(pack2(o0, o1), pack2(o2, o3));
            }
        }
    }
}

constexpr int LDS_LD = 72;
template <int BM, int BN> struct GemmLds { static constexpr int BYTES = 2 * (BM + BN) * LDS_LD * 2; };
template <int BM, int BN, class AF, class BF>
__device__ __forceinline__ void gemm_tile(char* smem, int K, AF aptr, BF bptr, f32x16 (&acc)[2][2]) {
    constexpr int WM = BM / 64;
    constexpr int NA = BM / 64, NBc = BN / 64;
    bf16_t* As = (bf16_t*)smem;
    bf16_t* Bs = As + 2 * BM * LDS_LD;
    const int tid = threadIdx.x, lane = tid & 63, wave = tid >> 6;
    const int wm = wave % WM, wn = wave / WM;
    uint4 ra[NA], rb[NBc];
#pragma unroll
    for (int m = 0; m < 2; ++m)
#pragma unroll
        for (int n = 0; n < 2; ++n)
#pragma unroll
            for (int r = 0; r < 16; ++r) acc[m][n][r] = 0.f;
    const int nk = K / 64;
    auto load_regs = [&](int kt) {
#pragma unroll
        for (int i = 0; i < NA; ++i) { const int c = tid + NTHREADS * i; ra[i] = *(const uint4*)aptr(c >> 3, kt * 64 + (c & 7) * 8); }
#pragma unroll
        for (int i = 0; i < NBc; ++i) { const int c = tid + NTHREADS * i; rb[i] = *(const uint4*)bptr(c >> 3, kt * 64 + (c & 7) * 8); }
    };
    auto store_lds = [&](int buf) {
#pragma unroll
        for (int i = 0; i < NA; ++i) { const int c = tid + NTHREADS * i; *(uint4*)(As + (buf * BM + (c >> 3)) * LDS_LD + (c & 7) * 8) = ra[i]; }
#pragma unroll
        for (int i = 0; i < NBc; ++i) { const int c = tid + NTHREADS * i; *(uint4*)(Bs + (buf * BN + (c >> 3)) * LDS_LD + (c & 7) * 8) = rb[i]; }
    };
    load_regs(0); store_lds(0); __syncthreads();
    for (int kt = 0; kt < nk; ++kt) {
        if (kt + 1 < nk) load_regs(kt + 1);
        const bf16_t* a0 = As + ((kt & 1) * BM + wm * 64 + (lane & 31)) * LDS_LD + 8 * (lane >> 5);
        const bf16_t* b0 = Bs + ((kt & 1) * BN + wn * 64 + (lane & 31)) * LDS_LD + 8 * (lane >> 5);
#pragma unroll
        for (int ks = 0; ks < 4; ++ks) {
            const bf16x8 fa0 = *(const bf16x8*)(a0 + ks * 16), fa1 = *(const bf16x8*)(a0 + 32 * LDS_LD + ks * 16);
            const bf16x8 fb0 = *(const bf16x8*)(b0 + ks * 16), fb1 = *(const bf16x8*)(b0 + 32 * LDS_LD + ks * 16);
            acc[0][0] = __builtin_amdgcn_mfma_f32_32x32x16_bf16(fa0, fb0, acc[0][0], 0, 0, 0);
            acc[0][1] = __builtin_amdgcn_mfma_f32_32x32x16_bf16(fa0, fb1, acc[0][1], 0, 0, 0);
            acc[1][0] = __builtin_amdgcn_mfma_f32_32x32x16_bf16(fa1, fb0, acc[1][0], 0, 0, 0);
            acc[1][1] = __builtin_amdgcn_mfma_f32_32x32x16_bf16(fa1, fb1, acc[1][1], 0, 0, 0);
        }
        if (kt + 1 < nk) store_lds((kt + 1) & 1);
        __syncthreads();
    }
}

__device__ void ph_gemm1(const P& p, char* smem) {
    constexpr int BM = 256, BN = 128;
    const bf16_t* h = (const bf16_t*)p.out; const bf16_t* Wt = (const bf16_t*)(p.ws + WS_WIN);
    bf16_t* proj = (bf16_t*)(p.ws + WS_PROJ);
    const int lane = threadIdx.x & 63, wave = threadIdx.x >> 6, wm = wave % 4, wn = wave / 4;
    const int ntn = NPROJ / BN, ntiles = (NTOK / BM) * ntn;
    for (int t = blockIdx.x; t < ntiles; t += gridDim.x) {
        const int tm = t / ntn, tn = t % ntn;
        const bf16_t* Ab = h + (size_t)tm * BM * ND; const bf16_t* Bb = Wt + (size_t)tn * BN * ND;
        f32x16 acc[2][2];
        gemm_tile<BM, BN>(smem, ND, [&](int r, int k) { return Ab + (size_t)r * ND + k; }, [&](int r, int k) { return Bb + (size_t)r * ND + k; }, acc);
#pragma unroll
        for (int m = 0; m < 2; ++m)
#pragma unroll
            for (int n = 0; n < 2; ++n)
#pragma unroll
                for (int r = 0; r < 16; ++r) {
                    const int row = tm * BM + wm * 64 + m * 32 + (r & 3) + 8 * (r >> 2) + 4 * (lane >> 5);
                    const int col = tn * BN + wn * 64 + n * 32 + (lane & 31);
                    proj[(size_t)row * NPROJ + col] = f2bf(acc[m][n][r]);
                }
    }
}

__device__ void ph_post(const P& p, char* smem) {
    float* sW = (float*)smem;
    for (int i = threadIdx.x; i < 128 * 128; i += NTHREADS) sW[i] = p.w_kv_up[i];
    __syncthreads();
    const int lane = threadIdx.x & 63, wave = threadIdx.x >> 6;
    const bf16_t* proj = (const bf16_t*)(p.ws + WS_PROJ);
    bf16_t* qn = (bf16_t*)(p.ws + WS_QN); bf16_t* Kb = (bf16_t*)(p.ws + WS_K); bf16_t* Vb = (bf16_t*)(p.ws + WS_V); bf16_t* kib = (bf16_t*)(p.ws + WS_KI);
    float* wi = (float*)(p.ws + WS_WI); float* dbeta = (float*)(p.ws + WS_DBG); float* dg = dbeta + NTOK * 4;
    bf16_t* dq = (bf16_t*)(p.ws + WS_DQ); bf16_t* dk = (bf16_t*)(p.ws + WS_DK); bf16_t* dvv = (bf16_t*)(p.ws + WS_DV);
    for (int tok = blockIdx.x * NWAVES + wave; tok < NTOK; tok += gridDim.x * NWAVES) {
        const int t = tok % NT;
        const bf16_t* pr = proj + (size_t)tok * NPROJ;
        {
            const uint4 raw = *(const uint4*)(pr + PC_QATT + lane * 8);
            const unsigned w[4] = {raw.x, raw.y, raw.z, raw.w};
            float v[8]; float ss = 0.f;
#pragma unroll
            for (int j = 0; j < 4; ++j) { v[2 * j] = __uint_as_float(w[j] << 16); v[2 * j + 1] = __uint_as_float(w[j] & 0xffff0000u); }
#pragma unroll
            for (int j = 0; j < 8; ++j) ss += v[j] * v[j];
            ss += __shfl_xor(ss, 1); ss += __shfl_xor(ss, 2); ss += __shfl_xor(ss, 4);
            const float rs = rsqrtf(ss * (1.f / 64.f) + EPS) * 0.125f;
            const int d0 = (lane & 7) * 8;
            unsigned o[4];
#pragma unroll
            for (int j = 0; j < 4; ++j) o[j] = pack2(v[2 * j] * rs * p.q_norm_g[d0 + 2 * j], v[2 * j + 1] * rs * p.q_norm_g[d0 + 2 * j + 1]);
            *(uint4*)(qn + (size_t)tok * 512 + lane * 8) = make_uint4(o[0], o[1], o[2], o[3]);
        }
        {
            const unsigned raw = *(const unsigned*)(pr + PC_KVLAT + lane * 2);
            float a0 = __uint_as_float(raw << 16), a1 = __uint_as_float(raw & 0xffff0000u);
            float ss = wave_sum(a0 * a0 + a1 * a1);
            const float rs = rsqrtf(ss * (1.f / 128.f) + EPS);
            a0 *= rs * p.kv_norm_g[lane * 2]; a1 *= rs * p.kv_norm_g[lane * 2 + 1];
            float k = 0.f, v = 0.f;
#pragma unroll 8
            for (int i = 0; i < 64; ++i) {
                const float x0 = __shfl(a0, i), x1 = __shfl(a1, i);
                k += x0 * sW[(2 * i) * 128 + lane] + x1 * sW[(2 * i + 1) * 128 + lane];
                v += x0 * sW[(2 * i) * 128 + 64 + lane] + x1 * sW[(2 * i + 1) * 128 + 64 + lane];
            }
            const float ks = wave_sum(k * k);
            k *= rsqrtf(ks * (1.f / 64.f) + EPS) * p.k_norm_g[lane];
            Kb[(size_t)tok * 64 + lane] = f2bf(k);
            Vb[(size_t)tok * 64 + lane] = f2bf(v);
        }
        {
            float a = (lane < 32) ? bf2f(pr[PC_KIDX + lane]) : 0.f;
            const float ss = wave_sum(a * a);
            a *= rsqrtf(ss * (1.f / 32.f) + EPS);
            if (lane < 32) kib[(size_t)tok * 32 + lane] = f2bf(a * p.idx_k_norm_g[lane]);
            if (lane < 8) wi[(size_t)tok * 8 + lane] = bf2f(pr[PC_WIDX + lane]) * 0.35355339059327373f * 0.17677669529663687f;
            if (lane < 4) {
                dbeta[(size_t)tok * 4 + lane] = sigmoid_f(bf2f(pr[PC_BETA + lane]));
                const float z = bf2f(pr[PC_A + lane]) + p.dt_bias[lane];
                const float sp = (z > 20.f) ? z : log1pf(__expf(z));
                dg[(size_t)tok * 4 + lane] = -__expf(p.a_log[lane]) * sp;
            }
        }
#pragma unroll 1
        for (int j = 0; j < 12; ++j) {
            const int ch = j * 128 + lane * 2;
            float y0 = 0.f, y1 = 0.f;
#pragma unroll
            for (int tap = 0; tap < 4; ++tap) {
                const int tt = t - 3 + tap;
                if (tt >= 0) {
                    const unsigned raw = *(const unsigned*)(pr + (ptrdiff_t)(tap - 3) * NPROJ + PC_DNQKV + ch);
                    y0 += p.conv_w[tap * 1536 + ch] * __uint_as_float(raw << 16);
                    y1 += p.conv_w[tap * 1536 + ch + 1] * __uint_as_float(raw & 0xffff0000u);
                }
            }
            y0 = silu_f(y0); y1 = silu_f(y1);
            if (j < 8) {
                const float ss = wave_sum(y0 * y0 + y1 * y1);
                float rs = rsqrtf(ss + EPS);
                if (j < 4) rs *= 0.08838834764831845f;
                y0 *= rs; y1 *= rs;
            }
            bf16_t* dst = (j < 4) ? dq : ((j < 8) ? dk : dvv);
            *(unsigned*)(dst + (size_t)tok * 512 + (j & 3) * 128 + lane * 2) = pack2(y0, y1);
        }
    }
}

__device__ __forceinline__ unsigned f2sortable(float f) { const unsigned u = __float_as_uint(f); return (u & 0x80000000u) ? ~u : (u | 0x80000000u); }
constexpr int ATT_WAVE_LDS = 8192 + 1024 + 2048 + 1024;
constexpr int ATT_LDS = NWAVES * ATT_WAVE_LDS + 132 * 4 + 32 * 8 * 4;
__device__ void ph_attn_naive(const P& p, char* smem) {
    const int lane = threadIdx.x & 63, wave = threadIdx.x >> 6;
    int* lut = (int*)(smem + NWAVES * ATT_WAVE_LDS);
    float* sbias = (float*)(lut + 132);
    for (int i = threadIdx.x; i <= 128; i += NTHREADS) {
        int bk;
        if (i < 16) bk = i;
        else { const float v = logf((float)i / 16.f) / 2.0794415416798357f * 16.f; bk = 16 + (int)v; if (bk > 31) bk = 31; }
        lut[i] = bk;
    }
    for (int i = threadIdx.x; i < 256; i += NTHREADS) sbias[i] = p.rel_bias[i];
    __syncthreads();
    char* wl = smem + wave * ATT_WAVE_LDS;
    float* sS = (float*)wl;
    float* sQi = (float*)(wl + 8192);
    float* sQ = (float*)(wl + 8192 + 1024);
    int* sSel = (int*)(wl + 8192 + 1024 + 2048);
    const bf16_t* proj = (const bf16_t*)(p.ws + WS_PROJ);
    bf16_t* qn = (bf16_t*)(p.ws + WS_QN); const bf16_t* Kb = (const bf16_t*)(p.ws + WS_K); const bf16_t* Vb = (const bf16_t*)(p.ws + WS_V); const bf16_t* kib = (const bf16_t*)(p.ws + WS_KI);
    const float* wi = (const float*)(p.ws + WS_WI);
    for (int q = blockIdx.x * NWAVES + wave; q < NTOK; q += gridDim.x * NWAVES) {
        const int b = q / NT, t = q % NT;
        for (int i = lane; i < 256; i += 64) sQi[i] = bf2f(proj[(size_t)q * NPROJ + PC_QIDX + i]);
        for (int i = lane; i < 512; i += 64) sQ[i] = bf2f(qn[(size_t)q * 512 + i]);
        float wv[8];
#pragma unroll
        for (int h = 0; h < 8; ++h) wv[h] = wi[(size_t)q * 8 + h];
        __threadfence_block();
        const int nch = t / 64 + 1;
        for (int i = 0; i < nch; ++i) {
            const int s = i * 64 + lane;
            const bf16_t* kr = kib + (size_t)(b * NT + s) * 32;
            float kf[32];
#pragma unroll
            for (int j = 0; j < 4; ++j) {
                const uint4 raw = *(const uint4*)(kr + j * 8);
                const unsigned w[4] = {raw.x, raw.y, raw.z, raw.w};
#pragma unroll
                for (int u = 0; u < 4; ++u) { kf[j * 8 + 2 * u] = __uint_as_float(w[u] << 16); kf[j * 8 + 2 * u + 1] = __uint_as_float(w[u] & 0xffff0000u); }
            }
            float sc = 0.f;
#pragma unroll
            for (int h = 0; h < 8; ++h) {
                float d = 0.f;
#pragma unroll
                for (int j = 0; j < 32; j += 4) { const f32x4 qv = *(const f32x4*)(sQi + h * 32 + j); d += qv[0] * kf[j] + qv[1] * kf[j + 1] + qv[2] * kf[j + 2] + qv[3] * kf[j + 3]; }
                sc += wv[h] * fmaxf(d, 0.f);
            }
            sS[s] = (s <= t) ? sc : -INFINITY;
        }
        __threadfence_block();
        const int nsel = (t + 1 < 256) ? (t + 1) : 256;
        unsigned u[32];
#pragma unroll
        for (int i = 0; i < 32; ++i) u[i] = (i < nch) ? f2sortable(sS[i * 64 + lane]) : 0u;
        unsigned prefix = 0u; int need = 0;
        if (t + 1 > 256) {
            for (int bit = 31; bit >= 0; --bit) {
                const unsigned cand = prefix | (1u << bit);
                int cnt = 0;
#pragma unroll
                for (int i = 0; i < 32; ++i) cnt += (u[i] >= cand) ? 1 : 0;
                cnt = wave_isum(cnt);
                if (cnt >= 256) prefix = cand;
            }
            int ngt = 0;
#pragma unroll
            for (int i = 0; i < 32; ++i) ngt += (u[i] > prefix) ? 1 : 0;
            ngt = wave_isum(ngt);
            need = 256 - ngt;
        } else { prefix = f2sortable(-INFINITY); need = 0; }
        {
            int base = 0, tierun = 0;
#pragma unroll
            for (int i = 0; i < 32; ++i) {
                const bool gt = u[i] > prefix, tie = (u[i] == prefix) && (t + 1 > 256);
                const unsigned long long tb = __ballot(tie);
                const int trank = tierun + __builtin_popcountll(tb & ((1ull << lane) - 1ull));
                const bool sel = gt || (tie && trank < need);
                const unsigned long long sb = __ballot(sel);
                if (sel) sSel[base + __builtin_popcountll(sb & ((1ull << lane) - 1ull))] = i * 64 + lane;
                base += __builtin_popcountll(sb); tierun += __builtin_popcountll(tb);
            }
        }
        __threadfence_block();
        const int pt = p.pos[q];
#pragma unroll 1
        for (int c = 0; c < 4; ++c) {
            const int j = c * 64 + lane;
            float acc[8];
            if (j < nsel) {
                const int s = sSel[j];
                const bf16_t* kr = Kb + (size_t)(b * NT + s) * 64;
#pragma unroll
                for (int h = 0; h < 8; ++h) acc[h] = 0.f;
#pragma unroll 2
                for (int jj = 0; jj < 8; ++jj) {
                    const uint4 raw = *(const uint4*)(kr + jj * 8);
                    const unsigned w[4] = {raw.x, raw.y, raw.z, raw.w};
                    float kf[8];
#pragma unroll
                    for (int uu = 0; uu < 4; ++uu) { kf[2 * uu] = __uint_as_float(w[uu] << 16); kf[2 * uu + 1] = __uint_as_float(w[uu] & 0xffff0000u); }
#pragma unroll
                    for (int h = 0; h < 8; ++h) {
                        const f32x4 q0 = *(const f32x4*)(sQ + h * 64 + jj * 8), q1 = *(const f32x4*)(sQ + h * 64 + jj * 8 + 4);
                        acc[h] += q0[0] * kf[0] + q0[1] * kf[1] + q0[2] * kf[2] + q0[3] * kf[3] + q1[0] * kf[4] + q1[1] * kf[5] + q1[2] * kf[6] + q1[3] * kf[7];
                    }
                }
                int n = pt - p.pos[b * NT + s]; n = n < 0 ? 0 : (n > 128 ? 128 : n);
                const int bk = lut[n];
#pragma unroll
                for (int h = 0; h < 8; ++h) acc[h] += sbias[bk * 8 + h];
            } else {
#pragma unroll
                for (int h = 0; h < 8; ++h) acc[h] = -INFINITY;
            }
            *(f32x4*)(sS + j * 8) = (f32x4){acc[0], acc[1], acc[2], acc[3]};
            *(f32x4*)(sS + j * 8 + 4) = (f32x4){acc[4], acc[5], acc[6], acc[7]};
        }
        {
            float lg[4][8];
#pragma unroll
            for (int c = 0; c < 4; ++c) {
                const f32x4 a = *(const f32x4*)(sS + (c * 64 + lane) * 8), bq = *(const f32x4*)(sS + (c * 64 + lane) * 8 + 4);
                lg[c][0] = a[0]; lg[c][1] = a[1]; lg[c][2] = a[2]; lg[c][3] = a[3]; lg[c][4] = bq[0]; lg[c][5] = bq[1]; lg[c][6] = bq[2]; lg[c][7] = bq[3];
            }
#pragma unroll
            for (int h = 0; h < 8; ++h) {
                float m = fmaxf(fmaxf(lg[0][h], lg[1][h]), fmaxf(lg[2][h], lg[3][h]));
                m = wave_max(m);
                float s = 0.f;
#pragma unroll
                for (int c = 0; c < 4; ++c) { lg[c][h] = __expf(lg[c][h] - m); s += lg[c][h]; }
                s = wave_sum(s);
                const float inv = 1.f / s;
#pragma unroll
                for (int c = 0; c < 4; ++c) lg[c][h] *= inv;
            }
#pragma unroll
            for (int c = 0; c < 4; ++c) {
                *(f32x4*)(sS + (c * 64 + lane) * 8) = (f32x4){lg[c][0], lg[c][1], lg[c][2], lg[c][3]};
                *(f32x4*)(sS + (c * 64 + lane) * 8 + 4) = (f32x4){lg[c][4], lg[c][5], lg[c][6], lg[c][7]};
            }
        }
        __threadfence_block();
        float o[8];
#pragma unroll
        for (int h = 0; h < 8; ++h) o[h] = 0.f;
        for (int j = 0; j < nsel; ++j) {
            const int s = sSel[j];
            const float v = bf2f(Vb[(size_t)(b * NT + s) * 64 + lane]);
            const f32x4 p0 = *(const f32x4*)(sS + j * 8), p1 = *(const f32x4*)(sS + j * 8 + 4);
            o[0] += p0[0] * v; o[1] += p0[1] * v; o[2] += p0[2] * v; o[3] += p0[3] * v;
            o[4] += p1[0] * v; o[5] += p1[1] * v; o[6] += p1[2] * v; o[7] += p1[3] * v;
        }
#pragma unroll
        for (int h = 0; h < 8; ++h) qn[(size_t)q * 512 + h * 64 + lane] = f2bf(o[h]);
        __threadfence_block();
    }
}

constexpr int DN_LDS = (64 * 129 * 2 + 64 * 65 * 2 + 128 * 33 + 64 * 33 * 2 + 64 * 4) * 4;
__device__ void ph_dn_naive(const P& p, char* smem) {
    float* kc = (float*)smem;
    float* qc = kc + 64 * 129;
    float* Am = qc + 64 * 129;
    float* Pm = Am + 64 * 65;
    float* S = Pm + 64 * 65;
    float* U = S + 128 * 33;
    float* Dl = U + 64 * 33;
    float* sG = Dl + 64 * 33;
    float* sB = sG + 64;
    float* sE = sB + 64;
    float* sL = sE + 64;
    const int tid = threadIdx.x;
    const bf16_t* dq = (const bf16_t*)(p.ws + WS_DQ); const bf16_t* dk = (const bf16_t*)(p.ws + WS_DK); const bf16_t* dvv = (const bf16_t*)(p.ws + WS_DV);
    const float* dbeta = (const float*)(p.ws + WS_DBG); const float* dg = dbeta + NTOK * 4;
    float* dno = p.out;
    for (int item = blockIdx.x; item < NB * 4 * 4; item += gridDim.x) {
        const int b = item / 16, hh = (item / 4) % 4, sl = item % 4;
        for (int i = tid; i < 128 * 33; i += NTHREADS) S[i] = 0.f;
        __syncthreads();
        for (int c = 0; c < NT / 64; ++c) {
            const int tok0 = b * NT + c * 64;
            for (int i = tid; i < 64 * 128; i += NTHREADS) { const int r = i >> 7, d = i & 127; kc[r * 129 + d] = bf2f(dk[(size_t)(tok0 + r) * 512 + hh * 128 + d]); qc[r * 129 + d] = bf2f(dq[(size_t)(tok0 + r) * 512 + hh * 128 + d]); }
            if (tid < 64) {
                const float g = dg[(size_t)(tok0 + tid) * 4 + hh];
                float G = g;
#pragma unroll
                for (int o = 1; o < 64; o <<= 1) { const float n = __shfl_up(G, o); if (tid >= o) G += n; }
                const float Gl = __shfl(G, 63);
                sG[tid] = G; sB[tid] = dbeta[(size_t)(tok0 + tid) * 4 + hh]; sE[tid] = __expf(G); sL[tid] = __expf(Gl - G);
            }
            __syncthreads();
            for (int i = tid; i < 64 * 32; i += NTHREADS) { const int r = i >> 5, e = i & 31; U[r * 33 + e] = sB[r] * bf2f(dvv[(size_t)(tok0 + r) * 512 + hh * 128 + sl * 32 + e]); }
            {
                const int ib = tid >> 4, jb = tid & 15;
                float ak[2][4], ap[2][4];
#pragma unroll
                for (int a = 0; a < 2; ++a)
#pragma unroll
                    for (int bb = 0; bb < 4; ++bb) { ak[a][bb] = 0.f; ap[a][bb] = 0.f; }
                for (int d = 0; d < 128; ++d) {
                    const float k0 = kc[(2 * ib) * 129 + d], k1 = kc[(2 * ib + 1) * 129 + d], q0 = qc[(2 * ib) * 129 + d], q1 = qc[(2 * ib + 1) * 129 + d];
#pragma unroll
                    for (int bb = 0; bb < 4; ++bb) { const float kj = kc[(4 * jb + bb) * 129 + d]; ak[0][bb] += k0 * kj; ak[1][bb] += k1 * kj; ap[0][bb] += q0 * kj; ap[1][bb] += q1 * kj; }
                }
#pragma unroll
                for (int a = 0; a < 2; ++a)
#pragma unroll
                    for (int bb = 0; bb < 4; ++bb) {
                        const int i = 2 * ib + a, j = 4 * jb + bb;
                        const float dec = (j <= i) ? __expf(sG[i] - sG[j]) : 0.f;
                        Am[i * 65 + j] = (j < i) ? sB[i] * ak[a][bb] * dec : 0.f;
                        Pm[i * 65 + j] = ap[a][bb] * dec;
                    }
            }
            __syncthreads();
            for (int i = tid; i < 64 * 128; i += NTHREADS) { const int r = i >> 7, d = i & 127; kc[r * 129 + d] *= sB[r] * sE[r]; }
            __syncthreads();
            if (tid < 160) {
                float* col = (tid < 128) ? (kc + tid) : (U + (tid - 128));
                const int ld = (tid < 128) ? 129 : 33;
                for (int i = 1; i < 64; ++i) {
                    float s = col[i * ld];
                    for (int j = 0; j < i; ++j) s -= Am[i * 65 + j] * col[j * ld];
                    col[i * ld] = s;
                }
            }
            __syncthreads();
            const int oi = tid >> 3, oe = (tid & 7) * 4;
            float o1[4];
            {
                float dl[4] = {0.f, 0.f, 0.f, 0.f}; o1[0] = o1[1] = o1[2] = o1[3] = 0.f;
                for (int d = 0; d < 128; ++d) {
                    const float w = kc[oi * 129 + d], qv = qc[oi * 129 + d];
#pragma unroll
                    for (int e = 0; e < 4; ++e) { const float sv = S[d * 33 + oe + e]; dl[e] += w * sv; o1[e] += qv * sv; }
                }
#pragma unroll
                for (int e = 0; e < 4; ++e) { Dl[oi * 33 + oe + e] = U[oi * 33 + oe + e] - dl[e]; o1[e] *= sE[oi]; }
            }
            __syncthreads();
            {
                for (int j = 0; j <= oi; ++j) {
                    const float pv = Pm[oi * 65 + j];
#pragma unroll
                    for (int e = 0; e < 4; ++e) o1[e] += pv * Dl[j * 33 + oe + e];
                }
                *(f32x4*)(dno + (size_t)(tok0 + oi) * 512 + hh * 128 + sl * 32 + oe) = (f32x4){o1[0], o1[1], o1[2], o1[3]};
            }
            for (int i = tid; i < 64 * 128; i += NTHREADS) { const int r = i >> 7, d = i & 127; kc[r * 129 + d] = bf2f(dk[(size_t)(tok0 + r) * 512 + hh * 128 + d]) * sL[r]; }
            __syncthreads();
            {
                const int d = tid >> 2, e0 = (tid & 3) * 8;
                float a[8];
#pragma unroll
                for (int e = 0; e < 8; ++e) a[e] = 0.f;
                for (int cc = 0; cc < 64; ++cc) {
                    const float kv = kc[cc * 129 + d];
#pragma unroll
                    for (int e = 0; e < 8; ++e) a[e] += kv * Dl[cc * 33 + e0 + e];
                }
                const float gl = sE[63];
#pragma unroll
                for (int e = 0; e < 8; ++e) S[d * 33 + e0 + e] = gl * S[d * 33 + e0 + e] + a[e];
            }
            __syncthreads();
        }
    }
}

__device__ void ph_dn_gate(const P& p) {
    const int lane = threadIdx.x & 63, wave = threadIdx.x >> 6;
    const float* dno = p.out; const bf16_t* proj = (const bf16_t*)(p.ws + WS_PROJ); bf16_t* dnn = (bf16_t*)(p.ws + WS_DQ);
    for (int tok = blockIdx.x * NWAVES + wave; tok < NTOK; tok += gridDim.x * NWAVES) {
#pragma unroll
        for (int hh = 0; hh < 4; ++hh) {
            const float o0 = dno[(size_t)tok * 512 + hh * 128 + lane * 2], o1 = dno[(size_t)tok * 512 + hh * 128 + lane * 2 + 1];
            const float ss = wave_sum(o0 * o0 + o1 * o1);
            const float rs = rsqrtf(ss * (1.f / 128.f) + EPS);
            const unsigned zr = *(const unsigned*)(proj + (size_t)tok * NPROJ + PC_DNZ + hh * 128 + lane * 2);
            const float z0 = __uint_as_float(zr << 16), z1 = __uint_as_float(zr & 0xffff0000u);
            *(unsigned*)(dnn + (size_t)tok * 512 + hh * 128 + lane * 2) = pack2(o0 * rs * p.dn_norm_g[lane * 2] * silu_f(z0), o1 * rs * p.dn_norm_g[lane * 2 + 1] * silu_f(z1));
        }
    }
}

__device__ void ph_gemm_out(const P& p, char* smem) {
    constexpr int BM = 256, BN = 128;
    const bf16_t* att = (const bf16_t*)(p.ws + WS_QN); const bf16_t* dnn = (const bf16_t*)(p.ws + WS_DQ); const bf16_t* Wt = (const bf16_t*)(p.ws + WS_WOUT);
    float* sgate = (float*)(smem + GemmLds<BM, BN>::BYTES);
    const int lane = threadIdx.x & 63, wave = threadIdx.x >> 6, wm = wave % 4, wn = wave / 4;
    const int ntn = ND / BN, ntiles = (NTOK / BM) * ntn;
    for (int t = blockIdx.x; t < ntiles; t += gridDim.x) {
        const int tm = t / ntn, tn = t % ntn;
        const int b = (tm * BM) / NT;
        if (threadIdx.x < BN) sgate[threadIdx.x] = mod_val(p, b, 2, tn * BN + threadIdx.x);
        const bf16_t* A1 = att + (size_t)tm * BM * 512; const bf16_t* A2 = dnn + (size_t)tm * BM * 512; const bf16_t* Bb = Wt + (size_t)tn * BN * ND;
        f32x16 acc[2][2];
        gemm_tile<BM, BN>(smem, ND, [&](int r, int k) { return (k < 512) ? (A1 + (size_t)r * 512 + k) : (A2 + (size_t)r * 512 + (k - 512)); },
                          [&](int r, int k) { return Bb + (size_t)r * ND + k; }, acc);
#pragma unroll
        for (int m = 0; m < 2; ++m)
#pragma unroll
            for (int n = 0; n < 2; ++n)
#pragma unroll
                for (int r = 0; r < 16; ++r) {
                    const int row = tm * BM + wm * 64 + m * 32 + (r & 3) + 8 * (r >> 2) + 4 * (lane >> 5);
                    const int cl = wn * 64 + n * 32 + (lane & 31);
                    const size_t idx = (size_t)row * ND + tn * BN + cl;
                    p.out[idx] = p.x[idx] + sgate[cl] * acc[m][n][r];
                }
        __syncthreads();
    }
}

constexpr int ROUTE_LDS = 36 * 1024 * 4 + 2 * 1024 * 4;
__device__ void ph_route(const P& p, char* smem) {
    float* sW = (float*)smem;
    float* sA = sW + 36 * 1024; float* sB = sA + 1024;
    const int lane = threadIdx.x & 63, wave = threadIdx.x >> 6;
    for (int i = threadIdx.x; i < 4 * 1024; i += NTHREADS) { const int d = i >> 2, j = i & 3; sW[j * 1024 + d] = p.rg_w[i]; }
    for (int i = threadIdx.x; i < 32 * 1024; i += NTHREADS) { const int d = i >> 5, j = i & 31; sW[(4 + j) * 1024 + d] = p.re_w[i]; }
    bf16_t* h2 = (bf16_t*)(p.ws + WS_H2);
    int* cnt = (int*)(p.ws + WS_CTL); int* list = (int*)(p.ws + WS_LIST); int* tokinfo = (int*)(p.ws + WS_TOKINFO);
    int curb = -1;
    for (int tile = blockIdx.x; tile < NTOK / 64; tile += gridDim.x) {
        const int b = tile / (NT / 64);
        if (b != curb) {
            __syncthreads();
            for (int d = threadIdx.x; d < ND; d += NTHREADS) { sA[d] = p.norm2_g[d] * (1.f + mod_val(p, b, 4, d)); sB[d] = mod_val(p, b, 3, d); }
            __syncthreads();
            curb = b;
        }
        for (int i = 0; i < 8; ++i) {
            const int tok = tile * 64 + wave * 8 + i;
            const float* xr = p.out + (size_t)tok * ND;
            float v[16]; float ss = 0.f;
#pragma unroll
            for (int j = 0; j < 16; ++j) { v[j] = xr[j * 64 + lane]; ss += v[j] * v[j]; }
            ss = wave_sum(ss);
            const float rstd = rsqrtf(ss * (1.f / ND) + EPS);
#pragma unroll
            for (int j = 0; j < 16; ++j) { const int d = j * 64 + lane; v[j] = v[j] * rstd * sA[d] + sB[d]; h2[(size_t)tok * ND + d] = f2bf(v[j]); }
            float mylogit = 0.f;
#pragma unroll 4
            for (int o = 0; o < 36; ++o) {
                float a = 0.f;
#pragma unroll
                for (int j = 0; j < 16; ++j) a += v[j] * sW[o * 1024 + j * 64 + lane];
                a = wave_sum(a);
                if (lane == o) mylogit = a;
            }
            if (lane < 4) mylogit += p.rg_b[lane]; else if (lane < 36) mylogit += p.re_b[lane - 4];
            float gl[4];
#pragma unroll
            for (int j = 0; j < 4; ++j) gl[j] = __shfl(mylogit, j);
            int gsel = 0; float gm = gl[0];
#pragma unroll
            for (int j = 1; j < 4; ++j) if (gl[j] > gm) { gm = gl[j]; gsel = j; }
            float gs = 0.f;
#pragma unroll
            for (int j = 0; j < 4; ++j) gs += __expf(gl[j] - gm);
            const float gtop = 1.f / gs;
            float el[8];
#pragma unroll
            for (int j = 0; j < 8; ++j) el[j] = __shfl(mylogit, 4 + gsel * 8 + j);
            int e1 = 0; float m1 = el[0];
#pragma unroll
            for (int j = 1; j < 8; ++j) if (el[j] > m1) { m1 = el[j]; e1 = j; }
            int e2 = -1; float m2 = -INFINITY;
#pragma unroll
            for (int j = 0; j < 8; ++j) if (j != e1 && el[j] > m2) { m2 = el[j]; e2 = j; }
            const float r2 = __expf(m2 - m1);
            const float w1v = gtop / (1.f + r2), w2v = gtop * r2 / (1.f + r2);
            if (lane == 0) {
                const int ea = gsel * 8 + e1, eb = gsel * 8 + e2;
                const int pa = atomicAdd(&cnt[ea], 1), pb = atomicAdd(&cnt[eb], 1);
                list[ea * NTOK + pa] = tok; list[eb * NTOK + pb] = tok;
                int* ti = tokinfo + (size_t)tok * 8;
                ti[0] = ea; ti[1] = pa; ti[2] = eb; ti[3] = pb; ti[4] = __float_as_int(w1v); ti[5] = __float_as_int(w2v);
            }
        }
    }
}

struct MoeIdx { int rowoff[NE + 1]; int tileoff[NE + 1]; };
__device__ void moe_index(const P& p, MoeIdx* mi) {
    if (threadIdx.x == 0) {
        const int* cnt = (const int*)(p.ws + WS_CTL);
        int r = 0, t = 0;
        for (int e = 0; e < NE; ++e) { mi->rowoff[e] = r; mi->tileoff[e] = t; const int c = cnt[e]; r += c; t += (c + 127) >> 7; }
        mi->rowoff[NE] = r; mi->tileoff[NE] = t;
    }
    __syncthreads();
}

constexpr int MOE_BM = 128, MOE_BN = 256;
__device__ void ph_moe_up(const P& p, char* smem) {
    MoeIdx* mi = (MoeIdx*)(smem + GemmLds<MOE_BM, MOE_BN>::BYTES);
    int* srow = (int*)(mi + 1);
    moe_index(p, mi);
    const bf16_t* h2 = (const bf16_t*)(p.ws + WS_H2); const bf16_t* Wt13 = (const bf16_t*)(p.ws + WS_W13); bf16_t* act = (bf16_t*)(p.ws + WS_ACT);
    const int* list = (const int*)(p.ws + WS_LIST);
    const int lane = threadIdx.x & 63, wave = threadIdx.x >> 6, wm = wave % 2, wn = wave / 2;
    const int ntiles = mi->tileoff[NE] * 4;
    for (int t = blockIdx.x; t < ntiles; t += gridDim.x) {
        const int mt = t >> 2, ni = t & 3;
        int e = 0;
        while (mi->tileoff[e + 1] <= mt) ++e;
        const int ml = mt - mi->tileoff[e];
        const int cnt_e = mi->rowoff[e + 1] - mi->rowoff[e];
        const int nrows = min(128, cnt_e - ml * 128);
        if (threadIdx.x < 128) srow[threadIdx.x] = list[e * NTOK + ml * 128 + min((int)threadIdx.x, nrows - 1)];
        __syncthreads();
        const bf16_t* Bb = Wt13 + ((size_t)e * 1024 + ni * 256) * ND;
        f32x16 acc[2][2];
        gemm_tile<MOE_BM, MOE_BN>(smem, ND, [&](int r, int k) { return h2 + (size_t)srow[r] * ND + k; }, [&](int r, int k) { return Bb + (size_t)r * ND + k; }, acc);
        const int row0 = mi->rowoff[e] + ml * 128;
#pragma unroll
        for (int m = 0; m < 2; ++m)
#pragma unroll
            for (int r = 0; r < 16; ++r) {
                const int rl = wm * 64 + m * 32 + (r & 3) + 8 * (r >> 2) + 4 * (lane >> 5);
                if (rl < nrows) {
                    const float g = acc[m][0][r], u = acc[m][1][r];
                    act[(size_t)(row0 + rl) * EFF + ni * 128 + wn * 32 + (lane & 31)] = f2bf(silu_f(g) * u);
                }
            }
        __syncthreads();
    }
}

__device__ void ph_moe_down(const P& p, char* smem) {
    MoeIdx* mi = (MoeIdx*)(smem + GemmLds<MOE_BM, MOE_BN>::BYTES);
    moe_index(p, mi);
    const bf16_t* act = (const bf16_t*)(p.ws + WS_ACT); const bf16_t* Wt2 = (const bf16_t*)(p.ws + WS_W2); bf16_t* yb = (bf16_t*)(p.ws + WS_YBUF);
    const int lane = threadIdx.x & 63, wave = threadIdx.x >> 6, wm = wave % 2, wn = wave / 2;
    const int ntiles = mi->tileoff[NE] * 4;
    for (int t = blockIdx.x; t < ntiles; t += gridDim.x) {
        const int mt = t >> 2, ni = t & 3;
        int e = 0;
        while (mi->tileoff[e + 1] <= mt) ++e;
        const int ml = mt - mi->tileoff[e];
        const int cnt_e = mi->rowoff[e + 1] - mi->rowoff[e];
        const int nrows = min(128, cnt_e - ml * 128);
        const int row0 = mi->rowoff[e] + ml * 128;
        const bf16_t* Ab = act + (size_t)row0 * EFF;
        const bf16_t* Bb = Wt2 + ((size_t)e * ND + ni * 256) * EFF;
        f32x16 acc[2][2];
        gemm_tile<MOE_BM, MOE_BN>(smem, EFF, [&](int r, int k) { return Ab + (size_t)min(r, nrows - 1) * EFF + k; }, [&](int r, int k) { return Bb + (size_t)r * EFF + k; }, acc);
#pragma unroll
        for (int m = 0; m < 2; ++m)
#pragma unroll
            for (int n = 0; n < 2; ++n)
#pragma unroll
                for (int r = 0; r < 16; ++r) {
                    const int rl = wm * 64 + m * 32 + (r & 3) + 8 * (r >> 2) + 4 * (lane >> 5);
                    if (rl < nrows) yb[(size_t)(row0 + rl) * ND + ni * 256 + wn * 64 + n * 32 + (lane & 31)] = f2bf(acc[m][n][r]);
                }
    }
}

__device__ void ph_combine(const P& p, char* smem) {
    MoeIdx* mi = (MoeIdx*)smem;
    float* sG = (float*)(mi + 1);
    moe_index(p, mi);
    const int lane = threadIdx.x & 63, wave = threadIdx.x >> 6;
    const bf16_t* yb = (const bf16_t*)(p.ws + WS_YBUF); const int* tokinfo = (const int*)(p.ws + WS_TOKINFO);
    int curb = -1;
    for (int tile = blockIdx.x; tile < NTOK / 64; tile += gridDim.x) {
        const int b = tile / (NT / 64);
        if (b != curb) {
            __syncthreads();
            for (int d = threadIdx.x; d < ND; d += NTHREADS) sG[d] = mod_val(p, b, 5, d);
            __syncthreads();
            curb = b;
        }
        for (int i = 0; i < 8; ++i) {
            const int tok = tile * 64 + wave * 8 + i;
            const int* ti = tokinfo + (size_t)tok * 8;
            const int ra = mi->rowoff[ti[0]] + ti[1], rb = mi->rowoff[ti[2]] + ti[3];
            const float wa = __int_as_float(ti[4]), wb = __int_as_float(ti[5]);
#pragma unroll
            for (int j = 0; j < 4; ++j) {
                const int d = j * 256 + lane * 4;
                const uint2 ya = *(const uint2*)(yb + (size_t)ra * ND + d), ybv = *(const uint2*)(yb + (size_t)rb * ND + d);
                f32x4 xv = *(const f32x4*)(p.out + (size_t)tok * ND + d);
                xv[0] += sG[d] * (wa * __uint_as_float(ya.x << 16) + wb * __uint_as_float(ybv.x << 16));
                xv[1] += sG[d + 1] * (wa * __uint_as_float(ya.x & 0xffff0000u) + wb * __uint_as_float(ybv.x & 0xffff0000u));
                xv[2] += sG[d + 2] * (wa * __uint_as_float(ya.y << 16) + wb * __uint_as_float(ybv.y << 16));
                xv[3] += sG[d + 3] * (wa * __uint_as_float(ya.y & 0xffff0000u) + wb * __uint_as_float(ybv.y & 0xffff0000u));
                *(f32x4*)(p.out + (size_t)tok * ND + d) = xv;
            }
        }
    }
}

extern __shared__ __attribute__((aligned(16))) char dyn_smem[];
__global__ void __launch_bounds__(NTHREADS) k_p0(P p) { ph_mod_partial(p); ph_convert(p, dyn_smem); }
__global__ void __launch_bounds__(NTHREADS) k_norm1(P p) { ph_norm1(p, dyn_smem); }
__global__ void __launch_bounds__(NTHREADS) k_gemm1(P p) { ph_gemm1(p, dyn_smem); }
__global__ void __launch_bounds__(NTHREADS) k_post(P p) { ph_post(p, dyn_smem); }
__global__ void __launch_bounds__(NTHREADS) k_attn(P p) { ph_attn_naive(p, dyn_smem); }
__global__ void __launch_bounds__(NTHREADS) k_dn(P p) { ph_dn_naive(p, dyn_smem); }
__global__ void __launch_bounds__(NTHREADS) k_dngate(P p) { ph_dn_gate(p); }
__global__ void __launch_bounds__(NTHREADS) k_gemmout(P p) { ph_gemm_out(p, dyn_smem); }
__global__ void __launch_bounds__(NTHREADS) k_route(P p) { ph_route(p, dyn_smem); }
__global__ void __launch_bounds__(NTHREADS) k_moeup(P p) { ph_moe_up(p, dyn_smem); }
__global__ void __launch_bounds__(NTHREADS) k_moedown(P p) { ph_moe_down(p, dyn_smem); }
__global__ void __launch_bounds__(NTHREADS) k_combine(P p) { ph_combine(p, dyn_smem); }

template <class K> static void set_lds(K k, int bytes) { (void)hipFuncSetAttribute((const void*)k, hipFuncAttributeMaxDynamicSharedMemorySize, bytes); }

extern "C" void kernel_launch(void* const* d_in, const int* in_sizes, int n_in, void* d_out, int out_size, void* d_ws, size_t ws_size, hipStream_t stream) {
    if (n_in != 26 || out_size != NTOK * ND || ws_size < WS_END) { fprintf(stderr, "kernel_launch: unexpected shapes (n_in %d out %d ws %zu need %zu)\n", n_in, out_size, ws_size, (size_t)WS_END); return; }
    P p{};
    const float** fp = (const float**)&p;
    for (int i = 0; i < 26; ++i) fp[i] = (const float*)d_in[i];
    p.pos = (const int*)d_in[2];
    p.out = (float*)d_out; p.ws = (unsigned char*)d_ws;
    constexpr int L_CONV = 64 * 65 * 4, L_NORM = 2 * 1024 * 4, L_G1 = GemmLds<256, 128>::BYTES + 512, L_POST = 128 * 128 * 4;
    constexpr int L_MOE = GemmLds<MOE_BM, MOE_BN>::BYTES + sizeof(MoeIdx) + 128 * 4, L_COMB = sizeof(MoeIdx) + 1024 * 4;
    static bool once = false;
    if (!once) {
        once = true;
        set_lds(k_gemm1, L_G1); set_lds(k_gemmout, L_G1); set_lds(k_attn, ATT_LDS); set_lds(k_dn, DN_LDS); set_lds(k_route, ROUTE_LDS);
        set_lds(k_moeup, L_MOE); set_lds(k_moedown, L_MOE); set_lds(k_post, L_POST);
    }
    (void)hipMemsetAsync((char*)d_ws + WS_CTL, 0, 4096, stream);
    const dim3 blk(NTHREADS);
    k_p0<<<1024, blk, L_CONV, stream>>>(p);
    k_norm1<<<256, blk, L_NORM, stream>>>(p);
    k_gemm1<<<512, blk, L_G1, stream>>>(p);
    k_post<<<512, blk, L_POST, stream>>>(p);
    k_attn<<<512, blk, ATT_LDS, stream>>>(p);
    k_dn<<<128, blk, DN_LDS, stream>>>(p);
    k_dngate<<<512, blk, 0, stream>>>(p);
    k_gemmout<<<512, blk, L_G1, stream>>>(p);
    k_route<<<256, blk, ROUTE_LDS, stream>>>(p);
    k_moeup<<<512, blk, L_MOE, stream>>>(p);
    k_moedown<<<512, blk, L_MOE, stream>>>(p);
    k_combine<<<256, blk, L_COMB, stream>>>(p);
}
```

```cpp
#include <hip/hip_runtime.h>
#include <hip/hip_cooperative_groups.h>
#include <cstdio>
#include <cstdint>

typedef unsigned short bf16_t;
typedef short bf16x8 __attribute__((ext_vector_type(8)));
typedef float f32x16 __attribute__((ext_vector_type(16)));
typedef float f32x4 __attribute__((ext_vector_type(4)));

constexpr int NB = 8, NT = 2048, ND = 1024, NTOK = NB * NT;
constexpr int NPROJ = 3072;
constexpr int PC_QATT = 0, PC_KVLAT = 512, PC_QIDX = 640, PC_DNQKV = 896, PC_DNZ = 2432, PC_KIDX = 2944, PC_WIDX = 2976, PC_BETA = 2984, PC_A = 2988;
constexpr int W_IN_SRC = 2992;
constexpr int NE = 32, EFF = 512;
constexpr int KSPLIT = 16;
constexpr int NTHREADS = 512, NWAVES = 8;
constexpr float EPS = 1e-6f;

constexpr size_t MiB = 1ull << 20;
constexpr size_t WS_CTL = 0;
constexpr size_t WS_MODP = WS_CTL + 1 * MiB;
constexpr size_t WS_WIN = WS_MODP + 3 * MiB;
constexpr size_t WS_WOUT = WS_WIN + 6 * MiB;
constexpr size_t WS_W13 = WS_WOUT + 2 * MiB;
constexpr size_t WS_W2 = WS_W13 + 64 * MiB;
constexpr size_t WS_PROJ = WS_W2 + 32 * MiB;
constexpr size_t WS_ACT = WS_PROJ;
constexpr size_t WS_YBUF = WS_PROJ + 32 * MiB;
constexpr size_t WS_QN = WS_PROJ + 96 * MiB;
constexpr size_t WS_K = WS_QN + 16 * MiB;
constexpr size_t WS_V = WS_K + 2 * MiB;
constexpr size_t WS_KI = WS_V + 2 * MiB;
constexpr size_t WS_WI = WS_KI + 1 * MiB;
constexpr size_t WS_DBG = WS_WI + 512 * 1024;
constexpr size_t WS_DQ = WS_DBG + 512 * 1024;
constexpr size_t WS_DK = WS_DQ + 16 * MiB;
constexpr size_t WS_DV = WS_DK + 16 * MiB;
constexpr size_t WS_H2 = WS_DK;
constexpr size_t WS_LIST = WS_DV + 16 * MiB;
constexpr size_t WS_TOKINFO = WS_LIST + 2 * MiB;
constexpr size_t WS_END = WS_TOKINFO + 512 * 1024;

struct P {
    const float* x; const float* c; const int* pos; const float* ada_w; const float* ada_b; const float* norm1_g; const float* norm2_g;
    const float* w_in; const float* q_norm_g; const float* k_norm_g; const float* kv_norm_g; const float* w_kv_up; const float* idx_k_norm_g;
    const float* rel_bias; const float* conv_w; const float* a_log; const float* dt_bias; const float* dn_norm_g; const float* w_out;
    const float* rg_w; const float* rg_b; const float* re_w; const float* re_b; const float* w1; const float* w3; const float* w2;
    float* out; unsigned char* ws;
};

__device__ __forceinline__ float bf2f(bf16_t h) { return __uint_as_float(((unsigned)h) << 16); }
__device__ __forceinline__ bf16_t f2bf(float f) { unsigned u = __float_as_uint(f); u += 0x7fffu + ((u >> 16) & 1u); return (bf16_t)(u >> 16); }
__device__ __forceinline__ unsigned pack2(float a, float b) { return (unsigned)f2bf(a) | ((unsigned)f2bf(b) << 16); }
__device__ __forceinline__ float wave_sum(float v) {
#pragma unroll
    for (int o = 32; o >= 1; o >>= 1) v += __shfl_xor(v, o);
    return v;
}
__device__ __forceinline__ float wave_max(float v) {
#pragma unroll
    for (int o = 32; o >= 1; o >>= 1) v = fmaxf(v, __shfl_xor(v, o));
    return v;
}
__device__ __forceinline__ int wave_isum(int v) {
#pragma unroll
    for (int o = 32; o >= 1; o >>= 1) v += __shfl_xor(v, o);
    return v;
}
__device__ __forceinline__ int tid_opaque() { int t = threadIdx.x; asm volatile("" : "+v"(t)); return t; }
__device__ __forceinline__ float silu_f(float x) { return x / (1.f + __expf(-x)); }
__device__ __forceinline__ float sigmoid_f(float x) { return 1.f / (1.f + __expf(-x)); }
__device__ __forceinline__ float mod_val(const P& p, int b, int which, int d) {
    const float* mp = (const float*)(p.ws + WS_MODP);
    const int col = which * ND + d;
    float s = p.ada_b[col];
#pragma unroll
    for (int ks = 0; ks < KSPLIT; ++ks) s += mp[(size_t)(ks * NB + b) * (6 * ND) + col];
    return s;
}

__device__ __forceinline__ void ph_mod_partial(const P& p) {
    const int tid = tid_opaque();
    const int lane = tid & 63, wave = tid >> 6;
    float* mp = (float*)(p.ws + WS_MODP);
    const int nitem = 96 * KSPLIT;
    for (int it = blockIdx.x * NWAVES + wave; it < nitem; it += gridDim.x * NWAVES) {
        const int cg = it % 96, ks = it / 96;
        const int col = cg * 64 + lane;
        float acc[NB];
#pragma unroll
        for (int b = 0; b < NB; ++b) acc[b] = 0.f;
        for (int kk = 0; kk < ND / KSPLIT; ++kk) {
            const int k = ks * (ND / KSPLIT) + kk;
            const float w = p.ada_w[(size_t)k * (6 * ND) + col];
#pragma unroll
            for (int b = 0; b < NB; ++b) acc[b] += silu_f(p.c[b * ND + k]) * w;
        }
#pragma unroll
        for (int b = 0; b < NB; ++b) mp[(size_t)(ks * NB + b) * (6 * ND) + col] = acc[b];
    }
}

__device__ __forceinline__ int win_src_col(int n) {
    if (n < 896) return n;
    if (n < 2944) return n + 40;
    if (n < 2976) return n - 2944 + 896;
    if (n < 2984) return n - 2976 + 928;
    if (n < 2992) return n;
    return -1;
}
__device__ __forceinline__ void conv_tile(const int tid, float* tile  , const float* src0, const float* src1, int nsrc, int mode, int n0, int k0, bf16_t* dst, int K, int qcol) {
    {
        const int n = tid & 63, r = tid >> 6;
        int col; const float* src = src0;
        if (mode == 0) col = n0 + n;
        else if (mode == 1) col = win_src_col(n0 + n);
        else { col = qcol + (n & 31); if (n >= 32) src = src1; }
#pragma unroll
        for (int i = 0; i < 8; ++i) {
            const int k = r + 8 * i;
            tile[k * 65 + n] = (col >= 0) ? src[(size_t)(k0 + k) * nsrc + col] : 0.f;
        }
    }
    __syncthreads();
    {
        const int n = tid >> 3, kc = tid & 7;
        unsigned w[4];
#pragma unroll
        for (int j = 0; j < 4; ++j) w[j] = pack2(tile[(kc * 8 + 2 * j) * 65 + n], tile[(kc * 8 + 2 * j + 1) * 65 + n]);
        *(uint4*)(dst + (size_t)(n0 + n) * K + k0 + kc * 8) = make_uint4(w[0], w[1], w[2], w[3]);
    }
    __syncthreads();
}
__device__ __forceinline__ void ph_convert(const P& p, char* smem) {
    const int tid = tid_opaque();
    float* tile = (float*)smem;
    bf16_t* Wt_in = (bf16_t*)(p.ws + WS_WIN); bf16_t* Wt_out = (bf16_t*)(p.ws + WS_WOUT);
    bf16_t* Wt13 = (bf16_t*)(p.ws + WS_W13); bf16_t* Wt2 = (bf16_t*)(p.ws + WS_W2);
    const int T0 = 48 * 16, T1 = 16 * 16, T2 = NE * 256, T3 = NE * 128;
    const int total = T0 + T1 + T2 + T3;
    for (int t = blockIdx.x; t < total; t += gridDim.x) {
        if (t < T0) { const int nt = t / 16, kt = t % 16; conv_tile(tid, tile, p.w_in, nullptr, W_IN_SRC, 1, nt * 64, kt * 64, Wt_in, ND, 0); }
        else if (t < T0 + T1) { const int u = t - T0; const int nt = u / 16, kt = u % 16; conv_tile(tid, tile, p.w_out, nullptr, ND, 0, nt * 64, kt * 64, Wt_out, ND, 0); }
        else if (t < T0 + T1 + T2) { const int u = t - T0 - T1; const int e = u / 256, v = u % 256; const int nt = v / 16, kt = v % 16;
            conv_tile(tid, tile, p.w1 + (size_t)e * ND * EFF, p.w3 + (size_t)e * ND * EFF, EFF, 2, nt * 64, kt * 64, Wt13 + (size_t)e * 1024 * ND, ND, nt * 32); }
        else { const int u = t - T0 - T1 - T2; const int e = u / 128, v = u % 128; const int nt = v / 8, kt = v % 8;
            conv_tile(tid, tile, p.w2 + (size_t)e * EFF * ND, nullptr, ND, 0, nt * 64, kt * 64, Wt2 + (size_t)e * ND * EFF, EFF, 0); }
    }
}

__device__ __forceinline__ void ph_norm1(const P& p, char* smem) {
    const int tid = tid_opaque();
    float* sA = (float*)smem; float* sB = sA + ND;
    const int lane = tid & 63, wave = tid >> 6;
    bf16_t* h = (bf16_t*)p.out;
    int curb = -1;
    for (int tile = blockIdx.x; tile < NTOK / 64; tile += gridDim.x) {
        const int b = tile / (NT / 64);
        if (b != curb) {
            __syncthreads();
            for (int d = tid; d < ND; d += NTHREADS) { sA[d] = p.norm1_g[d] * (1.f + mod_val(p, b, 1, d)); sB[d] = mod_val(p, b, 0, d); }
            __syncthreads();
            curb = b;
        }
        for (int i = 0; i < 8; ++i) {
            const int tok = tile * 64 + wave * 8 + i;
            const float* xr = p.x + (size_t)tok * ND;
            f32x4 v[4]; float ss = 0.f;
#pragma unroll
            for (int j = 0; j < 4; ++j) { v[j] = *(const f32x4*)(xr + j * 256 + lane * 4); ss += v[j][0] * v[j][0] + v[j][1] * v[j][1] + v[j][2] * v[j][2] + v[j][3] * v[j][3]; }
            ss = wave_sum(ss);
            const float rstd = rsqrtf(ss * (1.f / ND) + EPS);
#pragma unroll
            for (int j = 0; j < 4; ++j) {
                const int d = j * 256 + lane * 4;
                const float o0 = v[j][0] * rstd * sA[d] + sB[d], o1 = v[j][1] * rstd * sA[d + 1] + sB[d + 1], o2 = v[j][2] * rstd * sA[d + 2] + sB[d + 2], o3 = v[j][3] * rstd * sA[d + 3] + sB[d + 3];
                *(uint2*)(h + (size_t)tok * ND + d) = make_uint2(pack2(o0, o1), pack2(o2, o3));
            }
        }
    }
}

constexpr int LDS_LD = 72;
template <int BM, int BN> struct GemmLds { static constexpr int BYTES = 2 * (BM + BN) * LDS_LD * 2; };
template <int BM, int BN, class AF, class BF>
__device__ __forceinline__ void gemm_tile(const int tid, char* smem, int K, AF aptr, BF bptr, f32x16 (&acc)[2][2]) {
    constexpr int WM = BM / 64;
    constexpr int NA = BM / 64, NBc = BN / 64;
    bf16_t* As = (bf16_t*)smem;
    bf16_t* Bs = As + 2 * BM * LDS_LD;
    const int lane = tid & 63, wave = tid >> 6;
    const int wm = wave % WM, wn = wave / WM;
    uint4 ra0, ra1, ra2, ra3, rb0, rb1, rb2, rb3;
    ra0 = ra1 = ra2 = ra3 = rb0 = rb1 = rb2 = rb3 = make_uint4(0, 0, 0, 0);
#pragma unroll
    for (int m = 0; m < 2; ++m)
#pragma unroll
        for (int n = 0; n < 2; ++n)
#pragma unroll
            for (int r = 0; r < 16; ++r) acc[m][n][r] = 0.f;
    const int nk = K / 64;
    const int cr = tid >> 3, ck = (tid & 7) * 8;
#define GT_LOAD(kt) do { \
        ra0 = *(const uint4*)aptr(cr, (kt) * 64 + ck); ra1 = *(const uint4*)aptr(cr + 64, (kt) * 64 + ck); \
        if constexpr (NA > 2) { ra2 = *(const uint4*)aptr(cr + 128, (kt) * 64 + ck); ra3 = *(const uint4*)aptr(cr + 192, (kt) * 64 + ck); } \
        rb0 = *(const uint4*)bptr(cr, (kt) * 64 + ck); rb1 = *(const uint4*)bptr(cr + 64, (kt) * 64 + ck); \
        if constexpr (NBc > 2) { rb2 = *(const uint4*)bptr(cr + 128, (kt) * 64 + ck); rb3 = *(const uint4*)bptr(cr + 192, (kt) * 64 + ck); } } while (0)
#define GT_STORE(buf) do { \
        bf16_t* as_ = As + ((buf) * BM + cr) * LDS_LD + ck; bf16_t* bs_ = Bs + ((buf) * BN + cr) * LDS_LD + ck; \
        *(uint4*)as_ = ra0; *(uint4*)(as_ + 64 * LDS_LD) = ra1; \
        if constexpr (NA > 2) { *(uint4*)(as_ + 128 * LDS_LD) = ra2; *(uint4*)(as_ + 192 * LDS_LD) = ra3; } \
        *(uint4*)bs_ = rb0; *(uint4*)(bs_ + 64 * LDS_LD) = rb1; \
        if constexpr (NBc > 2) { *(uint4*)(bs_ + 128 * LDS_LD) = rb2; *(uint4*)(bs_ + 192 * LDS_LD) = rb3; } } while (0)
    GT_LOAD(0); GT_STORE(0); __syncthreads();
    for (int kt = 0; kt < nk; ++kt) {
        if (kt + 1 < nk) GT_LOAD(kt + 1);
        const bf16_t* a0 = As + ((kt & 1) * BM + wm * 64 + (lane & 31)) * LDS_LD + 8 * (lane >> 5);
        const bf16_t* b0 = Bs + ((kt & 1) * BN + wn * 64 + (lane & 31)) * LDS_LD + 8 * (lane >> 5);
#pragma unroll
        for (int ks = 0; ks < 4; ++ks) {
            const bf16x8 fa0 = *(const bf16x8*)(a0 + ks * 16), fa1 = *(const bf16x8*)(a0 + 32 * LDS_LD + ks * 16);
            const bf16x8 fb0 = *(const bf16x8*)(b0 + ks * 16), fb1 = *(const bf16x8*)(b0 + 32 * LDS_LD + ks * 16);
            acc[0][0] = __builtin_amdgcn_mfma_f32_32x32x16_bf16(fa0, fb0, acc[0][0], 0, 0, 0);
            acc[0][1] = __builtin_amdgcn_mfma_f32_32x32x16_bf16(fa0, fb1, acc[0][1], 0, 0, 0);
            acc[1][0] = __builtin_amdgcn_mfma_f32_32x32x16_bf16(fa1, fb0, acc[1][0], 0, 0, 0);
            acc[1][1] = __builtin_amdgcn_mfma_f32_32x32x16_bf16(fa1, fb1, acc[1][1], 0, 0, 0);
        }
        if (kt + 1 < nk) GT_STORE((kt + 1) & 1);
        __syncthreads();
    }
}

__device__ __forceinline__ void ph_gemm1(const P& p, char* smem) {
    const int tid = tid_opaque();
    constexpr int BM = 256, BN = 128;
    const bf16_t* h = (const bf16_t*)p.out; const bf16_t* Wt = (const bf16_t*)(p.ws + WS_WIN);
    bf16_t* proj = (bf16_t*)(p.ws + WS_PROJ);
    const int lane = tid & 63, wave = tid >> 6, wm = wave % 4, wn = wave / 4;
    const int ntn = NPROJ / BN, ntiles = (NTOK / BM) * ntn;
    for (int t = blockIdx.x; t < ntiles; t += gridDim.x) {
        const int tm = t / ntn, tn = t % ntn;
        const bf16_t* Ab = h + (size_t)tm * BM * ND; const bf16_t* Bb = Wt + (size_t)tn * BN * ND;
        f32x16 acc[2][2];
        gemm_tile<BM, BN>(tid, smem, ND, [&](int r, int k) __attribute__((always_inline)) { return Ab + (size_t)r * ND + k; }, [&](int r, int k) __attribute__((always_inline)) { return Bb + (size_t)r * ND + k; }, acc);
#pragma unroll
        for (int m = 0; m < 2; ++m)
#pragma unroll
            for (int n = 0; n < 2; ++n)
#pragma unroll
                for (int r = 0; r < 16; ++r) {
                    const int row = tm * BM + wm * 64 + m * 32 + (r & 3) + 8 * (r >> 2) + 4 * (lane >> 5);
                    const int col = tn * BN + wn * 64 + n * 32 + (lane & 31);
                    proj[(size_t)row * NPROJ + col] = f2bf(acc[m][n][r]);
                }
    }
}

__device__ __forceinline__ void ph_post(const P& p, char* smem) {
    const int tid = tid_opaque();
    float* sW = (float*)smem;
    for (int i = tid; i < 128 * 128; i += NTHREADS) sW[i] = p.w_kv_up[i];
    __syncthreads();
    const int lane = tid & 63, wave = tid >> 6;
    const bf16_t* proj = (const bf16_t*)(p.ws + WS_PROJ);
    bf16_t* qn = (bf16_t*)(p.ws + WS_QN); bf16_t* Kb = (bf16_t*)(p.ws + WS_K); bf16_t* Vb = (bf16_t*)(p.ws + WS_V); bf16_t* kib = (bf16_t*)(p.ws + WS_KI);
    float* wi = (float*)(p.ws + WS_WI); float* dbeta = (float*)(p.ws + WS_DBG); float* dg = dbeta + NTOK * 4;
    bf16_t* dq = (bf16_t*)(p.ws + WS_DQ); bf16_t* dk = (bf16_t*)(p.ws + WS_DK); bf16_t* dvv = (bf16_t*)(p.ws + WS_DV);
    for (int tok = blockIdx.x * NWAVES + wave; tok < NTOK; tok += gridDim.x * NWAVES) {
        const int t = tok % NT;
        const bf16_t* pr = proj + (size_t)tok * NPROJ;
        {
            const uint4 raw = *(const uint4*)(pr + PC_QATT + lane * 8);
            const unsigned w[4] = {raw.x, raw.y, raw.z, raw.w};
            float v[8]; float ss = 0.f;
#pragma unroll
            for (int j = 0; j < 4; ++j) { v[2 * j] = __uint_as_float(w[j] << 16); v[2 * j + 1] = __uint_as_float(w[j] & 0xffff0000u); }
#pragma unroll
            for (int j = 0; j < 8; ++j) ss += v[j] * v[j];
            ss += __shfl_xor(ss, 1); ss += __shfl_xor(ss, 2); ss += __shfl_xor(ss, 4);
            const float rs = rsqrtf(ss * (1.f / 64.f) + EPS) * 0.125f;
            const int d0 = (lane & 7) * 8;
            unsigned o[4];
#pragma unroll
            for (int j = 0; j < 4; ++j) o[j] = pack2(v[2 * j] * rs * p.q_norm_g[d0 + 2 * j], v[2 * j + 1] * rs * p.q_norm_g[d0 + 2 * j + 1]);
            *(uint4*)(qn + (size_t)tok * 512 + lane * 8) = make_uint4(o[0], o[1], o[2], o[3]);
        }
        {
            const unsigned raw = *(const unsigned*)(pr + PC_KVLAT + lane * 2);
            float a0 = __uint_as_float(raw << 16), a1 = __uint_as_float(raw & 0xffff0000u);
            float ss = wave_sum(a0 * a0 + a1 * a1);
            const float rs = rsqrtf(ss * (1.f / 128.f) + EPS);
            a0 *= rs * p.kv_norm_g[lane * 2]; a1 *= rs * p.kv_norm_g[lane * 2 + 1];
            float k = 0.f, v = 0.f;
#pragma unroll 8
            for (int i = 0; i < 64; ++i) {
                const float x0 = __shfl(a0, i), x1 = __shfl(a1, i);
                k += x0 * sW[(2 * i) * 128 + lane] + x1 * sW[(2 * i + 1) * 128 + lane];
                v += x0 * sW[(2 * i) * 128 + 64 + lane] + x1 * sW[(2 * i + 1) * 128 + 64 + lane];
            }
            const float ks = wave_sum(k * k);
            k *= rsqrtf(ks * (1.f / 64.f) + EPS) * p.k_norm_g[lane];
            Kb[(size_t)tok * 64 + lane] = f2bf(k);
            Vb[(size_t)tok * 64 + lane] = f2bf(v);
        }
        {
            float a = (lane < 32) ? bf2f(pr[PC_KIDX + lane]) : 0.f;
            const float ss = wave_sum(a * a);
            a *= rsqrtf(ss * (1.f / 32.f) + EPS);
            if (lane < 32) kib[(size_t)tok * 32 + lane] = f2bf(a * p.idx_k_norm_g[lane]);
            if (lane < 8) wi[(size_t)tok * 8 + lane] = bf2f(pr[PC_WIDX + lane]) * 0.35355339059327373f * 0.17677669529663687f;
            if (lane < 4) {
                dbeta[(size_t)tok * 4 + lane] = sigmoid_f(bf2f(pr[PC_BETA + lane]));
                const float z = bf2f(pr[PC_A + lane]) + p.dt_bias[lane];
                const float sp = (z > 20.f) ? z : log1pf(__expf(z));
                dg[(size_t)tok * 4 + lane] = -__expf(p.a_log[lane]) * sp;
            }
        }
#pragma unroll 1
        for (int j = 0; j < 12; ++j) {
            const int ch = j * 128 + lane * 2;
            float y0 = 0.f, y1 = 0.f;
#pragma unroll
            for (int tap = 0; tap < 4; ++tap) {
                const int tt = t - 3 + tap;
                if (tt >= 0) {
                    const unsigned raw = *(const unsigned*)(pr + (ptrdiff_t)(tap - 3) * NPROJ + PC_DNQKV + ch);
                    y0 += p.conv_w[tap * 1536 + ch] * __uint_as_float(raw << 16);
                    y1 += p.conv_w[tap * 1536 + ch + 1] * __uint_as_float(raw & 0xffff0000u);
                }
            }
            y0 = silu_f(y0); y1 = silu_f(y1);
            if (j < 8) {
                const float ss = wave_sum(y0 * y0 + y1 * y1);
                float rs = rsqrtf(ss + EPS);
                if (j < 4) rs *= 0.08838834764831845f;
                y0 *= rs; y1 *= rs;
            }
            bf16_t* dst = (j < 4) ? dq : ((j < 8) ? dk : dvv);
            *(unsigned*)(dst + (size_t)tok * 512 + (j & 3) * 128 + lane * 2) = pack2(y0, y1);
        }
    }
}

__device__ __forceinline__ unsigned f2sortable(float f) { const unsigned u = __float_as_uint(f); return (u & 0x80000000u) ? ~u : (u | 0x80000000u); }
constexpr int ATT_WAVE_LDS = 8192 + 1024 + 2048 + 1024;
constexpr int ATT_LDS = NWAVES * ATT_WAVE_LDS + 132 * 4 + 32 * 8 * 4;
__device__ __forceinline__ void ph_attn_naive(const P& p, char* smem) {
    const int tid = tid_opaque();
    const int lane = tid & 63, wave = tid >> 6;
    int* lut = (int*)(smem + NWAVES * ATT_WAVE_LDS);
    float* sbias = (float*)(lut + 132);
    for (int i = tid; i <= 128; i += NTHREADS) {
        int bk;
        if (i < 16) bk = i;
        else { const float v = logf((float)i / 16.f) / 2.0794415416798357f * 16.f; bk = 16 + (int)v; if (bk > 31) bk = 31; }
        lut[i] = bk;
    }
    for (int i = tid; i < 256; i += NTHREADS) sbias[i] = p.rel_bias[i];
    __syncthreads();
    char* wl = smem + wave * ATT_WAVE_LDS;
    float* sS = (float*)wl;
    float* sQi = (float*)(wl + 8192);
    float* sQ = (float*)(wl + 8192 + 1024);
    int* sSel = (int*)(wl + 8192 + 1024 + 2048);
    const bf16_t* proj = (const bf16_t*)(p.ws + WS_PROJ);
    bf16_t* qn = (bf16_t*)(p.ws + WS_QN); const bf16_t* Kb = (const bf16_t*)(p.ws + WS_K); const bf16_t* Vb = (const bf16_t*)(p.ws + WS_V); const bf16_t* kib = (const bf16_t*)(p.ws + WS_KI);
    const float* wi = (const float*)(p.ws + WS_WI);
    int* qctr = (int*)(p.ws + WS_CTL) + 64;
    for (;;) {
        int q = 0;
        if (lane == 0) q = atomicAdd(qctr, 1);
        q = __shfl(q, 0);
        if (q >= NTOK) break;
        q = NTOK - 1 - q;
        const int b = q / NT, t = q % NT;
        for (int i = lane; i < 256; i += 64) sQi[i] = bf2f(proj[(size_t)q * NPROJ + PC_QIDX + i]);
        for (int i = lane; i < 512; i += 64) sQ[i] = bf2f(qn[(size_t)q * 512 + i]);
        float wv[8];
#pragma unroll
        for (int h = 0; h < 8; ++h) wv[h] = wi[(size_t)q * 8 + h];
        __threadfence_block();
        const int nch = t / 64 + 1;
        for (int i = 0; i < nch; ++i) {
            const int s = i * 64 + lane;
            const bf16_t* kr = kib + (size_t)(b * NT + s) * 32;
            float kf[32];
#pragma unroll
            for (int j = 0; j < 4; ++j) {
                const uint4 raw = *(const uint4*)(kr + j * 8);
                const unsigned w[4] = {raw.x, raw.y, raw.z, raw.w};
#pragma unroll
                for (int u = 0; u < 4; ++u) { kf[j * 8 + 2 * u] = __uint_as_float(w[u] << 16); kf[j * 8 + 2 * u + 1] = __uint_as_float(w[u] & 0xffff0000u); }
            }
            float sc = 0.f;
#pragma unroll
            for (int h = 0; h < 8; ++h) {
                float d = 0.f;
#pragma unroll
                for (int j = 0; j < 32; j += 4) { const f32x4 qv = *(const f32x4*)(sQi + h * 32 + j); d += qv[0] * kf[j] + qv[1] * kf[j + 1] + qv[2] * kf[j + 2] + qv[3] * kf[j + 3]; }
                sc += wv[h] * fmaxf(d, 0.f);
            }
            sS[s] = (s <= t) ? sc : -INFINITY;
        }
        __threadfence_block();
        const int nsel = (t + 1 < 256) ? (t + 1) : 256;
        unsigned u[32];
#pragma unroll
        for (int i = 0; i < 32; ++i) u[i] = (i < nch) ? f2sortable(sS[i * 64 + lane]) : 0u;
        unsigned prefix = 0u; int need = 0;
        if (t + 1 > 256) {
            for (int bit = 31; bit >= 0; --bit) {
                const unsigned cand = prefix | (1u << bit);
                int cnt = 0;
#pragma unroll
                for (int i = 0; i < 32; ++i) cnt += (u[i] >= cand) ? 1 : 0;
                cnt = wave_isum(cnt);
                if (cnt >= 256) prefix = cand;
            }
            int ngt = 0;
#pragma unroll
            for (int i = 0; i < 32; ++i) ngt += (u[i] > prefix) ? 1 : 0;
            ngt = wave_isum(ngt);
            need = 256 - ngt;
        } else { prefix = f2sortable(-INFINITY); need = 0; }
        {
            int base = 0, tierun = 0;
#pragma unroll
            for (int i = 0; i < 32; ++i) {
                const bool gt = u[i] > prefix, tie = (u[i] == prefix) && (t + 1 > 256);
                const unsigned long long tb = __ballot(tie);
                const int trank = tierun + __builtin_popcountll(tb & ((1ull << lane) - 1ull));
                const bool sel = gt || (tie && trank < need);
                const unsigned long long sb = __ballot(sel);
                if (sel) sSel[base + __builtin_popcountll(sb & ((1ull << lane) - 1ull))] = i * 64 + lane;
                base += __builtin_popcountll(sb); tierun += __builtin_popcountll(tb);
            }
        }
        __threadfence_block();
        const int pt = p.pos[q];
#pragma unroll 1
        for (int c = 0; c < 4; ++c) {
            const int j = c * 64 + lane;
            float acc[8];
            if (j < nsel) {
                const int s = sSel[j];
                const bf16_t* kr = Kb + (size_t)(b * NT + s) * 64;
#pragma unroll
                for (int h = 0; h < 8; ++h) acc[h] = 0.f;
#pragma unroll 2
                for (int jj = 0; jj < 8; ++jj) {
                    const uint4 raw = *(const uint4*)(kr + jj * 8);
                    const unsigned w[4] = {raw.x, raw.y, raw.z, raw.w};
                    float kf[8];
#pragma unroll
                    for (int uu = 0; uu < 4; ++uu) { kf[2 * uu] = __uint_as_float(w[uu] << 16); kf[2 * uu + 1] = __uint_as_float(w[uu] & 0xffff0000u); }
#pragma unroll
                    for (int h = 0; h < 8; ++h) {
                        const f32x4 q0 = *(const f32x4*)(sQ + h * 64 + jj * 8), q1 = *(const f32x4*)(sQ + h * 64 + jj * 8 + 4);
                        acc[h] += q0[0] * kf[0] + q0[1] * kf[1] + q0[2] * kf[2] + q0[3] * kf[3] + q1[0] * kf[4] + q1[1] * kf[5] + q1[2] * kf[6] + q1[3] * kf[7];
                    }
                }
                int n = pt - p.pos[b * NT + s]; n = n < 0 ? 0 : (n > 128 ? 128 : n);
                const int bk = lut[n];
#pragma unroll
                for (int h = 0; h < 8; ++h) acc[h] += sbias[bk * 8 + h];
            } else {
#pragma unroll
                for (int h = 0; h < 8; ++h) acc[h] = -INFINITY;
            }
            *(f32x4*)(sS + j * 8) = (f32x4){acc[0], acc[1], acc[2], acc[3]};
            *(f32x4*)(sS + j * 8 + 4) = (f32x4){acc[4], acc[5], acc[6], acc[7]};
        }
        {
            float lg[4][8];
#pragma unroll
            for (int c = 0; c < 4; ++c) {
                const f32x4 a = *(const f32x4*)(sS + (c * 64 + lane) * 8), bq = *(const f32x4*)(sS + (c * 64 + lane) * 8 + 4);
                lg[c][0] = a[0]; lg[c][1] = a[1]; lg[c][2] = a[2]; lg[c][3] = a[3]; lg[c][4] = bq[0]; lg[c][5] = bq[1]; lg[c][6] = bq[2]; lg[c][7] = bq[3];
            }
#pragma unroll
            for (int h = 0; h < 8; ++h) {
                float m = fmaxf(fmaxf(lg[0][h], lg[1][h]), fmaxf(lg[2][h], lg[3][h]));
                m = wave_max(m);
                float s = 0.f;
#pragma unroll
                for (int c = 0; c < 4; ++c) { lg[c][h] = __expf(lg[c][h] - m); s += lg[c][h]; }
                s = wave_sum(s);
                const float inv = 1.f / s;
#pragma unroll
                for (int c = 0; c < 4; ++c) lg[c][h] *= inv;
            }
#pragma unroll
            for (int c = 0; c < 4; ++c) {
                *(f32x4*)(sS + (c * 64 + lane) * 8) = (f32x4){lg[c][0], lg[c][1], lg[c][2], lg[c][3]};
                *(f32x4*)(sS + (c * 64 + lane) * 8 + 4) = (f32x4){lg[c][4], lg[c][5], lg[c][6], lg[c][7]};
            }
        }
        __threadfence_block();
        float o[8];
#pragma unroll
        for (int h = 0; h < 8; ++h) o[h] = 0.f;
        for (int j = 0; j < nsel; ++j) {
            const int s = sSel[j];
            const float v = bf2f(Vb[(size_t)(b * NT + s) * 64 + lane]);
            const f32x4 p0 = *(const f32x4*)(sS + j * 8), p1 = *(const f32x4*)(sS + j * 8 + 4);
            o[0] += p0[0] * v; o[1] += p0[1] * v; o[2] += p0[2] * v; o[3] += p0[3] * v;
            o[4] += p1[0] * v; o[5] += p1[1] * v; o[6] += p1[2] * v; o[7] += p1[3] * v;
        }
#pragma unroll
        for (int h = 0; h < 8; ++h) qn[(size_t)q * 512 + h * 64 + lane] = f2bf(o[h]);
        __threadfence_block();
    }
}

constexpr int DN_LDS = (64 * 129 * 2 + 64 * 65 * 2 + 128 * 33 + 64 * 33 * 2 + 64 * 4) * 4;
__device__ __forceinline__ void ph_dn_naive(const P& p, char* smem) {
    const int tid = tid_opaque();
    float* kc = (float*)smem;
    float* qc = kc + 64 * 129;
    float* Am = qc + 64 * 129;
    float* Pm = Am + 64 * 65;
    float* S = Pm + 64 * 65;
    float* U = S + 128 * 33;
    float* Dl = U + 64 * 33;
    float* sG = Dl + 64 * 33;
    float* sB = sG + 64;
    float* sE = sB + 64;
    float* sL = sE + 64;
    const bf16_t* dq = (const bf16_t*)(p.ws + WS_DQ); const bf16_t* dk = (const bf16_t*)(p.ws + WS_DK); const bf16_t* dvv = (const bf16_t*)(p.ws + WS_DV);
    const float* dbeta = (const float*)(p.ws + WS_DBG); const float* dg = dbeta + NTOK * 4;
    float* dno = p.out;
    for (int item = blockIdx.x; item < NB * 4 * 4; item += gridDim.x) {
        const int b = item / 16, hh = (item / 4) % 4, sl = item % 4;
        for (int i = tid; i < 128 * 33; i += NTHREADS) S[i] = 0.f;
        __syncthreads();
        for (int c = 0; c < NT / 64; ++c) {
            const int tok0 = b * NT + c * 64;
            for (int i = tid; i < 64 * 128; i += NTHREADS) { const int r = i >> 7, d = i & 127; kc[r * 129 + d] = bf2f(dk[(size_t)(tok0 + r) * 512 + hh * 128 + d]); qc[r * 129 + d] = bf2f(dq[(size_t)(tok0 + r) * 512 + hh * 128 + d]); }
            if (tid < 64) {
                const float g = dg[(size_t)(tok0 + tid) * 4 + hh];
                float G = g;
#pragma unroll
                for (int o = 1; o < 64; o <<= 1) { const float n = __shfl_up(G, o); if (tid >= o) G += n; }
                const float Gl = __shfl(G, 63);
                sG[tid] = G; sB[tid] = dbeta[(size_t)(tok0 + tid) * 4 + hh]; sE[tid] = __expf(G); sL[tid] = __expf(Gl - G);
            }
            __syncthreads();
            for (int i = tid; i < 64 * 32; i += NTHREADS) { const int r = i >> 5, e = i & 31; U[r * 33 + e] = sB[r] * bf2f(dvv[(size_t)(tok0 + r) * 512 + hh * 128 + sl * 32 + e]); }
            {
                const int ib = tid >> 4, jb = tid & 15;
                float ak[2][4], ap[2][4];
#pragma unroll
                for (int a = 0; a < 2; ++a)
#pragma unroll
                    for (int bb = 0; bb < 4; ++bb) { ak[a][bb] = 0.f; ap[a][bb] = 0.f; }
                for (int d = 0; d < 128; ++d) {
                    const float k0 = kc[(2 * ib) * 129 + d], k1 = kc[(2 * ib + 1) * 129 + d], q0 = qc[(2 * ib) * 129 + d], q1 = qc[(2 * ib + 1) * 129 + d];
#pragma unroll
                    for (int bb = 0; bb < 4; ++bb) { const float kj = kc[(4 * jb + bb) * 129 + d]; ak[0][bb] += k0 * kj; ak[1][bb] += k1 * kj; ap[0][bb] += q0 * kj; ap[1][bb] += q1 * kj; }
                }
#pragma unroll
                for (int a = 0; a < 2; ++a)
#pragma unroll
                    for (int bb = 0; bb < 4; ++bb) {
                        const int i = 2 * ib + a, j = 4 * jb + bb;
                        const float dec = (j <= i) ? __expf(sG[i] - sG[j]) : 0.f;
                        Am[i * 65 + j] = (j < i) ? sB[i] * ak[a][bb] * dec : 0.f;
                        Pm[i * 65 + j] = ap[a][bb] * dec;
                    }
            }
            __syncthreads();
            for (int i = tid; i < 64 * 128; i += NTHREADS) { const int r = i >> 7, d = i & 127; kc[r * 129 + d] *= sB[r] * sE[r]; }
            __syncthreads();
            if (tid < 160) {
                float* col = (tid < 128) ? (kc + tid) : (U + (tid - 128));
                const int ld = (tid < 128) ? 129 : 33;
                for (int i = 1; i < 64; ++i) {
                    float s = col[i * ld];
                    for (int j = 0; j < i; ++j) s -= Am[i * 65 + j] * col[j * ld];
                    col[i * ld] = s;
                }
            }
            __syncthreads();
            const int oi = tid >> 3, oe = (tid & 7) * 4;
            float o1[4];
            {
                float dl[4] = {0.f, 0.f, 0.f, 0.f}; o1[0] = o1[1] = o1[2] = o1[3] = 0.f;
                for (int d = 0; d < 128; ++d) {
                    const float w = kc[oi * 129 + d], qv = qc[oi * 129 + d];
#pragma unroll
                    for (int e = 0; e < 4; ++e) { const float sv = S[d * 33 + oe + e]; dl[e] += w * sv; o1[e] += qv * sv; }
                }
#pragma unroll
                for (int e = 0; e < 4; ++e) { Dl[oi * 33 + oe + e] = U[oi * 33 + oe + e] - dl[e]; o1[e] *= sE[oi]; }
            }
            __syncthreads();
            {
                for (int j = 0; j <= oi; ++j) {
                    const float pv = Pm[oi * 65 + j];
#pragma unroll
                    for (int e = 0; e < 4; ++e) o1[e] += pv * Dl[j * 33 + oe + e];
                }
                *(f32x4*)(dno + (size_t)(tok0 + oi) * 512 + hh * 128 + sl * 32 + oe) = (f32x4){o1[0], o1[1], o1[2], o1[3]};
            }
            for (int i = tid; i < 64 * 128; i += NTHREADS) { const int r = i >> 7, d = i & 127; kc[r * 129 + d] = bf2f(dk[(size_t)(tok0 + r) * 512 + hh * 128 + d]) * sL[r]; }
            __syncthreads();
            {
                const int d = tid >> 2, e0 = (tid & 3) * 8;
                float a[8];
#pragma unroll
                for (int e = 0; e < 8; ++e) a[e] = 0.f;
                for (int cc = 0; cc < 64; ++cc) {
                    const float kv = kc[cc * 129 + d];
#pragma unroll
                    for (int e = 0; e < 8; ++e) a[e] += kv * Dl[cc * 33 + e0 + e];
                }
                const float gl = sE[63];
#pragma unroll
                for (int e = 0; e < 8; ++e) S[d * 33 + e0 + e] = gl * S[d * 33 + e0 + e] + a[e];
            }
            __syncthreads();
        }
    }
}

__device__ __forceinline__ void ph_dn_gate(const P& p) {
    const int tid = tid_opaque();
    const int lane = tid & 63, wave = tid >> 6;
    const float* dno = p.out; const bf16_t* proj = (const bf16_t*)(p.ws + WS_PROJ); bf16_t* dnn = (bf16_t*)(p.ws + WS_DQ);
    for (int tok = blockIdx.x * NWAVES + wave; tok < NTOK; tok += gridDim.x * NWAVES) {
#pragma unroll
        for (int hh = 0; hh < 4; ++hh) {
            const float o0 = dno[(size_t)tok * 512 + hh * 128 + lane * 2], o1 = dno[(size_t)tok * 512 + hh * 128 + lane * 2 + 1];
            const float ss = wave_sum(o0 * o0 + o1 * o1);
            const float rs = rsqrtf(ss * (1.f / 128.f) + EPS);
            const unsigned zr = *(const unsigned*)(proj + (size_t)tok * NPROJ + PC_DNZ + hh * 128 + lane * 2);
            const float z0 = __uint_as_float(zr << 16), z1 = __uint_as_float(zr & 0xffff0000u);
            *(unsigned*)(dnn + (size_t)tok * 512 + hh * 128 + lane * 2) = pack2(o0 * rs * p.dn_norm_g[lane * 2] * silu_f(z0), o1 * rs * p.dn_norm_g[lane * 2 + 1] * silu_f(z1));
        }
    }
}

__device__ __forceinline__ void ph_gemm_out(const P& p, char* smem) {
    const int tid = tid_opaque();
    constexpr int BM = 256, BN = 128;
    const bf16_t* att = (const bf16_t*)(p.ws + WS_QN); const bf16_t* dnn = (const bf16_t*)(p.ws + WS_DQ); const bf16_t* Wt = (const bf16_t*)(p.ws + WS_WOUT);
    float* sgate = (float*)(smem + GemmLds<BM, BN>::BYTES);
    const int lane = tid & 63, wave = tid >> 6, wm = wave % 4, wn = wave / 4;
    const int ntn = ND / BN, ntiles = (NTOK / BM) * ntn;
    for (int t = blockIdx.x; t < ntiles; t += gridDim.x) {
        const int tm = t / ntn, tn = t % ntn;
        const int b = (tm * BM) / NT;
        if (tid < BN) sgate[tid] = mod_val(p, b, 2, tn * BN + tid);
        const bf16_t* A1 = att + (size_t)tm * BM * 512; const bf16_t* A2 = dnn + (size_t)tm * BM * 512; const bf16_t* Bb = Wt + (size_t)tn * BN * ND;
        f32x16 acc[2][2];
        gemm_tile<BM, BN>(tid, smem, ND, [&](int r, int k) __attribute__((always_inline)) { return (k < 512) ? (A1 + (size_t)r * 512 + k) : (A2 + (size_t)r * 512 + (k - 512)); },
                          [&](int r, int k) __attribute__((always_inline)) { return Bb + (size_t)r * ND + k; }, acc);
#pragma unroll
        for (int m = 0; m < 2; ++m)
#pragma unroll
            for (int n = 0; n < 2; ++n)
#pragma unroll
                for (int r = 0; r < 16; ++r) {
                    const int row = tm * BM + wm * 64 + m * 32 + (r & 3) + 8 * (r >> 2) + 4 * (lane >> 5);
                    const int cl = wn * 64 + n * 32 + (lane & 31);
                    const size_t idx = (size_t)row * ND + tn * BN + cl;
                    p.out[idx] = p.x[idx] + sgate[cl] * acc[m][n][r];
                }
        __syncthreads();
    }
}

constexpr int ROUTE_LDS = 36 * 1024 * 4 + 2 * 1024 * 4;
__device__ __forceinline__ void ph_route(const P& p, char* smem) {
    const int tid = tid_opaque();
    float* sW = (float*)smem;
    float* sA = sW + 36 * 1024; float* sB = sA + 1024;
    const int lane = tid & 63, wave = tid >> 6;
    for (int i = tid; i < 4 * 1024; i += NTHREADS) { const int d = i >> 2, j = i & 3; sW[j * 1024 + d] = p.rg_w[i]; }
    for (int i = tid; i < 32 * 1024; i += NTHREADS) { const int d = i >> 5, j = i & 31; sW[(4 + j) * 1024 + d] = p.re_w[i]; }
    bf16_t* h2 = (bf16_t*)(p.ws + WS_H2);
    int* cnt = (int*)(p.ws + WS_CTL); int* list = (int*)(p.ws + WS_LIST); int* tokinfo = (int*)(p.ws + WS_TOKINFO);
    int curb = -1;
    for (int tile = blockIdx.x; tile < NTOK / 64; tile += gridDim.x) {
        const int b = tile / (NT / 64);
        if (b != curb) {
            __syncthreads();
            for (int d = tid; d < ND; d += NTHREADS) { sA[d] = p.norm2_g[d] * (1.f + mod_val(p, b, 4, d)); sB[d] = mod_val(p, b, 3, d); }
            __syncthreads();
            curb = b;
        }
        for (int i = 0; i < 8; ++i) {
            const int tok = tile * 64 + wave * 8 + i;
            const float* xr = p.out + (size_t)tok * ND;
            float v[16]; float ss = 0.f;
#pragma unroll
            for (int j = 0; j < 16; ++j) { v[j] = xr[j * 64 + lane]; ss += v[j] * v[j]; }
            ss = wave_sum(ss);
            const float rstd = rsqrtf(ss * (1.f / ND) + EPS);
#pragma unroll
            for (int j = 0; j < 16; ++j) { const int d = j * 64 + lane; v[j] = v[j] * rstd * sA[d] + sB[d]; h2[(size_t)tok * ND + d] = f2bf(v[j]); }
            float mylogit = 0.f;
#pragma unroll 4
            for (int o = 0; o < 36; ++o) {
                float a = 0.f;
#pragma unroll
                for (int j = 0; j < 16; ++j) a += v[j] * sW[o * 1024 + j * 64 + lane];
                a = wave_sum(a);
                if (lane == o) mylogit = a;
            }
            if (lane < 4) mylogit += p.rg_b[lane]; else if (lane < 36) mylogit += p.re_b[lane - 4];
            float gl[4];
#pragma unroll
            for (int j = 0; j < 4; ++j) gl[j] = __shfl(mylogit, j);
            int gsel = 0; float gm = gl[0];
#pragma unroll
            for (int j = 1; j < 4; ++j) if (gl[j] > gm) { gm = gl[j]; gsel = j; }
            float gs = 0.f;
#pragma unroll
            for (int j = 0; j < 4; ++j) gs += __expf(gl[j] - gm);
            const float gtop = 1.f / gs;
            float el[8];
#pragma unroll
            for (int j = 0; j < 8; ++j) el[j] = __shfl(mylogit, 4 + gsel * 8 + j);
            int e1 = 0; float m1 = el[0];
#pragma unroll
            for (int j = 1; j < 8; ++j) if (el[j] > m1) { m1 = el[j]; e1 = j; }
            int e2 = -1; float m2 = -INFINITY;
#pragma unroll
            for (int j = 0; j < 8; ++j) if (j != e1 && el[j] > m2) { m2 = el[j]; e2 = j; }
            const float r2 = __expf(m2 - m1);
            const float w1v = gtop / (1.f + r2), w2v = gtop * r2 / (1.f + r2);
            if (lane == 0) {
                const int ea = gsel * 8 + e1, eb = gsel * 8 + e2;
                const int pa = atomicAdd(&cnt[ea], 1), pb = atomicAdd(&cnt[eb], 1);
                list[ea * NTOK + pa] = tok; list[eb * NTOK + pb] = tok;
                int* ti = tokinfo + (size_t)tok * 8;
                ti[0] = ea; ti[1] = pa; ti[2] = eb; ti[3] = pb; ti[4] = __float_as_int(w1v); ti[5] = __float_as_int(w2v);
            }
        }
    }
}

struct MoeIdx { int rowoff[NE + 1]; int tileoff[NE + 1]; };
__device__ __forceinline__ void moe_index(const int tid, const P& p, MoeIdx* mi) {
    if (tid == 0) {
        const int* cnt = (const int*)(p.ws + WS_CTL);
        int r = 0, t = 0;
        for (int e = 0; e < NE; ++e) { mi->rowoff[e] = r; mi->tileoff[e] = t; const int c = cnt[e]; r += c; t += (c + 127) >> 7; }
        mi->rowoff[NE] = r; mi->tileoff[NE] = t;
    }
    __syncthreads();
}

constexpr int MOE_BM = 128, MOE_BN = 256;
__device__ __forceinline__ void ph_moe_up(const P& p, char* smem) {
    const int tid = tid_opaque();
    MoeIdx* mi = (MoeIdx*)(smem + GemmLds<MOE_BM, MOE_BN>::BYTES);
    int* srow = (int*)(mi + 1);
    moe_index(tid, p, mi);
    const bf16_t* h2 = (const bf16_t*)(p.ws + WS_H2); const bf16_t* Wt13 = (const bf16_t*)(p.ws + WS_W13); bf16_t* act = (bf16_t*)(p.ws + WS_ACT);
    const int* list = (const int*)(p.ws + WS_LIST);
    const int lane = tid & 63, wave = tid >> 6, wm = wave % 2, wn = wave / 2;
    const int ntiles = mi->tileoff[NE] * 4;
    for (int t = blockIdx.x; t < ntiles; t += gridDim.x) {
        const int mt = t >> 2, ni = t & 3;
        int e = 0;
        while (mi->tileoff[e + 1] <= mt) ++e;
        const int ml = mt - mi->tileoff[e];
        const int cnt_e = mi->rowoff[e + 1] - mi->rowoff[e];
        const int nrows = min(128, cnt_e - ml * 128);
        if (tid < 128) srow[tid] = list[e * NTOK + ml * 128 + min(tid, nrows - 1)];
        __syncthreads();
        const bf16_t* Bb = Wt13 + ((size_t)e * 1024 + ni * 256) * ND;
        f32x16 acc[2][2];
        gemm_tile<MOE_BM, MOE_BN>(tid, smem, ND, [&](int r, int k) __attribute__((always_inline)) { return h2 + (size_t)srow[r] * ND + k; }, [&](int r, int k) __attribute__((always_inline)) { return Bb + (size_t)r * ND + k; }, acc);
        const int row0 = mi->rowoff[e] + ml * 128;
#pragma unroll
        for (int m = 0; m < 2; ++m)
#pragma unroll
            for (int r = 0; r < 16; ++r) {
                const int rl = wm * 64 + m * 32 + (r & 3) + 8 * (r >> 2) + 4 * (lane >> 5);
                if (rl < nrows) {
                    const float g = acc[m][0][r], u = acc[m][1][r];
                    act[(size_t)(row0 + rl) * EFF + ni * 128 + wn * 32 + (lane & 31)] = f2bf(silu_f(g) * u);
                }
            }
        __syncthreads();
    }
}

__device__ __forceinline__ void ph_moe_down(const P& p, char* smem) {
    const int tid = tid_opaque();
    MoeIdx* mi = (MoeIdx*)(smem + GemmLds<MOE_BM, MOE_BN>::BYTES);
    moe_index(tid, p, mi);
    const bf16_t* act = (const bf16_t*)(p.ws + WS_ACT); const bf16_t* Wt2 = (const bf16_t*)(p.ws + WS_W2); bf16_t* yb = (bf16_t*)(p.ws + WS_YBUF);
    const int lane = tid & 63, wave = tid >> 6, wm = wave % 2, wn = wave / 2;
    const int ntiles = mi->tileoff[NE] * 4;
    for (int t = blockIdx.x; t < ntiles; t += gridDim.x) {
        const int mt = t >> 2, ni = t & 3;
        int e = 0;
        while (mi->tileoff[e + 1] <= mt) ++e;
        const int ml = mt - mi->tileoff[e];
        const int cnt_e = mi->rowoff[e + 1] - mi->rowoff[e];
        const int nrows = min(128, cnt_e - ml * 128);
        const int row0 = mi->rowoff[e] + ml * 128;
        const bf16_t* Ab = act + (size_t)row0 * EFF;
        const bf16_t* Bb = Wt2 + ((size_t)e * ND + ni * 256) * EFF;
        f32x16 acc[2][2];
        gemm_tile<MOE_BM, MOE_BN>(tid, smem, EFF, [&](int r, int k) __attribute__((always_inline)) { return Ab + (size_t)min(r, nrows - 1) * EFF + k; }, [&](int r, int k) __attribute__((always_inline)) { return Bb + (size_t)r * EFF + k; }, acc);
#pragma unroll
        for (int m = 0; m < 2; ++m)
#pragma unroll
            for (int n = 0; n < 2; ++n)
#pragma unroll
                for (int r = 0; r < 16; ++r) {
                    const int rl = wm * 64 + m * 32 + (r & 3) + 8 * (r >> 2) + 4 * (lane >> 5);
                    if (rl < nrows) yb[(size_t)(row0 + rl) * ND + ni * 256 + wn * 64 + n * 32 + (lane & 31)] = f2bf(acc[m][n][r]);
                }
    }
}

__device__ __forceinline__ void ph_combine(const P& p, char* smem) {
    const int tid = tid_opaque();
    MoeIdx* mi = (MoeIdx*)smem;
    float* sG = (float*)(mi + 1);
    moe_index(tid, p, mi);
    const int lane = tid & 63, wave = tid >> 6;
    const bf16_t* yb = (const bf16_t*)(p.ws + WS_YBUF); const int* tokinfo = (const int*)(p.ws + WS_TOKINFO);
    int curb = -1;
    for (int tile = blockIdx.x; tile < NTOK / 64; tile += gridDim.x) {
        const int b = tile / (NT / 64);
        if (b != curb) {
            __syncthreads();
            for (int d = tid; d < ND; d += NTHREADS) sG[d] = mod_val(p, b, 5, d);
            __syncthreads();
            curb = b;
        }
        for (int i = 0; i < 8; ++i) {
            const int tok = tile * 64 + wave * 8 + i;
            const int* ti = tokinfo + (size_t)tok * 8;
            const int ra = mi->rowoff[ti[0]] + ti[1], rb = mi->rowoff[ti[2]] + ti[3];
            const float wa = __int_as_float(ti[4]), wb = __int_as_float(ti[5]);
#pragma unroll
            for (int j = 0; j < 4; ++j) {
                const int d = j * 256 + lane * 4;
                const uint2 ya = *(const uint2*)(yb + (size_t)ra * ND + d), ybv = *(const uint2*)(yb + (size_t)rb * ND + d);
                f32x4 xv = *(const f32x4*)(p.out + (size_t)tok * ND + d);
                xv[0] += sG[d] * (wa * __uint_as_float(ya.x << 16) + wb * __uint_as_float(ybv.x << 16));
                xv[1] += sG[d + 1] * (wa * __uint_as_float(ya.x & 0xffff0000u) + wb * __uint_as_float(ybv.x & 0xffff0000u));
                xv[2] += sG[d + 2] * (wa * __uint_as_float(ya.y << 16) + wb * __uint_as_float(ybv.y << 16));
                xv[3] += sG[d + 3] * (wa * __uint_as_float(ya.y & 0xffff0000u) + wb * __uint_as_float(ybv.y & 0xffff0000u));
                *(f32x4*)(p.out + (size_t)tok * ND + d) = xv;
            }
        }
    }
}

namespace cg = cooperative_groups;
extern __shared__ __attribute__((aligned(16))) char dyn_smem[];
constexpr int cmax(int a, int b) { return a > b ? a : b; }
constexpr int L_G1 = GemmLds<256, 128>::BYTES + 512;
constexpr int L_MOE = GemmLds<MOE_BM, MOE_BN>::BYTES + (int)sizeof(MoeIdx) + 128 * 4;
constexpr int MEGA_LDS = cmax(cmax(cmax(ROUTE_LDS, DN_LDS), cmax(ATT_LDS, L_G1)), L_MOE);
typedef const unsigned long long __attribute__((address_space(4)))* kargp_t;
__device__ __forceinline__ void load_params(P& p, kargp_t ka) {
    asm volatile("" : "+s"(ka));
    unsigned long long* d = (unsigned long long*)&p;
#pragma unroll
    for (int i = 0; i < (int)(sizeof(P) / 8); ++i) d[i] = ka[i];
}
#define PHASE(call) do { P p; load_params(p, ka); call; } while (0)
__global__ void __launch_bounds__(NTHREADS) mega(P p_arg) {
    cg::grid_group grid = cg::this_grid();
    char* smem = dyn_smem;
    kargp_t ka = (kargp_t)__builtin_amdgcn_kernarg_segment_ptr();
    PHASE(ph_mod_partial(p));
    PHASE(ph_convert(p, smem));
    grid.sync();
    PHASE(ph_norm1(p, smem));
    grid.sync();
    PHASE(ph_gemm1(p, smem));
    grid.sync();
    PHASE(ph_post(p, smem));
    grid.sync();
    if (blockIdx.x < NB * 16) PHASE(ph_dn_naive(p, smem));
    __syncthreads();
    PHASE(ph_attn_naive(p, smem));
    grid.sync();
    PHASE(ph_dn_gate(p));
    grid.sync();
    PHASE(ph_gemm_out(p, smem));
    grid.sync();
    PHASE(ph_route(p, smem));
    grid.sync();
    PHASE(ph_moe_up(p, smem));
    grid.sync();
    PHASE(ph_moe_down(p, smem));
    grid.sync();
    PHASE(ph_combine(p, smem));
}

extern "C" void kernel_launch(void* const* d_in, const int* in_sizes, int n_in, void* d_out, int out_size, void* d_ws, size_t ws_size, hipStream_t stream) {
    if (n_in != 26 || out_size != NTOK * ND || ws_size < WS_END) { fprintf(stderr, "kernel_launch: unexpected shapes (n_in %d out %d ws %zu need %zu)\n", n_in, out_size, ws_size, (size_t)WS_END); return; }
    static int grid_blocks = 0;
    if (!grid_blocks) {
        int dev = 0, cus = 0, per_cu = 0;
        (void)hipGetDevice(&dev);
        (void)hipDeviceGetAttribute(&cus, hipDeviceAttributeMultiprocessorCount, dev);
        (void)hipFuncSetAttribute((const void*)mega, hipFuncAttributeMaxDynamicSharedMemorySize, MEGA_LDS);
        (void)hipOccupancyMaxActiveBlocksPerMultiprocessor(&per_cu, (const void*)mega, NTHREADS, MEGA_LDS);
        if (per_cu < 1) { fprintf(stderr, "kernel_launch: occupancy query says %d blocks/CU\n", per_cu); per_cu = 1; }
        grid_blocks = cus * per_cu;
    }
    P p{};
    const float** fp = (const float**)&p;
    for (int i = 0; i < 26; ++i) fp[i] = (const float*)d_in[i];
    p.pos = (const int*)d_in[2];
    p.out = (float*)d_out; p.ws = (unsigned char*)d_ws;
    (void)hipMemsetAsync((char*)d_ws + WS_CTL, 0, 4096, stream);
    void* args[] = {&p};
    hipError_t e = hipLaunchCooperativeKernel((const void*)mega, dim3(grid_blocks), dim3(NTHREADS), args, MEGA_LDS, stream);
    if (e != hipSuccess) fprintf(stderr, "cooperative launch failed: %s (grid %d)\n", hipGetErrorString(e), grid_blocks);
}
```

```cpp
#include <hip/hip_runtime.h>
#include <hip/hip_cooperative_groups.h>
#include <cstdio>
#include <cstdint>

typedef unsigned short bf16_t;
typedef short bf16x8 __attribute__((ext_vector_type(8)));
typedef float f32x16 __attribute__((ext_vector_type(16)));
typedef float f32x4 __attribute__((ext_vector_type(4)));

constexpr int NB = 8, NT = 2048, ND = 1024, NTOK = NB * NT;
constexpr int NPROJ = 3072;
constexpr int PC_QATT = 0, PC_KVLAT = 512, PC_QIDX = 640, PC_DNQKV = 896, PC_DNZ = 2432, PC_KIDX = 2944, PC_WIDX = 2976, PC_BETA = 2984, PC_A = 2988;
constexpr int W_IN_SRC = 2992;
constexpr int NE = 32, EFF = 512;
constexpr int KSPLIT = 16;
constexpr int NTHREADS = 512, NWAVES = 8;
constexpr float EPS = 1e-6f;
constexpr float LOG2E = 1.4426950408889634f;

constexpr size_t MiB = 1ull << 20;
constexpr size_t WS_CTL = 0;
constexpr size_t WS_MODP = WS_CTL + 1 * MiB;
constexpr size_t WS_WIN = WS_MODP + 3 * MiB;
constexpr size_t WS_WOUT = WS_WIN + 6 * MiB;
constexpr size_t WS_W13 = WS_WOUT + 2 * MiB;
constexpr size_t WS_W2 = WS_W13 + 64 * MiB;
constexpr size_t WS_PROJ = WS_W2 + 32 * MiB;
constexpr size_t WS_ACT = WS_PROJ;
constexpr size_t WS_YBUF = WS_PROJ + 32 * MiB;
constexpr size_t WS_QN = WS_PROJ + 96 * MiB;
constexpr size_t WS_K = WS_QN + 16 * MiB;
constexpr size_t WS_V = WS_K + 2 * MiB;
constexpr size_t WS_KI = WS_V + 2 * MiB;
constexpr size_t WS_WI = WS_KI + 1 * MiB;
constexpr size_t WS_DBG = WS_WI + 512 * 1024;
constexpr size_t WS_DQ = WS_DBG + 512 * 1024;
constexpr size_t WS_DK = WS_DQ + 16 * MiB;
constexpr size_t WS_DV = WS_DK + 16 * MiB;
constexpr size_t WS_H2 = WS_DK;
constexpr size_t WS_LIST = WS_DV + 16 * MiB;
constexpr size_t WS_TOKINFO = WS_LIST + 2 * MiB;
constexpr size_t WS_VT = WS_TOKINFO + 512 * 1024;
constexpr size_t WS_POSMM = WS_VT + 2 * MiB;
constexpr size_t WS_END = WS_POSMM + 64 * 1024;

struct P {
    const float* x; const float* c; const int* pos; const float* ada_w; const float* ada_b; const float* norm1_g; const float* norm2_g;
    const float* w_in; const float* q_norm_g; const float* k_norm_g; const float* kv_norm_g; const float* w_kv_up; const float* idx_k_norm_g;
    const float* rel_bias; const float* conv_w; const float* a_log; const float* dt_bias; const float* dn_norm_g; const float* w_out;
    const float* rg_w; const float* rg_b; const float* re_w; const float* re_b; const float* w1; const float* w3; const float* w2;
    float* out; unsigned char* ws;
};

__device__ __forceinline__ float bf2f(bf16_t h) { return __uint_as_float(((unsigned)h) << 16); }
__device__ __forceinline__ bf16_t f2bf(float f) { unsigned u = __float_as_uint(f); u += 0x7fffu + ((u >> 16) & 1u); return (bf16_t)(u >> 16); }
__device__ __forceinline__ unsigned pack2(float a, float b) { return (unsigned)f2bf(a) | ((unsigned)f2bf(b) << 16); }
__device__ __forceinline__ float wave_sum(float v) {
#pragma unroll
    for (int o = 32; o >= 1; o >>= 1) v += __shfl_xor(v, o);
    return v;
}
__device__ __forceinline__ float wave_max(float v) {
#pragma unroll
    for (int o = 32; o >= 1; o >>= 1) v = fmaxf(v, __shfl_xor(v, o));
    return v;
}
__device__ __forceinline__ int wave_isum(int v) {
#pragma unroll
    for (int o = 32; o >= 1; o >>= 1) v += __shfl_xor(v, o);
    return v;
}
__device__ __forceinline__ int tid_opaque() { int t = threadIdx.x; asm volatile("" : "+v"(t)); return t; }
__device__ __forceinline__ float silu_f(float x) { return x / (1.f + __expf(-x)); }
__device__ __forceinline__ float sigmoid_f(float x) { return 1.f / (1.f + __expf(-x)); }
__device__ __forceinline__ float mod_val(const P& p, int b, int which, int d) {
    const float* mp = (const float*)(p.ws + WS_MODP);
    const int col = which * ND + d;
    float s = p.ada_b[col];
#pragma unroll
    for (int ks = 0; ks < KSPLIT; ++ks) s += mp[(size_t)(ks * NB + b) * (6 * ND) + col];
    return s;
}

__device__ __forceinline__ void ph_mod_partial(const P& p) {
    const int tid = tid_opaque();
    const int lane = tid & 63, wave = tid >> 6;
    float* mp = (float*)(p.ws + WS_MODP);
    const int nitem = 96 * KSPLIT;
    for (int it = blockIdx.x * NWAVES + wave; it < nitem; it += gridDim.x * NWAVES) {
        const int cg = it % 96, ks = it / 96;
        const int col = cg * 64 + lane;
        float acc[NB];
#pragma unroll
        for (int b = 0; b < NB; ++b) acc[b] = 0.f;
        for (int kk = 0; kk < ND / KSPLIT; ++kk) {
            const int k = ks * (ND / KSPLIT) + kk;
            const float w = p.ada_w[(size_t)k * (6 * ND) + col];
#pragma unroll
            for (int b = 0; b < NB; ++b) acc[b] += silu_f(p.c[b * ND + k]) * w;
        }
#pragma unroll
        for (int b = 0; b < NB; ++b) mp[(size_t)(ks * NB + b) * (6 * ND) + col] = acc[b];
    }
}

__device__ __forceinline__ int win_src_col(int n) {
    if (n < 896) return n;
    if (n < 2944) return n + 40;
    if (n < 2976) return n - 2944 + 896;
    if (n < 2984) return n - 2976 + 928;
    if (n < 2992) return n;
    return -1;
}
__device__ __forceinline__ void conv_tile(const int tid, float* tile  , const float* src0, const float* src1, int nsrc, int mode, int n0, int k0, bf16_t* dst, int K, int qcol) {
    {
        const int n = tid & 63, r = tid >> 6;
        int col; const float* src = src0;
        if (mode == 0) col = n0 + n;
        else if (mode == 1) col = win_src_col(n0 + n);
        else { col = qcol + (n & 31); if (n >= 32) src = src1; }
#pragma unroll
        for (int i = 0; i < 8; ++i) {
            const int k = r + 8 * i;
            tile[k * 65 + n] = (col >= 0) ? src[(size_t)(k0 + k) * nsrc + col] : 0.f;
        }
    }
    __syncthreads();
    {
        const int n = tid >> 3, kc = tid & 7;
        unsigned w[4];
#pragma unroll
        for (int j = 0; j < 4; ++j) w[j] = pack2(tile[(kc * 8 + 2 * j) * 65 + n], tile[(kc * 8 + 2 * j + 1) * 65 + n]);
        *(uint4*)(dst + (size_t)(n0 + n) * K + k0 + kc * 8) = make_uint4(w[0], w[1], w[2], w[3]);
    }
    __syncthreads();
}
__device__ __forceinline__ void ph_convert(const P& p, char* smem) {
    const int tid = tid_opaque();
    float* tile = (float*)smem;
    bf16_t* Wt_in = (bf16_t*)(p.ws + WS_WIN); bf16_t* Wt_out = (bf16_t*)(p.ws + WS_WOUT);
    bf16_t* Wt13 = (bf16_t*)(p.ws + WS_W13); bf16_t* Wt2 = (bf16_t*)(p.ws + WS_W2);
    const int T0 = 48 * 16, T1 = 16 * 16, T2 = NE * 256, T3 = NE * 128;
    const int total = T0 + T1 + T2 + T3;
    for (int t = blockIdx.x; t < total; t += gridDim.x) {
        if (t < T0) { const int nt = t / 16, kt = t % 16; conv_tile(tid, tile, p.w_in, nullptr, W_IN_SRC, 1, nt * 64, kt * 64, Wt_in, ND, 0); }
        else if (t < T0 + T1) { const int u = t - T0; const int nt = u / 16, kt = u % 16; conv_tile(tid, tile, p.w_out, nullptr, ND, 0, nt * 64, kt * 64, Wt_out, ND, 0); }
        else if (t < T0 + T1 + T2) { const int u = t - T0 - T1; const int e = u / 256, v = u % 256; const int nt = v / 16, kt = v % 16;
            conv_tile(tid, tile, p.w1 + (size_t)e * ND * EFF, p.w3 + (size_t)e * ND * EFF, EFF, 2, nt * 64, kt * 64, Wt13 + (size_t)e * 1024 * ND, ND, nt * 32); }
        else { const int u = t - T0 - T1 - T2; const int e = u / 128, v = u % 128; const int nt = v / 8, kt = v % 8;
            conv_tile(tid, tile, p.w2 + (size_t)e * EFF * ND, nullptr, ND, 0, nt * 64, kt * 64, Wt2 + (size_t)e * ND * EFF, EFF, 0); }
    }
}

__device__ __forceinline__ void ph_norm1(const P& p, char* smem) {
    const int tid = tid_opaque();
    float* sA = (float*)smem; float* sB = sA + ND;
    const int lane = tid & 63, wave = tid >> 6;
    bf16_t* h = (bf16_t*)p.out;
    int curb = -1;
    for (int tile = blockIdx.x; tile < NTOK / 64; tile += gridDim.x) {
        const int b = tile / (NT / 64);
        if (b != curb) {
            __syncthreads();
            for (int d = tid; d < ND; d += NTHREADS) { sA[d] = p.norm1_g[d] * (1.f + mod_val(p, b, 1, d)); sB[d] = mod_val(p, b, 0, d); }
            __syncthreads();
            curb = b;
        }
        for (int i = 0; i < 8; ++i) {
            const int tok = tile * 64 + wave * 8 + i;
            const float* xr = p.x + (size_t)tok * ND;
            f32x4 v[4]; float ss = 0.f;
#pragma unroll
            for (int j = 0; j < 4; ++j) { v[j] = *(const f32x4*)(xr + j * 256 + lane * 4); ss += v[j][0] * v[j][0] + v[j][1] * v[j][1] + v[j][2] * v[j][2] + v[j][3] * v[j][3]; }
            ss = wave_sum(ss);
            const float rstd = rsqrtf(ss * (1.f / ND) + EPS);
#pragma unroll
            for (int j = 0; j < 4; ++j) {
                const int d = j * 256 + lane * 4;
                const float o0 = v[j][0] * rstd * sA[d] + sB[d], o1 = v[j][1] * rstd * sA[d + 1] + sB[d + 1], o2 = v[j][2] * rstd * sA[d + 2] + sB[d + 2], o3 = v[j][3] * rstd * sA[d + 3] + sB[d + 3];
                *(uint2*)(h + (size_t)tok * ND + d) = make_uint2(pack2(o0, o1), pack2(o2, o3));
            }
        }
    }
}

constexpr int LDS_LD = 72;
template <int BM, int BN> struct GemmLds { static constexpr int BYTES = 2 * (BM + BN) * LDS_LD * 2; };
template <int BM, int BN, class AF, class BF>
__device__ __forceinline__ void gemm_tile(const int tid, char* smem, int K, AF aptr, BF bptr, f32x16 (&acc)[2][2]) {
    constexpr int WM = BM / 64;
    constexpr int NA = BM / 64, NBc = BN / 64;
    bf16_t* As = (bf16_t*)smem;
    bf16_t* Bs = As + 2 * BM * LDS_LD;
    const int lane = tid & 63, wave = tid >> 6;
    const int wm = wave % WM, wn = wave / WM;
    uint4 ra0, ra1, ra2, ra3, rb0, rb1, rb2, rb3;
    ra0 = ra1 = ra2 = ra3 = rb0 = rb1 = rb2 = rb3 = make_uint4(0, 0, 0, 0);
#pragma unroll
    for (int m = 0; m < 2; ++m)
#pragma unroll
        for (int n = 0; n < 2; ++n)
#pragma unroll
            for (int r = 0; r < 16; ++r) acc[m][n][r] = 0.f;
    const int nk = K / 64;
    const int cr = tid >> 3, ck = (tid & 7) * 8;
#define GT_LOAD(kt) do { \
        ra0 = *(const uint4*)aptr(cr, (kt) * 64 + ck); ra1 = *(const uint4*)aptr(cr + 64, (kt) * 64 + ck); \
        if constexpr (NA > 2) { ra2 = *(const uint4*)aptr(cr + 128, (kt) * 64 + ck); ra3 = *(const uint4*)aptr(cr + 192, (kt) * 64 + ck); } \
        rb0 = *(const uint4*)bptr(cr, (kt) * 64 + ck); rb1 = *(const uint4*)bptr(cr + 64, (kt) * 64 + ck); \
        if constexpr (NBc > 2) { rb2 = *(const uint4*)bptr(cr + 128, (kt) * 64 + ck); rb3 = *(const uint4*)bptr(cr + 192, (kt) * 64 + ck); } } while (0)
#define GT_STORE(buf) do { \
        bf16_t* as_ = As + ((buf) * BM + cr) * LDS_LD + ck; bf16_t* bs_ = Bs + ((buf) * BN + cr) * LDS_LD + ck; \
        *(uint4*)as_ = ra0; *(uint4*)(as_ + 64 * LDS_LD) = ra1; \
        if constexpr (NA > 2) { *(uint4*)(as_ + 128 * LDS_LD) = ra2; *(uint4*)(as_ + 192 * LDS_LD) = ra3; } \
        *(uint4*)bs_ = rb0; *(uint4*)(bs_ + 64 * LDS_LD) = rb1; \
        if constexpr (NBc > 2) { *(uint4*)(bs_ + 128 * LDS_LD) = rb2; *(uint4*)(bs_ + 192 * LDS_LD) = rb3; } } while (0)
    GT_LOAD(0); GT_STORE(0); __syncthreads();
    for (int kt = 0; kt < nk; ++kt) {
        if (kt + 1 < nk) GT_LOAD(kt + 1);
        const bf16_t* a0 = As + ((kt & 1) * BM + wm * 64 + (lane & 31)) * LDS_LD + 8 * (lane >> 5);
        const bf16_t* b0 = Bs + ((kt & 1) * BN + wn * 64 + (lane & 31)) * LDS_LD + 8 * (lane >> 5);
#pragma unroll
        for (int ks = 0; ks < 4; ++ks) {
            const bf16x8 fa0 = *(const bf16x8*)(a0 + ks * 16), fa1 = *(const bf16x8*)(a0 + 32 * LDS_LD + ks * 16);
            const bf16x8 fb0 = *(const bf16x8*)(b0 + ks * 16), fb1 = *(const bf16x8*)(b0 + 32 * LDS_LD + ks * 16);
            acc[0][0] = __builtin_amdgcn_mfma_f32_32x32x16_bf16(fa0, fb0, acc[0][0], 0, 0, 0);
            acc[0][1] = __builtin_amdgcn_mfma_f32_32x32x16_bf16(fa0, fb1, acc[0][1], 0, 0, 0);
            acc[1][0] = __builtin_amdgcn_mfma_f32_32x32x16_bf16(fa1, fb0, acc[1][0], 0, 0, 0);
            acc[1][1] = __builtin_amdgcn_mfma_f32_32x32x16_bf16(fa1, fb1, acc[1][1], 0, 0, 0);
        }
        if (kt + 1 < nk) GT_STORE((kt + 1) & 1);
        __syncthreads();
    }
}

__device__ __forceinline__ void ph_gemm1(const P& p, char* smem) {
    const int tid = tid_opaque();
    constexpr int BM = 256, BN = 128;
    const bf16_t* h = (const bf16_t*)p.out; const bf16_t* Wt = (const bf16_t*)(p.ws + WS_WIN);
    bf16_t* proj = (bf16_t*)(p.ws + WS_PROJ);
    const int lane = tid & 63, wave = tid >> 6, wm = wave % 4, wn = wave / 4;
    const int ntn = NPROJ / BN, ntiles = (NTOK / BM) * ntn;
    for (int t = blockIdx.x; t < ntiles; t += gridDim.x) {
        const int tm = t / ntn, tn = t % ntn;
        const bf16_t* Ab = h + (size_t)tm * BM * ND; const bf16_t* Bb = Wt + (size_t)tn * BN * ND;
        f32x16 acc[2][2];
        gemm_tile<BM, BN>(tid, smem, ND, [&](int r, int k) __attribute__((always_inline)) { return Ab + (size_t)r * ND + k; }, [&](int r, int k) __attribute__((always_inline)) { return Bb + (size_t)r * ND + k; }, acc);
#pragma unroll
        for (int m = 0; m < 2; ++m)
#pragma unroll
            for (int n = 0; n < 2; ++n)
#pragma unroll
                for (int r = 0; r < 16; ++r) {
                    const int row = tm * BM + wm * 64 + m * 32 + (r & 3) + 8 * (r >> 2) + 4 * (lane >> 5);
                    const int col = tn * BN + wn * 64 + n * 32 + (lane & 31);
                    proj[(size_t)row * NPROJ + col] = f2bf(acc[m][n][r]);
                }
    }
}

__device__ __forceinline__ void ph_post(const P& p, char* smem) {
    const int tid = tid_opaque();
    float* sW = (float*)smem;
    for (int i = tid; i < 128 * 128; i += NTHREADS) sW[i] = p.w_kv_up[i];
    __syncthreads();
    const int lane = tid & 63, wave = tid >> 6;
    const bf16_t* proj = (const bf16_t*)(p.ws + WS_PROJ);
    bf16_t* qn = (bf16_t*)(p.ws + WS_QN); bf16_t* Kb = (bf16_t*)(p.ws + WS_K); bf16_t* Vb = (bf16_t*)(p.ws + WS_V); bf16_t* kib = (bf16_t*)(p.ws + WS_KI);
    float* wi = (float*)(p.ws + WS_WI); float* dbeta = (float*)(p.ws + WS_DBG); float* dg = dbeta + NTOK * 4;
    bf16_t* dq = (bf16_t*)(p.ws + WS_DQ); bf16_t* dk = (bf16_t*)(p.ws + WS_DK); bf16_t* dvv = (bf16_t*)(p.ws + WS_DV);
    bf16_t* Vt = (bf16_t*)(p.ws + WS_VT);
    {
        const int g = blockIdx.x * NTHREADS + tid;
        if (g < NB * 64) { int mn = 0x7fffffff, mx = -0x7fffffff; for (int i = 0; i < 32; ++i) { const int v = p.pos[g * 32 + i]; mn = min(mn, v); mx = max(mx, v); } int* pm = (int*)(p.ws + WS_POSMM); pm[g * 2] = mn; pm[g * 2 + 1] = mx; }
    }
    for (int tok = blockIdx.x * NWAVES + wave; tok < NTOK; tok += gridDim.x * NWAVES) {
        const int t = tok % NT;
        const bf16_t* pr = proj + (size_t)tok * NPROJ;
        {
            const uint4 raw = *(const uint4*)(pr + PC_QATT + lane * 8);
            const unsigned w[4] = {raw.x, raw.y, raw.z, raw.w};
            float v[8]; float ss = 0.f;
#pragma unroll
            for (int j = 0; j < 4; ++j) { v[2 * j] = __uint_as_float(w[j] << 16); v[2 * j + 1] = __uint_as_float(w[j] & 0xffff0000u); }
#pragma unroll
            for (int j = 0; j < 8; ++j) ss += v[j] * v[j];
            ss += __shfl_xor(ss, 1); ss += __shfl_xor(ss, 2); ss += __shfl_xor(ss, 4);
            const float rs = rsqrtf(ss * (1.f / 64.f) + EPS) * (0.125f * LOG2E);
            const int d0 = (lane & 7) * 8;
            unsigned o[4];
#pragma unroll
            for (int j = 0; j < 4; ++j) o[j] = pack2(v[2 * j] * rs * p.q_norm_g[d0 + 2 * j], v[2 * j + 1] * rs * p.q_norm_g[d0 + 2 * j + 1]);
            *(uint4*)(qn + (size_t)tok * 512 + lane * 8) = make_uint4(o[0], o[1], o[2], o[3]);
        }
        {
            const unsigned raw = *(const unsigned*)(pr + PC_KVLAT + lane * 2);
            float a0 = __uint_as_float(raw << 16), a1 = __uint_as_float(raw & 0xffff0000u);
            float ss = wave_sum(a0 * a0 + a1 * a1);
            const float rs = rsqrtf(ss * (1.f / 128.f) + EPS);
            a0 *= rs * p.kv_norm_g[lane * 2]; a1 *= rs * p.kv_norm_g[lane * 2 + 1];
            float k = 0.f, v = 0.f;
#pragma unroll 8
            for (int i = 0; i < 64; ++i) {
                const float x0 = __shfl(a0, i), x1 = __shfl(a1, i);
                k += x0 * sW[(2 * i) * 128 + lane] + x1 * sW[(2 * i + 1) * 128 + lane];
                v += x0 * sW[(2 * i) * 128 + 64 + lane] + x1 * sW[(2 * i + 1) * 128 + 64 + lane];
            }
            const float ks = wave_sum(k * k);
            k *= rsqrtf(ks * (1.f / 64.f) + EPS) * p.k_norm_g[lane];
            Kb[(size_t)tok * 64 + lane] = f2bf(k);
            Vb[(size_t)tok * 64 + lane] = f2bf(v);
            Vt[((size_t)(tok / NT) * 64 + lane) * NT + t] = f2bf(v);
        }
        {
            float a = (lane < 32) ? bf2f(pr[PC_KIDX + lane]) : 0.f;
            const float ss = wave_sum(a * a);
            a *= rsqrtf(ss * (1.f / 32.f) + EPS);
            if (lane < 32) kib[(size_t)tok * 32 + lane] = f2bf(a * p.idx_k_norm_g[lane]);
            if (lane < 8) wi[(size_t)tok * 8 + lane] = bf2f(pr[PC_WIDX + lane]) * 0.35355339059327373f * 0.17677669529663687f;
            if (lane < 4) {
                dbeta[(size_t)tok * 4 + lane] = sigmoid_f(bf2f(pr[PC_BETA + lane]));
                const float z = bf2f(pr[PC_A + lane]) + p.dt_bias[lane];
                const float sp = (z > 20.f) ? z : log1pf(__expf(z));
                dg[(size_t)tok * 4 + lane] = -__expf(p.a_log[lane]) * sp;
            }
        }
#pragma unroll 1
        for (int j = 0; j < 12; ++j) {
            const int ch = j * 128 + lane * 2;
            float y0 = 0.f, y1 = 0.f;
#pragma unroll
            for (int tap = 0; tap < 4; ++tap) {
                const int tt = t - 3 + tap;
                if (tt >= 0) {
                    const unsigned raw = *(const unsigned*)(pr + (ptrdiff_t)(tap - 3) * NPROJ + PC_DNQKV + ch);
                    y0 += p.conv_w[tap * 1536 + ch] * __uint_as_float(raw << 16);
                    y1 += p.conv_w[tap * 1536 + ch + 1] * __uint_as_float(raw & 0xffff0000u);
                }
            }
            y0 = silu_f(y0); y1 = silu_f(y1);
            if (j < 8) {
                const float ss = wave_sum(y0 * y0 + y1 * y1);
                float rs = rsqrtf(ss + EPS);
                if (j < 4) rs *= 0.08838834764831845f;
                y0 *= rs; y1 *= rs;
            }
            bf16_t* dst = (j < 4) ? dq : ((j < 8) ? dk : dvv);
            *(unsigned*)(dst + (size_t)tok * 512 + (j & 3) * 128 + lane * 2) = pack2(y0, y1);
        }
    }
}

__device__ __forceinline__ unsigned f2sortable(float f) { const unsigned u = __float_as_uint(f); return (u & 0x80000000u) ? ~u : (u | 0x80000000u); }
constexpr int ATT_WAVE_LDS = 8192 + 1024 + 2048 + 1024;
constexpr int ATT_LDS = NWAVES * ATT_WAVE_LDS + 132 * 4 + 32 * 8 * 4;
__device__ __forceinline__ void ph_attn_naive(const P& p, char* smem) {
    const int tid = tid_opaque();
    const int lane = tid & 63, wave = tid >> 6;
    int* lut = (int*)(smem + NWAVES * ATT_WAVE_LDS);
    float* sbias = (float*)(lut + 132);
    for (int i = tid; i <= 128; i += NTHREADS) {
        int bk;
        if (i < 16) bk = i;
        else { const float v = logf((float)i / 16.f) / 2.0794415416798357f * 16.f; bk = 16 + (int)v; if (bk > 31) bk = 31; }
        lut[i] = bk;
    }
    for (int i = tid; i < 256; i += NTHREADS) sbias[i] = p.rel_bias[i];
    __syncthreads();
    char* wl = smem + wave * ATT_WAVE_LDS;
    float* sS = (float*)wl;
    float* sQi = (float*)(wl + 8192);
    float* sQ = (float*)(wl + 8192 + 1024);
    int* sSel = (int*)(wl + 8192 + 1024 + 2048);
    const bf16_t* proj = (const bf16_t*)(p.ws + WS_PROJ);
    bf16_t* qn = (bf16_t*)(p.ws + WS_QN); const bf16_t* Kb = (const bf16_t*)(p.ws + WS_K); const bf16_t* Vb = (const bf16_t*)(p.ws + WS_V); const bf16_t* kib = (const bf16_t*)(p.ws + WS_KI);
    const float* wi = (const float*)(p.ws + WS_WI);
    int* qctr = (int*)(p.ws + WS_CTL) + 64;
    for (;;) {
        int q = 0;
        if (lane == 0) q = atomicAdd(qctr, 1);
        q = __shfl(q, 0);
        if (q >= NTOK) break;
        q = NTOK - 1 - q;
        const int b = q / NT, t = q % NT;
        for (int i = lane; i < 256; i += 64) sQi[i] = bf2f(proj[(size_t)q * NPROJ + PC_QIDX + i]);
        for (int i = lane; i < 512; i += 64) sQ[i] = bf2f(qn[(size_t)q * 512 + i]);
        float wv[8];
#pragma unroll
        for (int h = 0; h < 8; ++h) wv[h] = wi[(size_t)q * 8 + h];
        __threadfence_block();
        const int nch = t / 64 + 1;
        for (int i = 0; i < nch; ++i) {
            const int s = i * 64 + lane;
            const bf16_t* kr = kib + (size_t)(b * NT + s) * 32;
            float kf[32];
#pragma unroll
            for (int j = 0; j < 4; ++j) {
                const uint4 raw = *(const uint4*)(kr + j * 8);
                const unsigned w[4] = {raw.x, raw.y, raw.z, raw.w};
#pragma unroll
                for (int u = 0; u < 4; ++u) { kf[j * 8 + 2 * u] = __uint_as_float(w[u] << 16); kf[j * 8 + 2 * u + 1] = __uint_as_float(w[u] & 0xffff0000u); }
            }
            float sc = 0.f;
#pragma unroll
            for (int h = 0; h < 8; ++h) {
                float d = 0.f;
#pragma unroll
                for (int j = 0; j < 32; j += 4) { const f32x4 qv = *(const f32x4*)(sQi + h * 32 + j); d += qv[0] * kf[j] + qv[1] * kf[j + 1] + qv[2] * kf[j + 2] + qv[3] * kf[j + 3]; }
                sc += wv[h] * fmaxf(d, 0.f);
            }
            sS[s] = (s <= t) ? sc : -INFINITY;
        }
        __threadfence_block();
        const int nsel = (t + 1 < 256) ? (t + 1) : 256;
        unsigned u[32];
#pragma unroll
        for (int i = 0; i < 32; ++i) u[i] = (i < nch) ? f2sortable(sS[i * 64 + lane]) : 0u;
        unsigned prefix = 0u; int need = 0;
        if (t + 1 > 256) {
            for (int bit = 31; bit >= 0; --bit) {
                const unsigned cand = prefix | (1u << bit);
                int cnt = 0;
#pragma unroll
                for (int i = 0; i < 32; ++i) cnt += (u[i] >= cand) ? 1 : 0;
                cnt = wave_isum(cnt);
                if (cnt >= 256) prefix = cand;
            }
            int ngt = 0;
#pragma unroll
            for (int i = 0; i < 32; ++i) ngt += (u[i] > prefix) ? 1 : 0;
            ngt = wave_isum(ngt);
            need = 256 - ngt;
        } else { prefix = f2sortable(-INFINITY); need = 0; }
        {
            int base = 0, tierun = 0;
#pragma unroll
            for (int i = 0; i < 32; ++i) {
                const bool gt = u[i] > prefix, tie = (u[i] == prefix) && (t + 1 > 256);
                const unsigned long long tb = __ballot(tie);
                const int trank = tierun + __builtin_popcountll(tb & ((1ull << lane) - 1ull));
                const bool sel = gt || (tie && trank < need);
                const unsigned long long sb = __ballot(sel);
                if (sel) sSel[base + __builtin_popcountll(sb & ((1ull << lane) - 1ull))] = i * 64 + lane;
                base += __builtin_popcountll(sb); tierun += __builtin_popcountll(tb);
            }
        }
        __threadfence_block();
        const int pt = p.pos[q];
#pragma unroll 1
        for (int c = 0; c < 4; ++c) {
            const int j = c * 64 + lane;
            float acc[8];
            if (j < nsel) {
                const int s = sSel[j];
                const bf16_t* kr = Kb + (size_t)(b * NT + s) * 64;
#pragma unroll
                for (int h = 0; h < 8; ++h) acc[h] = 0.f;
#pragma unroll 2
                for (int jj = 0; jj < 8; ++jj) {
                    const uint4 raw = *(const uint4*)(kr + jj * 8);
                    const unsigned w[4] = {raw.x, raw.y, raw.z, raw.w};
                    float kf[8];
#pragma unroll
                    for (int uu = 0; uu < 4; ++uu) { kf[2 * uu] = __uint_as_float(w[uu] << 16); kf[2 * uu + 1] = __uint_as_float(w[uu] & 0xffff0000u); }
#pragma unroll
                    for (int h = 0; h < 8; ++h) {
                        const f32x4 q0 = *(const f32x4*)(sQ + h * 64 + jj * 8), q1 = *(const f32x4*)(sQ + h * 64 + jj * 8 + 4);
                        acc[h] += q0[0] * kf[0] + q0[1] * kf[1] + q0[2] * kf[2] + q0[3] * kf[3] + q1[0] * kf[4] + q1[1] * kf[5] + q1[2] * kf[6] + q1[3] * kf[7];
                    }
                }
                int n = pt - p.pos[b * NT + s]; n = n < 0 ? 0 : (n > 128 ? 128 : n);
                const int bk = lut[n];
#pragma unroll
                for (int h = 0; h < 8; ++h) acc[h] += sbias[bk * 8 + h] * LOG2E;
            } else {
#pragma unroll
                for (int h = 0; h < 8; ++h) acc[h] = -INFINITY;
            }
            *(f32x4*)(sS + j * 8) = (f32x4){acc[0], acc[1], acc[2], acc[3]};
            *(f32x4*)(sS + j * 8 + 4) = (f32x4){acc[4], acc[5], acc[6], acc[7]};
        }
        {
            float lg[4][8];
#pragma unroll
            for (int c = 0; c < 4; ++c) {
                const f32x4 a = *(const f32x4*)(sS + (c * 64 + lane) * 8), bq = *(const f32x4*)(sS + (c * 64 + lane) * 8 + 4);
                lg[c][0] = a[0]; lg[c][1] = a[1]; lg[c][2] = a[2]; lg[c][3] = a[3]; lg[c][4] = bq[0]; lg[c][5] = bq[1]; lg[c][6] = bq[2]; lg[c][7] = bq[3];
            }
#pragma unroll
            for (int h = 0; h < 8; ++h) {
                float m = fmaxf(fmaxf(lg[0][h], lg[1][h]), fmaxf(lg[2][h], lg[3][h]));
                m = wave_max(m);
                float s = 0.f;
#pragma unroll
                for (int c = 0; c < 4; ++c) { lg[c][h] = exp2f(lg[c][h] - m); s += lg[c][h]; }
                s = wave_sum(s);
                const float inv = 1.f / s;
#pragma unroll
                for (int c = 0; c < 4; ++c) lg[c][h] *= inv;
            }
#pragma unroll
            for (int c = 0; c < 4; ++c) {
                *(f32x4*)(sS + (c * 64 + lane) * 8) = (f32x4){lg[c][0], lg[c][1], lg[c][2], lg[c][3]};
                *(f32x4*)(sS + (c * 64 + lane) * 8 + 4) = (f32x4){lg[c][4], lg[c][5], lg[c][6], lg[c][7]};
            }
        }
        __threadfence_block();
        float o[8];
#pragma unroll
        for (int h = 0; h < 8; ++h) o[h] = 0.f;
        for (int j = 0; j < nsel; ++j) {
            const int s = sSel[j];
            const float v = bf2f(Vb[(size_t)(b * NT + s) * 64 + lane]);
            const f32x4 p0 = *(const f32x4*)(sS + j * 8), p1 = *(const f32x4*)(sS + j * 8 + 4);
            o[0] += p0[0] * v; o[1] += p0[1] * v; o[2] += p0[2] * v; o[3] += p0[3] * v;
            o[4] += p1[0] * v; o[5] += p1[1] * v; o[6] += p1[2] * v; o[7] += p1[3] * v;
        }
#pragma unroll
        for (int h = 0; h < 8; ++h) qn[(size_t)q * 512 + h * 64 + lane] = f2bf(o[h]);
        __threadfence_block();
    }
}

template <int CTRL> __device__ __forceinline__ float dpp_f(float v) { return __int_as_float(__builtin_amdgcn_update_dpp(0, __float_as_int(v), CTRL, 0xF, 0xF, false)); }
template <int CTRL> __device__ __forceinline__ int dpp_i(int v) { return __builtin_amdgcn_update_dpp(0, v, CTRL, 0xF, 0xF, false); }
__device__ __forceinline__ float sum8_f(float v) { v += dpp_f<0xB1>(v); v += dpp_f<0x4E>(v); v += dpp_f<0x141>(v); return v; }
__device__ __forceinline__ int sum16_i(int v) { v += dpp_i<0xB1>(v); v += dpp_i<0x4E>(v); v += dpp_i<0x141>(v); v += __shfl_xor(v, 32); return v; }
__device__ __forceinline__ int pi32(int r) { return (r & 0x13) | ((r & 4) << 1) | ((r & 8) >> 1); }
__device__ __forceinline__ constexpr int key_of_reg(int r) { return (r & 3) + 4 * ((r >> 2) & 1) + 16 * (r >> 3); }
struct KiFrag { bf16x8 a0, a1; };
__device__ __forceinline__ KiFrag ki_load(const bf16_t* ki_b, int kt, int lane) {
    const bf16_t* kr = ki_b + (size_t)(kt * 32 + pi32(lane & 31)) * 32 + 8 * (lane >> 5);
    KiFrag f; f.a0 = *(const bf16x8*)kr; f.a1 = *(const bf16x8*)(kr + 16); return f;
}
__device__ __forceinline__ void idx_scores(f32x16& sc, const KiFrag& f, bf16x8 qi0, bf16x8 qi1, float wl) {
    f32x16 z;
#pragma unroll
    for (int r = 0; r < 16; ++r) z[r] = 0.f;
    z = __builtin_amdgcn_mfma_f32_32x32x16_bf16(f.a0, qi0, z, 0, 0, 0);
    z = __builtin_amdgcn_mfma_f32_32x32x16_bf16(f.a1, qi1, z, 0, 0, 0);
#pragma unroll
    for (int r = 0; r < 16; ++r) sc[r] = sum8_f(fmaxf(z[r], 0.f) * wl);
}
constexpr int ATTM_LDS = 129 * 8 * 4;
__device__ __forceinline__ void attn_pass1(const P& p, int b, int t0, int lane, float& tauf, int& cut) {
    const int hf = lane >> 5, cq = (lane & 31) >> 3, ch = lane & 7;
    const int tq = t0 + cq, tok = b * NT + tq;
    const int ntile = (t0 + 3) / 32 + 1;
    const bf16_t* proj = (const bf16_t*)(p.ws + WS_PROJ);
    const bf16_t* ki_b = (const bf16_t*)(p.ws + WS_KI) + (size_t)b * NT * 32;
    const bf16x8 qi0 = *(const bf16x8*)(proj + (size_t)tok * NPROJ + PC_QIDX + ch * 32 + 8 * hf);
    const bf16x8 qi1 = *(const bf16x8*)(proj + (size_t)tok * NPROJ + PC_QIDX + ch * 32 + 16 + 8 * hf);
    const float wl = ((const float*)(p.ws + WS_WI))[(size_t)tok * 8 + ch];
    float keep[8][16];
#pragma unroll
    for (int s = 0; s < 8; ++s)
#pragma unroll
        for (int r = 0; r < 16; ++r) keep[s][r] = -INFINITY;
    KiFrag ring[2];
    ring[0] = ki_load(ki_b, 0, lane);
#pragma unroll
    for (int kt = 0; kt < 64; ++kt) {
        if (kt < ntile) {
            ring[(kt + 1) & 1] = ki_load(ki_b, min(kt + 1, ntile - 1), lane);
            __builtin_amdgcn_sched_barrier(0);
            f32x16 sc;
            idx_scores(sc, ring[kt & 1], qi0, qi1, wl);
            if (kt * 32 + 31 > t0) {
#pragma unroll
                for (int r = 0; r < 16; ++r) sc[r] = (kt * 32 + key_of_reg(r) + 8 * hf <= tq) ? sc[r] : -INFINITY;
            }
            if (ch == (kt & 7)) {
#pragma unroll
                for (int r = 0; r < 16; ++r) keep[kt >> 3][r] = sc[r];
            }
        }
    }
    unsigned u[8][16];
#pragma unroll
    for (int s = 0; s < 8; ++s)
#pragma unroll
        for (int r = 0; r < 16; ++r) u[s][r] = f2sortable(keep[s][r]);
    unsigned prefix = 0u;
    for (int bit = 31; bit >= 0; --bit) {
        const unsigned cand = prefix | (1u << bit);
        int cnt = 0;
#pragma unroll
        for (int s = 0; s < 8; ++s) {
            if (s * 256 <= t0 + 3) {
#pragma unroll
                for (int r = 0; r < 16; ++r) cnt += (u[s][r] >= cand) ? 1 : 0;
            }
        }
        cnt = sum16_i(cnt);
        if (cnt >= 256) prefix = cand;
    }
    int ngt = 0, neq = 0;
#pragma unroll
    for (int s = 0; s < 8; ++s)
#pragma unroll
        for (int r = 0; r < 16; ++r) { ngt += (u[s][r] > prefix) ? 1 : 0; neq += (u[s][r] == prefix) ? 1 : 0; asm volatile("" : "+v"(ngt), "+v"(neq)); }
    ngt = sum16_i(ngt); neq = sum16_i(neq);
    const bool big = tq >= 256;
    const int need = 256 - ngt;
    if (__any(big && need < neq)) {
        int lo = 0, hi = NT - 1;
        for (int it = 0; it < 11; ++it) {
            const int mid = (lo + hi) >> 1;
            int cnt = 0;
            unsigned pf = prefix; asm volatile("" : "+v"(pf));
#pragma unroll
            for (int s = 0; s < 8; ++s)
#pragma unroll
                for (int r = 0; r < 16; ++r) { cnt += (u[s][r] == pf && ((s * 8 + ch) * 32 + key_of_reg(r) + 8 * hf) <= mid) ? 1 : 0; asm volatile("" : "+v"(cnt)); }
            cnt = sum16_i(cnt);
            if (cnt >= need) hi = mid; else lo = mid + 1;
        }
        if (big && need < neq) cut = lo;
    }
    if (big) { const unsigned pu = prefix; tauf = __uint_as_float((pu & 0x80000000u) ? (pu & 0x7fffffffu) : ~pu); }
}
__device__ __forceinline__ void attn_pass2(const P& p, const float* sbl, int b, int t0, int lane, float tauf, int cut) {
    const int hf = lane >> 5, cq = (lane & 31) >> 3, ch = lane & 7;
    const int tq = t0 + cq, tok = b * NT + tq;
    const int ntile = (t0 + 3) / 32 + 1;
    const bf16_t* proj = (const bf16_t*)(p.ws + WS_PROJ);
    bf16_t* qn = (bf16_t*)(p.ws + WS_QN);
    const int* posmm = (const int*)(p.ws + WS_POSMM);
    const bf16_t* ki_b = (const bf16_t*)(p.ws + WS_KI) + (size_t)b * NT * 32;
    const bf16_t* K_b = (const bf16_t*)(p.ws + WS_K) + (size_t)b * NT * 64;
    const bf16_t* Vt_b = (const bf16_t*)(p.ws + WS_VT) + (size_t)b * 64 * NT;
    const bf16x8 qi0 = *(const bf16x8*)(proj + (size_t)tok * NPROJ + PC_QIDX + ch * 32 + 8 * hf);
    const bf16x8 qi1 = *(const bf16x8*)(proj + (size_t)tok * NPROJ + PC_QIDX + ch * 32 + 16 + 8 * hf);
    const float wl = ((const float*)(p.ws + WS_WI))[(size_t)tok * 8 + ch];
    bf16x8 qb[4];
#pragma unroll
    for (int ks = 0; ks < 4; ++ks) qb[ks] = *(const bf16x8*)(qn + (size_t)tok * 512 + ch * 64 + ks * 16 + 8 * hf);
    const int pq = p.pos[tok];
    int pqmin = pq;
    pqmin = min(pqmin, __shfl_xor(pqmin, 8)); pqmin = min(pqmin, __shfl_xor(pqmin, 16));
    pqmin = __builtin_amdgcn_readfirstlane(pqmin);
    const float bias_far = sbl[128 * 8 + ch];
    const bool anycut = __any(cut != 0x7fffffff);
    f32x16 o0, o1;
#pragma unroll
    for (int r = 0; r < 16; ++r) { o0[r] = 0.f; o1[r] = 0.f; }
    float m = -INFINITY, l = 0.f;
    struct TileFrags { KiFrag ki; bf16x8 k[4]; bf16x8 v[4]; };
    auto load_tile = [&](int kt) __attribute__((always_inline)) {
        TileFrags f;
        f.ki = ki_load(ki_b, kt, lane);
        const bf16_t* kr = K_b + (size_t)(kt * 32 + pi32(lane & 31)) * 64 + 8 * hf;
#pragma unroll
        for (int ks = 0; ks < 4; ++ks) f.k[ks] = *(const bf16x8*)(kr + ks * 16);
        const bf16_t* vr = Vt_b + (size_t)(lane & 31) * NT + kt * 32 + 8 * hf;
        f.v[0] = *(const bf16x8*)vr; f.v[1] = *(const bf16x8*)(vr + 16); f.v[2] = *(const bf16x8*)(vr + 32 * NT); f.v[3] = *(const bf16x8*)(vr + 32 * NT + 16);
        return f;
    };
    TileFrags cur = load_tile(0);
    for (int kt = 0; kt < ntile; ++kt) {
        const TileFrags nxt = load_tile(min(kt + 1, ntile - 1));
        f32x16 sc;
        idx_scores(sc, cur.ki, qi0, qi1, wl);
        f32x16 s;
#pragma unroll
        for (int r = 0; r < 16; ++r) s[r] = 0.f;
#pragma unroll
        for (int ks = 0; ks < 4; ++ks) s = __builtin_amdgcn_mfma_f32_32x32x16_bf16(cur.k[ks], qb[ks], s, 0, 0, 0);
        const int kbase = kt * 32 + 8 * hf;
        if (pqmin - posmm[(b * 64 + kt) * 2 + 1] >= 128) {
#pragma unroll
            for (int r = 0; r < 16; ++r) s[r] += bias_far;
        } else {
#pragma unroll
            for (int r = 0; r < 16; ++r) {
                int n = pq - p.pos[b * NT + kbase + key_of_reg(r)];
                n = n < 0 ? 0 : (n > 128 ? 128 : n);
                s[r] += sbl[n * 8 + ch];
            }
        }
        if (anycut) {
#pragma unroll
            for (int r = 0; r < 16; ++r) { const bool ok = (sc[r] > tauf) || (sc[r] == tauf && (kbase + key_of_reg(r)) <= cut); s[r] = ok ? s[r] : -INFINITY; }
        } else {
#pragma unroll
            for (int r = 0; r < 16; ++r) s[r] = (sc[r] >= tauf) ? s[r] : -INFINITY;
        }
        if (kt * 32 + 31 > t0) {
#pragma unroll
            for (int r = 0; r < 16; ++r) s[r] = (kbase + key_of_reg(r) <= tq) ? s[r] : -INFINITY;
        }
        float mx = s[0];
#pragma unroll
        for (int r = 1; r < 16; ++r) mx = fmaxf(mx, s[r]);
        mx = fmaxf(mx, __shfl_xor(mx, 32));
        const float mnew = fmaxf(m, mx);
        const float msafe = (mnew == -INFINITY) ? 0.f : mnew;
        const float alpha = exp2f(m - msafe);
        m = mnew;
        float ps = 0.f;
#pragma unroll
        for (int r = 0; r < 16; ++r) { s[r] = exp2f(s[r] - msafe); ps += s[r]; }
        l = l * alpha + ps;
        if (__any(alpha != 1.f)) {
#pragma unroll
            for (int r = 0; r < 16; ++r) { o0[r] *= alpha; o1[r] *= alpha; }
        }
        bf16x8 pb0, pb1;
#pragma unroll
        for (int jx = 0; jx < 8; ++jx) { pb0[jx] = (short)f2bf(s[jx]); pb1[jx] = (short)f2bf(s[8 + jx]); }
        o0 = __builtin_amdgcn_mfma_f32_32x32x16_bf16(cur.v[0], pb0, o0, 0, 0, 0);
        o0 = __builtin_amdgcn_mfma_f32_32x32x16_bf16(cur.v[1], pb1, o0, 0, 0, 0);
        o1 = __builtin_amdgcn_mfma_f32_32x32x16_bf16(cur.v[2], pb0, o1, 0, 0, 0);
        o1 = __builtin_amdgcn_mfma_f32_32x32x16_bf16(cur.v[3], pb1, o1, 0, 0, 0);
        cur = nxt;
    }
    l += __shfl_xor(l, 32);
    const float inv = 1.f / l;
    bf16_t* orow = qn + (size_t)tok * 512 + ch * 64;
#pragma unroll
    for (int gq = 0; gq < 4; ++gq) {
        *(uint2*)(orow + gq * 8 + 4 * hf) = make_uint2(pack2(o0[gq * 4] * inv, o0[gq * 4 + 1] * inv), pack2(o0[gq * 4 + 2] * inv, o0[gq * 4 + 3] * inv));
        *(uint2*)(orow + 32 + gq * 8 + 4 * hf) = make_uint2(pack2(o1[gq * 4] * inv, o1[gq * 4 + 1] * inv), pack2(o1[gq * 4 + 2] * inv, o1[gq * 4 + 3] * inv));
    }
}
__device__ __forceinline__ void ph_attn_mfma(const P& p, char* smem) {
    const int tid = tid_opaque();
    float* sbl = (float*)smem;
    for (int i = tid; i < 129 * 8; i += NTHREADS) {
        const int n = i >> 3, h = i & 7; int bk;
        if (n < 16) bk = n;
        else { const float v = logf((float)n / 16.f) / 2.0794415416798357f * 16.f; bk = 16 + (int)v; if (bk > 31) bk = 31; }
        sbl[i] = p.rel_bias[bk * 8 + h] * LOG2E;
    }
    __syncthreads();
    int* qctr = (int*)(p.ws + WS_CTL) + 64;
    for (;;) {
        int lane = tid & 63; asm volatile("" : "+v"(lane));
        int w = 0;
        if (lane == 0) w = atomicAdd(qctr, 1);
        w = __builtin_amdgcn_readfirstlane(w);
        if (w >= NTOK / 4) break;
        const int g = w >> 3, j = w & 7;
        const int b = g & 7, t0 = (63 - (g >> 3)) * 32 + (7 - j) * 4;
        float tauf = -INFINITY; int cut = 0x7fffffff;
        if (t0 + 3 >= 256) attn_pass1(p, b, t0, lane, tauf, cut);
        int lane2 = tid & 63; asm volatile("" : "+v"(lane2));
        attn_pass2(p, sbl, b, t0, lane2, tauf, cut);
    }
}

constexpr int DN_LDS = (64 * 129 * 2 + 64 * 65 * 2 + 128 * 33 + 64 * 33 * 2 + 64 * 4) * 4;
__device__ __forceinline__ void ph_dn_naive(const P& p, char* smem) {
    const int tid = tid_opaque();
    float* kc = (float*)smem;
    float* qc = kc + 64 * 129;
    float* Am = qc + 64 * 129;
    float* Pm = Am + 64 * 65;
    float* S = Pm + 64 * 65;
    float* U = S + 128 * 33;
    float* Dl = U + 64 * 33;
    float* sG = Dl + 64 * 33;
    float* sB = sG + 64;
    float* sE = sB + 64;
    float* sL = sE + 64;
    const bf16_t* dq = (const bf16_t*)(p.ws + WS_DQ); const bf16_t* dk = (const bf16_t*)(p.ws + WS_DK); const bf16_t* dvv = (const bf16_t*)(p.ws + WS_DV);
    const float* dbeta = (const float*)(p.ws + WS_DBG); const float* dg = dbeta + NTOK * 4;
    float* dno = p.out;
    for (int item = blockIdx.x; item < NB * 4 * 4; item += gridDim.x) {
        const int b = item / 16, hh = (item / 4) % 4, sl = item % 4;
        for (int i = tid; i < 128 * 33; i += NTHREADS) S[i] = 0.f;
        __syncthreads();
        for (int c = 0; c < NT / 64; ++c) {
            const int tok0 = b * NT + c * 64;
            for (int i = tid; i < 64 * 128; i += NTHREADS) { const int r = i >> 7, d = i & 127; kc[r * 129 + d] = bf2f(dk[(size_t)(tok0 + r) * 512 + hh * 128 + d]); qc[r * 129 + d] = bf2f(dq[(size_t)(tok0 + r) * 512 + hh * 128 + d]); }
            if (tid < 64) {
                const float g = dg[(size_t)(tok0 + tid) * 4 + hh];
                float G = g;
#pragma unroll
                for (int o = 1; o < 64; o <<= 1) { const float n = __shfl_up(G, o); if (tid >= o) G += n; }
                const float Gl = __shfl(G, 63);
                sG[tid] = G; sB[tid] = dbeta[(size_t)(tok0 + tid) * 4 + hh]; sE[tid] = __expf(G); sL[tid] = __expf(Gl - G);
            }
            __syncthreads();
            for (int i = tid; i < 64 * 32; i += NTHREADS) { const int r = i >> 5, e = i & 31; U[r * 33 + e] = sB[r] * bf2f(dvv[(size_t)(tok0 + r) * 512 + hh * 128 + sl * 32 + e]); }
            {
                const int ib = tid >> 4, jb = tid & 15;
                float ak[2][4], ap[2][4];
#pragma unroll
                for (int a = 0; a < 2; ++a)
#pragma unroll
                    for (int bb = 0; bb < 4; ++bb) { ak[a][bb] = 0.f; ap[a][bb] = 0.f; }
                for (int d = 0; d < 128; ++d) {
                    const float k0 = kc[(2 * ib) * 129 + d], k1 = kc[(2 * ib + 1) * 129 + d], q0 = qc[(2 * ib) * 129 + d], q1 = qc[(2 * ib + 1) * 129 + d];
#pragma unroll
                    for (int bb = 0; bb < 4; ++bb) { const float kj = kc[(4 * jb + bb) * 129 + d]; ak[0][bb] += k0 * kj; ak[1][bb] += k1 * kj; ap[0][bb] += q0 * kj; ap[1][bb] += q1 * kj; }
                }
#pragma unroll
                for (int a = 0; a < 2; ++a)
#pragma unroll
                    for (int bb = 0; bb < 4; ++bb) {
                        const int i = 2 * ib + a, j = 4 * jb + bb;
                        const float dec = (j <= i) ? __expf(sG[i] - sG[j]) : 0.f;
                        Am[i * 65 + j] = (j < i) ? sB[i] * ak[a][bb] * dec : 0.f;
                        Pm[i * 65 + j] = ap[a][bb] * dec;
                    }
            }
            __syncthreads();
            for (int i = tid; i < 64 * 128; i += NTHREADS) { const int r = i >> 7, d = i & 127; kc[r * 129 + d] *= sB[r] * sE[r]; }
            __syncthreads();
            if (tid < 160) {
                float* col = (tid < 128) ? (kc + tid) : (U + (tid - 128));
                const int ld = (tid < 128) ? 129 : 33;
                for (int i = 1; i < 64; ++i) {
                    float s = col[i * ld];
                    for (int j = 0; j < i; ++j) s -= Am[i * 65 + j] * col[j * ld];
                    col[i * ld] = s;
                }
            }
            __syncthreads();
            const int oi = tid >> 3, oe = (tid & 7) * 4;
            float o1[4];
            {
                float dl[4] = {0.f, 0.f, 0.f, 0.f}; o1[0] = o1[1] = o1[2] = o1[3] = 0.f;
                for (int d = 0; d < 128; ++d) {
                    const float w = kc[oi * 129 + d], qv = qc[oi * 129 + d];
#pragma unroll
                    for (int e = 0; e < 4; ++e) { const float sv = S[d * 33 + oe + e]; dl[e] += w * sv; o1[e] += qv * sv; }
                }
#pragma unroll
                for (int e = 0; e < 4; ++e) { Dl[oi * 33 + oe + e] = U[oi * 33 + oe + e] - dl[e]; o1[e] *= sE[oi]; }
            }
            __syncthreads();
            {
                for (int j = 0; j <= oi; ++j) {
                    const float pv = Pm[oi * 65 + j];
#pragma unroll
                    for (int e = 0; e < 4; ++e) o1[e] += pv * Dl[j * 33 + oe + e];
                }
                *(f32x4*)(dno + (size_t)(tok0 + oi) * 512 + hh * 128 + sl * 32 + oe) = (f32x4){o1[0], o1[1], o1[2], o1[3]};
            }
            for (int i = tid; i < 64 * 128; i += NTHREADS) { const int r = i >> 7, d = i & 127; kc[r * 129 + d] = bf2f(dk[(size_t)(tok0 + r) * 512 + hh * 128 + d]) * sL[r]; }
            __syncthreads();
            {
                const int d = tid >> 2, e0 = (tid & 3) * 8;
                float a[8];
#pragma unroll
                for (int e = 0; e < 8; ++e) a[e] = 0.f;
                for (int cc = 0; cc < 64; ++cc) {
                    const float kv = kc[cc * 129 + d];
#pragma unroll
                    for (int e = 0; e < 8; ++e) a[e] += kv * Dl[cc * 33 + e0 + e];
                }
                const float gl = sE[63];
#pragma unroll
                for (int e = 0; e < 8; ++e) S[d * 33 + e0 + e] = gl * S[d * 33 + e0 + e] + a[e];
            }
            __syncthreads();
        }
    }
}

__device__ __forceinline__ void ph_dn_gate(const P& p) {
    const int tid = tid_opaque();
    const int lane = tid & 63, wave = tid >> 6;
    const float* dno = p.out; const bf16_t* proj = (const bf16_t*)(p.ws + WS_PROJ); bf16_t* dnn = (bf16_t*)(p.ws + WS_DQ);
    for (int tok = blockIdx.x * NWAVES + wave; tok < NTOK; tok += gridDim.x * NWAVES) {
#pragma unroll
        for (int hh = 0; hh < 4; ++hh) {
            const float o0 = dno[(size_t)tok * 512 + hh * 128 + lane * 2], o1 = dno[(size_t)tok * 512 + hh * 128 + lane * 2 + 1];
            const float ss = wave_sum(o0 * o0 + o1 * o1);
            const float rs = rsqrtf(ss * (1.f / 128.f) + EPS);
            const unsigned zr = *(const unsigned*)(proj + (size_t)tok * NPROJ + PC_DNZ + hh * 128 + lane * 2);
            const float z0 = __uint_as_float(zr << 16), z1 = __uint_as_float(zr & 0xffff0000u);
            *(unsigned*)(dnn + (size_t)tok * 512 + hh * 128 + lane * 2) = pack2(o0 * rs * p.dn_norm_g[lane * 2] * silu_f(z0), o1 * rs * p.dn_norm_g[lane * 2 + 1] * silu_f(z1));
        }
    }
}

__device__ __forceinline__ void ph_gemm_out(const P& p, char* smem) {
    const int tid = tid_opaque();
    constexpr int BM = 256, BN = 128;
    const bf16_t* att = (const bf16_t*)(p.ws + WS_QN); const bf16_t* dnn = (const bf16_t*)(p.ws + WS_DQ); const bf16_t* Wt = (const bf16_t*)(p.ws + WS_WOUT);
    float* sgate = (float*)(smem + GemmLds<BM, BN>::BYTES);
    const int lane = tid & 63, wave = tid >> 6, wm = wave % 4, wn = wave / 4;
    const int ntn = ND / BN, ntiles = (NTOK / BM) * ntn;
    for (int t = blockIdx.x; t < ntiles; t += gridDim.x) {
        const int tm = t / ntn, tn = t % ntn;
        const int b = (tm * BM) / NT;
        if (tid < BN) sgate[tid] = mod_val(p, b, 2, tn * BN + tid);
        const bf16_t* A1 = att + (size_t)tm * BM * 512; const bf16_t* A2 = dnn + (size_t)tm * BM * 512; const bf16_t* Bb = Wt + (size_t)tn * BN * ND;
        f32x16 acc[2][2];
        gemm_tile<BM, BN>(tid, smem, ND, [&](int r, int k) __attribute__((always_inline)) { return (k < 512) ? (A1 + (size_t)r * 512 + k) : (A2 + (size_t)r * 512 + (k - 512)); },
                          [&](int r, int k) __attribute__((always_inline)) { return Bb + (size_t)r * ND + k; }, acc);
#pragma unroll
        for (int m = 0; m < 2; ++m)
#pragma unroll
            for (int n = 0; n < 2; ++n)
#pragma unroll
                for (int r = 0; r < 16; ++r) {
                    const int row = tm * BM + wm * 64 + m * 32 + (r & 3) + 8 * (r >> 2) + 4 * (lane >> 5);
                    const int cl = wn * 64 + n * 32 + (lane & 31);
                    const size_t idx = (size_t)row * ND + tn * BN + cl;
                    p.out[idx] = p.x[idx] + sgate[cl] * acc[m][n][r];
                }
        __syncthreads();
    }
}

constexpr int ROUTE_LDS = 36 * 1024 * 4 + 2 * 1024 * 4;
__device__ __forceinline__ void ph_route(const P& p, char* smem) {
    const int tid = tid_opaque();
    float* sW = (float*)smem;
    float* sA = sW + 36 * 1024; float* sB = sA + 1024;
    const int lane = tid & 63, wave = tid >> 6;
    for (int i = tid; i < 4 * 1024; i += NTHREADS) { const int d = i >> 2, j = i & 3; sW[j * 1024 + d] = p.rg_w[i]; }
    for (int i = tid; i < 32 * 1024; i += NTHREADS) { const int d = i >> 5, j = i & 31; sW[(4 + j) * 1024 + d] = p.re_w[i]; }
    bf16_t* h2 = (bf16_t*)(p.ws + WS_H2);
    int* cnt = (int*)(p.ws + WS_CTL); int* list = (int*)(p.ws + WS_LIST); int* tokinfo = (int*)(p.ws + WS_TOKINFO);
    int curb = -1;
    for (int tile = blockIdx.x; tile < NTOK / 64; tile += gridDim.x) {
        const int b = tile / (NT / 64);
        if (b != curb) {
            __syncthreads();
            for (int d = tid; d < ND; d += NTHREADS) { sA[d] = p.norm2_g[d] * (1.f + mod_val(p, b, 4, d)); sB[d] = mod_val(p, b, 3, d); }
            __syncthreads();
            curb = b;
        }
        for (int i = 0; i < 8; ++i) {
            const int tok = tile * 64 + wave * 8 + i;
            const float* xr = p.out + (size_t)tok * ND;
            float v[16]; float ss = 0.f;
#pragma unroll
            for (int j = 0; j < 16; ++j) { v[j] = xr[j * 64 + lane]; ss += v[j] * v[j]; }
            ss = wave_sum(ss);
            const float rstd = rsqrtf(ss * (1.f / ND) + EPS);
#pragma unroll
            for (int j = 0; j < 16; ++j) { const int d = j * 64 + lane; v[j] = v[j] * rstd * sA[d] + sB[d]; h2[(size_t)tok * ND + d] = f2bf(v[j]); }
            float mylogit = 0.f;
#pragma unroll 4
            for (int o = 0; o < 36; ++o) {
                float a = 0.f;
#pragma unroll
                for (int j = 0; j < 16; ++j) a += v[j] * sW[o * 1024 + j * 64 + lane];
                a = wave_sum(a);
                if (lane == o) mylogit = a;
            }
            if (lane < 4) mylogit += p.rg_b[lane]; else if (lane < 36) mylogit += p.re_b[lane - 4];
            float gl[4];
#pragma unroll
            for (int j = 0; j < 4; ++j) gl[j] = __shfl(mylogit, j);
            int gsel = 0; float gm = gl[0];
#pragma unroll
            for (int j = 1; j < 4; ++j) if (gl[j] > gm) { gm = gl[j]; gsel = j; }
            float gs = 0.f;
#pragma unroll
            for (int j = 0; j < 4; ++j) gs += __expf(gl[j] - gm);
            const float gtop = 1.f / gs;
            float el[8];
#pragma unroll
            for (int j = 0; j < 8; ++j) el[j] = __shfl(mylogit, 4 + gsel * 8 + j);
            int e1 = 0; float m1 = el[0];
#pragma unroll
            for (int j = 1; j < 8; ++j) if (el[j] > m1) { m1 = el[j]; e1 = j; }
            int e2 = -1; float m2 = -INFINITY;
#pragma unroll
            for (int j = 0; j < 8; ++j) if (j != e1 && el[j] > m2) { m2 = el[j]; e2 = j; }
            const float r2 = __expf(m2 - m1);
            const float w1v = gtop / (1.f + r2), w2v = gtop * r2 / (1.f + r2);
            if (lane == 0) {
                const int ea = gsel * 8 + e1, eb = gsel * 8 + e2;
                const int pa = atomicAdd(&cnt[ea], 1), pb = atomicAdd(&cnt[eb], 1);
                list[ea * NTOK + pa] = tok; list[eb * NTOK + pb] = tok;
                int* ti = tokinfo + (size_t)tok * 8;
                ti[0] = ea; ti[1] = pa; ti[2] = eb; ti[3] = pb; ti[4] = __float_as_int(w1v); ti[5] = __float_as_int(w2v);
            }
        }
    }
}

struct MoeIdx { int rowoff[NE + 1]; int tileoff[NE + 1]; };
__device__ __forceinline__ void moe_index(const int tid, const P& p, MoeIdx* mi) {
    if (tid == 0) {
        const int* cnt = (const int*)(p.ws + WS_CTL);
        int r = 0, t = 0;
        for (int e = 0; e < NE; ++e) { mi->rowoff[e] = r; mi->tileoff[e] = t; const int c = cnt[e]; r += c; t += (c + 127) >> 7; }
        mi->rowoff[NE] = r; mi->tileoff[NE] = t;
    }
    __syncthreads();
}

constexpr int MOE_BM = 128, MOE_BN = 256;
__device__ __forceinline__ void ph_moe_up(const P& p, char* smem) {
    const int tid = tid_opaque();
    MoeIdx* mi = (MoeIdx*)(smem + GemmLds<MOE_BM, MOE_BN>::BYTES);
    int* srow = (int*)(mi + 1);
    moe_index(tid, p, mi);
    const bf16_t* h2 = (const bf16_t*)(p.ws + WS_H2); const bf16_t* Wt13 = (const bf16_t*)(p.ws + WS_W13); bf16_t* act = (bf16_t*)(p.ws + WS_ACT);
    const int* list = (const int*)(p.ws + WS_LIST);
    const int lane = tid & 63, wave = tid >> 6, wm = wave % 2, wn = wave / 2;
    const int ntiles = mi->tileoff[NE] * 4;
    for (int t = blockIdx.x; t < ntiles; t += gridDim.x) {
        const int mt = t >> 2, ni = t & 3;
        int e = 0;
        while (mi->tileoff[e + 1] <= mt) ++e;
        const int ml = mt - mi->tileoff[e];
        const int cnt_e = mi->rowoff[e + 1] - mi->rowoff[e];
        const int nrows = min(128, cnt_e - ml * 128);
        if (tid < 128) srow[tid] = list[e * NTOK + ml * 128 + min(tid, nrows - 1)];
        __syncthreads();
        const bf16_t* Bb = Wt13 + ((size_t)e * 1024 + ni * 256) * ND;
        f32x16 acc[2][2];
        gemm_tile<MOE_BM, MOE_BN>(tid, smem, ND, [&](int r, int k) __attribute__((always_inline)) { return h2 + (size_t)srow[r] * ND + k; }, [&](int r, int k) __attribute__((always_inline)) { return Bb + (size_t)r * ND + k; }, acc);
        const int row0 = mi->rowoff[e] + ml * 128;
#pragma unroll
        for (int m = 0; m < 2; ++m)
#pragma unroll
            for (int r = 0; r < 16; ++r) {
                const int rl = wm * 64 + m * 32 + (r & 3) + 8 * (r >> 2) + 4 * (lane >> 5);
                if (rl < nrows) {
                    const float g = acc[m][0][r], u = acc[m][1][r];
                    act[(size_t)(row0 + rl) * EFF + ni * 128 + wn * 32 + (lane & 31)] = f2bf(silu_f(g) * u);
                }
            }
        __syncthreads();
    }
}

__device__ __forceinline__ void ph_moe_down(const P& p, char* smem) {
    const int tid = tid_opaque();
    MoeIdx* mi = (MoeIdx*)(smem + GemmLds<MOE_BM, MOE_BN>::BYTES);
    moe_index(tid, p, mi);
    const bf16_t* act = (const bf16_t*)(p.ws + WS_ACT); const bf16_t* Wt2 = (const bf16_t*)(p.ws + WS_W2); bf16_t* yb = (bf16_t*)(p.ws + WS_YBUF);
    const int lane = tid & 63, wave = tid >> 6, wm = wave % 2, wn = wave / 2;
    const int ntiles = mi->tileoff[NE] * 4;
    for (int t = blockIdx.x; t < ntiles; t += gridDim.x) {
        const int mt = t >> 2, ni = t & 3;
        int e = 0;
        while (mi->tileoff[e + 1] <= mt) ++e;
        const int ml = mt - mi->tileoff[e];
        const int cnt_e = mi->rowoff[e + 1] - mi->rowoff[e];
        const int nrows = min(128, cnt_e - ml * 128);
        const int row0 = mi->rowoff[e] + ml * 128;
        const bf16_t* Ab = act + (size_t)row0 * EFF;
        const bf16_t* Bb = Wt2 + ((size_t)e * ND + ni * 256) * EFF;
        f32x16 acc[2][2];
        gemm_tile<MOE_BM, MOE_BN>(tid, smem, EFF, [&](int r, int k) __attribute__((always_inline)) { return Ab + (size_t)min(r, nrows - 1) * EFF + k; }, [&](int r, int k) __attribute__((always_inline)) { return Bb + (size_t)r * EFF + k; }, acc);
#pragma unroll
        for (int m = 0; m < 2; ++m)
#pragma unroll
            for (int n = 0; n < 2; ++n)
#pragma unroll
                for (int r = 0; r < 16; ++r) {
                    const int rl = wm * 64 + m * 32 + (r & 3) + 8 * (r >> 2) + 4 * (lane >> 5);
                    if (rl < nrows) yb[(size_t)(row0 + rl) * ND + ni * 256 + wn * 64 + n * 32 + (lane & 31)] = f2bf(acc[m][n][r]);
                }
    }
}

__device__ __forceinline__ void ph_combine(const P& p, char* smem) {
    const int tid = tid_opaque();
    MoeIdx* mi = (MoeIdx*)smem;
    float* sG = (float*)(mi + 1);
    moe_index(tid, p, mi);
    const int lane = tid & 63, wave = tid >> 6;
    const bf16_t* yb = (const bf16_t*)(p.ws + WS_YBUF); const int* tokinfo = (const int*)(p.ws + WS_TOKINFO);
    int curb = -1;
    for (int tile = blockIdx.x; tile < NTOK / 64; tile += gridDim.x) {
        const int b = tile / (NT / 64);
        if (b != curb) {
            __syncthreads();
            for (int d = tid; d < ND; d += NTHREADS) sG[d] = mod_val(p, b, 5, d);
            __syncthreads();
            curb = b;
        }
        for (int i = 0; i < 8; ++i) {
            const int tok = tile * 64 + wave * 8 + i;
            const int* ti = tokinfo + (size_t)tok * 8;
            const int ra = mi->rowoff[ti[0]] + ti[1], rb = mi->rowoff[ti[2]] + ti[3];
            const float wa = __int_as_float(ti[4]), wb = __int_as_float(ti[5]);
#pragma unroll
            for (int j = 0; j < 4; ++j) {
                const int d = j * 256 + lane * 4;
                const uint2 ya = *(const uint2*)(yb + (size_t)ra * ND + d), ybv = *(const uint2*)(yb + (size_t)rb * ND + d);
                f32x4 xv = *(const f32x4*)(p.out + (size_t)tok * ND + d);
                xv[0] += sG[d] * (wa * __uint_as_float(ya.x << 16) + wb * __uint_as_float(ybv.x << 16));
                xv[1] += sG[d + 1] * (wa * __uint_as_float(ya.x & 0xffff0000u) + wb * __uint_as_float(ybv.x & 0xffff0000u));
                xv[2] += sG[d + 2] * (wa * __uint_as_float(ya.y << 16) + wb * __uint_as_float(ybv.y << 16));
                xv[3] += sG[d + 3] * (wa * __uint_as_float(ya.y & 0xffff0000u) + wb * __uint_as_float(ybv.y & 0xffff0000u));
                *(f32x4*)(p.out + (size_t)tok * ND + d) = xv;
            }
        }
    }
}

namespace cg = cooperative_groups;
extern __shared__ __attribute__((aligned(16))) char dyn_smem[];
constexpr int cmax(int a, int b) { return a > b ? a : b; }
constexpr int L_G1 = GemmLds<256, 128>::BYTES + 512;
constexpr int L_MOE = GemmLds<MOE_BM, MOE_BN>::BYTES + (int)sizeof(MoeIdx) + 128 * 4;
constexpr int MEGA_LDS = cmax(cmax(cmax(ROUTE_LDS, DN_LDS), cmax(ATT_LDS, L_G1)), L_MOE);
typedef const unsigned long long __attribute__((address_space(4)))* kargp_t;
__device__ __forceinline__ void load_params(P& p, kargp_t ka) {
    asm volatile("" : "+s"(ka));
    unsigned long long* d = (unsigned long long*)&p;
#pragma unroll
    for (int i = 0; i < (int)(sizeof(P) / 8); ++i) d[i] = ka[i];
}
#define PHASE(call) do { P p; load_params(p, ka); call; } while (0)
__global__ void __launch_bounds__(NTHREADS) mega(P p_arg) {
    cg::grid_group grid = cg::this_grid();
    char* smem = dyn_smem;
    kargp_t ka = (kargp_t)__builtin_amdgcn_kernarg_segment_ptr();
    PHASE(ph_mod_partial(p));
    PHASE(ph_convert(p, smem));
    grid.sync();
    PHASE(ph_norm1(p, smem));
    grid.sync();
    PHASE(ph_gemm1(p, smem));
    grid.sync();
    PHASE(ph_post(p, smem));
    grid.sync();
    if (blockIdx.x < NB * 16) PHASE(ph_dn_naive(p, smem));
    __syncthreads();
    PHASE(ph_attn_mfma(p, smem));
    grid.sync();
    PHASE(ph_dn_gate(p));
    grid.sync();
    PHASE(ph_gemm_out(p, smem));
    grid.sync();
    PHASE(ph_route(p, smem));
    grid.sync();
    PHASE(ph_moe_up(p, smem));
    grid.sync();
    PHASE(ph_moe_down(p, smem));
    grid.sync();
    PHASE(ph_combine(p, smem));
}

extern "C" void kernel_launch(void* const* d_in, const int* in_sizes, int n_in, void* d_out, int out_size, void* d_ws, size_t ws_size, hipStream_t stream) {
    if (n_in != 26 || out_size != NTOK * ND || ws_size < WS_END) { fprintf(stderr, "kernel_launch: unexpected shapes (n_in %d out %d ws %zu need %zu)\n", n_in, out_size, ws_size, (size_t)WS_END); return; }
    static int grid_blocks = 0;
    if (!grid_blocks) {
        int dev = 0, cus = 0, per_cu = 0;
        (void)hipGetDevice(&dev);
        (void)hipDeviceGetAttribute(&cus, hipDeviceAttributeMultiprocessorCount, dev);
        (void)hipFuncSetAttribute((const void*)mega, hipFuncAttributeMaxDynamicSharedMemorySize, MEGA_LDS);
        (void)hipOccupancyMaxActiveBlocksPerMultiprocessor(&per_cu, (const void*)mega, NTHREADS, MEGA_LDS);
        if (per_cu < 1) { fprintf(stderr, "kernel_launch: occupancy query says %d blocks/CU\n", per_cu); per_cu = 1; }
        grid_blocks = cus * per_cu;
    }
    P p{};
    const float** fp = (const float**)&p;
    for (int i = 0; i < 26; ++i) fp[i] = (const float*)d_in[i];
    p.pos = (const int*)d_in[2];
    p.out = (float*)d_out; p.ws = (unsigned char*)d_ws;
    (void)hipMemsetAsync((char*)d_ws + WS_CTL, 0, 4096, stream);
    void* args[] = {&p};
    hipError_t e = hipLaunchCooperativeKernel((const void*)mega, dim3(grid_blocks), dim3(NTHREADS), args, MEGA_LDS, stream);
    if (e != hipSuccess) fprintf(stderr, "cooperative launch failed: %s (grid %d)\n", hipGetErrorString(e), grid_blocks);
}
```

```cpp
#include <hip/hip_runtime.h>
#include <hip/hip_cooperative_groups.h>
#include <cstdio>
#include <cstdint>

typedef unsigned short bf16_t;
typedef short bf16x8 __attribute__((ext_vector_type(8)));
typedef float f32x16 __attribute__((ext_vector_type(16)));
typedef float f32x4 __attribute__((ext_vector_type(4)));

constexpr int NB = 8, NT = 2048, ND = 1024, NTOK = NB * NT;
constexpr int NPROJ = 3072;
constexpr int PC_QATT = 0, PC_KVLAT = 512, PC_QIDX = 640, PC_DNQKV = 896, PC_DNZ = 2432, PC_KIDX = 2944, PC_WIDX = 2976, PC_BETA = 2984, PC_A = 2988;
constexpr int W_IN_SRC = 2992;
constexpr int NE = 32, EFF = 512;
constexpr int KSPLIT = 16;
constexpr int NTHREADS = 512, NWAVES = 8;
constexpr float EPS = 1e-6f;
constexpr float LOG2E = 1.4426950408889634f;

constexpr size_t MiB = 1ull << 20;
constexpr size_t WS_CTL = 0;
constexpr size_t WS_MODP = WS_CTL + 1 * MiB;
constexpr size_t WS_WIN = WS_MODP + 3 * MiB;
constexpr size_t WS_WOUT = WS_WIN + 6 * MiB;
constexpr size_t WS_W13 = WS_WOUT + 2 * MiB;
constexpr size_t WS_W2 = WS_W13 + 64 * MiB;
constexpr size_t WS_PROJ = WS_W2 + 32 * MiB;
constexpr size_t WS_ACT = WS_PROJ;
constexpr size_t WS_YBUF = WS_PROJ + 32 * MiB;
constexpr size_t WS_QN = WS_PROJ + 96 * MiB;
constexpr size_t WS_K = WS_QN + 16 * MiB;
constexpr size_t WS_KI = WS_K + 2 * MiB;
constexpr size_t WS_WI = WS_KI + 1 * MiB;
constexpr size_t WS_DBG = WS_WI + 512 * 1024;
constexpr size_t WS_DQ = WS_DBG + 512 * 1024;
constexpr size_t WS_DK = WS_DQ + 16 * MiB;
constexpr size_t WS_H2 = WS_DQ;
constexpr size_t WS_DKT = WS_DK + 16 * MiB;
constexpr size_t WS_DVT = WS_DKT + 16 * MiB;
constexpr size_t WS_END = WS_DVT + 16 * MiB;
constexpr size_t WS_LIST = WS_K;
constexpr size_t WS_TOKINFO = WS_KI;
constexpr size_t WS_VT = WS_WIN;
constexpr size_t WS_POSMM = WS_WIN + 2 * MiB;
constexpr size_t DO_WN = 0, DO_U = 16 * MiB, DO_DNO = 32 * MiB, DO_PP = 48 * MiB, DO_EG = 56 * MiB, DO_LL = DO_EG + 256 * 1024, DO_GC = DO_LL + 256 * 1024;

struct P {
    const float* x; const float* c; const int* pos; const float* ada_w; const float* ada_b; const float* norm1_g; const float* norm2_g;
    const float* w_in; const float* q_norm_g; const float* k_norm_g; const float* kv_norm_g; const float* w_kv_up; const float* idx_k_norm_g;
    const float* rel_bias; const float* conv_w; const float* a_log; const float* dt_bias; const float* dn_norm_g; const float* w_out;
    const float* rg_w; const float* rg_b; const float* re_w; const float* re_b; const float* w1; const float* w3; const float* w2;
    float* out; unsigned char* ws;
};

__device__ __forceinline__ float bf2f(bf16_t h) { return __uint_as_float(((unsigned)h) << 16); }
__device__ __forceinline__ bf16_t f2bf(float f) { unsigned u = __float_as_uint(f); u += 0x7fffu + ((u >> 16) & 1u); return (bf16_t)(u >> 16); }
__device__ __forceinline__ unsigned pack2(float a, float b) { return (unsigned)f2bf(a) | ((unsigned)f2bf(b) << 16); }
__device__ __forceinline__ float wave_sum(float v) {
#pragma unroll
    for (int o = 32; o >= 1; o >>= 1) v += __shfl_xor(v, o);
    return v;
}
__device__ __forceinline__ float wave_max(float v) {
#pragma unroll
    for (int o = 32; o >= 1; o >>= 1) v = fmaxf(v, __shfl_xor(v, o));
    return v;
}
__device__ __forceinline__ int wave_isum(int v) {
#pragma unroll
    for (int o = 32; o >= 1; o >>= 1) v += __shfl_xor(v, o);
    return v;
}
__device__ __forceinline__ int tid_opaque() { int t = threadIdx.x; asm volatile("" : "+v"(t)); return t; }
__device__ __forceinline__ float silu_f(float x) { return x / (1.f + __expf(-x)); }
__device__ __forceinline__ float sigmoid_f(float x) { return 1.f / (1.f + __expf(-x)); }
__device__ __forceinline__ float mod_val(const P& p, int b, int which, int d) {
    const float* mp = (const float*)(p.ws + WS_MODP);
    const int col = which * ND + d;
    float s = p.ada_b[col];
#pragma unroll
    for (int ks = 0; ks < KSPLIT; ++ks) s += mp[(size_t)(ks * NB + b) * (6 * ND) + col];
    return s;
}

__device__ __forceinline__ void ph_mod_partial(const P& p) {
    const int tid = tid_opaque();
    const int lane = tid & 63, wave = tid >> 6;
    float* mp = (float*)(p.ws + WS_MODP);
    const int nitem = 96 * KSPLIT;
    for (int it = blockIdx.x * NWAVES + wave; it < nitem; it += gridDim.x * NWAVES) {
        const int cg = it % 96, ks = it / 96;
        const int col = cg * 64 + lane;
        float acc[NB];
#pragma unroll
        for (int b = 0; b < NB; ++b) acc[b] = 0.f;
        for (int kk = 0; kk < ND / KSPLIT; ++kk) {
            const int k = ks * (ND / KSPLIT) + kk;
            const float w = p.ada_w[(size_t)k * (6 * ND) + col];
#pragma unroll
            for (int b = 0; b < NB; ++b) acc[b] += silu_f(p.c[b * ND + k]) * w;
        }
#pragma unroll
        for (int b = 0; b < NB; ++b) mp[(size_t)(ks * NB + b) * (6 * ND) + col] = acc[b];
    }
}

__device__ __forceinline__ int win_src_col(int n) {
    if (n < 896) return n;
    if (n < 2944) return n + 40;
    if (n < 2976) return n - 2944 + 896;
    if (n < 2984) return n - 2976 + 928;
    if (n < 2992) return n;
    return -1;
}
__device__ __forceinline__ void conv_tile(const int tid, float* tile  , const float* src0, const float* src1, int nsrc, int mode, int n0, int k0, bf16_t* dst, int K, int qcol) {
    {
        const int n = tid & 63, r = tid >> 6;
        int col; const float* src = src0;
        if (mode == 0) col = n0 + n;
        else if (mode == 1) col = win_src_col(n0 + n);
        else { col = qcol + (n & 31); if (n >= 32) src = src1; }
#pragma unroll
        for (int i = 0; i < 8; ++i) {
            const int k = r + 8 * i;
            tile[k * 65 + n] = (col >= 0) ? src[(size_t)(k0 + k) * nsrc + col] : 0.f;
        }
    }
    __syncthreads();
    {
        const int n = tid >> 3, kc = tid & 7;
        unsigned w[4];
#pragma unroll
        for (int j = 0; j < 4; ++j) w[j] = pack2(tile[(kc * 8 + 2 * j) * 65 + n], tile[(kc * 8 + 2 * j + 1) * 65 + n]);
        *(uint4*)(dst + (size_t)(n0 + n) * K + k0 + kc * 8) = make_uint4(w[0], w[1], w[2], w[3]);
    }
    __syncthreads();
}
__device__ __forceinline__ void ph_convert(const P& p, char* smem) {
    const int tid = tid_opaque();
    float* tile = (float*)smem;
    bf16_t* Wt_in = (bf16_t*)(p.ws + WS_WIN); bf16_t* Wt_out = (bf16_t*)(p.ws + WS_WOUT);
    bf16_t* Wt13 = (bf16_t*)(p.ws + WS_W13); bf16_t* Wt2 = (bf16_t*)(p.ws + WS_W2);
    const int T0 = 48 * 16, T1 = 16 * 16, T2 = NE * 256, T3 = NE * 128;
    const int total = T0 + T1 + T2 + T3;
    for (int t = blockIdx.x; t < total; t += gridDim.x) {
        if (t < T0) { const int nt = t / 16, kt = t % 16; conv_tile(tid, tile, p.w_in, nullptr, W_IN_SRC, 1, nt * 64, kt * 64, Wt_in, ND, 0); }
        else if (t < T0 + T1) { const int u = t - T0; const int nt = u / 16, kt = u % 16; conv_tile(tid, tile, p.w_out, nullptr, ND, 0, nt * 64, kt * 64, Wt_out, ND, 0); }
        else if (t < T0 + T1 + T2) { const int u = t - T0 - T1; const int e = u / 256, v = u % 256; const int nt = v / 16, kt = v % 16;
            conv_tile(tid, tile, p.w1 + (size_t)e * ND * EFF, p.w3 + (size_t)e * ND * EFF, EFF, 2, nt * 64, kt * 64, Wt13 + (size_t)e * 1024 * ND, ND, nt * 32); }
        else { const int u = t - T0 - T1 - T2; const int e = u / 128, v = u % 128; const int nt = v / 8, kt = v % 8;
            conv_tile(tid, tile, p.w2 + (size_t)e * EFF * ND, nullptr, ND, 0, nt * 64, kt * 64, Wt2 + (size_t)e * ND * EFF, EFF, 0); }
    }
}

__device__ __forceinline__ void ph_norm1(const P& p, char* smem) {
    const int tid = tid_opaque();
    float* sA = (float*)smem; float* sB = sA + ND;
    const int lane = tid & 63, wave = tid >> 6;
    bf16_t* h = (bf16_t*)p.out;
    int curb = -1;
    for (int tile = blockIdx.x; tile < NTOK / 64; tile += gridDim.x) {
        const int b = tile / (NT / 64);
        if (b != curb) {
            __syncthreads();
            for (int d = tid; d < ND; d += NTHREADS) { sA[d] = p.norm1_g[d] * (1.f + mod_val(p, b, 1, d)); sB[d] = mod_val(p, b, 0, d); }
            __syncthreads();
            curb = b;
        }
        for (int i = 0; i < 8; ++i) {
            const int tok = tile * 64 + wave * 8 + i;
            const float* xr = p.x + (size_t)tok * ND;
            f32x4 v[4]; float ss = 0.f;
#pragma unroll
            for (int j = 0; j < 4; ++j) { v[j] = *(const f32x4*)(xr + j * 256 + lane * 4); ss += v[j][0] * v[j][0] + v[j][1] * v[j][1] + v[j][2] * v[j][2] + v[j][3] * v[j][3]; }
            ss = wave_sum(ss);
            const float rstd = rsqrtf(ss * (1.f / ND) + EPS);
#pragma unroll
            for (int j = 0; j < 4; ++j) {
                const int d = j * 256 + lane * 4;
                const float o0 = v[j][0] * rstd * sA[d] + sB[d], o1 = v[j][1] * rstd * sA[d + 1] + sB[d + 1], o2 = v[j][2] * rstd * sA[d + 2] + sB[d + 2], o3 = v[j][3] * rstd * sA[d + 3] + sB[d + 3];
                *(uint2*)(h + (size_t)tok * ND + d) = make_uint2(pack2(o0, o1), pack2(o2, o3));
            }
        }
    }
}

constexpr int LDS_LD = 72;
template <int BM, int BN> struct GemmLds { static constexpr int BYTES = 2 * (BM + BN) * LDS_LD * 2; };
template <int BM, int BN, class AF, class BF>
__device__ __forceinline__ void gemm_tile(const int tid, char* smem, int K, AF aptr, BF bptr, f32x16 (&acc)[2][2]) {
    constexpr int WM = BM / 64;
    constexpr int NA = BM / 64, NBc = BN / 64;
    bf16_t* As = (bf16_t*)smem;
    bf16_t* Bs = As + 2 * BM * LDS_LD;
    const int lane = tid & 63, wave = tid >> 6;
    const int wm = wave % WM, wn = wave / WM;
    uint4 ra0, ra1, ra2, ra3, rb0, rb1, rb2, rb3;
    ra0 = ra1 = ra2 = ra3 = rb0 = rb1 = rb2 = rb3 = make_uint4(0, 0, 0, 0);
#pragma unroll
    for (int m = 0; m < 2; ++m)
#pragma unroll
        for (int n = 0; n < 2; ++n)
#pragma unroll
            for (int r = 0; r < 16; ++r) acc[m][n][r] = 0.f;
    const int nk = K / 64;
    const int cr = tid >> 3, ck = (tid & 7) * 8;
#define GT_LOAD(kt) do { \
        ra0 = *(const uint4*)aptr(cr, (kt) * 64 + ck); ra1 = *(const uint4*)aptr(cr + 64, (kt) * 64 + ck); \
        if constexpr (NA > 2) { ra2 = *(const uint4*)aptr(cr + 128, (kt) * 64 + ck); ra3 = *(const uint4*)aptr(cr + 192, (kt) * 64 + ck); } \
        rb0 = *(const uint4*)bptr(cr, (kt) * 64 + ck); rb1 = *(const uint4*)bptr(cr + 64, (kt) * 64 + ck); \
        if constexpr (NBc > 2) { rb2 = *(const uint4*)bptr(cr + 128, (kt) * 64 + ck); rb3 = *(const uint4*)bptr(cr + 192, (kt) * 64 + ck); } } while (0)
#define GT_STORE(buf) do { \
        bf16_t* as_ = As + ((buf) * BM + cr) * LDS_LD + ck; bf16_t* bs_ = Bs + ((buf) * BN + cr) * LDS_LD + ck; \
        *(uint4*)as_ = ra0; *(uint4*)(as_ + 64 * LDS_LD) = ra1; \
        if constexpr (NA > 2) { *(uint4*)(as_ + 128 * LDS_LD) = ra2; *(uint4*)(as_ + 192 * LDS_LD) = ra3; } \
        *(uint4*)bs_ = rb0; *(uint4*)(bs_ + 64 * LDS_LD) = rb1; \
        if constexpr (NBc > 2) { *(uint4*)(bs_ + 128 * LDS_LD) = rb2; *(uint4*)(bs_ + 192 * LDS_LD) = rb3; } } while (0)
    GT_LOAD(0); GT_STORE(0); __syncthreads();
    for (int kt = 0; kt < nk; ++kt) {
        if (kt + 1 < nk) GT_LOAD(kt + 1);
        const bf16_t* a0 = As + ((kt & 1) * BM + wm * 64 + (lane & 31)) * LDS_LD + 8 * (lane >> 5);
        const bf16_t* b0 = Bs + ((kt & 1) * BN + wn * 64 + (lane & 31)) * LDS_LD + 8 * (lane >> 5);
#pragma unroll
        for (int ks = 0; ks < 4; ++ks) {
            const bf16x8 fa0 = *(const bf16x8*)(a0 + ks * 16), fa1 = *(const bf16x8*)(a0 + 32 * LDS_LD + ks * 16);
            const bf16x8 fb0 = *(const bf16x8*)(b0 + ks * 16), fb1 = *(const bf16x8*)(b0 + 32 * LDS_LD + ks * 16);
            acc[0][0] = __builtin_amdgcn_mfma_f32_32x32x16_bf16(fa0, fb0, acc[0][0], 0, 0, 0);
            acc[0][1] = __builtin_amdgcn_mfma_f32_32x32x16_bf16(fa0, fb1, acc[0][1], 0, 0, 0);
            acc[1][0] = __builtin_amdgcn_mfma_f32_32x32x16_bf16(fa1, fb0, acc[1][0], 0, 0, 0);
            acc[1][1] = __builtin_amdgcn_mfma_f32_32x32x16_bf16(fa1, fb1, acc[1][1], 0, 0, 0);
        }
        if (kt + 1 < nk) GT_STORE((kt + 1) & 1);
        __syncthreads();
    }
}

__device__ __forceinline__ void ph_gemm1(const P& p, char* smem) {
    const int tid = tid_opaque();
    constexpr int BM = 256, BN = 128;
    const bf16_t* h = (const bf16_t*)p.out; const bf16_t* Wt = (const bf16_t*)(p.ws + WS_WIN);
    bf16_t* proj = (bf16_t*)(p.ws + WS_PROJ);
    const int lane = tid & 63, wave = tid >> 6, wm = wave % 4, wn = wave / 4;
    const int ntn = NPROJ / BN, ntiles = (NTOK / BM) * ntn;
    for (int t = blockIdx.x; t < ntiles; t += gridDim.x) {
        const int tm = t / ntn, tn = t % ntn;
        const bf16_t* Ab = h + (size_t)tm * BM * ND; const bf16_t* Bb = Wt + (size_t)tn * BN * ND;
        f32x16 acc[2][2];
        gemm_tile<BM, BN>(tid, smem, ND, [&](int r, int k) __attribute__((always_inline)) { return Ab + (size_t)r * ND + k; }, [&](int r, int k) __attribute__((always_inline)) { return Bb + (size_t)r * ND + k; }, acc);
#pragma unroll
        for (int m = 0; m < 2; ++m)
#pragma unroll
            for (int n = 0; n < 2; ++n)
#pragma unroll
                for (int r = 0; r < 16; ++r) {
                    const int row = tm * BM + wm * 64 + m * 32 + (r & 3) + 8 * (r >> 2) + 4 * (lane >> 5);
                    const int col = tn * BN + wn * 64 + n * 32 + (lane & 31);
                    proj[(size_t)row * NPROJ + col] = f2bf(acc[m][n][r]);
                }
    }
}

__device__ __forceinline__ void ph_post(const P& p, char* smem) {
    const int tid = tid_opaque();
    float* sW = (float*)smem;
    for (int i = tid; i < 128 * 128; i += NTHREADS) sW[i] = p.w_kv_up[i];
    __syncthreads();
    const int lane = tid & 63, wave = tid >> 6;
    const bf16_t* proj = (const bf16_t*)(p.ws + WS_PROJ);
    bf16_t* qn = (bf16_t*)(p.ws + WS_QN); bf16_t* Kb = (bf16_t*)(p.ws + WS_K); bf16_t* kib = (bf16_t*)(p.ws + WS_KI);
    float* wi = (float*)(p.ws + WS_WI); float* dbeta = (float*)(p.ws + WS_DBG); float* dg = dbeta + NTOK * 4;
    bf16_t* dq = (bf16_t*)(p.ws + WS_DQ); bf16_t* dk = (bf16_t*)(p.ws + WS_DK); bf16_t* dkT = (bf16_t*)(p.ws + WS_DKT); bf16_t* dvT = (bf16_t*)(p.ws + WS_DVT);
    bf16_t* Vt = (bf16_t*)(p.ws + WS_VT);
    {
        const int g = blockIdx.x * NTHREADS + tid;
        if (g < NB * 64) { int mn = 0x7fffffff, mx = -0x7fffffff; for (int i = 0; i < 32; ++i) { const int v = p.pos[g * 32 + i]; mn = min(mn, v); mx = max(mx, v); } int* pm = (int*)(p.ws + WS_POSMM); pm[g * 2] = mn; pm[g * 2 + 1] = mx; }
    }
    for (int tg = blockIdx.x * NWAVES + wave; tg < NTOK / 8; tg += gridDim.x * NWAVES) {
      for (int ti = 0; ti < 8; ++ti) {
        const int tok = tg * 8 + ti;
        const int t = tok % NT;
        const bf16_t* pr = proj + (size_t)tok * NPROJ;
        {
            const uint4 raw = *(const uint4*)(pr + PC_QATT + lane * 8);
            const unsigned w[4] = {raw.x, raw.y, raw.z, raw.w};
            float v[8]; float ss = 0.f;
#pragma unroll
            for (int j = 0; j < 4; ++j) { v[2 * j] = __uint_as_float(w[j] << 16); v[2 * j + 1] = __uint_as_float(w[j] & 0xffff0000u); }
#pragma unroll
            for (int j = 0; j < 8; ++j) ss += v[j] * v[j];
            ss += __shfl_xor(ss, 1); ss += __shfl_xor(ss, 2); ss += __shfl_xor(ss, 4);
            const float rs = rsqrtf(ss * (1.f / 64.f) + EPS) * (0.125f * LOG2E);
            const int d0 = (lane & 7) * 8;
            unsigned o[4];
#pragma unroll
            for (int j = 0; j < 4; ++j) o[j] = pack2(v[2 * j] * rs * p.q_norm_g[d0 + 2 * j], v[2 * j + 1] * rs * p.q_norm_g[d0 + 2 * j + 1]);
            *(uint4*)(qn + (size_t)tok * 512 + lane * 8) = make_uint4(o[0], o[1], o[2], o[3]);
        }
        {
            const unsigned raw = *(const unsigned*)(pr + PC_KVLAT + lane * 2);
            float a0 = __uint_as_float(raw << 16), a1 = __uint_as_float(raw & 0xffff0000u);
            float ss = wave_sum(a0 * a0 + a1 * a1);
            const float rs = rsqrtf(ss * (1.f / 128.f) + EPS);
            a0 *= rs * p.kv_norm_g[lane * 2]; a1 *= rs * p.kv_norm_g[lane * 2 + 1];
            float k = 0.f, v = 0.f;
#pragma unroll 8
            for (int i = 0; i < 64; ++i) {
                const float x0 = __shfl(a0, i), x1 = __shfl(a1, i);
                k += x0 * sW[(2 * i) * 128 + lane] + x1 * sW[(2 * i + 1) * 128 + lane];
                v += x0 * sW[(2 * i) * 128 + 64 + lane] + x1 * sW[(2 * i + 1) * 128 + 64 + lane];
            }
            const float ks = wave_sum(k * k);
            k *= rsqrtf(ks * (1.f / 64.f) + EPS) * p.k_norm_g[lane];
            Kb[(size_t)tok * 64 + lane] = f2bf(k);
            Vt[((size_t)(tok / NT) * 64 + lane) * NT + t] = f2bf(v);
        }
        {
            float a = (lane < 32) ? bf2f(pr[PC_KIDX + lane]) : 0.f;
            const float ss = wave_sum(a * a);
            a *= rsqrtf(ss * (1.f / 32.f) + EPS);
            if (lane < 32) kib[(size_t)tok * 32 + lane] = f2bf(a * p.idx_k_norm_g[lane]);
            if (lane < 8) wi[(size_t)tok * 8 + lane] = bf2f(pr[PC_WIDX + lane]) * 0.35355339059327373f * 0.17677669529663687f;
            if (lane < 4) {
                dbeta[(size_t)tok * 4 + lane] = sigmoid_f(bf2f(pr[PC_BETA + lane]));
                const float z = bf2f(pr[PC_A + lane]) + p.dt_bias[lane];
                const float sp = (z > 20.f) ? z : log1pf(__expf(z));
                dg[(size_t)tok * 4 + lane] = -__expf(p.a_log[lane]) * sp;
            }
        }
      }
        {
            const int tok0 = tg * 8, t0 = tok0 % NT, bb = tok0 / NT;
#pragma unroll 1
            for (int j = 0; j < 12; ++j) {
                const int ch = j * 128 + lane * 2;
                float w0[11], w1[11];
#pragma unroll
                for (int i = 0; i < 11; ++i) {
                    unsigned raw = 0u;
                    if (t0 - 3 + i >= 0) raw = *(const unsigned*)(proj + (size_t)(tok0 - 3 + i) * NPROJ + PC_DNQKV + ch);
                    w0[i] = __uint_as_float(raw << 16); w1[i] = __uint_as_float(raw & 0xffff0000u);
                }
                float c0[4], c1[4];
#pragma unroll
                for (int tap = 0; tap < 4; ++tap) { c0[tap] = p.conv_w[tap * 1536 + ch]; c1[tap] = p.conv_w[tap * 1536 + ch + 1]; }
                float y0[8], y1[8];
#pragma unroll
                for (int i = 0; i < 8; ++i) {
                    float a0 = 0.f, a1 = 0.f;
#pragma unroll
                    for (int tap = 0; tap < 4; ++tap) { a0 += c0[tap] * w0[i + tap]; a1 += c1[tap] * w1[i + tap]; }
                    y0[i] = silu_f(a0); y1[i] = silu_f(a1);
                    if (j < 8) {
                        const float ss = wave_sum(y0[i] * y0[i] + y1[i] * y1[i]);
                        float rs = rsqrtf(ss + EPS);
                        if (j < 4) rs *= 0.08838834764831845f;
                        y0[i] *= rs; y1[i] *= rs;
                    }
                }
                if (j < 8) {
                    bf16_t* dst = (j < 4) ? dq : dk;
#pragma unroll
                    for (int i = 0; i < 8; ++i) *(unsigned*)(dst + (size_t)(tok0 + i) * 512 + (j & 3) * 128 + lane * 2) = pack2(y0[i], y1[i]);
                }
                if (j >= 4) {
                    bf16_t* dstT = ((j < 8) ? dkT : dvT) + ((size_t)(bb * 4 + (j & 3)) * 128 + lane * 2) * NT + t0;
                    *(uint4*)dstT = make_uint4(pack2(y0[0], y0[1]), pack2(y0[2], y0[3]), pack2(y0[4], y0[5]), pack2(y0[6], y0[7]));
                    *(uint4*)(dstT + NT) = make_uint4(pack2(y1[0], y1[1]), pack2(y1[2], y1[3]), pack2(y1[4], y1[5]), pack2(y1[6], y1[7]));
                }
            }
        }
    }
}

__device__ __forceinline__ unsigned f2sortable(float f) { const unsigned u = __float_as_uint(f); return (u & 0x80000000u) ? ~u : (u | 0x80000000u); }
template <int CTRL> __device__ __forceinline__ float dpp_f(float v) { return __int_as_float(__builtin_amdgcn_update_dpp(0, __float_as_int(v), CTRL, 0xF, 0xF, false)); }
template <int CTRL> __device__ __forceinline__ int dpp_i(int v) { return __builtin_amdgcn_update_dpp(0, v, CTRL, 0xF, 0xF, false); }
__device__ __forceinline__ float sum8_f(float v) { v += dpp_f<0xB1>(v); v += dpp_f<0x4E>(v); v += dpp_f<0x141>(v); return v; }
__device__ __forceinline__ int sum16_i(int v) { v += dpp_i<0xB1>(v); v += dpp_i<0x4E>(v); v += dpp_i<0x141>(v); v += __shfl_xor(v, 32); return v; }
__device__ __forceinline__ int pi32(int r) { return (r & 0x13) | ((r & 4) << 1) | ((r & 8) >> 1); }
__device__ __forceinline__ constexpr int key_of_reg(int r) { return (r & 3) + 4 * ((r >> 2) & 1) + 16 * (r >> 3); }
struct KiFrag { bf16x8 a0, a1; };
__device__ __forceinline__ KiFrag ki_load(const bf16_t* ki_b, int kt, int lane) {
    const bf16_t* kr = ki_b + (size_t)(kt * 32 + pi32(lane & 31)) * 32 + 8 * (lane >> 5);
    KiFrag f; f.a0 = *(const bf16x8*)kr; f.a1 = *(const bf16x8*)(kr + 16); return f;
}
__device__ __forceinline__ void idx_scores(f32x16& sc, const KiFrag& f, bf16x8 qi0, bf16x8 qi1, float wl) {
    f32x16 z;
#pragma unroll
    for (int r = 0; r < 16; ++r) z[r] = 0.f;
    z = __builtin_amdgcn_mfma_f32_32x32x16_bf16(f.a0, qi0, z, 0, 0, 0);
    z = __builtin_amdgcn_mfma_f32_32x32x16_bf16(f.a1, qi1, z, 0, 0, 0);
#pragma unroll
    for (int r = 0; r < 16; ++r) sc[r] = sum8_f(fmaxf(z[r], 0.f) * wl);
}
constexpr int ATTM_LDS = 129 * 8 * 4;
__device__ __forceinline__ void attn_pass1(const P& p, int b, int t0, int lane, float& tauf, int& cut) {
    const int hf = lane >> 5, cq = (lane & 31) >> 3, ch = lane & 7;
    const int tq = t0 + cq, tok = b * NT + tq;
    const int ntile = (t0 + 3) / 32 + 1;
    const bf16_t* proj = (const bf16_t*)(p.ws + WS_PROJ);
    const bf16_t* ki_b = (const bf16_t*)(p.ws + WS_KI) + (size_t)b * NT * 32;
    const bf16x8 qi0 = *(const bf16x8*)(proj + (size_t)tok * NPROJ + PC_QIDX + ch * 32 + 8 * hf);
    const bf16x8 qi1 = *(const bf16x8*)(proj + (size_t)tok * NPROJ + PC_QIDX + ch * 32 + 16 + 8 * hf);
    const float wl = ((const float*)(p.ws + WS_WI))[(size_t)tok * 8 + ch];
    float keep[8][16];
#pragma unroll
    for (int s = 0; s < 8; ++s)
#pragma unroll
        for (int r = 0; r < 16; ++r) keep[s][r] = -INFINITY;
    KiFrag ring[2];
    ring[0] = ki_load(ki_b, 0, lane);
#pragma unroll
    for (int kt = 0; kt < 64; ++kt) {
        if (kt < ntile) {
            ring[(kt + 1) & 1] = ki_load(ki_b, min(kt + 1, ntile - 1), lane);
            __builtin_amdgcn_sched_barrier(0);
            f32x16 sc;
            idx_scores(sc, ring[kt & 1], qi0, qi1, wl);
            if (kt * 32 + 31 > t0) {
#pragma unroll
                for (int r = 0; r < 16; ++r) sc[r] = (kt * 32 + key_of_reg(r) + 8 * hf <= tq) ? sc[r] : -INFINITY;
            }
            if (ch == (kt & 7)) {
#pragma unroll
                for (int r = 0; r < 16; ++r) keep[kt >> 3][r] = sc[r];
            }
        }
    }
    unsigned u[8][16];
#pragma unroll
    for (int s = 0; s < 8; ++s)
#pragma unroll
        for (int r = 0; r < 16; ++r) u[s][r] = f2sortable(keep[s][r]);
    unsigned prefix = 0u;
    for (int bit = 31; bit >= 0; --bit) {
        const unsigned cand = prefix | (1u << bit);
        int cnt = 0;
#pragma unroll
        for (int s = 0; s < 8; ++s) {
            if (s * 256 <= t0 + 3) {
#pragma unroll
                for (int r = 0; r < 16; ++r) cnt += (u[s][r] >= cand) ? 1 : 0;
            }
        }
        cnt = sum16_i(cnt);
        if (cnt >= 256) prefix = cand;
    }
    int ngt = 0, neq = 0;
#pragma unroll
    for (int s = 0; s < 8; ++s)
#pragma unroll
        for (int r = 0; r < 16; ++r) { ngt += (u[s][r] > prefix) ? 1 : 0; neq += (u[s][r] == prefix) ? 1 : 0; asm volatile("" : "+v"(ngt), "+v"(neq)); }
    ngt = sum16_i(ngt); neq = sum16_i(neq);
    const bool big = tq >= 256;
    const int need = 256 - ngt;
    if (__any(big && need < neq)) {
        int lo = 0, hi = NT - 1;
        for (int it = 0; it < 11; ++it) {
            const int mid = (lo + hi) >> 1;
            int cnt = 0;
            unsigned pf = prefix; asm volatile("" : "+v"(pf));
#pragma unroll
            for (int s = 0; s < 8; ++s)
#pragma unroll
                for (int r = 0; r < 16; ++r) { cnt += (u[s][r] == pf && ((s * 8 + ch) * 32 + key_of_reg(r) + 8 * hf) <= mid) ? 1 : 0; asm volatile("" : "+v"(cnt)); }
            cnt = sum16_i(cnt);
            if (cnt >= need) hi = mid; else lo = mid + 1;
        }
        if (big && need < neq) cut = lo;
    }
    if (big) { const unsigned pu = prefix; tauf = __uint_as_float((pu & 0x80000000u) ? (pu & 0x7fffffffu) : ~pu); }
}
__device__ __forceinline__ void attn_pass2(const P& p, const float* sbl, int b, int t0, int lane, float tauf, int cut) {
    const int hf = lane >> 5, cq = (lane & 31) >> 3, ch = lane & 7;
    const int tq = t0 + cq, tok = b * NT + tq;
    const int ntile = (t0 + 3) / 32 + 1;
    const bf16_t* proj = (const bf16_t*)(p.ws + WS_PROJ);
    bf16_t* qn = (bf16_t*)(p.ws + WS_QN);
    const int* posmm = (const int*)(p.ws + WS_POSMM);
    const bf16_t* ki_b = (const bf16_t*)(p.ws + WS_KI) + (size_t)b * NT * 32;
    const bf16_t* K_b = (const bf16_t*)(p.ws + WS_K) + (size_t)b * NT * 64;
    const bf16_t* Vt_b = (const bf16_t*)(p.ws + WS_VT) + (size_t)b * 64 * NT;
    const bf16x8 qi0 = *(const bf16x8*)(proj + (size_t)tok * NPROJ + PC_QIDX + ch * 32 + 8 * hf);
    const bf16x8 qi1 = *(const bf16x8*)(proj + (size_t)tok * NPROJ + PC_QIDX + ch * 32 + 16 + 8 * hf);
    const float wl = ((const float*)(p.ws + WS_WI))[(size_t)tok * 8 + ch];
    bf16x8 qb[4];
#pragma unroll
    for (int ks = 0; ks < 4; ++ks) qb[ks] = *(const bf16x8*)(qn + (size_t)tok * 512 + ch * 64 + ks * 16 + 8 * hf);
    const int pq = p.pos[tok];
    int pqmin = pq;
    pqmin = min(pqmin, __shfl_xor(pqmin, 8)); pqmin = min(pqmin, __shfl_xor(pqmin, 16));
    pqmin = __builtin_amdgcn_readfirstlane(pqmin);
    const float bias_far = sbl[128 * 8 + ch];
    const bool anycut = __any(cut != 0x7fffffff);
    f32x16 o0, o1;
#pragma unroll
    for (int r = 0; r < 16; ++r) { o0[r] = 0.f; o1[r] = 0.f; }
    float m = -INFINITY, l = 0.f;
    struct TileFrags { KiFrag ki; bf16x8 k[4]; bf16x8 v[4]; };
    auto load_tile = [&](int kt) __attribute__((always_inline)) {
        TileFrags f;
        f.ki = ki_load(ki_b, kt, lane);
        const bf16_t* kr = K_b + (size_t)(kt * 32 + pi32(lane & 31)) * 64 + 8 * hf;
#pragma unroll
        for (int ks = 0; ks < 4; ++ks) f.k[ks] = *(const bf16x8*)(kr + ks * 16);
        const bf16_t* vr = Vt_b + (size_t)(lane & 31) * NT + kt * 32 + 8 * hf;
        f.v[0] = *(const bf16x8*)vr; f.v[1] = *(const bf16x8*)(vr + 16); f.v[2] = *(const bf16x8*)(vr + 32 * NT); f.v[3] = *(const bf16x8*)(vr + 32 * NT + 16);
        return f;
    };
    TileFrags cur = load_tile(0);
    for (int kt = 0; kt < ntile; ++kt) {
        const TileFrags nxt = load_tile(min(kt + 1, ntile - 1));
        f32x16 sc;
        idx_scores(sc, cur.ki, qi0, qi1, wl);
        f32x16 s;
#pragma unroll
        for (int r = 0; r < 16; ++r) s[r] = 0.f;
#pragma unroll
        for (int ks = 0; ks < 4; ++ks) s = __builtin_amdgcn_mfma_f32_32x32x16_bf16(cur.k[ks], qb[ks], s, 0, 0, 0);
        const int kbase = kt * 32 + 8 * hf;
        if (pqmin - posmm[(b * 64 + kt) * 2 + 1] >= 128) {
#pragma unroll
            for (int r = 0; r < 16; ++r) s[r] += bias_far;
        } else {
#pragma unroll
            for (int r = 0; r < 16; ++r) {
                int n = pq - p.pos[b * NT + kbase + key_of_reg(r)];
                n = n < 0 ? 0 : (n > 128 ? 128 : n);
                s[r] += sbl[n * 8 + ch];
            }
        }
        if (anycut) {
#pragma unroll
            for (int r = 0; r < 16; ++r) { const bool ok = (sc[r] > tauf) || (sc[r] == tauf && (kbase + key_of_reg(r)) <= cut); s[r] = ok ? s[r] : -INFINITY; }
        } else {
#pragma unroll
            for (int r = 0; r < 16; ++r) s[r] = (sc[r] >= tauf) ? s[r] : -INFINITY;
        }
        if (kt * 32 + 31 > t0) {
#pragma unroll
            for (int r = 0; r < 16; ++r) s[r] = (kbase + key_of_reg(r) <= tq) ? s[r] : -INFINITY;
        }
        float mx = s[0];
#pragma unroll
        for (int r = 1; r < 16; ++r) mx = fmaxf(mx, s[r]);
        mx = fmaxf(mx, __shfl_xor(mx, 32));
        const float mnew = fmaxf(m, mx);
        const float msafe = (mnew == -INFINITY) ? 0.f : mnew;
        const float alpha = exp2f(m - msafe);
        m = mnew;
        float ps = 0.f;
#pragma unroll
        for (int r = 0; r < 16; ++r) { s[r] = exp2f(s[r] - msafe); ps += s[r]; }
        l = l * alpha + ps;
        if (__any(alpha != 1.f)) {
#pragma unroll
            for (int r = 0; r < 16; ++r) { o0[r] *= alpha; o1[r] *= alpha; }
        }
        bf16x8 pb0, pb1;
#pragma unroll
        for (int jx = 0; jx < 8; ++jx) { pb0[jx] = (short)f2bf(s[jx]); pb1[jx] = (short)f2bf(s[8 + jx]); }
        o0 = __builtin_amdgcn_mfma_f32_32x32x16_bf16(cur.v[0], pb0, o0, 0, 0, 0);
        o0 = __builtin_amdgcn_mfma_f32_32x32x16_bf16(cur.v[1], pb1, o0, 0, 0, 0);
        o1 = __builtin_amdgcn_mfma_f32_32x32x16_bf16(cur.v[2], pb0, o1, 0, 0, 0);
        o1 = __builtin_amdgcn_mfma_f32_32x32x16_bf16(cur.v[3], pb1, o1, 0, 0, 0);
        cur = nxt;
    }
    l += __shfl_xor(l, 32);
    const float inv = 1.f / l;
    bf16_t* orow = qn + (size_t)tok * 512 + ch * 64;
#pragma unroll
    for (int gq = 0; gq < 4; ++gq) {
        *(uint2*)(orow + gq * 8 + 4 * hf) = make_uint2(pack2(o0[gq * 4] * inv, o0[gq * 4 + 1] * inv), pack2(o0[gq * 4 + 2] * inv, o0[gq * 4 + 3] * inv));
        *(uint2*)(orow + 32 + gq * 8 + 4 * hf) = make_uint2(pack2(o1[gq * 4] * inv, o1[gq * 4 + 1] * inv), pack2(o1[gq * 4 + 2] * inv, o1[gq * 4 + 3] * inv));
    }
}
__device__ __forceinline__ void dn_scan_wave(const P& p, int item, int lane);
__device__ __forceinline__ void ph_attn_mfma(const P& p, char* smem) {
    const int tid = tid_opaque();
    float* sbl = (float*)smem;
    for (int i = tid; i < 129 * 8; i += NTHREADS) {
        const int n = i >> 3, h = i & 7; int bk;
        if (n < 16) bk = n;
        else { const float v = logf((float)n / 16.f) / 2.0794415416798357f * 16.f; bk = 16 + (int)v; if (bk > 31) bk = 31; }
        sbl[i] = p.rel_bias[bk * 8 + h] * LOG2E;
    }
    __syncthreads();
    int* qctr = (int*)(p.ws + WS_CTL) + 64;
    if (blockIdx.x < NB * 4 && (tid >> 6) < 4) {
        int lane0 = tid & 63; asm volatile("" : "+v"(lane0));
        dn_scan_wave(p, blockIdx.x * 4 + (tid >> 6), lane0);
    }
    for (;;) {
        int lane = tid & 63; asm volatile("" : "+v"(lane));
        int w = 0;
        if (lane == 0) w = atomicAdd(qctr, 1);
        w = __builtin_amdgcn_readfirstlane(w);
        if (w >= NTOK / 4) break;
        const int g = w >> 3, j = w & 7;
        const int b = g & 7, t0 = (63 - (g >> 3)) * 32 + (7 - j) * 4;
        float tauf = -INFINITY; int cut = 0x7fffffff;
        if (t0 + 3 >= 256) attn_pass1(p, b, t0, lane, tauf, cut);
        int lane2 = tid & 63; asm volatile("" : "+v"(lane2));
        attn_pass2(p, sbl, b, t0, lane2, tauf, cut);
    }
}

__device__ __forceinline__ constexpr int sig16(int x) { return (x & ~12) | ((x & 4) << 1) | ((x & 8) >> 1); }
constexpr int PREP_WAVE_LDS = 2 * 64 * 72 * 2 + 4 * 64 * 4;
constexpr int PREP_LDS = NWAVES * PREP_WAVE_LDS;
__device__ __forceinline__ void ph_dn_prep(const P& p, char* smem) {
    const int tid = tid_opaque();
    const int wave = tid >> 6;
    char* wl = smem + wave * PREP_WAVE_LDS;
    float* sA = (float*)wl;
    bf16_t* sTw = (bf16_t*)wl; bf16_t* sTu = sTw + 64 * 72;
    float* sG = (float*)(wl + 2 * 64 * 72 * 2); float* sB = sG + 64; float* sE = sB + 64; float* sL = sE + 64;
    const bf16_t* dq = (const bf16_t*)(p.ws + WS_DQ); const bf16_t* dk = (const bf16_t*)(p.ws + WS_DK);
    const bf16_t* dkT = (const bf16_t*)(p.ws + WS_DKT); const bf16_t* dvT = (const bf16_t*)(p.ws + WS_DVT);
    const float* dbeta = (const float*)(p.ws + WS_DBG); const float* dg = dbeta + NTOK * 4;
    unsigned char* dob = (unsigned char*)p.out;
    bf16_t* PPg = (bf16_t*)(dob + DO_PP); float* GCg = (float*)(dob + DO_GC); float* EGg = (float*)(dob + DO_EG); float* LLg = (float*)(dob + DO_LL);
    for (int item = blockIdx.x * NWAVES + wave; item < NB * 4 * 32; item += gridDim.x * NWAVES) {
        int lane = tid & 63; asm volatile("" : "+v"(lane));
        const int hf = lane >> 5, l31 = lane & 31;
        const int bh = item >> 5, c = item & 31, b = bh >> 2, hh = bh & 3;
        const int tok0 = b * NT + c * 64;
        bf16_t* WN = (bf16_t*)(dob + DO_WN) + (size_t)item * 64 * 128; bf16_t* Ug = (bf16_t*)(dob + DO_U) + (size_t)item * 64 * 128;
        bf16_t* PP = PPg + (size_t)item * 64 * 64;
        float G, beta, eG;
        {
            const float g = dg[(size_t)(tok0 + lane) * 4 + hh];
            beta = dbeta[(size_t)(tok0 + lane) * 4 + hh];
            G = g;
#pragma unroll
            for (int o = 1; o < 64; o <<= 1) { const float n = __shfl_up(G, o); if (lane >= o) G += n; }
            const float Gl = __shfl(G, 63);
            eG = __expf(G);
            sG[lane] = G; sB[lane] = beta; sE[lane] = eG; sL[lane] = __expf(Gl - G);
            EGg[item * 64 + lane] = eG; LLg[item * 64 + lane] = __expf(Gl - G);
            if (lane == 0) GCg[item] = __expf(Gl);
        }
        f32x16 kk00, kk10, kk11, qk00, qk10, qk11;
#pragma unroll
        for (int r = 0; r < 16; ++r) { kk00[r] = 0.f; kk10[r] = 0.f; kk11[r] = 0.f; qk00[r] = 0.f; qk10[r] = 0.f; qk11[r] = 0.f; }
        {
            const bf16_t* kr0 = dk + (size_t)(tok0 + l31) * 512 + hh * 128 + 8 * hf; const bf16_t* kr1 = kr0 + 32 * 512;
            const bf16_t* qr0 = dq + (size_t)(tok0 + l31) * 512 + hh * 128 + 8 * hf; const bf16_t* qr1 = qr0 + 32 * 512;
#pragma unroll
            for (int s = 0; s < 8; ++s) {
                const bf16x8 k0 = *(const bf16x8*)(kr0 + s * 16), k1 = *(const bf16x8*)(kr1 + s * 16), q0 = *(const bf16x8*)(qr0 + s * 16), q1 = *(const bf16x8*)(qr1 + s * 16);
                kk00 = __builtin_amdgcn_mfma_f32_32x32x16_bf16(k0, k0, kk00, 0, 0, 0);
                kk10 = __builtin_amdgcn_mfma_f32_32x32x16_bf16(k1, k0, kk10, 0, 0, 0);
                kk11 = __builtin_amdgcn_mfma_f32_32x32x16_bf16(k1, k1, kk11, 0, 0, 0);
                qk00 = __builtin_amdgcn_mfma_f32_32x32x16_bf16(q0, k0, qk00, 0, 0, 0);
                qk10 = __builtin_amdgcn_mfma_f32_32x32x16_bf16(q1, k0, qk10, 0, 0, 0);
                qk11 = __builtin_amdgcn_mfma_f32_32x32x16_bf16(q1, k1, qk11, 0, 0, 0);
            }
        }
        __threadfence_block();
        {
            const float Gc0 = sG[l31], Gc1 = sG[32 + l31];
            float* sA0 = sA + (4 * hf) * 64 + l31;
            bf16_t* PP0 = PP + (4 * hf) * 64 + sig16(l31);
            const float* sGr = sG + 4 * hf; const float* sBr = sB + 4 * hf;
            const int jrel = l31 - 4 * hf;
#pragma unroll
            for (int r = 0; r < 16; ++r) {
                const int ro = (r & 3) + 8 * (r >> 2);
                const float Gi0 = sGr[ro], Gi1 = sGr[32 + ro], Bi0 = sBr[ro], Bi1 = sBr[32 + ro];
                {
                    const float dec = (jrel <= ro) ? __expf(Gi0 - Gc0) : 0.f;
                    sA0[ro * 64] = (jrel < ro) ? Bi0 * kk00[r] * dec : 0.f;
                    PP0[ro * 64] = f2bf(qk00[r] * dec);
                    PP0[ro * 64 + 32] = 0;
                }
                {
                    const float dec = __expf(Gi1 - Gc0);
                    sA0[(32 + ro) * 64] = Bi1 * kk10[r] * dec;
                    PP0[(32 + ro) * 64] = f2bf(qk10[r] * dec);
                }
                {
                    const float dec = (jrel <= ro) ? __expf(Gi1 - Gc1) : 0.f;
                    sA0[(32 + ro) * 64 + 32] = (jrel < ro) ? Bi1 * kk11[r] * dec : 0.f;
                    PP0[(32 + ro) * 64 + 32] = f2bf(qk11[r] * dec);
                }
            }
        }
        __threadfence_block();
        float x[64];
#pragma unroll
        for (int i = 0; i < 64; ++i) x[i] = (i == lane) ? 1.f : 0.f;
#pragma unroll
        for (int i = 1; i < 64; ++i) {
            float acc = x[i];
#pragma unroll
            for (int m4 = 0; m4 < i; m4 += 4) {
                const f32x4 a = *(const f32x4*)(sA + i * 64 + m4);
                acc -= a[0] * x[m4];
                if (m4 + 1 < i) acc -= a[1] * x[m4 + 1];
                if (m4 + 2 < i) acc -= a[2] * x[m4 + 2];
                if (m4 + 3 < i) acc -= a[3] * x[m4 + 3];
            }
            x[i] = acc;
            __builtin_amdgcn_sched_barrier(0);
        }
        __threadfence_block();
        {
            const float sw = beta * eG;
#pragma unroll
            for (int i = 0; i < 64; ++i) { sTw[i * 72 + lane] = f2bf(x[i] * sw); sTu[i * 72 + lane] = f2bf(x[i] * beta); }
        }
        __threadfence_block();
        {
            bf16x8 tw[2][4], tu[2][4];
#pragma unroll
            for (int mt = 0; mt < 2; ++mt)
#pragma unroll
                for (int s = 0; s < 4; ++s) { tw[mt][s] = *(const bf16x8*)(sTw + (mt * 32 + l31) * 72 + s * 16 + 8 * hf); tu[mt][s] = *(const bf16x8*)(sTu + (mt * 32 + l31) * 72 + s * 16 + 8 * hf); }
            const bf16_t* kTb = dkT + ((size_t)bh * 128 + l31) * NT + c * 64 + 8 * hf;
            const bf16_t* vTb = dvT + ((size_t)bh * 128 + l31) * NT + c * 64 + 8 * hf;
#pragma unroll 1
            for (int nt = 0; nt < 4; ++nt) {
                f32x16 w0, w1, u0, u1;
#pragma unroll
                for (int r = 0; r < 16; ++r) { w0[r] = 0.f; w1[r] = 0.f; u0[r] = 0.f; u1[r] = 0.f; }
#pragma unroll
                for (int s = 0; s < 4; ++s) {
                    const bf16x8 kb = *(const bf16x8*)(kTb + (size_t)nt * 32 * NT + s * 16), vb = *(const bf16x8*)(vTb + (size_t)nt * 32 * NT + s * 16);
                    w0 = __builtin_amdgcn_mfma_f32_32x32x16_bf16(tw[0][s], kb, w0, 0, 0, 0);
                    w1 = __builtin_amdgcn_mfma_f32_32x32x16_bf16(tw[1][s], kb, w1, 0, 0, 0);
                    u0 = __builtin_amdgcn_mfma_f32_32x32x16_bf16(tu[0][s], vb, u0, 0, 0, 0);
                    u1 = __builtin_amdgcn_mfma_f32_32x32x16_bf16(tu[1][s], vb, u1, 0, 0, 0);
                }
                bf16_t* WN0 = WN + (4 * hf) * 128 + nt * 32 + sig16(l31); bf16_t* U0 = Ug + (4 * hf) * 128 + nt * 32 + l31;
#pragma unroll
                for (int r = 0; r < 16; ++r) {
                    const int ro = (r & 3) + 8 * (r >> 2);
                    WN0[ro * 128] = f2bf(-w0[r]); WN0[(32 + ro) * 128] = f2bf(-w1[r]);
                    U0[ro * 128] = f2bf(u0[r]); U0[(32 + ro) * 128] = f2bf(u1[r]);
                }
            }
        }
        __threadfence_block();
    }
}

__device__ __forceinline__ bf16x8 pack_frag(const f32x16& t, int s) {
    bf16x8 f;
#pragma unroll
    for (int j = 0; j < 8; ++j) f[j] = (short)f2bf(t[8 * s + j]);
    return f;
}
__device__ __forceinline__ bf16x8 pack_frag_scaled(const f32x16& t, int s, const f32x4& sc0, const f32x4& sc1) {
    bf16x8 f;
#pragma unroll
    for (int j = 0; j < 4; ++j) { f[j] = (short)f2bf(t[8 * s + j] * sc0[j]); f[4 + j] = (short)f2bf(t[8 * s + 4 + j] * sc1[j]); }
    return f;
}
__device__ __forceinline__ bf16x8 load_perm_frag(const bf16_t* ptr) {
    const uint2 lo = *(const uint2*)ptr, hi = *(const uint2*)(ptr + 8);
    union { uint4 u; bf16x8 f; } cv; cv.u = make_uint4(lo.x, lo.y, hi.x, hi.y); return cv.f;
}
__device__ __forceinline__ void dn_scan_wave(const P& p, int item, int lane) {
    const int bh = item >> 2, sl = item & 3, b = bh >> 2, hh = bh & 3;
    const int hf = lane >> 5, l31 = lane & 31;
    unsigned char* dob = (unsigned char*)p.out;
    const bf16_t* PPg = (const bf16_t*)(dob + DO_PP); const float* GCg = (const float*)(dob + DO_GC);
    const float* EGg = (const float*)(dob + DO_EG); const float* LLg = (const float*)(dob + DO_LL);
    bf16_t* dno = (bf16_t*)(dob + DO_DNO);
    const bf16_t* dq = (const bf16_t*)(p.ws + WS_DQ); const bf16_t* dkT = (const bf16_t*)(p.ws + WS_DKT);
    f32x16 S[4];
#pragma unroll
    for (int T = 0; T < 4; ++T)
#pragma unroll
        for (int r = 0; r < 16; ++r) S[T][r] = 0.f;
#pragma unroll 1
    for (int c = 0; c < NT / 64; ++c) {
        const int ci = bh * 32 + c;
        const int tok0 = b * NT + c * 64;
        const bf16_t* WN = (const bf16_t*)(dob + DO_WN) + (size_t)ci * 64 * 128 + l31 * 128 + 8 * hf;
        const bf16_t* Qr = dq + (size_t)(tok0 + l31) * 512 + hh * 128 + 4 * hf;
        const bf16_t* Kr = dkT + ((size_t)bh * 128 + l31) * NT + c * 64 + 4 * hf;
        const bf16_t* PP = PPg + (size_t)ci * 64 * 64 + l31 * 64 + 8 * hf;
        const bf16_t* Ug = (const bf16_t*)(dob + DO_U) + (size_t)ci * 64 * 128 + sl * 32 + l31;
        const float gc = GCg[ci];
        bf16x8 SB[4][2];
#pragma unroll
        for (int T = 0; T < 4; ++T) { SB[T][0] = pack_frag(S[T], 0); SB[T][1] = pack_frag(S[T], 1); }
        f32x16 D[2], O[2];
#pragma unroll
        for (int mt = 0; mt < 2; ++mt)
#pragma unroll
            for (int r = 0; r < 16; ++r) { D[mt][r] = bf2f(Ug[(mt * 32 + (r & 3) + 8 * (r >> 2) + 4 * hf) * 128]); O[mt][r] = 0.f; }
#pragma unroll
        for (int mt = 0; mt < 2; ++mt)
#pragma unroll
            for (int T = 0; T < 4; ++T)
#pragma unroll
                for (int s = 0; s < 2; ++s) {
                    const bf16x8 wa = *(const bf16x8*)(WN + mt * 32 * 128 + (2 * T + s) * 16);
                    const bf16x8 qa = load_perm_frag(Qr + (size_t)mt * 32 * 512 + (2 * T + s) * 16);
                    D[mt] = __builtin_amdgcn_mfma_f32_32x32x16_bf16(wa, SB[T][s], D[mt], 0, 0, 0);
                    O[mt] = __builtin_amdgcn_mfma_f32_32x32x16_bf16(qa, SB[T][s], O[mt], 0, 0, 0);
                }
        bf16x8 DB[2][2], DL[2][2];
#pragma unroll
        for (int mt = 0; mt < 2; ++mt) {
#pragma unroll
            for (int g4 = 0; g4 < 4; ++g4) {
                const f32x4 eg = *(const f32x4*)(EGg + ci * 64 + mt * 32 + g4 * 8 + 4 * hf);
#pragma unroll
                for (int j = 0; j < 4; ++j) O[mt][g4 * 4 + j] *= eg[j];
            }
            const f32x4 l0 = *(const f32x4*)(LLg + ci * 64 + mt * 32 + 0 + 4 * hf), l1 = *(const f32x4*)(LLg + ci * 64 + mt * 32 + 8 + 4 * hf);
            const f32x4 l2 = *(const f32x4*)(LLg + ci * 64 + mt * 32 + 16 + 4 * hf), l3 = *(const f32x4*)(LLg + ci * 64 + mt * 32 + 24 + 4 * hf);
            DB[mt][0] = pack_frag(D[mt], 0); DB[mt][1] = pack_frag(D[mt], 1);
            DL[mt][0] = pack_frag_scaled(D[mt], 0, l0, l1); DL[mt][1] = pack_frag_scaled(D[mt], 1, l2, l3);
        }
#pragma unroll
        for (int mt = 0; mt < 2; ++mt)
#pragma unroll
            for (int ks = 0; ks < 4; ++ks) {
                const bf16x8 pa = *(const bf16x8*)(PP + mt * 32 * 64 + ks * 16);
                O[mt] = __builtin_amdgcn_mfma_f32_32x32x16_bf16(pa, DB[ks >> 1][ks & 1], O[mt], 0, 0, 0);
            }
        {
            bf16_t* orow = dno + (size_t)tok0 * 512 + hh * 128 + sl * 32 + l31;
#pragma unroll
            for (int mt = 0; mt < 2; ++mt)
#pragma unroll
                for (int r = 0; r < 16; ++r) orow[(size_t)(mt * 32 + (r & 3) + 8 * (r >> 2) + 4 * hf) * 512] = f2bf(O[mt][r]);
        }
#pragma unroll
        for (int T = 0; T < 4; ++T) {
#pragma unroll
            for (int r = 0; r < 16; ++r) S[T][r] *= gc;
#pragma unroll
            for (int ks = 0; ks < 4; ++ks) {
                const bf16x8 ka = load_perm_frag(Kr + (size_t)T * 32 * NT + ks * 16);
                S[T] = __builtin_amdgcn_mfma_f32_32x32x16_bf16(ka, DL[ks >> 1][ks & 1], S[T], 0, 0, 0);
            }
        }
    }
}

__device__ __forceinline__ void ph_dn_gate(const P& p) {
    const int tid = tid_opaque();
    const int lane = tid & 63, wave = tid >> 6;
    const bf16_t* dno = (const bf16_t*)((const unsigned char*)p.out + DO_DNO); const bf16_t* proj = (const bf16_t*)(p.ws + WS_PROJ); bf16_t* dnn = (bf16_t*)(p.ws + WS_DK);
    for (int tok = blockIdx.x * NWAVES + wave; tok < NTOK; tok += gridDim.x * NWAVES) {
#pragma unroll
        for (int hh = 0; hh < 4; ++hh) {
            const unsigned orw = *(const unsigned*)(dno + (size_t)tok * 512 + hh * 128 + lane * 2);
            const float o0 = __uint_as_float(orw << 16), o1 = __uint_as_float(orw & 0xffff0000u);
            const float ss = wave_sum(o0 * o0 + o1 * o1);
            const float rs = rsqrtf(ss * (1.f / 128.f) + EPS);
            const unsigned zr = *(const unsigned*)(proj + (size_t)tok * NPROJ + PC_DNZ + hh * 128 + lane * 2);
            const float z0 = __uint_as_float(zr << 16), z1 = __uint_as_float(zr & 0xffff0000u);
            *(unsigned*)(dnn + (size_t)tok * 512 + hh * 128 + lane * 2) = pack2(o0 * rs * p.dn_norm_g[lane * 2] * silu_f(z0), o1 * rs * p.dn_norm_g[lane * 2 + 1] * silu_f(z1));
        }
    }
}

__device__ __forceinline__ void ph_gemm_out(const P& p, char* smem) {
    const int tid = tid_opaque();
    constexpr int BM = 256, BN = 128;
    const bf16_t* att = (const bf16_t*)(p.ws + WS_QN); const bf16_t* dnn = (const bf16_t*)(p.ws + WS_DK); const bf16_t* Wt = (const bf16_t*)(p.ws + WS_WOUT);
    float* sgate = (float*)(smem + GemmLds<BM, BN>::BYTES);
    const int lane = tid & 63, wave = tid >> 6, wm = wave % 4, wn = wave / 4;
    const int ntn = ND / BN, ntiles = (NTOK / BM) * ntn;
    for (int t = blockIdx.x; t < ntiles; t += gridDim.x) {
        const int tm = t / ntn, tn = t % ntn;
        const int b = (tm * BM) / NT;
        if (tid < BN) sgate[tid] = mod_val(p, b, 2, tn * BN + tid);
        const bf16_t* A1 = att + (size_t)tm * BM * 512; const bf16_t* A2 = dnn + (size_t)tm * BM * 512; const bf16_t* Bb = Wt + (size_t)tn * BN * ND;
        f32x16 acc[2][2];
        gemm_tile<BM, BN>(tid, smem, ND, [&](int r, int k) __attribute__((always_inline)) { return (k < 512) ? (A1 + (size_t)r * 512 + k) : (A2 + (size_t)r * 512 + (k - 512)); },
                          [&](int r, int k) __attribute__((always_inline)) { return Bb + (size_t)r * ND + k; }, acc);
#pragma unroll
        for (int m = 0; m < 2; ++m)
#pragma unroll
            for (int n = 0; n < 2; ++n)
#pragma unroll
                for (int r = 0; r < 16; ++r) {
                    const int row = tm * BM + wm * 64 + m * 32 + (r & 3) + 8 * (r >> 2) + 4 * (lane >> 5);
                    const int cl = wn * 64 + n * 32 + (lane & 31);
                    const size_t idx = (size_t)row * ND + tn * BN + cl;
                    p.out[idx] = p.x[idx] + sgate[cl] * acc[m][n][r];
                }
        __syncthreads();
    }
}

constexpr int ROUTE_LDS = 36 * 1024 * 4 + 2 * 1024 * 4;
__device__ __forceinline__ void ph_route(const P& p, char* smem) {
    const int tid = tid_opaque();
    float* sW = (float*)smem;
    float* sA = sW + 36 * 1024; float* sB = sA + 1024;
    const int lane = tid & 63, wave = tid >> 6;
    for (int i = tid; i < 4 * 1024; i += NTHREADS) { const int d = i >> 2, j = i & 3; sW[j * 1024 + d] = p.rg_w[i]; }
    for (int i = tid; i < 32 * 1024; i += NTHREADS) { const int d = i >> 5, j = i & 31; sW[(4 + j) * 1024 + d] = p.re_w[i]; }
    bf16_t* h2 = (bf16_t*)(p.ws + WS_H2);
    int* cnt = (int*)(p.ws + WS_CTL); int* list = (int*)(p.ws + WS_LIST); int* tokinfo = (int*)(p.ws + WS_TOKINFO);
    int curb = -1;
    for (int tile = blockIdx.x; tile < NTOK / 64; tile += gridDim.x) {
        const int b = tile / (NT / 64);
        if (b != curb) {
            __syncthreads();
            for (int d = tid; d < ND; d += NTHREADS) { sA[d] = p.norm2_g[d] * (1.f + mod_val(p, b, 4, d)); sB[d] = mod_val(p, b, 3, d); }
            __syncthreads();
            curb = b;
        }
        for (int i = 0; i < 8; ++i) {
            const int tok = tile * 64 + wave * 8 + i;
            const float* xr = p.out + (size_t)tok * ND;
            float v[16]; float ss = 0.f;
#pragma unroll
            for (int j = 0; j < 16; ++j) { v[j] = xr[j * 64 + lane]; ss += v[j] * v[j]; }
            ss = wave_sum(ss);
            const float rstd = rsqrtf(ss * (1.f / ND) + EPS);
#pragma unroll
            for (int j = 0; j < 16; ++j) { const int d = j * 64 + lane; v[j] = v[j] * rstd * sA[d] + sB[d]; h2[(size_t)tok * ND + d] = f2bf(v[j]); }
            float mylogit = 0.f;
#pragma unroll 4
            for (int o = 0; o < 36; ++o) {
                float a = 0.f;
#pragma unroll
                for (int j = 0; j < 16; ++j) a += v[j] * sW[o * 1024 + j * 64 + lane];
                a = wave_sum(a);
                if (lane == o) mylogit = a;
            }
            if (lane < 4) mylogit += p.rg_b[lane]; else if (lane < 36) mylogit += p.re_b[lane - 4];
            float gl[4];
#pragma unroll
            for (int j = 0; j < 4; ++j) gl[j] = __shfl(mylogit, j);
            int gsel = 0; float gm = gl[0];
#pragma unroll
            for (int j = 1; j < 4; ++j) if (gl[j] > gm) { gm = gl[j]; gsel = j; }
            float gs = 0.f;
#pragma unroll
            for (int j = 0; j < 4; ++j) gs += __expf(gl[j] - gm);
            const float gtop = 1.f / gs;
            float el[8];
#pragma unroll
            for (int j = 0; j < 8; ++j) el[j] = __shfl(mylogit, 4 + gsel * 8 + j);
            int e1 = 0; float m1 = el[0];
#pragma unroll
            for (int j = 1; j < 8; ++j) if (el[j] > m1) { m1 = el[j]; e1 = j; }
            int e2 = -1; float m2 = -INFINITY;
#pragma unroll
            for (int j = 0; j < 8; ++j) if (j != e1 && el[j] > m2) { m2 = el[j]; e2 = j; }
            const float r2 = __expf(m2 - m1);
            const float w1v = gtop / (1.f + r2), w2v = gtop * r2 / (1.f + r2);
            if (lane == 0) {
                const int ea = gsel * 8 + e1, eb = gsel * 8 + e2;
                const int pa = atomicAdd(&cnt[ea], 1), pb = atomicAdd(&cnt[eb], 1);
                list[ea * NTOK + pa] = tok; list[eb * NTOK + pb] = tok;
                int* ti = tokinfo + (size_t)tok * 8;
                ti[0] = ea; ti[1] = pa; ti[2] = eb; ti[3] = pb; ti[4] = __float_as_int(w1v); ti[5] = __float_as_int(w2v);
            }
        }
    }
}

struct MoeIdx { int rowoff[NE + 1]; int tileoff[NE + 1]; };
__device__ __forceinline__ void moe_index(const int tid, const P& p, MoeIdx* mi) {
    if (tid == 0) {
        const int* cnt = (const int*)(p.ws + WS_CTL);
        int r = 0, t = 0;
        for (int e = 0; e < NE; ++e) { mi->rowoff[e] = r; mi->tileoff[e] = t; const int c = cnt[e]; r += c; t += (c + 127) >> 7; }
        mi->rowoff[NE] = r; mi->tileoff[NE] = t;
    }
    __syncthreads();
}

constexpr int MOE_BM = 128, MOE_BN = 256;
__device__ __forceinline__ void ph_moe_up(const P& p, char* smem) {
    const int tid = tid_opaque();
    MoeIdx* mi = (MoeIdx*)(smem + GemmLds<MOE_BM, MOE_BN>::BYTES);
    int* srow = (int*)(mi + 1);
    moe_index(tid, p, mi);
    const bf16_t* h2 = (const bf16_t*)(p.ws + WS_H2); const bf16_t* Wt13 = (const bf16_t*)(p.ws + WS_W13); bf16_t* act = (bf16_t*)(p.ws + WS_ACT);
    const int* list = (const int*)(p.ws + WS_LIST);
    const int lane = tid & 63, wave = tid >> 6, wm = wave % 2, wn = wave / 2;
    const int ntiles = mi->tileoff[NE] * 4;
    for (int t = blockIdx.x; t < ntiles; t += gridDim.x) {
        const int mt = t >> 2, ni = t & 3;
        int e = 0;
        while (mi->tileoff[e + 1] <= mt) ++e;
        const int ml = mt - mi->tileoff[e];
        const int cnt_e = mi->rowoff[e + 1] - mi->rowoff[e];
        const int nrows = min(128, cnt_e - ml * 128);
        if (tid < 128) srow[tid] = list[e * NTOK + ml * 128 + min(tid, nrows - 1)];
        __syncthreads();
        const bf16_t* Bb = Wt13 + ((size_t)e * 1024 + ni * 256) * ND;
        f32x16 acc[2][2];
        gemm_tile<MOE_BM, MOE_BN>(tid, smem, ND, [&](int r, int k) __attribute__((always_inline)) { return h2 + (size_t)srow[r] * ND + k; }, [&](int r, int k) __attribute__((always_inline)) { return Bb + (size_t)r * ND + k; }, acc);
        const int row0 = mi->rowoff[e] + ml * 128;
#pragma unroll
        for (int m = 0; m < 2; ++m)
#pragma unroll
            for (int r = 0; r < 16; ++r) {
                const int rl = wm * 64 + m * 32 + (r & 3) + 8 * (r >> 2) + 4 * (lane >> 5);
                if (rl < nrows) {
                    const float g = acc[m][0][r], u = acc[m][1][r];
                    act[(size_t)(row0 + rl) * EFF + ni * 128 + wn * 32 + (lane & 31)] = f2bf(silu_f(g) * u);
                }
            }
        __syncthreads();
    }
}

__device__ __forceinline__ void ph_moe_down(const P& p, char* smem) {
    const int tid = tid_opaque();
    MoeIdx* mi = (MoeIdx*)(smem + GemmLds<MOE_BM, MOE_BN>::BYTES);
    moe_index(tid, p, mi);
    const bf16_t* act = (const bf16_t*)(p.ws + WS_ACT); const bf16_t* Wt2 = (const bf16_t*)(p.ws + WS_W2); bf16_t* yb = (bf16_t*)(p.ws + WS_YBUF);
    const int lane = tid & 63, wave = tid >> 6, wm = wave % 2, wn = wave / 2;
    const int ntiles = mi->tileoff[NE] * 4;
    for (int t = blockIdx.x; t < ntiles; t += gridDim.x) {
        const int mt = t >> 2, ni = t & 3;
        int e = 0;
        while (mi->tileoff[e + 1] <= mt) ++e;
        const int ml = mt - mi->tileoff[e];
        const int cnt_e = mi->rowoff[e + 1] - mi->rowoff[e];
        const int nrows = min(128, cnt_e - ml * 128);
        const int row0 = mi->rowoff[e] + ml * 128;
        const bf16_t* Ab = act + (size_t)row0 * EFF;
        const bf16_t* Bb = Wt2 + ((size_t)e * ND + ni * 256) * EFF;
        f32x16 acc[2][2];
        gemm_tile<MOE_BM, MOE_BN>(tid, smem, EFF, [&](int r, int k) __attribute__((always_inline)) { return Ab + (size_t)min(r, nrows - 1) * EFF + k; }, [&](int r, int k) __attribute__((always_inline)) { return Bb + (size_t)r * EFF + k; }, acc);
#pragma unroll
        for (int m = 0; m < 2; ++m)
#pragma unroll
            for (int n = 0; n < 2; ++n)
#pragma unroll
                for (int r = 0; r < 16; ++r) {
                    const int rl = wm * 64 + m * 32 + (r & 3) + 8 * (r >> 2) + 4 * (lane >> 5);
                    if (rl < nrows) yb[(size_t)(row0 + rl) * ND + ni * 256 + wn * 64 + n * 32 + (lane & 31)] = f2bf(acc[m][n][r]);
                }
    }
}

__device__ __forceinline__ void ph_combine(const P& p, char* smem) {
    const int tid = tid_opaque();
    MoeIdx* mi = (MoeIdx*)smem;
    float* sG = (float*)(mi + 1);
    moe_index(tid, p, mi);
    const int lane = tid & 63, wave = tid >> 6;
    const bf16_t* yb = (const bf16_t*)(p.ws + WS_YBUF); const int* tokinfo = (const int*)(p.ws + WS_TOKINFO);
    int curb = -1;
    for (int tile = blockIdx.x; tile < NTOK / 64; tile += gridDim.x) {
        const int b = tile / (NT / 64);
        if (b != curb) {
            __syncthreads();
            for (int d = tid; d < ND; d += NTHREADS) sG[d] = mod_val(p, b, 5, d);
            __syncthreads();
            curb = b;
        }
        for (int i = 0; i < 8; ++i) {
            const int tok = tile * 64 + wave * 8 + i;
            const int* ti = tokinfo + (size_t)tok * 8;
            const int ra = mi->rowoff[ti[0]] + ti[1], rb = mi->rowoff[ti[2]] + ti[3];
            const float wa = __int_as_float(ti[4]), wb = __int_as_float(ti[5]);
#pragma unroll
            for (int j = 0; j < 4; ++j) {
                const int d = j * 256 + lane * 4;
                const uint2 ya = *(const uint2*)(yb + (size_t)ra * ND + d), ybv = *(const uint2*)(yb + (size_t)rb * ND + d);
                f32x4 xv = *(const f32x4*)(p.out + (size_t)tok * ND + d);
                xv[0] += sG[d] * (wa * __uint_as_float(ya.x << 16) + wb * __uint_as_float(ybv.x << 16));
                xv[1] += sG[d + 1] * (wa * __uint_as_float(ya.x & 0xffff0000u) + wb * __uint_as_float(ybv.x & 0xffff0000u));
                xv[2] += sG[d + 2] * (wa * __uint_as_float(ya.y << 16) + wb * __uint_as_float(ybv.y << 16));
                xv[3] += sG[d + 3] * (wa * __uint_as_float(ya.y & 0xffff0000u) + wb * __uint_as_float(ybv.y & 0xffff0000u));
                *(f32x4*)(p.out + (size_t)tok * ND + d) = xv;
            }
        }
    }
}

namespace cg = cooperative_groups;
extern __shared__ __attribute__((aligned(16))) char dyn_smem[];
constexpr int cmax(int a, int b) { return a > b ? a : b; }
constexpr int L_G1 = GemmLds<256, 128>::BYTES + 512;
constexpr int L_MOE = GemmLds<MOE_BM, MOE_BN>::BYTES + (int)sizeof(MoeIdx) + 128 * 4;
constexpr int MEGA_LDS = cmax(cmax(cmax(ROUTE_LDS, PREP_LDS), cmax(ATTM_LDS, L_G1)), L_MOE);
typedef const unsigned long long __attribute__((address_space(4)))* kargp_t;
__device__ __forceinline__ void load_params(P& p, kargp_t ka) {
    asm volatile("" : "+s"(ka));
    unsigned long long* d = (unsigned long long*)&p;
#pragma unroll
    for (int i = 0; i < (int)(sizeof(P) / 8); ++i) d[i] = ka[i];
}
#define PHASE(call) do { P p; load_params(p, ka); call; } while (0)
__global__ void __launch_bounds__(NTHREADS) mega(P p_arg) {
    cg::grid_group grid = cg::this_grid();
    char* smem = dyn_smem;
    kargp_t ka = (kargp_t)__builtin_amdgcn_kernarg_segment_ptr();
    PHASE(ph_mod_partial(p));
    PHASE(ph_convert(p, smem));
    grid.sync();
    PHASE(ph_norm1(p, smem));
    grid.sync();
    PHASE(ph_gemm1(p, smem));
    grid.sync();
    PHASE(ph_post(p, smem));
    grid.sync();
    PHASE(ph_dn_prep(p, smem));
    grid.sync();
    PHASE(ph_attn_mfma(p, smem));
    grid.sync();
    PHASE(ph_dn_gate(p));
    grid.sync();
    PHASE(ph_gemm_out(p, smem));
    grid.sync();
    PHASE(ph_route(p, smem));
    grid.sync();
    PHASE(ph_moe_up(p, smem));
    grid.sync();
    PHASE(ph_moe_down(p, smem));
    grid.sync();
    PHASE(ph_combine(p, smem));
}

extern "C" void kernel_launch(void* const* d_in, const int* in_sizes, int n_in, void* d_out, int out_size, void* d_ws, size_t ws_size, hipStream_t stream) {
    if (n_in != 26 || out_size != NTOK * ND || ws_size < WS_END) { fprintf(stderr, "kernel_launch: unexpected shapes (n_in %d out %d ws %zu need %zu)\n", n_in, out_size, ws_size, (size_t)WS_END); return; }
    static int grid_blocks = 0;
    if (!grid_blocks) {
        int dev = 0, cus = 0, per_cu = 0;
        (void)hipGetDevice(&dev);
        (void)hipDeviceGetAttribute(&cus, hipDeviceAttributeMultiprocessorCount, dev);
        (void)hipFuncSetAttribute((const void*)mega, hipFuncAttributeMaxDynamicSharedMemorySize, MEGA_LDS);
        (void)hipOccupancyMaxActiveBlocksPerMultiprocessor(&per_cu, (const void*)mega, NTHREADS, MEGA_LDS);
        if (per_cu < 1) { fprintf(stderr, "kernel_launch: occupancy query says %d blocks/CU\n", per_cu); per_cu = 1; }
        grid_blocks = cus * per_cu;
    }
    P p{};
    const float** fp = (const float**)&p;
    for (int i = 0; i < 26; ++i) fp[i] = (const float*)d_in[i];
    p.pos = (const int*)d_in[2];
    p.out = (float*)d_out; p.ws = (unsigned char*)d_ws;
    (void)hipMemsetAsync((char*)d_ws + WS_CTL, 0, 4096, stream);
    void* args[] = {&p};
    hipError_t e = hipLaunchCooperativeKernel((const void*)mega, dim3(grid_blocks), dim3(NTHREADS), args, MEGA_LDS, stream);
    if (e != hipSuccess) fprintf(stderr, "cooperative launch failed: %s (grid %d)\n", hipGetErrorString(e), grid_blocks);
}
```

```cpp
#include <hip/hip_runtime.h>
#include <hip/hip_cooperative_groups.h>
#include <cstdio>
#include <cstdint>

typedef unsigned short bf16_t;
typedef short bf16x8 __attribute__((ext_vector_type(8)));
typedef float f32x16 __attribute__((ext_vector_type(16)));
typedef float f32x4 __attribute__((ext_vector_type(4)));

constexpr int NB = 8, NT = 2048, ND = 1024, NTOK = NB * NT;
constexpr int NPROJ = 3072;
constexpr int PC_QATT = 0, PC_KVLAT = 512, PC_QIDX = 640, PC_DNQKV = 896, PC_DNZ = 2432, PC_KIDX = 2944, PC_WIDX = 2976, PC_BETA = 2984, PC_A = 2988;
constexpr int W_IN_SRC = 2992;
constexpr int NE = 32, EFF = 512;
constexpr int KSPLIT = 16;
constexpr int NTHREADS = 512, NWAVES = 8;
constexpr float EPS = 1e-6f;
constexpr float LOG2E = 1.4426950408889634f;

constexpr size_t MiB = 1ull << 20;
constexpr size_t WS_CTL = 0;
constexpr size_t WS_MODP = WS_CTL + 1 * MiB;
constexpr size_t WS_WIN = WS_MODP + 3 * MiB;
constexpr size_t WS_WOUT = WS_WIN + 6 * MiB;
constexpr size_t WS_W13 = WS_WOUT + 2 * MiB;
constexpr size_t WS_W2 = WS_W13 + 64 * MiB;
constexpr size_t WS_PROJ = WS_W2 + 32 * MiB;
constexpr size_t WS_ACT = WS_PROJ;
constexpr size_t WS_YBUF = WS_PROJ + 32 * MiB;
constexpr size_t WS_QN = WS_PROJ + 96 * MiB;
constexpr size_t WS_K = WS_QN + 16 * MiB;
constexpr size_t WS_KI = WS_K + 2 * MiB;
constexpr size_t WS_WI = WS_KI + 1 * MiB;
constexpr size_t WS_DBG = WS_WI + 512 * 1024;
constexpr size_t WS_DQ = WS_DBG + 512 * 1024;
constexpr size_t WS_DK = WS_DQ + 16 * MiB;
constexpr size_t WS_H2 = WS_DQ;
constexpr size_t WS_DKT = WS_DK + 16 * MiB;
constexpr size_t WS_DVT = WS_DKT + 16 * MiB;
constexpr size_t WS_END = WS_DVT + 16 * MiB;
constexpr size_t WS_LIST = WS_K;
constexpr size_t WS_TOKINFO = WS_KI;
constexpr size_t WS_VT = WS_WIN;
constexpr size_t WS_POSMM = WS_WIN + 2 * MiB;
constexpr size_t DO_WN = 0, DO_U = 16 * MiB, DO_DNO = 32 * MiB, DO_PP = 48 * MiB, DO_EG = 56 * MiB, DO_LL = DO_EG + 256 * 1024, DO_GC = DO_LL + 256 * 1024;

struct P {
    const float* x; const float* c; const int* pos; const float* ada_w; const float* ada_b; const float* norm1_g; const float* norm2_g;
    const float* w_in; const float* q_norm_g; const float* k_norm_g; const float* kv_norm_g; const float* w_kv_up; const float* idx_k_norm_g;
    const float* rel_bias; const float* conv_w; const float* a_log; const float* dt_bias; const float* dn_norm_g; const float* w_out;
    const float* rg_w; const float* rg_b; const float* re_w; const float* re_b; const float* w1; const float* w3; const float* w2;
    float* out; unsigned char* ws;
};

__device__ __forceinline__ float bf2f(bf16_t h) { return __uint_as_float(((unsigned)h) << 16); }
__device__ __forceinline__ bf16_t f2bf(float f) { unsigned u = __float_as_uint(f); u += 0x7fffu + ((u >> 16) & 1u); return (bf16_t)(u >> 16); }
__device__ __forceinline__ unsigned pack2(float a, float b) { return (unsigned)f2bf(a) | ((unsigned)f2bf(b) << 16); }
__device__ __forceinline__ float wave_sum(float v) {
#pragma unroll
    for (int o = 32; o >= 1; o >>= 1) v += __shfl_xor(v, o);
    return v;
}
__device__ __forceinline__ float wave_max(float v) {
#pragma unroll
    for (int o = 32; o >= 1; o >>= 1) v = fmaxf(v, __shfl_xor(v, o));
    return v;
}
__device__ __forceinline__ int wave_isum(int v) {
#pragma unroll
    for (int o = 32; o >= 1; o >>= 1) v += __shfl_xor(v, o);
    return v;
}
__device__ __forceinline__ int tid_opaque() { int t = threadIdx.x; asm volatile("" : "+v"(t)); return t; }
__device__ __forceinline__ float silu_f(float x) { return x / (1.f + __expf(-x)); }
__device__ __forceinline__ float sigmoid_f(float x) { return 1.f / (1.f + __expf(-x)); }
__device__ __forceinline__ float mod_val(const P& p, int b, int which, int d) {
    const float* mp = (const float*)(p.ws + WS_MODP);
    const int col = which * ND + d;
    float s = p.ada_b[col];
#pragma unroll
    for (int ks = 0; ks < KSPLIT; ++ks) s += mp[(size_t)(ks * NB + b) * (6 * ND) + col];
    return s;
}

__device__ __forceinline__ void ph_mod_partial(const P& p) {
    const int tid = tid_opaque();
    const int lane = tid & 63, wave = tid >> 6;
    float* mp = (float*)(p.ws + WS_MODP);
    const int nitem = 96 * KSPLIT;
    for (int it = blockIdx.x * NWAVES + wave; it < nitem; it += gridDim.x * NWAVES) {
        const int cg = it % 96, ks = it / 96;
        const int col = cg * 64 + lane;
        float acc[NB];
#pragma unroll
        for (int b = 0; b < NB; ++b) acc[b] = 0.f;
        for (int kk = 0; kk < ND / KSPLIT; ++kk) {
            const int k = ks * (ND / KSPLIT) + kk;
            const float w = p.ada_w[(size_t)k * (6 * ND) + col];
#pragma unroll
            for (int b = 0; b < NB; ++b) acc[b] += silu_f(p.c[b * ND + k]) * w;
        }
#pragma unroll
        for (int b = 0; b < NB; ++b) mp[(size_t)(ks * NB + b) * (6 * ND) + col] = acc[b];
    }
}

__device__ __forceinline__ int win_src_col(int n) {
    if (n < 896) return n;
    if (n < 2944) return n + 40;
    if (n < 2976) return n - 2944 + 896;
    if (n < 2984) return n - 2976 + 928;
    if (n < 2992) return n;
    return -1;
}
__device__ __forceinline__ void conv_tile(const int tid, float* tile  , const float* src0, const float* src1, int nsrc, int mode, int n0, int k0, bf16_t* dst, int K, int qcol) {
    {
        const int n = tid & 63, r = tid >> 6;
        int col; const float* src = src0;
        if (mode == 0) col = n0 + n;
        else if (mode == 1) col = win_src_col(n0 + n);
        else { col = qcol + (n & 31); if (n >= 32) src = src1; }
#pragma unroll
        for (int i = 0; i < 8; ++i) {
            const int k = r + 8 * i;
            tile[k * 65 + n] = (col >= 0) ? src[(size_t)(k0 + k) * nsrc + col] : 0.f;
        }
    }
    __syncthreads();
    {
        const int n = tid >> 3, kc = tid & 7;
        unsigned w[4];
#pragma unroll
        for (int j = 0; j < 4; ++j) w[j] = pack2(tile[(kc * 8 + 2 * j) * 65 + n], tile[(kc * 8 + 2 * j + 1) * 65 + n]);
        *(uint4*)(dst + (size_t)(n0 + n) * K + k0 + kc * 8) = make_uint4(w[0], w[1], w[2], w[3]);
    }
    __syncthreads();
}
__device__ __forceinline__ void ph_convert(const P& p, char* smem) {
    const int tid = tid_opaque();
    float* tile = (float*)smem;
    bf16_t* Wt_in = (bf16_t*)(p.ws + WS_WIN); bf16_t* Wt_out = (bf16_t*)(p.ws + WS_WOUT);
    bf16_t* Wt13 = (bf16_t*)(p.ws + WS_W13); bf16_t* Wt2 = (bf16_t*)(p.ws + WS_W2);
    const int T0 = 48 * 16, T1 = 16 * 16, T2 = NE * 256, T3 = NE * 128;
    const int total = T0 + T1 + T2 + T3;
    for (int t = blockIdx.x; t < total; t += gridDim.x) {
        if (t < T0) { const int nt = t / 16, kt = t % 16; conv_tile(tid, tile, p.w_in, nullptr, W_IN_SRC, 1, nt * 64, kt * 64, Wt_in, ND, 0); }
        else if (t < T0 + T1) { const int u = t - T0; const int nt = u / 16, kt = u % 16; conv_tile(tid, tile, p.w_out, nullptr, ND, 0, nt * 64, kt * 64, Wt_out, ND, 0); }
        else if (t < T0 + T1 + T2) { const int u = t - T0 - T1; const int e = u / 256, v = u % 256; const int nt = v / 16, kt = v % 16;
            conv_tile(tid, tile, p.w1 + (size_t)e * ND * EFF, p.w3 + (size_t)e * ND * EFF, EFF, 2, nt * 64, kt * 64, Wt13 + (size_t)e * 1024 * ND, ND, nt * 32); }
        else { const int u = t - T0 - T1 - T2; const int e = u / 128, v = u % 128; const int nt = v / 8, kt = v % 8;
            conv_tile(tid, tile, p.w2 + (size_t)e * EFF * ND, nullptr, ND, 0, nt * 64, kt * 64, Wt2 + (size_t)e * ND * EFF, EFF, 0); }
    }
}

__device__ __forceinline__ void ph_norm1(const P& p, char* smem) {
    const int tid = tid_opaque();
    float* sA = (float*)smem; float* sB = sA + ND;
    const int lane = tid & 63, wave = tid >> 6;
    bf16_t* h = (bf16_t*)p.out;
    int curb = -1;
    for (int tile = blockIdx.x; tile < NTOK / 64; tile += gridDim.x) {
        const int b = tile / (NT / 64);
        if (b != curb) {
            __syncthreads();
            for (int d = tid; d < ND; d += NTHREADS) { sA[d] = p.norm1_g[d] * (1.f + mod_val(p, b, 1, d)); sB[d] = mod_val(p, b, 0, d); }
            __syncthreads();
            curb = b;
        }
        for (int i = 0; i < 8; ++i) {
            const int tok = tile * 64 + wave * 8 + i;
            const float* xr = p.x + (size_t)tok * ND;
            f32x4 v[4]; float ss = 0.f;
#pragma unroll
            for (int j = 0; j < 4; ++j) { v[j] = *(const f32x4*)(xr + j * 256 + lane * 4); ss += v[j][0] * v[j][0] + v[j][1] * v[j][1] + v[j][2] * v[j][2] + v[j][3] * v[j][3]; }
            ss = wave_sum(ss);
            const float rstd = rsqrtf(ss * (1.f / ND) + EPS);
#pragma unroll
            for (int j = 0; j < 4; ++j) {
                const int d = j * 256 + lane * 4;
                const float o0 = v[j][0] * rstd * sA[d] + sB[d], o1 = v[j][1] * rstd * sA[d + 1] + sB[d + 1], o2 = v[j][2] * rstd * sA[d + 2] + sB[d + 2], o3 = v[j][3] * rstd * sA[d + 3] + sB[d + 3];
                *(uint2*)(h + (size_t)tok * ND + d) = make_uint2(pack2(o0, o1), pack2(o2, o3));
            }
        }
    }
}

constexpr int LDS_LD = 72;
template <int BM, int BN> struct GemmLds { static constexpr int BYTES = 2 * (BM + BN) * LDS_LD * 2; };
template <int BM, int BN, class AF, class BF>
__device__ __forceinline__ void gemm_tile(const int tid, char* smem, int K, AF aptr, BF bptr, f32x16 (&acc)[2][2]) {
    constexpr int WM = BM / 64;
    constexpr int NA = BM / 64, NBc = BN / 64;
    bf16_t* As = (bf16_t*)smem;
    bf16_t* Bs = As + 2 * BM * LDS_LD;
    const int lane = tid & 63, wave = tid >> 6;
    const int wm = wave % WM, wn = wave / WM;
    uint4 ra0, ra1, ra2, ra3, rb0, rb1, rb2, rb3;
    ra0 = ra1 = ra2 = ra3 = rb0 = rb1 = rb2 = rb3 = make_uint4(0, 0, 0, 0);
#pragma unroll
    for (int m = 0; m < 2; ++m)
#pragma unroll
        for (int n = 0; n < 2; ++n)
#pragma unroll
            for (int r = 0; r < 16; ++r) acc[m][n][r] = 0.f;
    const int nk = K / 64;
    const int cr = tid >> 3, ck = (tid & 7) * 8;
#define GT_LOAD(kt) do { \
        ra0 = *(const uint4*)aptr(cr, (kt) * 64 + ck); ra1 = *(const uint4*)aptr(cr + 64, (kt) * 64 + ck); \
        if constexpr (NA > 2) { ra2 = *(const uint4*)aptr(cr + 128, (kt) * 64 + ck); ra3 = *(const uint4*)aptr(cr + 192, (kt) * 64 + ck); } \
        rb0 = *(const uint4*)bptr(cr, (kt) * 64 + ck); rb1 = *(const uint4*)bptr(cr + 64, (kt) * 64 + ck); \
        if constexpr (NBc > 2) { rb2 = *(const uint4*)bptr(cr + 128, (kt) * 64 + ck); rb3 = *(const uint4*)bptr(cr + 192, (kt) * 64 + ck); } } while (0)
#define GT_STORE(buf) do { \
        bf16_t* as_ = As + ((buf) * BM + cr) * LDS_LD + ck; bf16_t* bs_ = Bs + ((buf) * BN + cr) * LDS_LD + ck; \
        *(uint4*)as_ = ra0; *(uint4*)(as_ + 64 * LDS_LD) = ra1; \
        if constexpr (NA > 2) { *(uint4*)(as_ + 128 * LDS_LD) = ra2; *(uint4*)(as_ + 192 * LDS_LD) = ra3; } \
        *(uint4*)bs_ = rb0; *(uint4*)(bs_ + 64 * LDS_LD) = rb1; \
        if constexpr (NBc > 2) { *(uint4*)(bs_ + 128 * LDS_LD) = rb2; *(uint4*)(bs_ + 192 * LDS_LD) = rb3; } } while (0)
    GT_LOAD(0); GT_STORE(0); __syncthreads();
    for (int kt = 0; kt < nk; ++kt) {
        if (kt + 1 < nk) GT_LOAD(kt + 1);
        const bf16_t* a0 = As + ((kt & 1) * BM + wm * 64 + (lane & 31)) * LDS_LD + 8 * (lane >> 5);
        const bf16_t* b0 = Bs + ((kt & 1) * BN + wn * 64 + (lane & 31)) * LDS_LD + 8 * (lane >> 5);
#pragma unroll
        for (int ks = 0; ks < 4; ++ks) {
            const bf16x8 fa0 = *(const bf16x8*)(a0 + ks * 16), fa1 = *(const bf16x8*)(a0 + 32 * LDS_LD + ks * 16);
            const bf16x8 fb0 = *(const bf16x8*)(b0 + ks * 16), fb1 = *(const bf16x8*)(b0 + 32 * LDS_LD + ks * 16);
            acc[0][0] = __builtin_amdgcn_mfma_f32_32x32x16_bf16(fa0, fb0, acc[0][0], 0, 0, 0);
            acc[0][1] = __builtin_amdgcn_mfma_f32_32x32x16_bf16(fa0, fb1, acc[0][1], 0, 0, 0);
            acc[1][0] = __builtin_amdgcn_mfma_f32_32x32x16_bf16(fa1, fb0, acc[1][0], 0, 0, 0);
            acc[1][1] = __builtin_amdgcn_mfma_f32_32x32x16_bf16(fa1, fb1, acc[1][1], 0, 0, 0);
        }
        if (kt + 1 < nk) GT_STORE((kt + 1) & 1);
        __syncthreads();
    }
}

__device__ __forceinline__ void ph_gemm1(const P& p, char* smem) {
    const int tid = tid_opaque();
    constexpr int BM = 256, BN = 128;
    const bf16_t* h = (const bf16_t*)p.out; const bf16_t* Wt = (const bf16_t*)(p.ws + WS_WIN);
    bf16_t* proj = (bf16_t*)(p.ws + WS_PROJ);
    const int lane = tid & 63, wave = tid >> 6, wm = wave % 4, wn = wave / 4;
    const int ntn = NPROJ / BN, ntiles = (NTOK / BM) * ntn;
    for (int t = blockIdx.x; t < ntiles; t += gridDim.x) {
        const int tm = t / ntn, tn = t % ntn;
        const bf16_t* Ab = h + (size_t)tm * BM * ND; const bf16_t* Bb = Wt + (size_t)tn * BN * ND;
        f32x16 acc[2][2];
        gemm_tile<BM, BN>(tid, smem, ND, [&](int r, int k) __attribute__((always_inline)) { return Ab + (size_t)r * ND + k; }, [&](int r, int k) __attribute__((always_inline)) { return Bb + (size_t)r * ND + k; }, acc);
#pragma unroll
        for (int m = 0; m < 2; ++m)
#pragma unroll
            for (int n = 0; n < 2; ++n)
#pragma unroll
                for (int r = 0; r < 16; ++r) {
                    const int row = tm * BM + wm * 64 + m * 32 + (r & 3) + 8 * (r >> 2) + 4 * (lane >> 5);
                    const int col = tn * BN + wn * 64 + n * 32 + (lane & 31);
                    proj[(size_t)row * NPROJ + col] = f2bf(acc[m][n][r]);
                }
    }
}

__device__ __forceinline__ void ph_post(const P& p, char* smem) {
    const int tid = tid_opaque();
    float* sW = (float*)smem;
    for (int i = tid; i < 128 * 128; i += NTHREADS) sW[i] = p.w_kv_up[i];
    __syncthreads();
    const int lane = tid & 63, wave = tid >> 6;
    const bf16_t* proj = (const bf16_t*)(p.ws + WS_PROJ);
    bf16_t* qn = (bf16_t*)(p.ws + WS_QN); bf16_t* Kb = (bf16_t*)(p.ws + WS_K); bf16_t* kib = (bf16_t*)(p.ws + WS_KI);
    float* wi = (float*)(p.ws + WS_WI); float* dbeta = (float*)(p.ws + WS_DBG); float* dg = dbeta + NTOK * 4;
    bf16_t* dq = (bf16_t*)(p.ws + WS_DQ); bf16_t* dk = (bf16_t*)(p.ws + WS_DK); bf16_t* dkT = (bf16_t*)(p.ws + WS_DKT); bf16_t* dvT = (bf16_t*)(p.ws + WS_DVT);
    bf16_t* Vt = (bf16_t*)(p.ws + WS_VT);
    {
        const int g = blockIdx.x * NTHREADS + tid;
        if (g < NB * 64) { int mn = 0x7fffffff, mx = -0x7fffffff; for (int i = 0; i < 32; ++i) { const int v = p.pos[g * 32 + i]; mn = min(mn, v); mx = max(mx, v); } int* pm = (int*)(p.ws + WS_POSMM); pm[g * 2] = mn; pm[g * 2 + 1] = mx; }
    }
    for (int tg = blockIdx.x * NWAVES + wave; tg < NTOK / 8; tg += gridDim.x * NWAVES) {
      for (int ti = 0; ti < 8; ++ti) {
        const int tok = tg * 8 + ti;
        const int t = tok % NT;
        const bf16_t* pr = proj + (size_t)tok * NPROJ;
        {
            const uint4 raw = *(const uint4*)(pr + PC_QATT + lane * 8);
            const unsigned w[4] = {raw.x, raw.y, raw.z, raw.w};
            float v[8]; float ss = 0.f;
#pragma unroll
            for (int j = 0; j < 4; ++j) { v[2 * j] = __uint_as_float(w[j] << 16); v[2 * j + 1] = __uint_as_float(w[j] & 0xffff0000u); }
#pragma unroll
            for (int j = 0; j < 8; ++j) ss += v[j] * v[j];
            ss += __shfl_xor(ss, 1); ss += __shfl_xor(ss, 2); ss += __shfl_xor(ss, 4);
            const float rs = rsqrtf(ss * (1.f / 64.f) + EPS) * (0.125f * LOG2E);
            const int d0 = (lane & 7) * 8;
            unsigned o[4];
#pragma unroll
            for (int j = 0; j < 4; ++j) o[j] = pack2(v[2 * j] * rs * p.q_norm_g[d0 + 2 * j], v[2 * j + 1] * rs * p.q_norm_g[d0 + 2 * j + 1]);
            *(uint4*)(qn + (size_t)tok * 512 + lane * 8) = make_uint4(o[0], o[1], o[2], o[3]);
        }
        {
            const unsigned raw = *(const unsigned*)(pr + PC_KVLAT + lane * 2);
            float a0 = __uint_as_float(raw << 16), a1 = __uint_as_float(raw & 0xffff0000u);
            float ss = wave_sum(a0 * a0 + a1 * a1);
            const float rs = rsqrtf(ss * (1.f / 128.f) + EPS);
            a0 *= rs * p.kv_norm_g[lane * 2]; a1 *= rs * p.kv_norm_g[lane * 2 + 1];
            float k = 0.f, v = 0.f;
#pragma unroll 8
            for (int i = 0; i < 64; ++i) {
                const float x0 = __shfl(a0, i), x1 = __shfl(a1, i);
                k += x0 * sW[(2 * i) * 128 + lane] + x1 * sW[(2 * i + 1) * 128 + lane];
                v += x0 * sW[(2 * i) * 128 + 64 + lane] + x1 * sW[(2 * i + 1) * 128 + 64 + lane];
            }
            const float ks = wave_sum(k * k);
            k *= rsqrtf(ks * (1.f / 64.f) + EPS) * p.k_norm_g[lane];
            Kb[(size_t)tok * 64 + lane] = f2bf(k);
            Vt[((size_t)(tok / NT) * 64 + lane) * NT + t] = f2bf(v);
        }
        {
            float a = (lane < 32) ? bf2f(pr[PC_KIDX + lane]) : 0.f;
            const float ss = wave_sum(a * a);
            a *= rsqrtf(ss * (1.f / 32.f) + EPS);
            if (lane < 32) kib[(size_t)tok * 32 + lane] = f2bf(a * p.idx_k_norm_g[lane]);
            if (lane < 8) wi[(size_t)tok * 8 + lane] = bf2f(pr[PC_WIDX + lane]) * 0.35355339059327373f * 0.17677669529663687f;
            if (lane < 4) {
                dbeta[(size_t)tok * 4 + lane] = sigmoid_f(bf2f(pr[PC_BETA + lane]));
                const float z = bf2f(pr[PC_A + lane]) + p.dt_bias[lane];
                const float sp = (z > 20.f) ? z : log1pf(__expf(z));
                dg[(size_t)tok * 4 + lane] = -__expf(p.a_log[lane]) * sp;
            }
        }
      }
        {
            const int tok0 = tg * 8, t0 = tok0 % NT, bb = tok0 / NT;
#pragma unroll 1
            for (int j = 0; j < 12; ++j) {
                const int ch = j * 128 + lane * 2;
                float w0[11], w1[11];
#pragma unroll
                for (int i = 0; i < 11; ++i) {
                    unsigned raw = 0u;
                    if (t0 - 3 + i >= 0) raw = *(const unsigned*)(proj + (size_t)(tok0 - 3 + i) * NPROJ + PC_DNQKV + ch);
                    w0[i] = __uint_as_float(raw << 16); w1[i] = __uint_as_float(raw & 0xffff0000u);
                }
                float c0[4], c1[4];
#pragma unroll
                for (int tap = 0; tap < 4; ++tap) { c0[tap] = p.conv_w[tap * 1536 + ch]; c1[tap] = p.conv_w[tap * 1536 + ch + 1]; }
                float y0[8], y1[8];
#pragma unroll
                for (int i = 0; i < 8; ++i) {
                    float a0 = 0.f, a1 = 0.f;
#pragma unroll
                    for (int tap = 0; tap < 4; ++tap) { a0 += c0[tap] * w0[i + tap]; a1 += c1[tap] * w1[i + tap]; }
                    y0[i] = silu_f(a0); y1[i] = silu_f(a1);
                    if (j < 8) {
                        const float ss = wave_sum(y0[i] * y0[i] + y1[i] * y1[i]);
                        float rs = rsqrtf(ss + EPS);
                        if (j < 4) rs *= 0.08838834764831845f;
                        y0[i] *= rs; y1[i] *= rs;
                    }
                }
                if (j < 8) {
                    bf16_t* dst = (j < 4) ? dq : dk;
#pragma unroll
                    for (int i = 0; i < 8; ++i) *(unsigned*)(dst + (size_t)(tok0 + i) * 512 + (j & 3) * 128 + lane * 2) = pack2(y0[i], y1[i]);
                }
                if (j >= 4) {
                    bf16_t* dstT = ((j < 8) ? dkT : dvT) + ((size_t)(bb * 4 + (j & 3)) * 128 + lane * 2) * NT + t0;
                    *(uint4*)dstT = make_uint4(pack2(y0[0], y0[1]), pack2(y0[2], y0[3]), pack2(y0[4], y0[5]), pack2(y0[6], y0[7]));
                    *(uint4*)(dstT + NT) = make_uint4(pack2(y1[0], y1[1]), pack2(y1[2], y1[3]), pack2(y1[4], y1[5]), pack2(y1[6], y1[7]));
                }
            }
        }
    }
}

__device__ __forceinline__ unsigned f2sortable(float f) { const unsigned u = __float_as_uint(f); return (u & 0x80000000u) ? ~u : (u | 0x80000000u); }
template <int CTRL> __device__ __forceinline__ float dpp_f(float v) { return __int_as_float(__builtin_amdgcn_update_dpp(0, __float_as_int(v), CTRL, 0xF, 0xF, false)); }
template <int CTRL> __device__ __forceinline__ int dpp_i(int v) { return __builtin_amdgcn_update_dpp(0, v, CTRL, 0xF, 0xF, false); }
__device__ __forceinline__ float sum8_f(float v) { v += dpp_f<0xB1>(v); v += dpp_f<0x4E>(v); v += dpp_f<0x141>(v); return v; }
__device__ __forceinline__ int sum16_i(int v) { v += dpp_i<0xB1>(v); v += dpp_i<0x4E>(v); v += dpp_i<0x141>(v); v += __shfl_xor(v, 32); return v; }
__device__ __forceinline__ int pi32(int r) { return (r & 0x13) | ((r & 4) << 1) | ((r & 8) >> 1); }
__device__ __forceinline__ constexpr int key_of_reg(int r) { return (r & 3) + 4 * ((r >> 2) & 1) + 16 * (r >> 3); }
struct KiFrag { bf16x8 a0, a1; };
__device__ __forceinline__ KiFrag ki_load(const bf16_t* ki_b, int kt, int lane) {
    const bf16_t* kr = ki_b + (size_t)(kt * 32 + pi32(lane & 31)) * 32 + 8 * (lane >> 5);
    KiFrag f; f.a0 = *(const bf16x8*)kr; f.a1 = *(const bf16x8*)(kr + 16); return f;
}
__device__ __forceinline__ void idx_scores(f32x16& sc, const KiFrag& f, bf16x8 qi0, bf16x8 qi1, float wl) {
    f32x16 z;
#pragma unroll
    for (int r = 0; r < 16; ++r) z[r] = 0.f;
    z = __builtin_amdgcn_mfma_f32_32x32x16_bf16(f.a0, qi0, z, 0, 0, 0);
    z = __builtin_amdgcn_mfma_f32_32x32x16_bf16(f.a1, qi1, z, 0, 0, 0);
#pragma unroll
    for (int r = 0; r < 16; ++r) sc[r] = sum8_f(fmaxf(z[r], 0.f) * wl);
}
constexpr int ATTM_LDS = 129 * 8 * 4;
__device__ __forceinline__ void attn_pass1(const P& p, int b, int t0, int lane, float& tauf, int& cut) {
    const int hf = lane >> 5, cq = (lane & 31) >> 3, ch = lane & 7;
    const int tq = t0 + cq, tok = b * NT + tq;
    const int ntile = (t0 + 3) / 32 + 1;
    const bf16_t* proj = (const bf16_t*)(p.ws + WS_PROJ);
    const bf16_t* ki_b = (const bf16_t*)(p.ws + WS_KI) + (size_t)b * NT * 32;
    const bf16x8 qi0 = *(const bf16x8*)(proj + (size_t)tok * NPROJ + PC_QIDX + ch * 32 + 8 * hf);
    const bf16x8 qi1 = *(const bf16x8*)(proj + (size_t)tok * NPROJ + PC_QIDX + ch * 32 + 16 + 8 * hf);
    const float wl = ((const float*)(p.ws + WS_WI))[(size_t)tok * 8 + ch];
    float keep[8][16];
#pragma unroll
    for (int s = 0; s < 8; ++s)
#pragma unroll
        for (int r = 0; r < 16; ++r) keep[s][r] = -INFINITY;
    KiFrag ring[2];
    ring[0] = ki_load(ki_b, 0, lane);
#pragma unroll
    for (int kt = 0; kt < 64; ++kt) {
        if (kt < ntile) {
            ring[(kt + 1) & 1] = ki_load(ki_b, min(kt + 1, ntile - 1), lane);
            __builtin_amdgcn_sched_barrier(0);
            f32x16 sc;
            idx_scores(sc, ring[kt & 1], qi0, qi1, wl);
            if (kt * 32 + 31 > t0) {
#pragma unroll
                for (int r = 0; r < 16; ++r) sc[r] = (kt * 32 + key_of_reg(r) + 8 * hf <= tq) ? sc[r] : -INFINITY;
            }
            if (ch == (kt & 7)) {
#pragma unroll
                for (int r = 0; r < 16; ++r) keep[kt >> 3][r] = sc[r];
            }
        }
    }
    unsigned u[8][16];
#pragma unroll
    for (int s = 0; s < 8; ++s)
#pragma unroll
        for (int r = 0; r < 16; ++r) u[s][r] = f2sortable(keep[s][r]);
    unsigned prefix = 0u;
    for (int bit = 31; bit >= 0; --bit) {
        const unsigned cand = prefix | (1u << bit);
        int cnt = 0;
#pragma unroll
        for (int s = 0; s < 8; ++s) {
            if (s * 256 <= t0 + 3) {
#pragma unroll
                for (int r = 0; r < 16; ++r) cnt += (u[s][r] >= cand) ? 1 : 0;
            }
        }
        cnt = sum16_i(cnt);
        if (cnt >= 256) prefix = cand;
    }
    int ngt = 0, neq = 0;
#pragma unroll
    for (int s = 0; s < 8; ++s)
#pragma unroll
        for (int r = 0; r < 16; ++r) { ngt += (u[s][r] > prefix) ? 1 : 0; neq += (u[s][r] == prefix) ? 1 : 0; asm volatile("" : "+v"(ngt), "+v"(neq)); }
    ngt = sum16_i(ngt); neq = sum16_i(neq);
    const bool big = tq >= 256;
    const int need = 256 - ngt;
    if (__any(big && need < neq)) {
        int lo = 0, hi = NT - 1;
        for (int it = 0; it < 11; ++it) {
            const int mid = (lo + hi) >> 1;
            int cnt = 0;
            unsigned pf = prefix; asm volatile("" : "+v"(pf));
#pragma unroll
            for (int s = 0; s < 8; ++s)
#pragma unroll
                for (int r = 0; r < 16; ++r) { cnt += (u[s][r] == pf && ((s * 8 + ch) * 32 + key_of_reg(r) + 8 * hf) <= mid) ? 1 : 0; asm volatile("" : "+v"(cnt)); }
            cnt = sum16_i(cnt);
            if (cnt >= need) hi = mid; else lo = mid + 1;
        }
        if (big && need < neq) cut = lo;
    }
    if (big) { const unsigned pu = prefix; tauf = __uint_as_float((pu & 0x80000000u) ? (pu & 0x7fffffffu) : ~pu); }
}
__device__ __forceinline__ void attn_pass2(const P& p, const float* sbl, int b, int t0, int lane, float tauf, int cut) {
    const int hf = lane >> 5, cq = (lane & 31) >> 3, ch = lane & 7;
    const int tq = t0 + cq, tok = b * NT + tq;
    const int ntile = (t0 + 3) / 32 + 1;
    const bf16_t* proj = (const bf16_t*)(p.ws + WS_PROJ);
    bf16_t* qn = (bf16_t*)(p.ws + WS_QN);
    const int* posmm = (const int*)(p.ws + WS_POSMM);
    const bf16_t* ki_b = (const bf16_t*)(p.ws + WS_KI) + (size_t)b * NT * 32;
    const bf16_t* K_b = (const bf16_t*)(p.ws + WS_K) + (size_t)b * NT * 64;
    const bf16_t* Vt_b = (const bf16_t*)(p.ws + WS_VT) + (size_t)b * 64 * NT;
    const bf16x8 qi0 = *(const bf16x8*)(proj + (size_t)tok * NPROJ + PC_QIDX + ch * 32 + 8 * hf);
    const bf16x8 qi1 = *(const bf16x8*)(proj + (size_t)tok * NPROJ + PC_QIDX + ch * 32 + 16 + 8 * hf);
    const float wl = ((const float*)(p.ws + WS_WI))[(size_t)tok * 8 + ch];
    bf16x8 qb[4];
#pragma unroll
    for (int ks = 0; ks < 4; ++ks) qb[ks] = *(const bf16x8*)(qn + (size_t)tok * 512 + ch * 64 + ks * 16 + 8 * hf);
    const int pq = p.pos[tok];
    int pqmin = pq;
    pqmin = min(pqmin, __shfl_xor(pqmin, 8)); pqmin = min(pqmin, __shfl_xor(pqmin, 16));
    pqmin = __builtin_amdgcn_readfirstlane(pqmin);
    const float bias_far = sbl[128 * 8 + ch];
    const bool anycut = __any(cut != 0x7fffffff);
    f32x16 o0, o1;
#pragma unroll
    for (int r = 0; r < 16; ++r) { o0[r] = 0.f; o1[r] = 0.f; }
    float m = -INFINITY, l = 0.f;
    struct TileFrags { KiFrag ki; bf16x8 k[4]; bf16x8 v[4]; };
    auto load_tile = [&](int kt) __attribute__((always_inline)) {
        TileFrags f;
        f.ki = ki_load(ki_b, kt, lane);
        const bf16_t* kr = K_b + (size_t)(kt * 32 + pi32(lane & 31)) * 64 + 8 * hf;
#pragma unroll
        for (int ks = 0; ks < 4; ++ks) f.k[ks] = *(const bf16x8*)(kr + ks * 16);
        const bf16_t* vr = Vt_b + (size_t)(lane & 31) * NT + kt * 32 + 8 * hf;
        f.v[0] = *(const bf16x8*)vr; f.v[1] = *(const bf16x8*)(vr + 16); f.v[2] = *(const bf16x8*)(vr + 32 * NT); f.v[3] = *(const bf16x8*)(vr + 32 * NT + 16);
        return f;
    };
    TileFrags cur = load_tile(0);
    for (int kt = 0; kt < ntile; ++kt) {
        const TileFrags nxt = load_tile(min(kt + 1, ntile - 1));
        f32x16 sc;
        idx_scores(sc, cur.ki, qi0, qi1, wl);
        f32x16 s;
#pragma unroll
        for (int r = 0; r < 16; ++r) s[r] = 0.f;
#pragma unroll
        for (int ks = 0; ks < 4; ++ks) s = __builtin_amdgcn_mfma_f32_32x32x16_bf16(cur.k[ks], qb[ks], s, 0, 0, 0);
        const int kbase = kt * 32 + 8 * hf;
        if (pqmin - posmm[(b * 64 + kt) * 2 + 1] >= 128) {
#pragma unroll
            for (int r = 0; r < 16; ++r) s[r] += bias_far;
        } else {
#pragma unroll
            for (int r = 0; r < 16; ++r) {
                int n = pq - p.pos[b * NT + kbase + key_of_reg(r)];
                n = n < 0 ? 0 : (n > 128 ? 128 : n);
                s[r] += sbl[n * 8 + ch];
            }
        }
        if (anycut) {
#pragma unroll
            for (int r = 0; r < 16; ++r) { const bool ok = (sc[r] > tauf) || (sc[r] == tauf && (kbase + key_of_reg(r)) <= cut); s[r] = ok ? s[r] : -INFINITY; }
        } else {
#pragma unroll
            for (int r = 0; r < 16; ++r) s[r] = (sc[r] >= tauf) ? s[r] : -INFINITY;
        }
        if (kt * 32 + 31 > t0) {
#pragma unroll
            for (int r = 0; r < 16; ++r) s[r] = (kbase + key_of_reg(r) <= tq) ? s[r] : -INFINITY;
        }
        float mx = s[0];
#pragma unroll
        for (int r = 1; r < 16; ++r) mx = fmaxf(mx, s[r]);
        mx = fmaxf(mx, __shfl_xor(mx, 32));
        const float mnew = fmaxf(m, mx);
        const float msafe = (mnew == -INFINITY) ? 0.f : mnew;
        const float alpha = exp2f(m - msafe);
        m = mnew;
        float ps = 0.f;
#pragma unroll
        for (int r = 0; r < 16; ++r) { s[r] = exp2f(s[r] - msafe); ps += s[r]; }
        l = l * alpha + ps;
        if (__any(alpha != 1.f)) {
#pragma unroll
            for (int r = 0; r < 16; ++r) { o0[r] *= alpha; o1[r] *= alpha; }
        }
        bf16x8 pb0, pb1;
#pragma unroll
        for (int jx = 0; jx < 8; ++jx) { pb0[jx] = (short)f2bf(s[jx]); pb1[jx] = (short)f2bf(s[8 + jx]); }
        o0 = __builtin_amdgcn_mfma_f32_32x32x16_bf16(cur.v[0], pb0, o0, 0, 0, 0);
        o0 = __builtin_amdgcn_mfma_f32_32x32x16_bf16(cur.v[1], pb1, o0, 0, 0, 0);
        o1 = __builtin_amdgcn_mfma_f32_32x32x16_bf16(cur.v[2], pb0, o1, 0, 0, 0);
        o1 = __builtin_amdgcn_mfma_f32_32x32x16_bf16(cur.v[3], pb1, o1, 0, 0, 0);
        cur = nxt;
    }
    l += __shfl_xor(l, 32);
    const float inv = 1.f / l;
    bf16_t* orow = qn + (size_t)tok * 512 + ch * 64;
#pragma unroll
    for (int gq = 0; gq < 4; ++gq) {
        *(uint2*)(orow + gq * 8 + 4 * hf) = make_uint2(pack2(o0[gq * 4] * inv, o0[gq * 4 + 1] * inv), pack2(o0[gq * 4 + 2] * inv, o0[gq * 4 + 3] * inv));
        *(uint2*)(orow + 32 + gq * 8 + 4 * hf) = make_uint2(pack2(o1[gq * 4] * inv, o1[gq * 4 + 1] * inv), pack2(o1[gq * 4 + 2] * inv, o1[gq * 4 + 3] * inv));
    }
}
__device__ __forceinline__ void dn_scan_block(const P& p, char* smem, int bh, int tid);
template <int MODE>
__device__ __forceinline__ void ph_attn_mfma(const P& p, char* smem) {
    const int tid = tid_opaque();
    float* sbl = (float*)smem;
    for (int i = tid; i < 129 * 8; i += NTHREADS) {
        const int n = i >> 3, h = i & 7; int bk;
        if (n < 16) bk = n;
        else { const float v = logf((float)n / 16.f) / 2.0794415416798357f * 16.f; bk = 16 + (int)v; if (bk > 31) bk = 31; }
        sbl[i] = p.rel_bias[bk * 8 + h] * LOG2E;
    }
    __syncthreads();
    int* qctr = (int*)(p.ws + WS_CTL) + 64;
    if (MODE != 2 && blockIdx.x < NB * 4) {
        int tid0 = tid; asm volatile("" : "+v"(tid0));
        dn_scan_block(p, smem + 4608, blockIdx.x, tid0);
    }
    if (MODE != 1) for (;;) {
        int lane = tid & 63; asm volatile("" : "+v"(lane));
        int w = 0;
        if (lane == 0) w = atomicAdd(qctr, 1);
        w = __builtin_amdgcn_readfirstlane(w);
        if (w >= NTOK / 4) break;
        const int g = w >> 3, j = w & 7;
        const int b = g & 7, t0 = (63 - (g >> 3)) * 32 + (7 - j) * 4;
        float tauf = -INFINITY; int cut = 0x7fffffff;
        if (t0 + 3 >= 256) attn_pass1(p, b, t0, lane, tauf, cut);
        int lane2 = tid & 63; asm volatile("" : "+v"(lane2));
        attn_pass2(p, sbl, b, t0, lane2, tauf, cut);
    }
}

__device__ __forceinline__ constexpr int sig16(int x) { return (x & ~12) | ((x & 4) << 1) | ((x & 8) >> 1); }
constexpr int PREP_WAVE_LDS = 2 * 64 * 72 * 2 + 4 * 64 * 4;
constexpr int PREP_LDS = NWAVES * PREP_WAVE_LDS;
__device__ __forceinline__ void ph_dn_prep(const P& p, char* smem) {
    const int tid = tid_opaque();
    const int wave = tid >> 6;
    char* wl = smem + wave * PREP_WAVE_LDS;
    float* sA = (float*)wl;
    bf16_t* sTw = (bf16_t*)wl; bf16_t* sTu = sTw + 64 * 72;
    float* sG = (float*)(wl + 2 * 64 * 72 * 2); float* sB = sG + 64; float* sE = sB + 64; float* sL = sE + 64;
    const bf16_t* dq = (const bf16_t*)(p.ws + WS_DQ); const bf16_t* dk = (const bf16_t*)(p.ws + WS_DK);
    const bf16_t* dkT = (const bf16_t*)(p.ws + WS_DKT); const bf16_t* dvT = (const bf16_t*)(p.ws + WS_DVT);
    const float* dbeta = (const float*)(p.ws + WS_DBG); const float* dg = dbeta + NTOK * 4;
    unsigned char* dob = (unsigned char*)p.out;
    bf16_t* PPg = (bf16_t*)(dob + DO_PP); float* GCg = (float*)(dob + DO_GC); float* EGg = (float*)(dob + DO_EG); float* LLg = (float*)(dob + DO_LL);
    for (int item = blockIdx.x * NWAVES + wave; item < NB * 4 * 32; item += gridDim.x * NWAVES) {
        int lane = tid & 63; asm volatile("" : "+v"(lane));
        const int hf = lane >> 5, l31 = lane & 31;
        const int bh = item >> 5, c = item & 31, b = bh >> 2, hh = bh & 3;
        const int tok0 = b * NT + c * 64;
        bf16_t* WN = (bf16_t*)(dob + DO_WN) + (size_t)item * 64 * 128; bf16_t* Ug = (bf16_t*)(dob + DO_U) + (size_t)item * 64 * 128;
        bf16_t* PP = PPg + (size_t)item * 64 * 64;
        float G, beta, eG;
        {
            const float g = dg[(size_t)(tok0 + lane) * 4 + hh];
            beta = dbeta[(size_t)(tok0 + lane) * 4 + hh];
            G = g;
#pragma unroll
            for (int o = 1; o < 64; o <<= 1) { const float n = __shfl_up(G, o); if (lane >= o) G += n; }
            const float Gl = __shfl(G, 63);
            eG = __expf(G);
            sG[lane] = G; sB[lane] = beta; sE[lane] = eG; sL[lane] = __expf(Gl - G);
            EGg[item * 64 + lane] = eG; LLg[item * 64 + lane] = __expf(Gl - G);
            if (lane == 0) GCg[item] = __expf(Gl);
        }
        f32x16 kk00, kk10, kk11, qk00, qk10, qk11;
#pragma unroll
        for (int r = 0; r < 16; ++r) { kk00[r] = 0.f; kk10[r] = 0.f; kk11[r] = 0.f; qk00[r] = 0.f; qk10[r] = 0.f; qk11[r] = 0.f; }
        {
            const bf16_t* kr0 = dk + (size_t)(tok0 + l31) * 512 + hh * 128 + 8 * hf; const bf16_t* kr1 = kr0 + 32 * 512;
            const bf16_t* qr0 = dq + (size_t)(tok0 + l31) * 512 + hh * 128 + 8 * hf; const bf16_t* qr1 = qr0 + 32 * 512;
#pragma unroll
            for (int s = 0; s < 8; ++s) {
                const bf16x8 k0 = *(const bf16x8*)(kr0 + s * 16), k1 = *(const bf16x8*)(kr1 + s * 16), q0 = *(const bf16x8*)(qr0 + s * 16), q1 = *(const bf16x8*)(qr1 + s * 16);
                kk00 = __builtin_amdgcn_mfma_f32_32x32x16_bf16(k0, k0, kk00, 0, 0, 0);
                kk10 = __builtin_amdgcn_mfma_f32_32x32x16_bf16(k1, k0, kk10, 0, 0, 0);
                kk11 = __builtin_amdgcn_mfma_f32_32x32x16_bf16(k1, k1, kk11, 0, 0, 0);
                qk00 = __builtin_amdgcn_mfma_f32_32x32x16_bf16(q0, k0, qk00, 0, 0, 0);
                qk10 = __builtin_amdgcn_mfma_f32_32x32x16_bf16(q1, k0, qk10, 0, 0, 0);
                qk11 = __builtin_amdgcn_mfma_f32_32x32x16_bf16(q1, k1, qk11, 0, 0, 0);
            }
        }
        __threadfence_block();
        {
            const float Gc0 = sG[l31], Gc1 = sG[32 + l31];
            float* sA0 = sA + (4 * hf) * 64 + l31;
            bf16_t* PP0 = PP + (4 * hf) * 64 + sig16(l31);
            const float* sGr = sG + 4 * hf; const float* sBr = sB + 4 * hf;
            const int jrel = l31 - 4 * hf;
#pragma unroll
            for (int r = 0; r < 16; ++r) {
                const int ro = (r & 3) + 8 * (r >> 2);
                const float Gi0 = sGr[ro], Gi1 = sGr[32 + ro], Bi0 = sBr[ro], Bi1 = sBr[32 + ro];
                {
                    const float dec = (jrel <= ro) ? __expf(Gi0 - Gc0) : 0.f;
                    sA0[ro * 64] = (jrel < ro) ? Bi0 * kk00[r] * dec : 0.f;
                    PP0[ro * 64] = f2bf(qk00[r] * dec);
                    PP0[ro * 64 + 32] = 0;
                }
                {
                    const float dec = __expf(Gi1 - Gc0);
                    sA0[(32 + ro) * 64] = Bi1 * kk10[r] * dec;
                    PP0[(32 + ro) * 64] = f2bf(qk10[r] * dec);
                }
                {
                    const float dec = (jrel <= ro) ? __expf(Gi1 - Gc1) : 0.f;
                    sA0[(32 + ro) * 64 + 32] = (jrel < ro) ? Bi1 * kk11[r] * dec : 0.f;
                    PP0[(32 + ro) * 64 + 32] = f2bf(qk11[r] * dec);
                }
            }
        }
        __threadfence_block();
        float x[64];
#pragma unroll
        for (int i = 0; i < 64; ++i) x[i] = (i == lane) ? 1.f : 0.f;
#pragma unroll
        for (int i = 1; i < 64; ++i) {
            float acc = x[i];
#pragma unroll
            for (int m4 = 0; m4 < i; m4 += 4) {
                const f32x4 a = *(const f32x4*)(sA + i * 64 + m4);
                acc -= a[0] * x[m4];
                if (m4 + 1 < i) acc -= a[1] * x[m4 + 1];
                if (m4 + 2 < i) acc -= a[2] * x[m4 + 2];
                if (m4 + 3 < i) acc -= a[3] * x[m4 + 3];
            }
            x[i] = acc;
            __builtin_amdgcn_sched_barrier(0);
        }
        __threadfence_block();
        {
            const float sw = beta * eG;
#pragma unroll
            for (int i = 0; i < 64; ++i) { sTw[i * 72 + lane] = f2bf(x[i] * sw); sTu[i * 72 + lane] = f2bf(x[i] * beta); }
        }
        __threadfence_block();
        {
            bf16x8 tw[2][4], tu[2][4];
#pragma unroll
            for (int mt = 0; mt < 2; ++mt)
#pragma unroll
                for (int s = 0; s < 4; ++s) { tw[mt][s] = *(const bf16x8*)(sTw + (mt * 32 + l31) * 72 + s * 16 + 8 * hf); tu[mt][s] = *(const bf16x8*)(sTu + (mt * 32 + l31) * 72 + s * 16 + 8 * hf); }
            const bf16_t* kTb = dkT + ((size_t)bh * 128 + l31) * NT + c * 64 + 8 * hf;
            const bf16_t* vTb = dvT + ((size_t)bh * 128 + l31) * NT + c * 64 + 8 * hf;
#pragma unroll 1
            for (int nt = 0; nt < 4; ++nt) {
                f32x16 w0, w1, u0, u1;
#pragma unroll
                for (int r = 0; r < 16; ++r) { w0[r] = 0.f; w1[r] = 0.f; u0[r] = 0.f; u1[r] = 0.f; }
#pragma unroll
                for (int s = 0; s < 4; ++s) {
                    const bf16x8 kb = *(const bf16x8*)(kTb + (size_t)nt * 32 * NT + s * 16), vb = *(const bf16x8*)(vTb + (size_t)nt * 32 * NT + s * 16);
                    w0 = __builtin_amdgcn_mfma_f32_32x32x16_bf16(tw[0][s], kb, w0, 0, 0, 0);
                    w1 = __builtin_amdgcn_mfma_f32_32x32x16_bf16(tw[1][s], kb, w1, 0, 0, 0);
                    u0 = __builtin_amdgcn_mfma_f32_32x32x16_bf16(tu[0][s], vb, u0, 0, 0, 0);
                    u1 = __builtin_amdgcn_mfma_f32_32x32x16_bf16(tu[1][s], vb, u1, 0, 0, 0);
                }
                bf16_t* WN0 = WN + (4 * hf) * 128 + nt * 32 + sig16(l31); bf16_t* U0 = Ug + (4 * hf) * 128 + nt * 32 + l31;
#pragma unroll
                for (int r = 0; r < 16; ++r) {
                    const int ro = (r & 3) + 8 * (r >> 2);
                    WN0[ro * 128] = f2bf(-w0[r]); WN0[(32 + ro) * 128] = f2bf(-w1[r]);
                    U0[ro * 128] = f2bf(u0[r]); U0[(32 + ro) * 128] = f2bf(u1[r]);
                }
            }
        }
        __threadfence_block();
    }
}

__device__ __forceinline__ bf16x8 pack_frag(const f32x16& t, int s) {
    bf16x8 f;
#pragma unroll
    for (int j = 0; j < 8; ++j) f[j] = (short)f2bf(t[8 * s + j]);
    return f;
}
__device__ __forceinline__ bf16x8 pack_frag_scaled(const f32x16& t, int s, const f32x4& sc0, const f32x4& sc1) {
    bf16x8 f;
#pragma unroll
    for (int j = 0; j < 4; ++j) { f[j] = (short)f2bf(t[8 * s + j] * sc0[j]); f[4 + j] = (short)f2bf(t[8 * s + 4 + j] * sc1[j]); }
    return f;
}
__device__ __forceinline__ bf16x8 load_perm_frag(const bf16_t* ptr) {
    const uint2 lo = *(const uint2*)ptr, hi = *(const uint2*)(ptr + 8);
    union { uint4 u; bf16x8 f; } cv; cv.u = make_uint4(lo.x, lo.y, hi.x, hi.y); return cv.f;
}
constexpr int SC_WN = 0, SC_Q = 16384, SC_KT = 32768, SC_PP = SC_KT + 128 * 144, SC_U = SC_PP + 64 * 144, SC_EG = SC_U + 16384, SC_LL = SC_EG + 256, SC_GC = SC_LL + 256, SC_BYTES = SC_GC + 16;
constexpr int SCAN_LDS = 2 * SC_BYTES;
#define SCAN_DECL uint4 wn0, wn1, wn2, wn3, q0, q1, q2, q3, kt0, kt1, kt2, kt3, pp0, pp1, u0, u1, u2, u3; float egv = 0.f, gcv = 0.f;
#define SCAN_LD4(i, WNR, UR, QR, KTR) { const int x = hl + 256 * (i); WNR = WNp[x]; UR = Up[x]; \
        QR = *(const uint4*)(dqb + (size_t)(x >> 4) * 512 + (x & 15) * 8); \
        KTR = *(const uint4*)(ktb + (size_t)(x >> 3) * NT + (x & 7) * 8); }
#define SCAN_LOAD(c) { const int ci = bh * 32 + (c); \
        const uint4* WNp = (const uint4*)(dob + DO_WN + (size_t)ci * 16384); const uint4* Up = (const uint4*)(dob + DO_U + (size_t)ci * 16384); const uint4* PPp = (const uint4*)(dob + DO_PP + (size_t)ci * 8192); \
        const bf16_t* dqb = dqh + (size_t)(c) * 64 * 512; const bf16_t* ktb = dkTh + (c) * 64; \
        SCAN_LD4(0, wn0, u0, q0, kt0) SCAN_LD4(1, wn1, u1, q1, kt1) SCAN_LD4(2, wn2, u2, q2, kt2) SCAN_LD4(3, wn3, u3, q3, kt3) \
        pp0 = PPp[hl]; pp1 = PPp[hl + 256]; \
        if (hl < 64) egv = ((const float*)(dob + DO_EG))[ci * 64 + hl]; else if (hl < 128) egv = ((const float*)(dob + DO_LL))[ci * 64 + hl - 64]; \
        if (hl == 128) gcv = ((const float*)(dob + DO_GC))[ci]; }
#define SCAN_ST4(i, WNR, UR, QR, KTR) { const int x = hl + 256 * (i); \
        { const int r = x >> 4, cc = x & 15; *(uint4*)(sbuf + SC_WN + r * 256 + ((cc ^ (r & 15)) << 4)) = WNR; } \
        *(uint4*)(sbuf + SC_U + x * 16) = UR; \
        { const int r = x >> 4, cc = x & 15, a = cc >> 1, g = cc & 1; char* row = sbuf + SC_Q + r * 256; \
          *(uint2*)(row + (((2 * a) ^ (r & 15)) << 4) + g * 8) = make_uint2(QR.x, QR.y); \
          *(uint2*)(row + (((2 * a + 1) ^ (r & 15)) << 4) + g * 8) = make_uint2(QR.z, QR.w); } \
        { const int d = x >> 3, cc = x & 7, a = cc >> 1, g = cc & 1; char* row = sbuf + SC_KT + d * 144; \
          *(uint2*)(row + (2 * a) * 16 + g * 8) = make_uint2(KTR.x, KTR.y); \
          *(uint2*)(row + (2 * a + 1) * 16 + g * 8) = make_uint2(KTR.z, KTR.w); } }
#define SCAN_STORE(bufptr) { char* sbuf = (bufptr); \
        SCAN_ST4(0, wn0, u0, q0, kt0) SCAN_ST4(1, wn1, u1, q1, kt1) SCAN_ST4(2, wn2, u2, q2, kt2) SCAN_ST4(3, wn3, u3, q3, kt3) \
        *(uint4*)(sbuf + SC_PP + (hl >> 3) * 144 + (hl & 7) * 16) = pp0; \
        *(uint4*)(sbuf + SC_PP + ((hl + 256) >> 3) * 144 + (hl & 7) * 16) = pp1; \
        if (hl < 128) ((float*)(sbuf + SC_EG))[hl] = egv; \
        if (hl == 128) *(float*)(sbuf + SC_GC) = gcv; }
__device__ __forceinline__ void dn_scan_block(const P& p, char* smem, int bh, int tid) {
    const int wave = tid >> 6, lane = tid & 63;
    const int hf = lane >> 5, l31 = lane & 31;
    const int b = bh >> 2, hh = bh & 3;
    const bool helper = wave >= 4;
    const int hl = tid - 256, sl = wave;
    bf16_t* dno = (bf16_t*)((unsigned char*)p.out + DO_DNO);
    if (helper) {
        const unsigned char* dob = (const unsigned char*)p.out;
        const bf16_t* dqh = (const bf16_t*)(p.ws + WS_DQ) + (size_t)b * NT * 512 + hh * 128; const bf16_t* dkTh = (const bf16_t*)(p.ws + WS_DKT) + (size_t)bh * 128 * NT;
        SCAN_DECL
        SCAN_LOAD(0) SCAN_STORE(smem) SCAN_LOAD(1)
        __syncthreads();
#pragma unroll 1
        for (int c = 0; c < NT / 64; ++c) {
            if (c + 1 < NT / 64) SCAN_STORE(smem + ((c + 1) & 1) * SC_BYTES)
            if (c + 2 < NT / 64) SCAN_LOAD(c + 2)
            __syncthreads();
        }
        return;
    }
    f32x16 S[4];
#pragma unroll
    for (int T = 0; T < 4; ++T)
#pragma unroll
        for (int r = 0; r < 16; ++r) S[T][r] = 0.f;
    __syncthreads();
#pragma unroll 1
    for (int c = 0; c < NT / 64; ++c) {
        char* buf = smem + (c & 1) * SC_BYTES;
        {
            const int tok0 = b * NT + c * 64;
            const int sw = l31 & 15;
            const char* wnr = buf + SC_WN + l31 * 256; const char* qr = buf + SC_Q + l31 * 256;
            const char* ktr = buf + SC_KT + l31 * 144 + 16 * hf; const char* ppr = buf + SC_PP + l31 * 144 + 16 * hf;
            const bf16_t* ur = (const bf16_t*)(buf + SC_U) + sl * 32 + l31;
            const float* egs = (const float*)(buf + SC_EG); const float* lls = (const float*)(buf + SC_LL);
            const float gc = *(const float*)(buf + SC_GC);
            bf16x8 SB[4][2];
#pragma unroll
            for (int T = 0; T < 4; ++T) { SB[T][0] = pack_frag(S[T], 0); SB[T][1] = pack_frag(S[T], 1); }
            f32x16 D[2], O[2];
#pragma unroll
            for (int mt = 0; mt < 2; ++mt)
#pragma unroll
                for (int r = 0; r < 16; ++r) { D[mt][r] = bf2f(ur[(mt * 32 + (r & 3) + 8 * (r >> 2) + 4 * hf) * 128]); O[mt][r] = 0.f; }
#pragma unroll
            for (int mt = 0; mt < 2; ++mt)
#pragma unroll
                for (int T = 0; T < 4; ++T)
#pragma unroll
                    for (int s = 0; s < 2; ++s) {
                        const int co = (((2 * (2 * T + s) + hf) ^ sw) << 4) + mt * 32 * 256;
                        const bf16x8 wa = *(const bf16x8*)(wnr + co);
                        const bf16x8 qa = *(const bf16x8*)(qr + co);
                        D[mt] = __builtin_amdgcn_mfma_f32_32x32x16_bf16(wa, SB[T][s], D[mt], 0, 0, 0);
                        O[mt] = __builtin_amdgcn_mfma_f32_32x32x16_bf16(qa, SB[T][s], O[mt], 0, 0, 0);
                    }
            __builtin_amdgcn_sched_barrier(0);
            bf16x8 DB[2][2], DL[2][2];
#pragma unroll
            for (int mt = 0; mt < 2; ++mt) {
#pragma unroll
                for (int g4 = 0; g4 < 4; ++g4) {
                    const f32x4 eg = *(const f32x4*)(egs + mt * 32 + g4 * 8 + 4 * hf);
#pragma unroll
                    for (int j = 0; j < 4; ++j) O[mt][g4 * 4 + j] *= eg[j];
                }
                const f32x4 l0 = *(const f32x4*)(lls + mt * 32 + 0 + 4 * hf), l1 = *(const f32x4*)(lls + mt * 32 + 8 + 4 * hf);
                const f32x4 l2 = *(const f32x4*)(lls + mt * 32 + 16 + 4 * hf), l3 = *(const f32x4*)(lls + mt * 32 + 24 + 4 * hf);
                DB[mt][0] = pack_frag(D[mt], 0); DB[mt][1] = pack_frag(D[mt], 1);
                DL[mt][0] = pack_frag_scaled(D[mt], 0, l0, l1); DL[mt][1] = pack_frag_scaled(D[mt], 1, l2, l3);
            }
#pragma unroll
            for (int mt = 0; mt < 2; ++mt)
#pragma unroll
                for (int ks = 0; ks < 4; ++ks) {
                    const bf16x8 pa = *(const bf16x8*)(ppr + mt * 32 * 144 + ks * 32);
                    O[mt] = __builtin_amdgcn_mfma_f32_32x32x16_bf16(pa, DB[ks >> 1][ks & 1], O[mt], 0, 0, 0);
                }
            __builtin_amdgcn_sched_barrier(0);
            {
                bf16_t* orow = dno + (size_t)tok0 * 512 + hh * 128 + sl * 32 + l31;
#pragma unroll
                for (int mt = 0; mt < 2; ++mt)
#pragma unroll
                    for (int r = 0; r < 16; ++r) orow[(size_t)(mt * 32 + (r & 3) + 8 * (r >> 2) + 4 * hf) * 512] = f2bf(O[mt][r]);
            }
#pragma unroll
            for (int T = 0; T < 4; ++T) {
#pragma unroll
                for (int r = 0; r < 16; ++r) S[T][r] *= gc;
#pragma unroll
                for (int ks = 0; ks < 4; ++ks) {
                    const bf16x8 ka = *(const bf16x8*)(ktr + T * 32 * 144 + ks * 32);
                    S[T] = __builtin_amdgcn_mfma_f32_32x32x16_bf16(ka, DL[ks >> 1][ks & 1], S[T], 0, 0, 0);
                }
            }
        }
        __syncthreads();
    }
}

__device__ __forceinline__ void ph_dn_gate(const P& p) {
    const int tid = tid_opaque();
    const int lane = tid & 63, wave = tid >> 6;
    const bf16_t* dno = (const bf16_t*)((const unsigned char*)p.out + DO_DNO); const bf16_t* proj = (const bf16_t*)(p.ws + WS_PROJ); bf16_t* dnn = (bf16_t*)(p.ws + WS_DK);
    for (int tok = blockIdx.x * NWAVES + wave; tok < NTOK; tok += gridDim.x * NWAVES) {
#pragma unroll
        for (int hh = 0; hh < 4; ++hh) {
            const unsigned orw = *(const unsigned*)(dno + (size_t)tok * 512 + hh * 128 + lane * 2);
            const float o0 = __uint_as_float(orw << 16), o1 = __uint_as_float(orw & 0xffff0000u);
            const float ss = wave_sum(o0 * o0 + o1 * o1);
            const float rs = rsqrtf(ss * (1.f / 128.f) + EPS);
            const unsigned zr = *(const unsigned*)(proj + (size_t)tok * NPROJ + PC_DNZ + hh * 128 + lane * 2);
            const float z0 = __uint_as_float(zr << 16), z1 = __uint_as_float(zr & 0xffff0000u);
            *(unsigned*)(dnn + (size_t)tok * 512 + hh * 128 + lane * 2) = pack2(o0 * rs * p.dn_norm_g[lane * 2] * silu_f(z0), o1 * rs * p.dn_norm_g[lane * 2 + 1] * silu_f(z1));
        }
    }
}

__device__ __forceinline__ void ph_gemm_out(const P& p, char* smem) {
    const int tid = tid_opaque();
    constexpr int BM = 256, BN = 128;
    const bf16_t* att = (const bf16_t*)(p.ws + WS_QN); const bf16_t* dnn = (const bf16_t*)(p.ws + WS_DK); const bf16_t* Wt = (const bf16_t*)(p.ws + WS_WOUT);
    float* sgate = (float*)(smem + GemmLds<BM, BN>::BYTES);
    const int lane = tid & 63, wave = tid >> 6, wm = wave % 4, wn = wave / 4;
    const int ntn = ND / BN, ntiles = (NTOK / BM) * ntn;
    for (int t = blockIdx.x; t < ntiles; t += gridDim.x) {
        const int tm = t / ntn, tn = t % ntn;
        const int b = (tm * BM) / NT;
        if (tid < BN) sgate[tid] = mod_val(p, b, 2, tn * BN + tid);
        const bf16_t* A1 = att + (size_t)tm * BM * 512; const bf16_t* A2 = dnn + (size_t)tm * BM * 512; const bf16_t* Bb = Wt + (size_t)tn * BN * ND;
        f32x16 acc[2][2];
        gemm_tile<BM, BN>(tid, smem, ND, [&](int r, int k) __attribute__((always_inline)) { return (k < 512) ? (A1 + (size_t)r * 512 + k) : (A2 + (size_t)r * 512 + (k - 512)); },
                          [&](int r, int k) __attribute__((always_inline)) { return Bb + (size_t)r * ND + k; }, acc);
#pragma unroll
        for (int m = 0; m < 2; ++m)
#pragma unroll
            for (int n = 0; n < 2; ++n)
#pragma unroll
                for (int r = 0; r < 16; ++r) {
                    const int row = tm * BM + wm * 64 + m * 32 + (r & 3) + 8 * (r >> 2) + 4 * (lane >> 5);
                    const int cl = wn * 64 + n * 32 + (lane & 31);
                    const size_t idx = (size_t)row * ND + tn * BN + cl;
                    p.out[idx] = p.x[idx] + sgate[cl] * acc[m][n][r];
                }
        __syncthreads();
    }
}

constexpr int ROUTE_LDS = 36 * 1024 * 4 + 2 * 1024 * 4;
__device__ __forceinline__ void ph_route(const P& p, char* smem) {
    const int tid = tid_opaque();
    float* sW = (float*)smem;
    float* sA = sW + 36 * 1024; float* sB = sA + 1024;
    const int lane = tid & 63, wave = tid >> 6;
    for (int i = tid; i < 4 * 1024; i += NTHREADS) { const int d = i >> 2, j = i & 3; sW[j * 1024 + d] = p.rg_w[i]; }
    for (int i = tid; i < 32 * 1024; i += NTHREADS) { const int d = i >> 5, j = i & 31; sW[(4 + j) * 1024 + d] = p.re_w[i]; }
    bf16_t* h2 = (bf16_t*)(p.ws + WS_H2);
    int* cnt = (int*)(p.ws + WS_CTL); int* list = (int*)(p.ws + WS_LIST); int* tokinfo = (int*)(p.ws + WS_TOKINFO);
    int curb = -1;
    for (int tile = blockIdx.x; tile < NTOK / 64; tile += gridDim.x) {
        const int b = tile / (NT / 64);
        if (b != curb) {
            __syncthreads();
            for (int d = tid; d < ND; d += NTHREADS) { sA[d] = p.norm2_g[d] * (1.f + mod_val(p, b, 4, d)); sB[d] = mod_val(p, b, 3, d); }
            __syncthreads();
            curb = b;
        }
        for (int i = 0; i < 8; ++i) {
            const int tok = tile * 64 + wave * 8 + i;
            const float* xr = p.out + (size_t)tok * ND;
            float v[16]; float ss = 0.f;
#pragma unroll
            for (int j = 0; j < 16; ++j) { v[j] = xr[j * 64 + lane]; ss += v[j] * v[j]; }
            ss = wave_sum(ss);
            const float rstd = rsqrtf(ss * (1.f / ND) + EPS);
#pragma unroll
            for (int j = 0; j < 16; ++j) { const int d = j * 64 + lane; v[j] = v[j] * rstd * sA[d] + sB[d]; h2[(size_t)tok * ND + d] = f2bf(v[j]); }
            float mylogit = 0.f;
#pragma unroll 4
            for (int o = 0; o < 36; ++o) {
                float a = 0.f;
#pragma unroll
                for (int j = 0; j < 16; ++j) a += v[j] * sW[o * 1024 + j * 64 + lane];
                a = wave_sum(a);
                if (lane == o) mylogit = a;
            }
            if (lane < 4) mylogit += p.rg_b[lane]; else if (lane < 36) mylogit += p.re_b[lane - 4];
            float gl[4];
#pragma unroll
            for (int j = 0; j < 4; ++j) gl[j] = __shfl(mylogit, j);
            int gsel = 0; float gm = gl[0];
#pragma unroll
            for (int j = 1; j < 4; ++j) if (gl[j] > gm) { gm = gl[j]; gsel = j; }
            float gs = 0.f;
#pragma unroll
            for (int j = 0; j < 4; ++j) gs += __expf(gl[j] - gm);
            const float gtop = 1.f / gs;
            float el[8];
#pragma unroll
            for (int j = 0; j < 8; ++j) el[j] = __shfl(mylogit, 4 + gsel * 8 + j);
            int e1 = 0; float m1 = el[0];
#pragma unroll
            for (int j = 1; j < 8; ++j) if (el[j] > m1) { m1 = el[j]; e1 = j; }
            int e2 = -1; float m2 = -INFINITY;
#pragma unroll
            for (int j = 0; j < 8; ++j) if (j != e1 && el[j] > m2) { m2 = el[j]; e2 = j; }
            const float r2 = __expf(m2 - m1);
            const float w1v = gtop / (1.f + r2), w2v = gtop * r2 / (1.f + r2);
            if (lane == 0) {
                const int ea = gsel * 8 + e1, eb = gsel * 8 + e2;
                const int pa = atomicAdd(&cnt[ea], 1), pb = atomicAdd(&cnt[eb], 1);
                list[ea * NTOK + pa] = tok; list[eb * NTOK + pb] = tok;
                int* ti = tokinfo + (size_t)tok * 8;
                ti[0] = ea; ti[1] = pa; ti[2] = eb; ti[3] = pb; ti[4] = __float_as_int(w1v); ti[5] = __float_as_int(w2v);
            }
        }
    }
}

struct MoeIdx { int rowoff[NE + 1]; int tileoff[NE + 1]; };
__device__ __forceinline__ void moe_index(const int tid, const P& p, MoeIdx* mi) {
    if (tid == 0) {
        const int* cnt = (const int*)(p.ws + WS_CTL);
        int r = 0, t = 0;
        for (int e = 0; e < NE; ++e) { mi->rowoff[e] = r; mi->tileoff[e] = t; const int c = cnt[e]; r += c; t += (c + 127) >> 7; }
        mi->rowoff[NE] = r; mi->tileoff[NE] = t;
    }
    __syncthreads();
}

constexpr int MOE_BM = 128, MOE_BN = 256;
__device__ __forceinline__ void ph_moe_up(const P& p, char* smem) {
    const int tid = tid_opaque();
    MoeIdx* mi = (MoeIdx*)(smem + GemmLds<MOE_BM, MOE_BN>::BYTES);
    int* srow = (int*)(mi + 1);
    moe_index(tid, p, mi);
    const bf16_t* h2 = (const bf16_t*)(p.ws + WS_H2); const bf16_t* Wt13 = (const bf16_t*)(p.ws + WS_W13); bf16_t* act = (bf16_t*)(p.ws + WS_ACT);
    const int* list = (const int*)(p.ws + WS_LIST);
    const int lane = tid & 63, wave = tid >> 6, wm = wave % 2, wn = wave / 2;
    const int ntiles = mi->tileoff[NE] * 4;
    for (int t = blockIdx.x; t < ntiles; t += gridDim.x) {
        const int mt = t >> 2, ni = t & 3;
        int e = 0;
        while (mi->tileoff[e + 1] <= mt) ++e;
        const int ml = mt - mi->tileoff[e];
        const int cnt_e = mi->rowoff[e + 1] - mi->rowoff[e];
        const int nrows = min(128, cnt_e - ml * 128);
        if (tid < 128) srow[tid] = list[e * NTOK + ml * 128 + min(tid, nrows - 1)];
        __syncthreads();
        const bf16_t* Bb = Wt13 + ((size_t)e * 1024 + ni * 256) * ND;
        f32x16 acc[2][2];
        gemm_tile<MOE_BM, MOE_BN>(tid, smem, ND, [&](int r, int k) __attribute__((always_inline)) { return h2 + (size_t)srow[r] * ND + k; }, [&](int r, int k) __attribute__((always_inline)) { return Bb + (size_t)r * ND + k; }, acc);
        const int row0 = mi->rowoff[e] + ml * 128;
#pragma unroll
        for (int m = 0; m < 2; ++m)
#pragma unroll
            for (int r = 0; r < 16; ++r) {
                const int rl = wm * 64 + m * 32 + (r & 3) + 8 * (r >> 2) + 4 * (lane >> 5);
                if (rl < nrows) {
                    const float g = acc[m][0][r], u = acc[m][1][r];
                    act[(size_t)(row0 + rl) * EFF + ni * 128 + wn * 32 + (lane & 31)] = f2bf(silu_f(g) * u);
                }
            }
        __syncthreads();
    }
}

__device__ __forceinline__ void ph_moe_down(const P& p, char* smem) {
    const int tid = tid_opaque();
    MoeIdx* mi = (MoeIdx*)(smem + GemmLds<MOE_BM, MOE_BN>::BYTES);
    moe_index(tid, p, mi);
    const bf16_t* act = (const bf16_t*)(p.ws + WS_ACT); const bf16_t* Wt2 = (const bf16_t*)(p.ws + WS_W2); bf16_t* yb = (bf16_t*)(p.ws + WS_YBUF);
    const int lane = tid & 63, wave = tid >> 6, wm = wave % 2, wn = wave / 2;
    const int ntiles = mi->tileoff[NE] * 4;
    for (int t = blockIdx.x; t < ntiles; t += gridDim.x) {
        const int mt = t >> 2, ni = t & 3;
        int e = 0;
        while (mi->tileoff[e + 1] <= mt) ++e;
        const int ml = mt - mi->tileoff[e];
        const int cnt_e = mi->rowoff[e + 1] - mi->rowoff[e];
        const int nrows = min(128, cnt_e - ml * 128);
        const int row0 = mi->rowoff[e] + ml * 128;
        const bf16_t* Ab = act + (size_t)row0 * EFF;
        const bf16_t* Bb = Wt2 + ((size_t)e * ND + ni * 256) * EFF;
        f32x16 acc[2][2];
        gemm_tile<MOE_BM, MOE_BN>(tid, smem, EFF, [&](int r, int k) __attribute__((always_inline)) { return Ab + (size_t)min(r, nrows - 1) * EFF + k; }, [&](int r, int k) __attribute__((always_inline)) { return Bb + (size_t)r * EFF + k; }, acc);
#pragma unroll
        for (int m = 0; m < 2; ++m)
#pragma unroll
            for (int n = 0; n < 2; ++n)
#pragma unroll
                for (int r = 0; r < 16; ++r) {
                    const int rl = wm * 64 + m * 32 + (r & 3) + 8 * (r >> 2) + 4 * (lane >> 5);
                    if (rl < nrows) yb[(size_t)(row0 + rl) * ND + ni * 256 + wn * 64 + n * 32 + (lane & 31)] = f2bf(acc[m][n][r]);
                }
    }
}

__device__ __forceinline__ void ph_combine(const P& p, char* smem) {
    const int tid = tid_opaque();
    MoeIdx* mi = (MoeIdx*)smem;
    float* sG = (float*)(mi + 1);
    moe_index(tid, p, mi);
    const int lane = tid & 63, wave = tid >> 6;
    const bf16_t* yb = (const bf16_t*)(p.ws + WS_YBUF); const int* tokinfo = (const int*)(p.ws + WS_TOKINFO);
    int curb = -1;
    for (int tile = blockIdx.x; tile < NTOK / 64; tile += gridDim.x) {
        const int b = tile / (NT / 64);
        if (b != curb) {
            __syncthreads();
            for (int d = tid; d < ND; d += NTHREADS) sG[d] = mod_val(p, b, 5, d);
            __syncthreads();
            curb = b;
        }
        for (int i = 0; i < 8; ++i) {
            const int tok = tile * 64 + wave * 8 + i;
            const int* ti = tokinfo + (size_t)tok * 8;
            const int ra = mi->rowoff[ti[0]] + ti[1], rb = mi->rowoff[ti[2]] + ti[3];
            const float wa = __int_as_float(ti[4]), wb = __int_as_float(ti[5]);
#pragma unroll
            for (int j = 0; j < 4; ++j) {
                const int d = j * 256 + lane * 4;
                const uint2 ya = *(const uint2*)(yb + (size_t)ra * ND + d), ybv = *(const uint2*)(yb + (size_t)rb * ND + d);
                f32x4 xv = *(const f32x4*)(p.out + (size_t)tok * ND + d);
                xv[0] += sG[d] * (wa * __uint_as_float(ya.x << 16) + wb * __uint_as_float(ybv.x << 16));
                xv[1] += sG[d + 1] * (wa * __uint_as_float(ya.x & 0xffff0000u) + wb * __uint_as_float(ybv.x & 0xffff0000u));
                xv[2] += sG[d + 2] * (wa * __uint_as_float(ya.y << 16) + wb * __uint_as_float(ybv.y << 16));
                xv[3] += sG[d + 3] * (wa * __uint_as_float(ya.y & 0xffff0000u) + wb * __uint_as_float(ybv.y & 0xffff0000u));
                *(f32x4*)(p.out + (size_t)tok * ND + d) = xv;
            }
        }
    }
}

namespace cg = cooperative_groups;
extern __shared__ __attribute__((aligned(16))) char dyn_smem[];
constexpr int cmax(int a, int b) { return a > b ? a : b; }
constexpr int L_G1 = GemmLds<256, 128>::BYTES + 512;
constexpr int L_MOE = GemmLds<MOE_BM, MOE_BN>::BYTES + (int)sizeof(MoeIdx) + 128 * 4;
constexpr int MEGA_LDS = cmax(cmax(cmax(ROUTE_LDS, PREP_LDS), cmax(4608 + SCAN_LDS, L_G1)), L_MOE);
typedef const unsigned long long __attribute__((address_space(4)))* kargp_t;
__device__ __forceinline__ void load_params(P& p, kargp_t ka) {
    asm volatile("" : "+s"(ka));
    typedef __attribute__((address_space(1))) char* gptr_t;
    const void** d = (const void**)&p;
#pragma unroll
    for (int i = 0; i < (int)(sizeof(P) / 8); ++i) d[i] = (const void*)(gptr_t)ka[i];
}
#define PHASE(call) do { P p; load_params(p, ka); call; } while (0)
#ifndef PROBE_MODE
#define PROBE_MODE 0
#endif
#ifndef PROBE_K
#define PROBE_K -1
#endif
template <int KMAX>
__device__ __forceinline__ void run_phases(cg::grid_group& grid, kargp_t ka, char* smem) {
    if constexpr (KMAX >= 0) { PHASE(ph_mod_partial(p)); PHASE(ph_convert(p, smem)); grid.sync(); }
    if constexpr (KMAX >= 1) { PHASE(ph_norm1(p, smem)); grid.sync(); }
    if constexpr (KMAX >= 2) { PHASE(ph_gemm1(p, smem)); grid.sync(); }
    if constexpr (KMAX >= 3) { PHASE(ph_post(p, smem)); grid.sync(); }
    if constexpr (KMAX >= 4) { PHASE(ph_dn_prep(p, smem)); grid.sync(); }
    if constexpr (KMAX >= 5) { PHASE(ph_attn_mfma<(KMAX == 5 ? PROBE_MODE : 0)>(p, smem)); grid.sync(); }
    if constexpr (KMAX >= 6) { PHASE(ph_dn_gate(p)); grid.sync(); }
    if constexpr (KMAX >= 7) { PHASE(ph_gemm_out(p, smem)); grid.sync(); }
    if constexpr (KMAX >= 8) { PHASE(ph_route(p, smem)); grid.sync(); }
    if constexpr (KMAX >= 9) { PHASE(ph_moe_up(p, smem)); grid.sync(); }
    if constexpr (KMAX >= 10) { PHASE(ph_moe_down(p, smem)); grid.sync(); }
    if constexpr (KMAX >= 11) { PHASE(ph_combine(p, smem)); }
}
__global__ void __launch_bounds__(NTHREADS) mega(P p_arg) {
    cg::grid_group grid = cg::this_grid();
    char* smem = dyn_smem;
    kargp_t ka = (kargp_t)__builtin_amdgcn_kernarg_segment_ptr();
    if constexpr (PROBE_K >= 0) {
        run_phases<PROBE_K>(grid, ka, smem);
        P p; load_params(p, ka);
        if (blockIdx.x == 0 && threadIdx.x < 256) ((int*)(p.ws + WS_CTL))[threadIdx.x] = 0;
        grid.sync();
    }
    run_phases<99>(grid, ka, smem);
}

extern "C" void kernel_launch(void* const* d_in, const int* in_sizes, int n_in, void* d_out, int out_size, void* d_ws, size_t ws_size, hipStream_t stream) {
    if (n_in != 26 || out_size != NTOK * ND || ws_size < WS_END) { fprintf(stderr, "kernel_launch: unexpected shapes (n_in %d out %d ws %zu need %zu)\n", n_in, out_size, ws_size, (size_t)WS_END); return; }
    static int grid_blocks = 0;
    if (!grid_blocks) {
        int dev = 0, cus = 0, per_cu = 0;
        (void)hipGetDevice(&dev);
        (void)hipDeviceGetAttribute(&cus, hipDeviceAttributeMultiprocessorCount, dev);
        (void)hipFuncSetAttribute((const void*)mega, hipFuncAttributeMaxDynamicSharedMemorySize, MEGA_LDS);
        (void)hipOccupancyMaxActiveBlocksPerMultiprocessor(&per_cu, (const void*)mega, NTHREADS, MEGA_LDS);
        if (per_cu < 1) { fprintf(stderr, "kernel_launch: occupancy query says %d blocks/CU\n", per_cu); per_cu = 1; }
        grid_blocks = cus * per_cu;
    }
    P p{};
    const float** fp = (const float**)&p;
    for (int i = 0; i < 26; ++i) fp[i] = (const float*)d_in[i];
    p.pos = (const int*)d_in[2];
    p.out = (float*)d_out; p.ws = (unsigned char*)d_ws;
    (void)hipMemsetAsync((char*)d_ws + WS_CTL, 0, 4096, stream);
    void* args[] = {&p};
    hipError_t e = hipLaunchCooperativeKernel((const void*)mega, dim3(grid_blocks), dim3(NTHREADS), args, MEGA_LDS, stream);
    if (e != hipSuccess) fprintf(stderr, "cooperative launch failed: %s (grid %d)\n", hipGetErrorString(e), grid_blocks);
}
```

```cpp
#include <hip/hip_runtime.h>
#include <hip/hip_cooperative_groups.h>
#include <cstdio>
#include <cstdint>

typedef unsigned short bf16_t;
typedef short bf16x8 __attribute__((ext_vector_type(8)));
typedef float f32x16 __attribute__((ext_vector_type(16)));
typedef float f32x4 __attribute__((ext_vector_type(4)));

constexpr int NB = 8, NT = 2048, ND = 1024, NTOK = NB * NT;
constexpr int NPROJ = 3072;
constexpr int PC_QATT = 0, PC_KVLAT = 512, PC_QIDX = 640, PC_DNQKV = 896, PC_DNZ = 2432, PC_KIDX = 2944, PC_WIDX = 2976, PC_BETA = 2984, PC_A = 2988;
constexpr int W_IN_SRC = 2992;
constexpr int NE = 32, EFF = 512;
constexpr int KSPLIT = 16;
constexpr int NTHREADS = 512, NWAVES = 8;
constexpr float EPS = 1e-6f;
constexpr float LOG2E = 1.4426950408889634f;

constexpr size_t MiB = 1ull << 20;
constexpr size_t WS_CTL = 0;
constexpr size_t WS_MODP = WS_CTL + 1 * MiB;
constexpr size_t WS_WIN = WS_MODP + 3 * MiB;
constexpr size_t WS_WOUT = WS_WIN + 6 * MiB;
constexpr size_t WS_W13 = WS_WOUT + 2 * MiB;
constexpr size_t WS_W2 = WS_W13 + 64 * MiB;
constexpr size_t WS_PROJ = WS_W2 + 32 * MiB;
constexpr size_t WS_ACT = WS_PROJ;
constexpr size_t WS_YBUF = WS_PROJ + 32 * MiB;
constexpr size_t WS_QN = WS_PROJ + 96 * MiB;
constexpr size_t WS_K = WS_QN + 16 * MiB;
constexpr size_t WS_KI = WS_K + 2 * MiB;
constexpr size_t WS_WI = WS_KI + 1 * MiB;
constexpr size_t WS_DBG = WS_WI + 512 * 1024;
constexpr size_t WS_DQ = WS_DBG + 512 * 1024;
constexpr size_t WS_DK = WS_DQ + 16 * MiB;
constexpr size_t WS_H2 = WS_DQ;
constexpr size_t WS_DKT = WS_DK + 16 * MiB;
constexpr size_t WS_DVT = WS_DKT + 16 * MiB;
constexpr size_t WS_END = WS_DVT + 16 * MiB;
constexpr size_t WS_LIST = WS_K;
constexpr size_t WS_TOKINFO = WS_KI;
constexpr size_t WS_VT = WS_WIN;
constexpr size_t WS_POSMM = WS_WIN + 2 * MiB;
constexpr size_t DO_WN = 0, DO_U = 16 * MiB, DO_DNO = 32 * MiB, DO_PP = 48 * MiB, DO_EG = 56 * MiB, DO_LL = DO_EG + 256 * 1024, DO_GC = DO_LL + 256 * 1024;

struct P {
    const float* x; const float* c; const int* pos; const float* ada_w; const float* ada_b; const float* norm1_g; const float* norm2_g;
    const float* w_in; const float* q_norm_g; const float* k_norm_g; const float* kv_norm_g; const float* w_kv_up; const float* idx_k_norm_g;
    const float* rel_bias; const float* conv_w; const float* a_log; const float* dt_bias; const float* dn_norm_g; const float* w_out;
    const float* rg_w; const float* rg_b; const float* re_w; const float* re_b; const float* w1; const float* w3; const float* w2;
    float* out; unsigned char* ws;
};

__device__ __forceinline__ float bf2f(bf16_t h) { return __uint_as_float(((unsigned)h) << 16); }
__device__ __forceinline__ bf16_t f2bf(float f) { unsigned u = __float_as_uint(f); u += 0x7fffu + ((u >> 16) & 1u); return (bf16_t)(u >> 16); }
__device__ __forceinline__ unsigned pack2(float a, float b) { unsigned r; asm volatile("v_cvt_pk_bf16_f32 %0, %1, %2" : "=v"(r) : "v"(a), "v"(b)); return r; }
template <int CTRL> __device__ __forceinline__ float dpp_f(float v) { return __int_as_float(__builtin_amdgcn_update_dpp(0, __float_as_int(v), CTRL, 0xF, 0xF, false)); }
template <int CTRL> __device__ __forceinline__ int dpp_i(int v) { return __builtin_amdgcn_update_dpp(0, v, CTRL, 0xF, 0xF, false); }
__device__ __forceinline__ float wave_sum(float v) {
    v += dpp_f<0xB1>(v); v += dpp_f<0x4E>(v); v += dpp_f<0x141>(v); v += dpp_f<0x140>(v);
    v += __shfl_xor(v, 16); v += __shfl_xor(v, 32);
    return v;
}
__device__ __forceinline__ float wave_max(float v) {
#pragma unroll
    for (int o = 32; o >= 1; o >>= 1) v = fmaxf(v, __shfl_xor(v, o));
    return v;
}
__device__ __forceinline__ int wave_isum(int v) {
#pragma unroll
    for (int o = 32; o >= 1; o >>= 1) v += __shfl_xor(v, o);
    return v;
}
__device__ __forceinline__ int tid_opaque() { int t = threadIdx.x; asm volatile("" : "+v"(t)); return t; }
__device__ __forceinline__ float silu_f(float x) { return x / (1.f + __expf(-x)); }
__device__ __forceinline__ float sigmoid_f(float x) { return 1.f / (1.f + __expf(-x)); }
__device__ __forceinline__ float mod_val(const P& p, int b, int which, int d) {
    const float* mp = (const float*)(p.ws + WS_MODP);
    const int col = which * ND + d;
    float s = p.ada_b[col];
#pragma unroll
    for (int ks = 0; ks < KSPLIT; ++ks) s += mp[(size_t)(ks * NB + b) * (6 * ND) + col];
    return s;
}

__device__ __forceinline__ void ph_mod_partial(const P& p, char* smem) {
    const int tid = tid_opaque();
    const int lane = tid & 63, wave = tid >> 6;
    float* sc = (float*)smem;
    for (int i = tid; i < NB * ND; i += NTHREADS) sc[i] = silu_f(p.c[i]);
    __syncthreads();
    float* mp = (float*)(p.ws + WS_MODP);
    const int nitem = 96 * KSPLIT;
    for (int it = blockIdx.x * NWAVES + wave; it < nitem; it += gridDim.x * NWAVES) {
        const int cg = it % 96, ks = it / 96;
        const int col = cg * 64 + lane;
        float acc[NB];
#pragma unroll
        for (int b = 0; b < NB; ++b) acc[b] = 0.f;
#pragma unroll 8
        for (int kk = 0; kk < ND / KSPLIT; ++kk) {
            const int k = ks * (ND / KSPLIT) + kk;
            const float w = p.ada_w[(size_t)k * (6 * ND) + col];
#pragma unroll
            for (int b = 0; b < NB; ++b) acc[b] += sc[b * ND + k] * w;
        }
#pragma unroll
        for (int b = 0; b < NB; ++b) mp[(size_t)(ks * NB + b) * (6 * ND) + col] = acc[b];
    }
    __syncthreads();
}

__device__ __forceinline__ int win_src_col(int n) {
    if (n < 896) return n;
    if (n < 2944) return n + 40;
    if (n < 2976) return n - 2944 + 896;
    if (n < 2984) return n - 2976 + 928;
    if (n < 2992) return n;
    return -1;
}
__device__ __forceinline__ void conv_tile_wave(const int lane, float* tile, const float* src0, const float* src1, int nsrc, int mode, int n0, int k0, bf16_t* dst, int K, int qcol) {
    if (mode == 1) {
        const int col = win_src_col(n0 + lane);
#pragma unroll 8
        for (int k = 0; k < 64; ++k) tile[k * 65 + lane] = (col >= 0) ? src0[(size_t)(k0 + k) * nsrc + col] : 0.f;
    } else {
        const int kr = lane >> 4, c4 = lane & 15;
        const float* src = src0; int col = n0 + c4 * 4;
        if (mode == 2) { src = (c4 >= 8) ? src1 : src0; col = qcol + (c4 & 7) * 4; }
        f32x4 v[16];
#pragma unroll
        for (int i = 0; i < 16; ++i) v[i] = *(const f32x4*)(src + (size_t)(k0 + i * 4 + kr) * nsrc + col);
#pragma unroll
        for (int i = 0; i < 16; ++i) { float* t = tile + (i * 4 + kr) * 65 + c4 * 4; t[0] = v[i][0]; t[1] = v[i][1]; t[2] = v[i][2]; t[3] = v[i][3]; }
    }
    __threadfence_block();
    {
        const int kc = lane & 7, nr = lane >> 3;
#pragma unroll
        for (int i = 0; i < 8; ++i) {
            const int n = i * 8 + nr;
            unsigned w[4];
#pragma unroll
            for (int j = 0; j < 4; ++j) w[j] = pack2(tile[(kc * 8 + 2 * j) * 65 + n], tile[(kc * 8 + 2 * j + 1) * 65 + n]);
            *(uint4*)(dst + (size_t)(n0 + n) * K + k0 + kc * 8) = make_uint4(w[0], w[1], w[2], w[3]);
        }
    }
    __threadfence_block();
}
__device__ __forceinline__ void ph_convert(const P& p, char* smem) {
    const int tid = tid_opaque();
    const int lane = tid & 63, wave = tid >> 6;
    float* tile = (float*)smem + wave * (64 * 65);
    bf16_t* Wt_in = (bf16_t*)(p.ws + WS_WIN); bf16_t* Wt_out = (bf16_t*)(p.ws + WS_WOUT);
    bf16_t* Wt13 = (bf16_t*)(p.ws + WS_W13); bf16_t* Wt2 = (bf16_t*)(p.ws + WS_W2);
    const int T0 = 48 * 16, T1 = 16 * 16, T2 = NE * 256, T3 = NE * 128;
    const int total = T0 + T1 + T2 + T3;
    for (int t = blockIdx.x * NWAVES + wave; t < total; t += gridDim.x * NWAVES) {
        if (t < T0) { const int nt = t / 16, kt = t % 16; conv_tile_wave(lane, tile, p.w_in, nullptr, W_IN_SRC, 1, nt * 64, kt * 64, Wt_in, ND, 0); }
        else if (t < T0 + T1) { const int u = t - T0; const int nt = u / 16, kt = u % 16; conv_tile_wave(lane, tile, p.w_out, nullptr, ND, 0, nt * 64, kt * 64, Wt_out, ND, 0); }
        else if (t < T0 + T1 + T2) { const int u = t - T0 - T1; const int e = u / 256, v = u % 256; const int nt = v / 16, kt = v % 16;
            conv_tile_wave(lane, tile, p.w1 + (size_t)e * ND * EFF, p.w3 + (size_t)e * ND * EFF, EFF, 2, nt * 64, kt * 64, Wt13 + (size_t)e * 1024 * ND, ND, nt * 32); }
        else { const int u = t - T0 - T1 - T2; const int e = u / 128, v = u % 128; const int nt = v / 8, kt = v % 8;
            conv_tile_wave(lane, tile, p.w2 + (size_t)e * EFF * ND, nullptr, ND, 0, nt * 64, kt * 64, Wt2 + (size_t)e * ND * EFF, EFF, 0); }
    }
}

__device__ __forceinline__ void ph_norm1(const P& p, char* smem) {
    const int tid = tid_opaque();
    float* sA = (float*)smem; float* sB = sA + ND;
    const int lane = tid & 63, wave = tid >> 6;
    bf16_t* h = (bf16_t*)p.out;
    int curb = -1;
    for (int tile = blockIdx.x; tile < NTOK / 64; tile += gridDim.x) {
        const int b = tile / (NT / 64);
        if (b != curb) {
            __syncthreads();
            for (int d = tid; d < ND; d += NTHREADS) { sA[d] = p.norm1_g[d] * (1.f + mod_val(p, b, 1, d)); sB[d] = mod_val(p, b, 0, d); }
            __syncthreads();
            curb = b;
        }
        for (int i = 0; i < 8; ++i) {
            const int tok = tile * 64 + wave * 8 + i;
            const float* xr = p.x + (size_t)tok * ND;
            f32x4 v[4]; float ss = 0.f;
#pragma unroll
            for (int j = 0; j < 4; ++j) { v[j] = *(const f32x4*)(xr + j * 256 + lane * 4); ss += v[j][0] * v[j][0] + v[j][1] * v[j][1] + v[j][2] * v[j][2] + v[j][3] * v[j][3]; }
            ss = wave_sum(ss);
            const float rstd = rsqrtf(ss * (1.f / ND) + EPS);
#pragma unroll
            for (int j = 0; j < 4; ++j) {
                const int d = j * 256 + lane * 4;
                const float o0 = v[j][0] * rstd * sA[d] + sB[d], o1 = v[j][1] * rstd * sA[d + 1] + sB[d + 1], o2 = v[j][2] * rstd * sA[d + 2] + sB[d + 2], o3 = v[j][3] * rstd * sA[d + 3] + sB[d + 3];
                *(uint2*)(h + (size_t)tok * ND + d) = make_uint2(pack2(o0, o1), pack2(o2, o3));
            }
        }
    }
}

constexpr int LDS_LD = 72;
template <int BM, int BN> struct GemmLds { static constexpr int BYTES = 2 * (BM + BN) * LDS_LD * 2; };
template <int BM, int BN, class AF, class BF>
__device__ __forceinline__ void gemm_tile(const int tid, char* smem, int K, AF aptr, BF bptr, f32x16 (&acc)[2][2]) {
    constexpr int WM = BM / 64;
    constexpr int NA = BM / 64, NBc = BN / 64;
    bf16_t* As = (bf16_t*)smem;
    bf16_t* Bs = As + 2 * BM * LDS_LD;
    const int lane = tid & 63, wave = tid >> 6;
    const int wm = wave % WM, wn = wave / WM;
    uint4 ra0, ra1, ra2, ra3, rb0, rb1, rb2, rb3;
    ra0 = ra1 = ra2 = ra3 = rb0 = rb1 = rb2 = rb3 = make_uint4(0, 0, 0, 0);
#pragma unroll
    for (int m = 0; m < 2; ++m)
#pragma unroll
        for (int n = 0; n < 2; ++n)
#pragma unroll
            for (int r = 0; r < 16; ++r) acc[m][n][r] = 0.f;
    const int nk = K / 64;
    const int cr = tid >> 3, ck = (tid & 7) * 8;
#define GT_LOAD(kt) do { \
        ra0 = *(const uint4*)aptr(cr, (kt) * 64 + ck); ra1 = *(const uint4*)aptr(cr + 64, (kt) * 64 + ck); \
        if constexpr (NA > 2) { ra2 = *(const uint4*)aptr(cr + 128, (kt) * 64 + ck); ra3 = *(const uint4*)aptr(cr + 192, (kt) * 64 + ck); } \
        rb0 = *(const uint4*)bptr(cr, (kt) * 64 + ck); rb1 = *(const uint4*)bptr(cr + 64, (kt) * 64 + ck); \
        if constexpr (NBc > 2) { rb2 = *(const uint4*)bptr(cr + 128, (kt) * 64 + ck); rb3 = *(const uint4*)bptr(cr + 192, (kt) * 64 + ck); } } while (0)
#define GT_STORE(buf) do { \
        bf16_t* as_ = As + ((buf) * BM + cr) * LDS_LD + ck; bf16_t* bs_ = Bs + ((buf) * BN + cr) * LDS_LD + ck; \
        *(uint4*)as_ = ra0; *(uint4*)(as_ + 64 * LDS_LD) = ra1; \
        if constexpr (NA > 2) { *(uint4*)(as_ + 128 * LDS_LD) = ra2; *(uint4*)(as_ + 192 * LDS_LD) = ra3; } \
        *(uint4*)bs_ = rb0; *(uint4*)(bs_ + 64 * LDS_LD) = rb1; \
        if constexpr (NBc > 2) { *(uint4*)(bs_ + 128 * LDS_LD) = rb2; *(uint4*)(bs_ + 192 * LDS_LD) = rb3; } } while (0)
    GT_LOAD(0); GT_STORE(0); __syncthreads();
    for (int kt = 0; kt < nk; ++kt) {
        if (kt + 1 < nk) GT_LOAD(kt + 1);
        const bf16_t* a0 = As + ((kt & 1) * BM + wm * 64 + (lane & 31)) * LDS_LD + 8 * (lane >> 5);
        const bf16_t* b0 = Bs + ((kt & 1) * BN + wn * 64 + (lane & 31)) * LDS_LD + 8 * (lane >> 5);
#pragma unroll
        for (int ks = 0; ks < 4; ++ks) {
            const bf16x8 fa0 = *(const bf16x8*)(a0 + ks * 16), fa1 = *(const bf16x8*)(a0 + 32 * LDS_LD + ks * 16);
            const bf16x8 fb0 = *(const bf16x8*)(b0 + ks * 16), fb1 = *(const bf16x8*)(b0 + 32 * LDS_LD + ks * 16);
            acc[0][0] = __builtin_amdgcn_mfma_f32_32x32x16_bf16(fa0, fb0, acc[0][0], 0, 0, 0);
            acc[0][1] = __builtin_amdgcn_mfma_f32_32x32x16_bf16(fa0, fb1, acc[0][1], 0, 0, 0);
            acc[1][0] = __builtin_amdgcn_mfma_f32_32x32x16_bf16(fa1, fb0, acc[1][0], 0, 0, 0);
            acc[1][1] = __builtin_amdgcn_mfma_f32_32x32x16_bf16(fa1, fb1, acc[1][1], 0, 0, 0);
        }
        if (kt + 1 < nk) GT_STORE((kt + 1) & 1);
        __syncthreads();
    }
}

__device__ __forceinline__ void ph_gemm1(const P& p, char* smem) {
    const int tid = tid_opaque();
    constexpr int BM = 256, BN = 128;
    const bf16_t* h = (const bf16_t*)p.out; const bf16_t* Wt = (const bf16_t*)(p.ws + WS_WIN);
    bf16_t* proj = (bf16_t*)(p.ws + WS_PROJ);
    const int lane = tid & 63, wave = tid >> 6, wm = wave % 4, wn = wave / 4;
    const int ntn = NPROJ / BN, ntiles = (NTOK / BM) * ntn;
    for (int t = blockIdx.x; t < ntiles; t += gridDim.x) {
        const int tm = t / ntn, tn = t % ntn;
        const bf16_t* Ab = h + (size_t)tm * BM * ND; const bf16_t* Bb = Wt + (size_t)tn * BN * ND;
        f32x16 acc[2][2];
        gemm_tile<BM, BN>(tid, smem, ND, [&](int r, int k) __attribute__((always_inline)) { return Ab + (size_t)r * ND + k; }, [&](int r, int k) __attribute__((always_inline)) { return Bb + (size_t)r * ND + k; }, acc);
#pragma unroll
        for (int m = 0; m < 2; ++m)
#pragma unroll
            for (int n = 0; n < 2; ++n)
#pragma unroll
                for (int r = 0; r < 16; ++r) {
                    const int row = tm * BM + wm * 64 + m * 32 + (r & 3) + 8 * (r >> 2) + 4 * (lane >> 5);
                    const int col = tn * BN + wn * 64 + n * 32 + (lane & 31);
                    proj[(size_t)row * NPROJ + col] = f2bf(acc[m][n][r]);
                }
    }
}

__device__ __forceinline__ void ph_post(const P& p, char* smem) {
    const int tid = tid_opaque();
    float* sW = (float*)smem;
    for (int i = tid; i < 128 * 128; i += NTHREADS) sW[i] = p.w_kv_up[i];
    __syncthreads();
    const int lane = tid & 63, wave = tid >> 6;
    const bf16_t* proj = (const bf16_t*)(p.ws + WS_PROJ);
    bf16_t* qn = (bf16_t*)(p.ws + WS_QN); bf16_t* Kb = (bf16_t*)(p.ws + WS_K); bf16_t* kib = (bf16_t*)(p.ws + WS_KI);
    float* wi = (float*)(p.ws + WS_WI); float* dbeta = (float*)(p.ws + WS_DBG); float* dg = dbeta + NTOK * 4;
    bf16_t* dq = (bf16_t*)(p.ws + WS_DQ); bf16_t* dk = (bf16_t*)(p.ws + WS_DK); bf16_t* dkT = (bf16_t*)(p.ws + WS_DKT); bf16_t* dvT = (bf16_t*)(p.ws + WS_DVT);
    bf16_t* Vt = (bf16_t*)(p.ws + WS_VT);
    {
        const int g = blockIdx.x * NTHREADS + tid;
        if (g < NB * 64) { int mn = 0x7fffffff, mx = -0x7fffffff; for (int i = 0; i < 32; ++i) { const int v = p.pos[g * 32 + i]; mn = min(mn, v); mx = max(mx, v); } int* pm = (int*)(p.ws + WS_POSMM); pm[g * 2] = mn; pm[g * 2 + 1] = mx; }
    }
    for (int tg = blockIdx.x * NWAVES + wave; tg < NTOK / 8; tg += gridDim.x * NWAVES) {
      for (int ti = 0; ti < 8; ++ti) {
        const int tok = tg * 8 + ti;
        const int t = tok % NT;
        const bf16_t* pr = proj + (size_t)tok * NPROJ;
        {
            const uint4 raw = *(const uint4*)(pr + PC_QATT + lane * 8);
            const unsigned w[4] = {raw.x, raw.y, raw.z, raw.w};
            float v[8]; float ss = 0.f;
#pragma unroll
            for (int j = 0; j < 4; ++j) { v[2 * j] = __uint_as_float(w[j] << 16); v[2 * j + 1] = __uint_as_float(w[j] & 0xffff0000u); }
#pragma unroll
            for (int j = 0; j < 8; ++j) ss += v[j] * v[j];
            ss += __shfl_xor(ss, 1); ss += __shfl_xor(ss, 2); ss += __shfl_xor(ss, 4);
            const float rs = rsqrtf(ss * (1.f / 64.f) + EPS) * (0.125f * LOG2E);
            const int d0 = (lane & 7) * 8;
            unsigned o[4];
#pragma unroll
            for (int j = 0; j < 4; ++j) o[j] = pack2(v[2 * j] * rs * p.q_norm_g[d0 + 2 * j], v[2 * j + 1] * rs * p.q_norm_g[d0 + 2 * j + 1]);
            *(uint4*)(qn + (size_t)tok * 512 + lane * 8) = make_uint4(o[0], o[1], o[2], o[3]);
        }
        {
            const unsigned raw = *(const unsigned*)(pr + PC_KVLAT + lane * 2);
            float a0 = __uint_as_float(raw << 16), a1 = __uint_as_float(raw & 0xffff0000u);
            float ss = wave_sum(a0 * a0 + a1 * a1);
            const float rs = rsqrtf(ss * (1.f / 128.f) + EPS);
            a0 *= rs * p.kv_norm_g[lane * 2]; a1 *= rs * p.kv_norm_g[lane * 2 + 1];
            float k = 0.f, v = 0.f;
#pragma unroll 8
            for (int i = 0; i < 64; ++i) {
                const float x0 = __shfl(a0, i), x1 = __shfl(a1, i);
                k += x0 * sW[(2 * i) * 128 + lane] + x1 * sW[(2 * i + 1) * 128 + lane];
                v += x0 * sW[(2 * i) * 128 + 64 + lane] + x1 * sW[(2 * i + 1) * 128 + 64 + lane];
            }
            const float ks = wave_sum(k * k);
            k *= rsqrtf(ks * (1.f / 64.f) + EPS) * p.k_norm_g[lane];
            Kb[(size_t)tok * 64 + lane] = f2bf(k);
            Vt[((size_t)(tok / NT) * 64 + lane) * NT + t] = f2bf(v);
        }
        {
            float a = (lane < 32) ? bf2f(pr[PC_KIDX + lane]) : 0.f;
            const float ss = wave_sum(a * a);
            a *= rsqrtf(ss * (1.f / 32.f) + EPS);
            if (lane < 32) kib[(size_t)tok * 32 + lane] = f2bf(a * p.idx_k_norm_g[lane]);
            if (lane < 8) wi[(size_t)tok * 8 + lane] = bf2f(pr[PC_WIDX + lane]) * 0.35355339059327373f * 0.17677669529663687f;
            if (lane < 4) {
                dbeta[(size_t)tok * 4 + lane] = sigmoid_f(bf2f(pr[PC_BETA + lane]));
                const float z = bf2f(pr[PC_A + lane]) + p.dt_bias[lane];
                const float sp = (z > 20.f) ? z : log1pf(__expf(z));
                dg[(size_t)tok * 4 + lane] = -__expf(p.a_log[lane]) * sp;
            }
        }
      }
        {
            const int tok0 = tg * 8, t0 = tok0 % NT, bb = tok0 / NT;
#pragma unroll 1
            for (int j = 0; j < 12; ++j) {
                const int ch = j * 128 + lane * 2;
                float w0[11], w1[11];
#pragma unroll
                for (int i = 0; i < 11; ++i) {
                    unsigned raw = 0u;
                    if (t0 - 3 + i >= 0) raw = *(const unsigned*)(proj + (size_t)(tok0 - 3 + i) * NPROJ + PC_DNQKV + ch);
                    w0[i] = __uint_as_float(raw << 16); w1[i] = __uint_as_float(raw & 0xffff0000u);
                }
                float c0[4], c1[4];
#pragma unroll
                for (int tap = 0; tap < 4; ++tap) { c0[tap] = p.conv_w[tap * 1536 + ch]; c1[tap] = p.conv_w[tap * 1536 + ch + 1]; }
                float y0[8], y1[8];
#pragma unroll
                for (int i = 0; i < 8; ++i) {
                    float a0 = 0.f, a1 = 0.f;
#pragma unroll
                    for (int tap = 0; tap < 4; ++tap) { a0 += c0[tap] * w0[i + tap]; a1 += c1[tap] * w1[i + tap]; }
                    y0[i] = silu_f(a0); y1[i] = silu_f(a1);
                    if (j < 8) {
                        const float ss = wave_sum(y0[i] * y0[i] + y1[i] * y1[i]);
                        float rs = rsqrtf(ss + EPS);
                        if (j < 4) rs *= 0.08838834764831845f;
                        y0[i] *= rs; y1[i] *= rs;
                    }
                }
                if (j < 8) {
                    bf16_t* dst = (j < 4) ? dq : dk;
#pragma unroll
                    for (int i = 0; i < 8; ++i) *(unsigned*)(dst + (size_t)(tok0 + i) * 512 + (j & 3) * 128 + lane * 2) = pack2(y0[i], y1[i]);
                }
                if (j >= 4) {
                    bf16_t* dstT = ((j < 8) ? dkT : dvT) + ((size_t)(bb * 4 + (j & 3)) * 128 + lane * 2) * NT + t0;
                    *(uint4*)dstT = make_uint4(pack2(y0[0], y0[1]), pack2(y0[2], y0[3]), pack2(y0[4], y0[5]), pack2(y0[6], y0[7]));
                    *(uint4*)(dstT + NT) = make_uint4(pack2(y1[0], y1[1]), pack2(y1[2], y1[3]), pack2(y1[4], y1[5]), pack2(y1[6], y1[7]));
                }
            }
        }
    }
}

__device__ __forceinline__ unsigned f2sortable(float f) { const unsigned u = __float_as_uint(f); return (u & 0x80000000u) ? ~u : (u | 0x80000000u); }
__device__ __forceinline__ float sum8_f(float v) { v += dpp_f<0xB1>(v); v += dpp_f<0x4E>(v); v += dpp_f<0x141>(v); return v; }
__device__ __forceinline__ int sum16_i(int v) { v += dpp_i<0xB1>(v); v += dpp_i<0x4E>(v); v += dpp_i<0x141>(v); v += __shfl_xor(v, 32); return v; }
__device__ __forceinline__ int pi32(int r) { return (r & 0x13) | ((r & 4) << 1) | ((r & 8) >> 1); }
__device__ __forceinline__ constexpr int key_of_reg(int r) { return (r & 3) + 4 * ((r >> 2) & 1) + 16 * (r >> 3); }
struct KiFrag { bf16x8 a0, a1; };
__device__ __forceinline__ void idx_scores(f32x16& sc, const KiFrag& f, bf16x8 qi0, bf16x8 qi1, float wl) {
    f32x16 z;
#pragma unroll
    for (int r = 0; r < 16; ++r) z[r] = 0.f;
    z = __builtin_amdgcn_mfma_f32_32x32x16_bf16(f.a0, qi0, z, 0, 0, 0);
    z = __builtin_amdgcn_mfma_f32_32x32x16_bf16(f.a1, qi1, z, 0, 0, 0);
#pragma unroll
    for (int r = 0; r < 16; ++r) sc[r] = sum8_f(fmaxf(z[r], 0.f) * wl);
}
constexpr int AT_SBL = 0, AT_POSMAX = 4352, AT_ITEM = 6400, AT_BUF = 6656;
constexpr int AT_KI_ROW = 80, AT_P1_BUF = 256 * AT_KI_ROW;
constexpr int AT_K = 0, AT_VT = 64 * 144, AT_KI = 2 * 64 * 144, AT_PK = AT_KI + 64 * AT_KI_ROW, AT_P2_BUF = AT_PK + 256;
constexpr int ATTM_LDS = AT_BUF + 2 * (AT_P1_BUF > AT_P2_BUF ? AT_P1_BUF : AT_P2_BUF);
__device__ __forceinline__ KiFrag ki_lds(const char* buf, int row, int hf) {
    KiFrag f; const char* r = buf + row * AT_KI_ROW + 16 * hf;
    f.a0 = *(const bf16x8*)r; f.a1 = *(const bf16x8*)(r + 32); return f;
}
__device__ __forceinline__ void attn_pass1(const P& p, char* smem, int b, int tb, int tid, float& tauf, int& cut) {
    const int lane = tid & 63, wave = tid >> 6;
    const int hf = lane >> 5, cq = (lane & 31) >> 3, ch = lane & 7, prow = pi32(lane & 31);
    const int t0 = tb * 32 + wave * 4, tq = t0 + cq, tok = b * NT + tq;
    const bf16_t* proj = (const bf16_t*)(p.ws + WS_PROJ);
    const bf16_t* ki_b = (const bf16_t*)(p.ws + WS_KI) + (size_t)b * NT * 32;
    const bf16x8 qi0 = *(const bf16x8*)(proj + (size_t)tok * NPROJ + PC_QIDX + ch * 32 + 8 * hf);
    const bf16x8 qi1 = *(const bf16x8*)(proj + (size_t)tok * NPROJ + PC_QIDX + ch * 32 + 16 + 8 * hf);
    const float wl = ((const float*)(p.ws + WS_WI))[(size_t)tok * 8 + ch];
    char* bufs = smem + AT_BUF;
    float keep[8][16];
#pragma unroll
    for (int s = 0; s < 8; ++s)
#pragma unroll
        for (int r = 0; r < 16; ++r) keep[s][r] = -INFINITY;
    {
#pragma unroll
        for (int i = 0; i < 2; ++i) { const int x = tid + 512 * i; *(uint4*)(bufs + (x >> 2) * AT_KI_ROW + (x & 3) * 16) = *(const uint4*)(ki_b + (size_t)(x >> 2) * 32 + (x & 3) * 8); }
    }
    __syncthreads();
#pragma unroll
    for (int g = 0; g < 8; ++g) {
        if (g * 8 <= tb) {
            const bool more = (g + 1) * 8 <= tb;
            uint4 n0 = make_uint4(0, 0, 0, 0), n1 = n0;
            if (more) {
                n0 = *(const uint4*)(ki_b + (size_t)((g + 1) * 256 + (tid >> 2)) * 32 + (tid & 3) * 8);
                n1 = *(const uint4*)(ki_b + (size_t)((g + 1) * 256 + 128 + (tid >> 2)) * 32 + (tid & 3) * 8);
            }
            const char* buf = bufs + (g & 1) * AT_P1_BUF;
#pragma unroll
            for (int kk = 0; kk < 8; ++kk) {
                const int kt = g * 8 + kk;
                if (kt <= tb) {
                    const KiFrag f = ki_lds(buf, kk * 32 + prow, hf);
                    f32x16 sc;
                    idx_scores(sc, f, qi0, qi1, wl);
                    if (kt == tb) {
#pragma unroll
                        for (int r = 0; r < 16; ++r) sc[r] = (kt * 32 + key_of_reg(r) + 8 * hf <= tq) ? sc[r] : -INFINITY;
                    }
                    if (ch == kk) {
#pragma unroll
                        for (int r = 0; r < 16; ++r) keep[g][r] = sc[r];
                    }
                    __builtin_amdgcn_sched_barrier(0);
                }
            }
            if (more) {
                char* nb = bufs + ((g + 1) & 1) * AT_P1_BUF;
                *(uint4*)(nb + (tid >> 2) * AT_KI_ROW + (tid & 3) * 16) = n0;
                *(uint4*)(nb + (128 + (tid >> 2)) * AT_KI_ROW + (tid & 3) * 16) = n1;
            }
            __syncthreads();
        }
    }
    unsigned u[8][16];
#pragma unroll
    for (int s = 0; s < 8; ++s)
#pragma unroll
        for (int r = 0; r < 16; ++r) u[s][r] = f2sortable(keep[s][r]);
    unsigned prefix = 0u;
    for (int bit = 31; bit >= 0; --bit) {
        const unsigned cand = prefix | (1u << bit);
        int cnt = 0;
#pragma unroll
        for (int s = 0; s < 8; ++s) {
            if (s * 8 <= tb) {
#pragma unroll
                for (int r = 0; r < 16; ++r) cnt += (u[s][r] >= cand) ? 1 : 0;
            }
        }
        cnt = sum16_i(cnt);
        if (cnt >= 256) prefix = cand;
    }
    int ngt = 0, neq = 0;
#pragma unroll
    for (int s = 0; s < 8; ++s)
#pragma unroll
        for (int r = 0; r < 16; ++r) { ngt += (u[s][r] > prefix) ? 1 : 0; neq += (u[s][r] == prefix) ? 1 : 0; asm volatile("" : "+v"(ngt), "+v"(neq)); }
    ngt = sum16_i(ngt); neq = sum16_i(neq);
    const int need = 256 - ngt;
    if (__any(need < neq)) {
        int lo = 0, hi = NT - 1;
        for (int it = 0; it < 11; ++it) {
            const int mid = (lo + hi) >> 1;
            int cnt = 0;
            unsigned pf = prefix; asm volatile("" : "+v"(pf));
#pragma unroll
            for (int s = 0; s < 8; ++s)
#pragma unroll
                for (int r = 0; r < 16; ++r) { cnt += (u[s][r] == pf && ((s * 8 + ch) * 32 + key_of_reg(r) + 8 * hf) <= mid) ? 1 : 0; asm volatile("" : "+v"(cnt)); }
            cnt = sum16_i(cnt);
            if (cnt >= need) hi = mid; else lo = mid + 1;
        }
        if (need < neq) cut = lo;
    }
    { const unsigned pu = prefix; tauf = __uint_as_float((pu & 0x80000000u) ? (pu & 0x7fffffffu) : ~pu); }
}
__device__ __forceinline__ void attn_pass2(const P& p, char* smem, int b, int tb, int tid, float tauf, int cut) {
    const int lane = tid & 63, wave = tid >> 6;
    const int hf = lane >> 5, l31 = lane & 31, cq = l31 >> 3, ch = lane & 7, prow = pi32(l31);
    const int t0 = tb * 32 + wave * 4, tq = t0 + cq, tok = b * NT + tq;
    const bf16_t* proj = (const bf16_t*)(p.ws + WS_PROJ);
    bf16_t* qn = (bf16_t*)(p.ws + WS_QN);
    const bf16_t* ki_b = (const bf16_t*)(p.ws + WS_KI) + (size_t)b * NT * 32;
    const bf16_t* K_b = (const bf16_t*)(p.ws + WS_K) + (size_t)b * NT * 64;
    const bf16_t* Vt_b = (const bf16_t*)(p.ws + WS_VT) + (size_t)b * 64 * NT;
    const float* sbl = (const float*)(smem + AT_SBL); const int* posmax = (const int*)(smem + AT_POSMAX) + b * 64;
    char* bufs = smem + AT_BUF;
    const bf16x8 qi0 = *(const bf16x8*)(proj + (size_t)tok * NPROJ + PC_QIDX + ch * 32 + 8 * hf);
    const bf16x8 qi1 = *(const bf16x8*)(proj + (size_t)tok * NPROJ + PC_QIDX + ch * 32 + 16 + 8 * hf);
    const float wl = ((const float*)(p.ws + WS_WI))[(size_t)tok * 8 + ch];
    bf16x8 qb[4];
#pragma unroll
    for (int ks = 0; ks < 4; ++ks) qb[ks] = *(const bf16x8*)(qn + (size_t)tok * 512 + ch * 64 + ks * 16 + 8 * hf);
    const int pq = p.pos[tok];
    int pqmin = pq;
    pqmin = min(pqmin, __shfl_xor(pqmin, 8)); pqmin = min(pqmin, __shfl_xor(pqmin, 16));
    pqmin = __builtin_amdgcn_readfirstlane(pqmin);
    const float bias_far = sbl[128 * 8 + ch];
    const bool anycut = __any(cut != 0x7fffffff);
    f32x16 o0, o1;
#pragma unroll
    for (int r = 0; r < 16; ++r) { o0[r] = 0.f; o1[r] = 0.f; }
    float m = -INFINITY, l = 0.f;
    const int nt64 = (tb + 2) >> 1;
    uint4 rk, rv, rki = make_uint4(0, 0, 0, 0); int rpos = 0;
#define AT_LOAD(j) { rk = *(const uint4*)(K_b + (size_t)((j) * 64 + (tid >> 3)) * 64 + (tid & 7) * 8); \
                     rv = *(const uint4*)(Vt_b + (size_t)(tid >> 3) * NT + (j) * 64 + (tid & 7) * 8); \
                     if (tid < 256) rki = *(const uint4*)(ki_b + (size_t)((j) * 64 + (tid >> 2)) * 32 + (tid & 3) * 8); \
                     else if (tid < 320) rpos = p.pos[b * NT + (j) * 64 + tid - 256]; }
#define AT_STORE(bp) { char* sb_ = (bp); *(uint4*)(sb_ + AT_K + (tid >> 3) * 144 + (tid & 7) * 16) = rk; *(uint4*)(sb_ + AT_VT + (tid >> 3) * 144 + (tid & 7) * 16) = rv; \
                       if (tid < 256) *(uint4*)(sb_ + AT_KI + (tid >> 2) * AT_KI_ROW + (tid & 3) * 16) = rki; else if (tid < 320) ((int*)(sb_ + AT_PK))[tid - 256] = rpos; }
    AT_LOAD(0) AT_STORE(bufs)
    __syncthreads();
#pragma unroll 1
    for (int j = 0; j < nt64; ++j) {
        if (j + 1 < nt64) AT_LOAD(j + 1)
        const char* buf = bufs + (j & 1) * AT_P2_BUF;
#pragma unroll
        for (int sub = 0; sub < 2; ++sub) {
            const int kt = 2 * j + sub;
            if (kt <= tb) {
                const KiFrag kf = ki_lds(buf + AT_KI, sub * 32 + prow, hf);
                f32x16 sc;
                idx_scores(sc, kf, qi0, qi1, wl);
                const bool far = (pqmin - posmax[kt] >= 128);
                f32x16 s;
#pragma unroll
                for (int r = 0; r < 16; ++r) s[r] = far ? bias_far : 0.f;
                {
                    const char* kr = buf + AT_K + (sub * 32 + prow) * 144 + 16 * hf;
#pragma unroll
                    for (int ks = 0; ks < 4; ++ks) s = __builtin_amdgcn_mfma_f32_32x32x16_bf16(*(const bf16x8*)(kr + ks * 32), qb[ks], s, 0, 0, 0);
                }
                const int kbase = kt * 32 + 8 * hf;
                if (!far) {
                    const int* pk = (const int*)(buf + AT_PK) + sub * 32 + 8 * hf;
#pragma unroll
                    for (int r = 0; r < 16; ++r) {
                        int n = pq - pk[key_of_reg(r)];
                        n = n < 0 ? 0 : (n > 128 ? 128 : n);
                        s[r] += sbl[n * 8 + ch];
                    }
                }
                if (anycut) {
#pragma unroll
                    for (int r = 0; r < 16; ++r) { const bool ok = (sc[r] > tauf) || (sc[r] == tauf && (kbase + key_of_reg(r)) <= cut); s[r] = ok ? s[r] : -INFINITY; }
                } else {
#pragma unroll
                    for (int r = 0; r < 16; ++r) s[r] = (sc[r] >= tauf) ? s[r] : -INFINITY;
                }
                if (kt == tb) {
#pragma unroll
                    for (int r = 0; r < 16; ++r) s[r] = (kbase + key_of_reg(r) <= tq) ? s[r] : -INFINITY;
                }
                float mx = s[0];
#pragma unroll
                for (int r = 1; r < 16; ++r) mx = fmaxf(mx, s[r]);
                mx = fmaxf(mx, __shfl_xor(mx, 32));
                const float mnew = fmaxf(m, mx);
                const float msafe = (mnew == -INFINITY) ? 0.f : mnew;
                const float alpha = __builtin_amdgcn_exp2f(m - msafe);
                m = mnew;
                float ps = 0.f;
#pragma unroll
                for (int r = 0; r < 16; ++r) { s[r] = __builtin_amdgcn_exp2f(s[r] - msafe); ps += s[r]; }
                l = l * alpha + ps;
                if (__any(alpha != 1.f)) {
#pragma unroll
                    for (int r = 0; r < 16; ++r) { o0[r] *= alpha; o1[r] *= alpha; }
                }
                union { uint4 u; bf16x8 f; } pb0, pb1;
                pb0.u = make_uint4(pack2(s[0], s[1]), pack2(s[2], s[3]), pack2(s[4], s[5]), pack2(s[6], s[7]));
                pb1.u = make_uint4(pack2(s[8], s[9]), pack2(s[10], s[11]), pack2(s[12], s[13]), pack2(s[14], s[15]));
                const char* vr = buf + AT_VT + l31 * 144 + sub * 64 + 16 * hf;
                o0 = __builtin_amdgcn_mfma_f32_32x32x16_bf16(*(const bf16x8*)vr, pb0.f, o0, 0, 0, 0);
                o0 = __builtin_amdgcn_mfma_f32_32x32x16_bf16(*(const bf16x8*)(vr + 32), pb1.f, o0, 0, 0, 0);
                o1 = __builtin_amdgcn_mfma_f32_32x32x16_bf16(*(const bf16x8*)(vr + 32 * 144), pb0.f, o1, 0, 0, 0);
                o1 = __builtin_amdgcn_mfma_f32_32x32x16_bf16(*(const bf16x8*)(vr + 32 * 144 + 32), pb1.f, o1, 0, 0, 0);
            }
        }
        if (j + 1 < nt64) AT_STORE(bufs + ((j + 1) & 1) * AT_P2_BUF)
        __syncthreads();
    }
#undef AT_LOAD
#undef AT_STORE
    l += __shfl_xor(l, 32);
    const float inv = 1.f / l;
    bf16_t* orow = qn + (size_t)tok * 512 + ch * 64;
#pragma unroll
    for (int gq = 0; gq < 4; ++gq) {
        *(uint2*)(orow + gq * 8 + 4 * hf) = make_uint2(pack2(o0[gq * 4] * inv, o0[gq * 4 + 1] * inv), pack2(o0[gq * 4 + 2] * inv, o0[gq * 4 + 3] * inv));
        *(uint2*)(orow + 32 + gq * 8 + 4 * hf) = make_uint2(pack2(o1[gq * 4] * inv, o1[gq * 4 + 1] * inv), pack2(o1[gq * 4 + 2] * inv, o1[gq * 4 + 3] * inv));
    }
}
__device__ __forceinline__ void dn_scan_block(const P& p, char* smem, int bh, int tid);
template <int MODE>
__device__ __forceinline__ void ph_attn_mfma(const P& p, char* smem) {
    const int tid = tid_opaque();
    float* sbl = (float*)(smem + AT_SBL);
    for (int i = tid; i < 129 * 8; i += NTHREADS) {
        const int n = i >> 3, h = i & 7; int bk;
        if (n < 16) bk = n;
        else { const float v = logf((float)n / 16.f) / 2.0794415416798357f * 16.f; bk = 16 + (int)v; if (bk > 31) bk = 31; }
        sbl[i] = p.rel_bias[bk * 8 + h] * LOG2E;
    }
    ((int*)(smem + AT_POSMAX))[tid] = ((const int*)(p.ws + WS_POSMM))[tid * 2 + 1];
    __syncthreads();
    if (MODE != 2 && blockIdx.x < NB * 4) {
        int tid0 = tid; asm volatile("" : "+v"(tid0));
        dn_scan_block(p, smem + AT_BUF, blockIdx.x, tid0);
        __syncthreads();
    }
    int* qctr = (int*)(p.ws + WS_CTL) + 64;
    if (MODE != 1) for (;;) {
        int tid1 = tid; asm volatile("" : "+v"(tid1));
        if (tid1 == 0) *(int*)(smem + AT_ITEM) = atomicAdd(qctr, 1);
        __syncthreads();
        const int item = *(const int*)(smem + AT_ITEM);
        if (item >= NB * 64) break;
        const int b = item & 7, tb = 63 - (item >> 3);
        float tauf = -INFINITY; int cut = 0x7fffffff;
        if (tb >= 8) attn_pass1(p, smem, b, tb, tid1, tauf, cut);
        int tid2 = tid; asm volatile("" : "+v"(tid2));
        attn_pass2(p, smem, b, tb, tid2, tauf, cut);
    }
}

__device__ __forceinline__ constexpr int sig16(int x) { return (x & ~12) | ((x & 4) << 1) | ((x & 8) >> 1); }
constexpr int PREP_WAVE_LDS = 2 * 64 * 72 * 2 + 4 * 64 * 4;
constexpr int PREP_LDS = NWAVES * PREP_WAVE_LDS;
__device__ __forceinline__ void ph_dn_prep(const P& p, char* smem) {
    const int tid = tid_opaque();
    const int wave = tid >> 6;
    char* wl = smem + wave * PREP_WAVE_LDS;
    float* sA = (float*)wl;
    bf16_t* sTw = (bf16_t*)wl; bf16_t* sTu = sTw + 64 * 72;
    float* sG = (float*)(wl + 2 * 64 * 72 * 2); float* sB = sG + 64; float* sE = sB + 64; float* sL = sE + 64;
    const bf16_t* dq = (const bf16_t*)(p.ws + WS_DQ); const bf16_t* dk = (const bf16_t*)(p.ws + WS_DK);
    const bf16_t* dkT = (const bf16_t*)(p.ws + WS_DKT); const bf16_t* dvT = (const bf16_t*)(p.ws + WS_DVT);
    const float* dbeta = (const float*)(p.ws + WS_DBG); const float* dg = dbeta + NTOK * 4;
    unsigned char* dob = (unsigned char*)p.out;
    bf16_t* PPg = (bf16_t*)(dob + DO_PP); float* GCg = (float*)(dob + DO_GC); float* EGg = (float*)(dob + DO_EG); float* LLg = (float*)(dob + DO_LL);
    for (int item = blockIdx.x * NWAVES + wave; item < NB * 4 * 32; item += gridDim.x * NWAVES) {
        int lane = tid & 63; asm volatile("" : "+v"(lane));
        const int hf = lane >> 5, l31 = lane & 31;
        const int bh = item >> 5, c = item & 31, b = bh >> 2, hh = bh & 3;
        const int tok0 = b * NT + c * 64;
        bf16_t* WN = (bf16_t*)(dob + DO_WN) + (size_t)item * 64 * 128; bf16_t* Ug = (bf16_t*)(dob + DO_U) + (size_t)item * 64 * 128;
        bf16_t* PP = PPg + (size_t)item * 64 * 64;
        float G, beta, eG;
        {
            const float g = dg[(size_t)(tok0 + lane) * 4 + hh];
            beta = dbeta[(size_t)(tok0 + lane) * 4 + hh];
            G = g;
#pragma unroll
            for (int o = 1; o < 64; o <<= 1) { const float n = __shfl_up(G, o); if (lane >= o) G += n; }
            const float Gl = __shfl(G, 63);
            eG = __expf(G);
            sG[lane] = G; sB[lane] = beta; sE[lane] = eG; sL[lane] = __expf(Gl - G);
            EGg[item * 64 + lane] = eG; LLg[item * 64 + lane] = __expf(Gl - G);
            if (lane == 0) GCg[item] = __expf(Gl);
        }
        f32x16 kk00, kk10, kk11, qk00, qk10, qk11;
#pragma unroll
        for (int r = 0; r < 16; ++r) { kk00[r] = 0.f; kk10[r] = 0.f; kk11[r] = 0.f; qk00[r] = 0.f; qk10[r] = 0.f; qk11[r] = 0.f; }
        {
            const bf16_t* kr0 = dk + (size_t)(tok0 + l31) * 512 + hh * 128 + 8 * hf; const bf16_t* kr1 = kr0 + 32 * 512;
            const bf16_t* qr0 = dq + (size_t)(tok0 + l31) * 512 + hh * 128 + 8 * hf; const bf16_t* qr1 = qr0 + 32 * 512;
#pragma unroll
            for (int s = 0; s < 8; ++s) {
                const bf16x8 k0 = *(const bf16x8*)(kr0 + s * 16), k1 = *(const bf16x8*)(kr1 + s * 16), q0 = *(const bf16x8*)(qr0 + s * 16), q1 = *(const bf16x8*)(qr1 + s * 16);
                kk00 = __builtin_amdgcn_mfma_f32_32x32x16_bf16(k0, k0, kk00, 0, 0, 0);
                kk10 = __builtin_amdgcn_mfma_f32_32x32x16_bf16(k1, k0, kk10, 0, 0, 0);
                kk11 = __builtin_amdgcn_mfma_f32_32x32x16_bf16(k1, k1, kk11, 0, 0, 0);
                qk00 = __builtin_amdgcn_mfma_f32_32x32x16_bf16(q0, k0, qk00, 0, 0, 0);
                qk10 = __builtin_amdgcn_mfma_f32_32x32x16_bf16(q1, k0, qk10, 0, 0, 0);
                qk11 = __builtin_amdgcn_mfma_f32_32x32x16_bf16(q1, k1, qk11, 0, 0, 0);
            }
        }
        __threadfence_block();
        {
            const float Gc0 = sG[l31], Gc1 = sG[32 + l31];
            float* sA0 = sA + (4 * hf) * 64 + l31;
            bf16_t* PP0 = PP + (4 * hf) * 64 + sig16(l31);
            const float* sGr = sG + 4 * hf; const float* sBr = sB + 4 * hf;
            const int jrel = l31 - 4 * hf;
#pragma unroll
            for (int r = 0; r < 16; ++r) {
                const int ro = (r & 3) + 8 * (r >> 2);
                const float Gi0 = sGr[ro], Gi1 = sGr[32 + ro], Bi0 = sBr[ro], Bi1 = sBr[32 + ro];
                {
                    const float dec = (jrel <= ro) ? __expf(Gi0 - Gc0) : 0.f;
                    sA0[ro * 64] = (jrel < ro) ? Bi0 * kk00[r] * dec : 0.f;
                    PP0[ro * 64] = f2bf(qk00[r] * dec);
                    PP0[ro * 64 + 32] = 0;
                }
                {
                    const float dec = __expf(Gi1 - Gc0);
                    sA0[(32 + ro) * 64] = Bi1 * kk10[r] * dec;
                    PP0[(32 + ro) * 64] = f2bf(qk10[r] * dec);
                }
                {
                    const float dec = (jrel <= ro) ? __expf(Gi1 - Gc1) : 0.f;
                    sA0[(32 + ro) * 64 + 32] = (jrel < ro) ? Bi1 * kk11[r] * dec : 0.f;
                    PP0[(32 + ro) * 64 + 32] = f2bf(qk11[r] * dec);
                }
            }
        }
        __threadfence_block();
        float x[64];
#pragma unroll
        for (int i = 0; i < 64; ++i) x[i] = (i == lane) ? 1.f : 0.f;
#pragma unroll
        for (int i = 1; i < 64; ++i) {
            float acc = x[i];
#pragma unroll
            for (int m4 = 0; m4 < i; m4 += 4) {
                const f32x4 a = *(const f32x4*)(sA + i * 64 + m4);
                acc -= a[0] * x[m4];
                if (m4 + 1 < i) acc -= a[1] * x[m4 + 1];
                if (m4 + 2 < i) acc -= a[2] * x[m4 + 2];
                if (m4 + 3 < i) acc -= a[3] * x[m4 + 3];
            }
            x[i] = acc;
            __builtin_amdgcn_sched_barrier(0);
        }
        __threadfence_block();
        {
            const float sw = beta * eG;
#pragma unroll
            for (int i = 0; i < 64; ++i) { sTw[i * 72 + lane] = f2bf(x[i] * sw); sTu[i * 72 + lane] = f2bf(x[i] * beta); }
        }
        __threadfence_block();
        {
            bf16x8 tw[2][4], tu[2][4];
#pragma unroll
            for (int mt = 0; mt < 2; ++mt)
#pragma unroll
                for (int s = 0; s < 4; ++s) { tw[mt][s] = *(const bf16x8*)(sTw + (mt * 32 + l31) * 72 + s * 16 + 8 * hf); tu[mt][s] = *(const bf16x8*)(sTu + (mt * 32 + l31) * 72 + s * 16 + 8 * hf); }
            const bf16_t* kTb = dkT + ((size_t)bh * 128 + l31) * NT + c * 64 + 8 * hf;
            const bf16_t* vTb = dvT + ((size_t)bh * 128 + l31) * NT + c * 64 + 8 * hf;
#pragma unroll 1
            for (int nt = 0; nt < 4; ++nt) {
                f32x16 w0, w1, u0, u1;
#pragma unroll
                for (int r = 0; r < 16; ++r) { w0[r] = 0.f; w1[r] = 0.f; u0[r] = 0.f; u1[r] = 0.f; }
#pragma unroll
                for (int s = 0; s < 4; ++s) {
                    const bf16x8 kb = *(const bf16x8*)(kTb + (size_t)nt * 32 * NT + s * 16), vb = *(const bf16x8*)(vTb + (size_t)nt * 32 * NT + s * 16);
                    w0 = __builtin_amdgcn_mfma_f32_32x32x16_bf16(tw[0][s], kb, w0, 0, 0, 0);
                    w1 = __builtin_amdgcn_mfma_f32_32x32x16_bf16(tw[1][s], kb, w1, 0, 0, 0);
                    u0 = __builtin_amdgcn_mfma_f32_32x32x16_bf16(tu[0][s], vb, u0, 0, 0, 0);
                    u1 = __builtin_amdgcn_mfma_f32_32x32x16_bf16(tu[1][s], vb, u1, 0, 0, 0);
                }
                bf16_t* WN0 = WN + (4 * hf) * 128 + nt * 32 + sig16(l31); bf16_t* U0 = Ug + (4 * hf) * 128 + nt * 32 + l31;
#pragma unroll
                for (int r = 0; r < 16; ++r) {
                    const int ro = (r & 3) + 8 * (r >> 2);
                    WN0[ro * 128] = f2bf(-w0[r]); WN0[(32 + ro) * 128] = f2bf(-w1[r]);
                    U0[ro * 128] = f2bf(u0[r]); U0[(32 + ro) * 128] = f2bf(u1[r]);
                }
            }
        }
        __threadfence_block();
    }
}

__device__ __forceinline__ bf16x8 pack_frag(const f32x16& t, int s) {
    bf16x8 f;
#pragma unroll
    for (int j = 0; j < 8; ++j) f[j] = (short)f2bf(t[8 * s + j]);
    return f;
}
__device__ __forceinline__ bf16x8 pack_frag_scaled(const f32x16& t, int s, const f32x4& sc0, const f32x4& sc1) {
    bf16x8 f;
#pragma unroll
    for (int j = 0; j < 4; ++j) { f[j] = (short)f2bf(t[8 * s + j] * sc0[j]); f[4 + j] = (short)f2bf(t[8 * s + 4 + j] * sc1[j]); }
    return f;
}
__device__ __forceinline__ bf16x8 load_perm_frag(const bf16_t* ptr) {
    const uint2 lo = *(const uint2*)ptr, hi = *(const uint2*)(ptr + 8);
    union { uint4 u; bf16x8 f; } cv; cv.u = make_uint4(lo.x, lo.y, hi.x, hi.y); return cv.f;
}
constexpr int SC_WN = 0, SC_Q = 16384, SC_KT = 32768, SC_PP = SC_KT + 128 * 144, SC_U = SC_PP + 64 * 144, SC_EG = SC_U + 16384, SC_LL = SC_EG + 256, SC_GC = SC_LL + 256, SC_BYTES = SC_GC + 16;
constexpr int SCAN_LDS = 2 * SC_BYTES;
#define SCAN_DECL uint4 wn0, wn1, wn2, wn3, q0, q1, q2, q3, kt0, kt1, kt2, kt3, pp0, pp1, u0, u1, u2, u3; float egv = 0.f, gcv = 0.f;
#define SCAN_LD4(i, WNR, UR, QR, KTR) { const int x = hl + 256 * (i); WNR = WNp[x]; UR = Up[x]; \
        QR = *(const uint4*)(dqb + (size_t)(x >> 4) * 512 + (x & 15) * 8); \
        KTR = *(const uint4*)(ktb + (size_t)(x >> 3) * NT + (x & 7) * 8); }
#define SCAN_LOAD(c) { const int ci = bh * 32 + (c); \
        const uint4* WNp = (const uint4*)(dob + DO_WN + (size_t)ci * 16384); const uint4* Up = (const uint4*)(dob + DO_U + (size_t)ci * 16384); const uint4* PPp = (const uint4*)(dob + DO_PP + (size_t)ci * 8192); \
        const bf16_t* dqb = dqh + (size_t)(c) * 64 * 512; const bf16_t* ktb = dkTh + (c) * 64; \
        SCAN_LD4(0, wn0, u0, q0, kt0) SCAN_LD4(1, wn1, u1, q1, kt1) SCAN_LD4(2, wn2, u2, q2, kt2) SCAN_LD4(3, wn3, u3, q3, kt3) \
        pp0 = PPp[hl]; pp1 = PPp[hl + 256]; \
        if (hl < 64) egv = ((const float*)(dob + DO_EG))[ci * 64 + hl]; else if (hl < 128) egv = ((const float*)(dob + DO_LL))[ci * 64 + hl - 64]; \
        if (hl == 128) gcv = ((const float*)(dob + DO_GC))[ci]; }
#define SCAN_ST4(i, WNR, UR, QR, KTR) { const int x = hl + 256 * (i); \
        { const int r = x >> 4, cc = x & 15; *(uint4*)(sbuf + SC_WN + r * 256 + ((cc ^ (r & 15)) << 4)) = WNR; } \
        *(uint4*)(sbuf + SC_U + x * 16) = UR; \
        { const int r = x >> 4, cc = x & 15, a = cc >> 1, g = cc & 1; char* row = sbuf + SC_Q + r * 256; \
          *(uint2*)(row + (((2 * a) ^ (r & 15)) << 4) + g * 8) = make_uint2(QR.x, QR.y); \
          *(uint2*)(row + (((2 * a + 1) ^ (r & 15)) << 4) + g * 8) = make_uint2(QR.z, QR.w); } \
        { const int d = x >> 3, cc = x & 7, a = cc >> 1, g = cc & 1; char* row = sbuf + SC_KT + d * 144; \
          *(uint2*)(row + (2 * a) * 16 + g * 8) = make_uint2(KTR.x, KTR.y); \
          *(uint2*)(row + (2 * a + 1) * 16 + g * 8) = make_uint2(KTR.z, KTR.w); } }
#define SCAN_STORE(bufptr) { char* sbuf = (bufptr); \
        SCAN_ST4(0, wn0, u0, q0, kt0) SCAN_ST4(1, wn1, u1, q1, kt1) SCAN_ST4(2, wn2, u2, q2, kt2) SCAN_ST4(3, wn3, u3, q3, kt3) \
        *(uint4*)(sbuf + SC_PP + (hl >> 3) * 144 + (hl & 7) * 16) = pp0; \
        *(uint4*)(sbuf + SC_PP + ((hl + 256) >> 3) * 144 + (hl & 7) * 16) = pp1; \
        if (hl < 128) ((float*)(sbuf + SC_EG))[hl] = egv; \
        if (hl == 128) *(float*)(sbuf + SC_GC) = gcv; }
__device__ __forceinline__ void dn_scan_block(const P& p, char* smem, int bh, int tid) {
    const int wave = tid >> 6, lane = tid & 63;
    const int hf = lane >> 5, l31 = lane & 31;
    const int b = bh >> 2, hh = bh & 3;
    const bool helper = wave >= 4;
    const int hl = tid - 256, sl = wave;
    bf16_t* dno = (bf16_t*)((unsigned char*)p.out + DO_DNO);
    if (helper) {
        const unsigned char* dob = (const unsigned char*)p.out;
        const bf16_t* dqh = (const bf16_t*)(p.ws + WS_DQ) + (size_t)b * NT * 512 + hh * 128; const bf16_t* dkTh = (const bf16_t*)(p.ws + WS_DKT) + (size_t)bh * 128 * NT;
        SCAN_DECL
        SCAN_LOAD(0) SCAN_STORE(smem) SCAN_LOAD(1)
        __syncthreads();
#pragma unroll 1
        for (int c = 0; c < NT / 64; ++c) {
            if (c + 1 < NT / 64) SCAN_STORE(smem + ((c + 1) & 1) * SC_BYTES)
            if (c + 2 < NT / 64) SCAN_LOAD(c + 2)
            __syncthreads();
        }
        return;
    }
    f32x16 S[4];
#pragma unroll
    for (int T = 0; T < 4; ++T)
#pragma unroll
        for (int r = 0; r < 16; ++r) S[T][r] = 0.f;
    __syncthreads();
#pragma unroll 1
    for (int c = 0; c < NT / 64; ++c) {
        char* buf = smem + (c & 1) * SC_BYTES;
        {
            const int tok0 = b * NT + c * 64;
            const int sw = l31 & 15;
            const char* wnr = buf + SC_WN + l31 * 256; const char* qr = buf + SC_Q + l31 * 256;
            const char* ktr = buf + SC_KT + l31 * 144 + 16 * hf; const char* ppr = buf + SC_PP + l31 * 144 + 16 * hf;
            const bf16_t* ur = (const bf16_t*)(buf + SC_U) + sl * 32 + l31;
            const float* egs = (const float*)(buf + SC_EG); const float* lls = (const float*)(buf + SC_LL);
            const float gc = *(const float*)(buf + SC_GC);
            bf16x8 SB[4][2];
#pragma unroll
            for (int T = 0; T < 4; ++T) { SB[T][0] = pack_frag(S[T], 0); SB[T][1] = pack_frag(S[T], 1); }
            f32x16 D[2], O[2];
#pragma unroll
            for (int mt = 0; mt < 2; ++mt)
#pragma unroll
                for (int r = 0; r < 16; ++r) { D[mt][r] = bf2f(ur[(mt * 32 + (r & 3) + 8 * (r >> 2) + 4 * hf) * 128]); O[mt][r] = 0.f; }
#pragma unroll
            for (int mt = 0; mt < 2; ++mt)
#pragma unroll
                for (int T = 0; T < 4; ++T)
#pragma unroll
                    for (int s = 0; s < 2; ++s) {
                        const int co = (((2 * (2 * T + s) + hf) ^ sw) << 4) + mt * 32 * 256;
                        const bf16x8 wa = *(const bf16x8*)(wnr + co);
                        const bf16x8 qa = *(const bf16x8*)(qr + co);
                        D[mt] = __builtin_amdgcn_mfma_f32_32x32x16_bf16(wa, SB[T][s], D[mt], 0, 0, 0);
                        O[mt] = __builtin_amdgcn_mfma_f32_32x32x16_bf16(qa, SB[T][s], O[mt], 0, 0, 0);
                    }
            __builtin_amdgcn_sched_barrier(0);
            bf16x8 DB[2][2], DL[2][2];
#pragma unroll
            for (int mt = 0; mt < 2; ++mt) {
#pragma unroll
                for (int g4 = 0; g4 < 4; ++g4) {
                    const f32x4 eg = *(const f32x4*)(egs + mt * 32 + g4 * 8 + 4 * hf);
#pragma unroll
                    for (int j = 0; j < 4; ++j) O[mt][g4 * 4 + j] *= eg[j];
                }
                const f32x4 l0 = *(const f32x4*)(lls + mt * 32 + 0 + 4 * hf), l1 = *(const f32x4*)(lls + mt * 32 + 8 + 4 * hf);
                const f32x4 l2 = *(const f32x4*)(lls + mt * 32 + 16 + 4 * hf), l3 = *(const f32x4*)(lls + mt * 32 + 24 + 4 * hf);
                DB[mt][0] = pack_frag(D[mt], 0); DB[mt][1] = pack_frag(D[mt], 1);
                DL[mt][0] = pack_frag_scaled(D[mt], 0, l0, l1); DL[mt][1] = pack_frag_scaled(D[mt], 1, l2, l3);
            }
#pragma unroll
            for (int mt = 0; mt < 2; ++mt)
#pragma unroll
                for (int ks = 0; ks < 4; ++ks) {
                    const bf16x8 pa = *(const bf16x8*)(ppr + mt * 32 * 144 + ks * 32);
                    O[mt] = __builtin_amdgcn_mfma_f32_32x32x16_bf16(pa, DB[ks >> 1][ks & 1], O[mt], 0, 0, 0);
                }
            __builtin_amdgcn_sched_barrier(0);
            {
                bf16_t* orow = dno + (size_t)tok0 * 512 + hh * 128 + sl * 32 + l31;
#pragma unroll
                for (int mt = 0; mt < 2; ++mt)
#pragma unroll
                    for (int r = 0; r < 16; ++r) orow[(size_t)(mt * 32 + (r & 3) + 8 * (r >> 2) + 4 * hf) * 512] = f2bf(O[mt][r]);
            }
#pragma unroll
            for (int T = 0; T < 4; ++T) {
#pragma unroll
                for (int r = 0; r < 16; ++r) S[T][r] *= gc;
#pragma unroll
                for (int ks = 0; ks < 4; ++ks) {
                    const bf16x8 ka = *(const bf16x8*)(ktr + T * 32 * 144 + ks * 32);
                    S[T] = __builtin_amdgcn_mfma_f32_32x32x16_bf16(ka, DL[ks >> 1][ks & 1], S[T], 0, 0, 0);
                }
            }
        }
        __syncthreads();
    }
}

__device__ __forceinline__ void ph_dn_gate(const P& p) {
    const int tid = tid_opaque();
    const int lane = tid & 63, wave = tid >> 6;
    const bf16_t* dno = (const bf16_t*)((const unsigned char*)p.out + DO_DNO); const bf16_t* proj = (const bf16_t*)(p.ws + WS_PROJ); bf16_t* dnn = (bf16_t*)(p.ws + WS_DK);
    for (int tok = blockIdx.x * NWAVES + wave; tok < NTOK; tok += gridDim.x * NWAVES) {
#pragma unroll
        for (int hh = 0; hh < 4; ++hh) {
            const unsigned orw = *(const unsigned*)(dno + (size_t)tok * 512 + hh * 128 + lane * 2);
            const float o0 = __uint_as_float(orw << 16), o1 = __uint_as_float(orw & 0xffff0000u);
            const float ss = wave_sum(o0 * o0 + o1 * o1);
            const float rs = rsqrtf(ss * (1.f / 128.f) + EPS);
            const unsigned zr = *(const unsigned*)(proj + (size_t)tok * NPROJ + PC_DNZ + hh * 128 + lane * 2);
            const float z0 = __uint_as_float(zr << 16), z1 = __uint_as_float(zr & 0xffff0000u);
            *(unsigned*)(dnn + (size_t)tok * 512 + hh * 128 + lane * 2) = pack2(o0 * rs * p.dn_norm_g[lane * 2] * silu_f(z0), o1 * rs * p.dn_norm_g[lane * 2 + 1] * silu_f(z1));
        }
    }
}

__device__ __forceinline__ void ph_gemm_out(const P& p, char* smem) {
    const int tid = tid_opaque();
    constexpr int BM = 256, BN = 128;
    const bf16_t* att = (const bf16_t*)(p.ws + WS_QN); const bf16_t* dnn = (const bf16_t*)(p.ws + WS_DK); const bf16_t* Wt = (const bf16_t*)(p.ws + WS_WOUT);
    float* sgate = (float*)(smem + GemmLds<BM, BN>::BYTES);
    const int lane = tid & 63, wave = tid >> 6, wm = wave % 4, wn = wave / 4;
    const int ntn = ND / BN, ntiles = (NTOK / BM) * ntn;
    for (int t = blockIdx.x; t < ntiles; t += gridDim.x) {
        const int tm = t / ntn, tn = t % ntn;
        const int b = (tm * BM) / NT;
        if (tid < BN) sgate[tid] = mod_val(p, b, 2, tn * BN + tid);
        const bf16_t* A1 = att + (size_t)tm * BM * 512; const bf16_t* A2 = dnn + (size_t)tm * BM * 512; const bf16_t* Bb = Wt + (size_t)tn * BN * ND;
        f32x16 acc[2][2];
        gemm_tile<BM, BN>(tid, smem, ND, [&](int r, int k) __attribute__((always_inline)) { return (k < 512) ? (A1 + (size_t)r * 512 + k) : (A2 + (size_t)r * 512 + (k - 512)); },
                          [&](int r, int k) __attribute__((always_inline)) { return Bb + (size_t)r * ND + k; }, acc);
#pragma unroll
        for (int m = 0; m < 2; ++m)
#pragma unroll
            for (int n = 0; n < 2; ++n)
#pragma unroll
                for (int r = 0; r < 16; ++r) {
                    const int row = tm * BM + wm * 64 + m * 32 + (r & 3) + 8 * (r >> 2) + 4 * (lane >> 5);
                    const int cl = wn * 64 + n * 32 + (lane & 31);
                    const size_t idx = (size_t)row * ND + tn * BN + cl;
                    p.out[idx] = p.x[idx] + sgate[cl] * acc[m][n][r];
                }
        __syncthreads();
    }
}

constexpr int ROUTE_LDS = 1024 * 37 * 4 + 2 * 1024 * 4 + 2048;
__device__ __forceinline__ void ph_route(const P& p, char* smem) {
    const int tid = tid_opaque();
    float* sW = (float*)smem;
    float* sA = sW + 1024 * 37; float* sB = sA + 1024;
    int* s_cnt = (int*)(sB + 1024);
    int* s_base = s_cnt + 32; int* s_tok = s_base + 32;
    const int lane = tid & 63, wave = tid >> 6;
    for (int i = tid; i < 4 * 1024; i += NTHREADS) sW[(i >> 2) * 37 + (i & 3)] = p.rg_w[i];
    for (int i = tid; i < 32 * 1024; i += NTHREADS) sW[(i >> 5) * 37 + 4 + (i & 31)] = p.re_w[i];
    bf16_t* h2 = (bf16_t*)(p.ws + WS_H2);
    int* cnt = (int*)(p.ws + WS_CTL); int* list = (int*)(p.ws + WS_LIST); int* tokinfo = (int*)(p.ws + WS_TOKINFO);
    int curb = -1;
    for (int tile = blockIdx.x; tile < NTOK / 64; tile += gridDim.x) {
        const int b = tile / (NT / 64);
        __syncthreads();
        if (b != curb) {
            for (int d = tid; d < ND; d += NTHREADS) { sA[d] = p.norm2_g[d] * (1.f + mod_val(p, b, 4, d)); sB[d] = mod_val(p, b, 3, d); }
            curb = b;
        }
        if (tid < 32) s_cnt[tid] = 0;
        __syncthreads();
        for (int i2 = 0; i2 < 4; ++i2) {
            const int tokA = tile * 64 + wave * 8 + i2 * 2, tokB = tokA + 1;
            const float* xa = p.out + (size_t)tokA * ND; const float* xb = xa + ND;
            float va[16], vb[16]; float sa = 0.f, sb = 0.f;
#pragma unroll
            for (int j = 0; j < 16; ++j) { va[j] = xa[j * 64 + lane]; vb[j] = xb[j * 64 + lane]; sa += va[j] * va[j]; sb += vb[j] * vb[j]; }
            sa = wave_sum(sa); sb = wave_sum(sb);
            const float ra = rsqrtf(sa * (1.f / ND) + EPS), rb = rsqrtf(sb * (1.f / ND) + EPS);
#pragma unroll
            for (int j = 0; j < 16; ++j) {
                const int d = j * 64 + lane;
                va[j] = va[j] * ra * sA[d] + sB[d]; vb[j] = vb[j] * rb * sA[d] + sB[d];
                h2[(size_t)tokA * ND + d] = f2bf(va[j]); h2[(size_t)tokB * ND + d] = f2bf(vb[j]);
            }
            float la = 0.f, lb = 0.f;
#pragma unroll 4
            for (int o = 0; o < 36; ++o) {
                float a = 0.f, c = 0.f;
#pragma unroll
                for (int j = 0; j < 16; ++j) { const float w = sW[(j * 64 + lane) * 37 + o]; a += va[j] * w; c += vb[j] * w; }
                a = wave_sum(a); c = wave_sum(c);
                if (lane == o) { la = a; lb = c; }
            }
            const float bias = (lane < 4) ? p.rg_b[lane] : ((lane < 36) ? p.re_b[lane - 4] : 0.f);
            la += bias; lb += bias;
#pragma unroll
            for (int which = 0; which < 2; ++which) {
                const float mylogit = which ? lb : la; const int tok = which ? tokB : tokA;
                float gl[4];
#pragma unroll
                for (int j = 0; j < 4; ++j) gl[j] = __shfl(mylogit, j);
                int gsel = 0; float gm = gl[0];
#pragma unroll
                for (int j = 1; j < 4; ++j) if (gl[j] > gm) { gm = gl[j]; gsel = j; }
                float gs = 0.f;
#pragma unroll
                for (int j = 0; j < 4; ++j) gs += __expf(gl[j] - gm);
                const float gtop = 1.f / gs;
                float el[8];
#pragma unroll
                for (int j = 0; j < 8; ++j) el[j] = __shfl(mylogit, 4 + gsel * 8 + j);
                int e1 = 0; float m1 = el[0];
#pragma unroll
                for (int j = 1; j < 8; ++j) if (el[j] > m1) { m1 = el[j]; e1 = j; }
                int e2 = -1; float m2 = -INFINITY;
#pragma unroll
                for (int j = 0; j < 8; ++j) if (j != e1 && el[j] > m2) { m2 = el[j]; e2 = j; }
                const float r2 = __expf(m2 - m1);
                const float w1v = gtop / (1.f + r2), w2v = gtop * r2 / (1.f + r2);
                if (lane == 0) {
                    const int ea = gsel * 8 + e1, eb = gsel * 8 + e2;
                    const int pa = atomicAdd(&s_cnt[ea], 1), pb = atomicAdd(&s_cnt[eb], 1);
                    int* st = s_tok + (tok & 63) * 4; st[0] = ea; st[1] = pa; st[2] = eb; st[3] = pb;
                    int* ti = tokinfo + (size_t)tok * 8; ti[4] = __float_as_int(w1v); ti[5] = __float_as_int(w2v);
                }
            }
        }
        __syncthreads();
        if (tid < 32) s_base[tid] = atomicAdd(&cnt[tid], s_cnt[tid]);
        __syncthreads();
        if (tid < 64) {
            const int tok = tile * 64 + tid; const int* st = s_tok + tid * 4;
            const int ea = st[0], pa = s_base[ea] + st[1], eb = st[2], pb = s_base[eb] + st[3];
            list[ea * NTOK + pa] = tok; list[eb * NTOK + pb] = tok;
            int* ti = tokinfo + (size_t)tok * 8; ti[0] = ea; ti[1] = pa; ti[2] = eb; ti[3] = pb;
        }
    }
}

struct MoeIdx { int rowoff[NE + 1]; int tileoff[NE + 1]; };
__device__ __forceinline__ void moe_index(const int tid, const P& p, MoeIdx* mi) {
    if (tid == 0) {
        const int* cnt = (const int*)(p.ws + WS_CTL);
        int r = 0, t = 0;
        for (int e = 0; e < NE; ++e) { mi->rowoff[e] = r; mi->tileoff[e] = t; const int c = cnt[e]; r += c; t += (c + 127) >> 7; }
        mi->rowoff[NE] = r; mi->tileoff[NE] = t;
    }
    __syncthreads();
}

constexpr int MOE_BM = 128, MOE_BN = 256;
__device__ __forceinline__ void ph_moe_up(const P& p, char* smem) {
    const int tid = tid_opaque();
    MoeIdx* mi = (MoeIdx*)(smem + GemmLds<MOE_BM, MOE_BN>::BYTES);
    int* srow = (int*)(mi + 1);
    moe_index(tid, p, mi);
    const bf16_t* h2 = (const bf16_t*)(p.ws + WS_H2); const bf16_t* Wt13 = (const bf16_t*)(p.ws + WS_W13); bf16_t* act = (bf16_t*)(p.ws + WS_ACT);
    const int* list = (const int*)(p.ws + WS_LIST);
    const int lane = tid & 63, wave = tid >> 6, wm = wave % 2, wn = wave / 2;
    const int ntiles = mi->tileoff[NE] * 4;
    for (int t = blockIdx.x; t < ntiles; t += gridDim.x) {
        const int mt = t >> 2, ni = t & 3;
        int e = 0;
        while (mi->tileoff[e + 1] <= mt) ++e;
        const int ml = mt - mi->tileoff[e];
        const int cnt_e = mi->rowoff[e + 1] - mi->rowoff[e];
        const int nrows = min(128, cnt_e - ml * 128);
        if (tid < 128) srow[tid] = list[e * NTOK + ml * 128 + min(tid, nrows - 1)];
        __syncthreads();
        const bf16_t* Bb = Wt13 + ((size_t)e * 1024 + ni * 256) * ND;
        f32x16 acc[2][2];
        gemm_tile<MOE_BM, MOE_BN>(tid, smem, ND, [&](int r, int k) __attribute__((always_inline)) { return h2 + (size_t)srow[r] * ND + k; }, [&](int r, int k) __attribute__((always_inline)) { return Bb + (size_t)r * ND + k; }, acc);
        const int row0 = mi->rowoff[e] + ml * 128;
#pragma unroll
        for (int m = 0; m < 2; ++m)
#pragma unroll
            for (int r = 0; r < 16; ++r) {
                const int rl = wm * 64 + m * 32 + (r & 3) + 8 * (r >> 2) + 4 * (lane >> 5);
                if (rl < nrows) {
                    const float g = acc[m][0][r], u = acc[m][1][r];
                    act[(size_t)(row0 + rl) * EFF + ni * 128 + wn * 32 + (lane & 31)] = f2bf(silu_f(g) * u);
                }
            }
        __syncthreads();
    }
}

__device__ __forceinline__ void ph_moe_down(const P& p, char* smem) {
    const int tid = tid_opaque();
    MoeIdx* mi = (MoeIdx*)(smem + GemmLds<MOE_BM, MOE_BN>::BYTES);
    moe_index(tid, p, mi);
    const bf16_t* act = (const bf16_t*)(p.ws + WS_ACT); const bf16_t* Wt2 = (const bf16_t*)(p.ws + WS_W2); bf16_t* yb = (bf16_t*)(p.ws + WS_YBUF);
    const int lane = tid & 63, wave = tid >> 6, wm = wave % 2, wn = wave / 2;
    const int ntiles = mi->tileoff[NE] * 4;
    for (int t = blockIdx.x; t < ntiles; t += gridDim.x) {
        const int mt = t >> 2, ni = t & 3;
        int e = 0;
        while (mi->tileoff[e + 1] <= mt) ++e;
        const int ml = mt - mi->tileoff[e];
        const int cnt_e = mi->rowoff[e + 1] - mi->rowoff[e];
        const int nrows = min(128, cnt_e - ml * 128);
        const int row0 = mi->rowoff[e] + ml * 128;
        const bf16_t* Ab = act + (size_t)row0 * EFF;
        const bf16_t* Bb = Wt2 + ((size_t)e * ND + ni * 256) * EFF;
        f32x16 acc[2][2];
        gemm_tile<MOE_BM, MOE_BN>(tid, smem, EFF, [&](int r, int k) __attribute__((always_inline)) { return Ab + (size_t)min(r, nrows - 1) * EFF + k; }, [&](int r, int k) __attribute__((always_inline)) { return Bb + (size_t)r * EFF + k; }, acc);
#pragma unroll
        for (int m = 0; m < 2; ++m)
#pragma unroll
            for (int n = 0; n < 2; ++n)
#pragma unroll
                for (int r = 0; r < 16; ++r) {
                    const int rl = wm * 64 + m * 32 + (r & 3) + 8 * (r >> 2) + 4 * (lane >> 5);
                    if (rl < nrows) yb[(size_t)(row0 + rl) * ND + ni * 256 + wn * 64 + n * 32 + (lane & 31)] = f2bf(acc[m][n][r]);
                }
    }
}

__device__ __forceinline__ void ph_combine(const P& p, char* smem) {
    const int tid = tid_opaque();
    MoeIdx* mi = (MoeIdx*)smem;
    float* sG = (float*)(mi + 1);
    moe_index(tid, p, mi);
    const int lane = tid & 63, wave = tid >> 6;
    const bf16_t* yb = (const bf16_t*)(p.ws + WS_YBUF); const int* tokinfo = (const int*)(p.ws + WS_TOKINFO);
    int curb = -1;
    for (int tile = blockIdx.x; tile < NTOK / 64; tile += gridDim.x) {
        const int b = tile / (NT / 64);
        if (b != curb) {
            __syncthreads();
            for (int d = tid; d < ND; d += NTHREADS) sG[d] = mod_val(p, b, 5, d);
            __syncthreads();
            curb = b;
        }
        for (int i = 0; i < 8; ++i) {
            const int tok = tile * 64 + wave * 8 + i;
            const int* ti = tokinfo + (size_t)tok * 8;
            const int ra = mi->rowoff[ti[0]] + ti[1], rb = mi->rowoff[ti[2]] + ti[3];
            const float wa = __int_as_float(ti[4]), wb = __int_as_float(ti[5]);
#pragma unroll
            for (int j = 0; j < 4; ++j) {
                const int d = j * 256 + lane * 4;
                const uint2 ya = *(const uint2*)(yb + (size_t)ra * ND + d), ybv = *(const uint2*)(yb + (size_t)rb * ND + d);
                f32x4 xv = *(const f32x4*)(p.out + (size_t)tok * ND + d);
                xv[0] += sG[d] * (wa * __uint_as_float(ya.x << 16) + wb * __uint_as_float(ybv.x << 16));
                xv[1] += sG[d + 1] * (wa * __uint_as_float(ya.x & 0xffff0000u) + wb * __uint_as_float(ybv.x & 0xffff0000u));
                xv[2] += sG[d + 2] * (wa * __uint_as_float(ya.y << 16) + wb * __uint_as_float(ybv.y << 16));
                xv[3] += sG[d + 3] * (wa * __uint_as_float(ya.y & 0xffff0000u) + wb * __uint_as_float(ybv.y & 0xffff0000u));
                *(f32x4*)(p.out + (size_t)tok * ND + d) = xv;
            }
        }
    }
}

namespace cg = cooperative_groups;
extern __shared__ __attribute__((aligned(16))) char dyn_smem[];
constexpr int cmax(int a, int b) { return a > b ? a : b; }
constexpr int L_G1 = GemmLds<256, 128>::BYTES + 512;
constexpr int L_MOE = GemmLds<MOE_BM, MOE_BN>::BYTES + (int)sizeof(MoeIdx) + 128 * 4;
constexpr int MEGA_LDS = cmax(cmax(cmax(ROUTE_LDS, PREP_LDS), cmax(cmax(AT_BUF + SCAN_LDS, ATTM_LDS), L_G1)), L_MOE);
typedef const unsigned long long __attribute__((address_space(4)))* kargp_t;
__device__ __forceinline__ void load_params(P& p, kargp_t ka) {
    asm volatile("" : "+s"(ka));
    typedef __attribute__((address_space(1))) char* gptr_t;
    const void** d = (const void**)&p;
#pragma unroll
    for (int i = 0; i < (int)(sizeof(P) / 8); ++i) d[i] = (const void*)(gptr_t)ka[i];
}
#define PHASE(call) do { P p; load_params(p, ka); call; } while (0)
#ifndef PROBE_MODE
#define PROBE_MODE 0
#endif
#ifndef PROBE_K
#define PROBE_K -1
#endif
template <int KMAX>
__device__ __forceinline__ void run_phases(cg::grid_group& grid, kargp_t ka, char* smem) {
    if constexpr (KMAX >= 0) { PHASE(ph_mod_partial(p, smem)); PHASE(ph_convert(p, smem)); grid.sync(); }
    if constexpr (KMAX >= 1) { PHASE(ph_norm1(p, smem)); grid.sync(); }
    if constexpr (KMAX >= 2) { PHASE(ph_gemm1(p, smem)); grid.sync(); }
    if constexpr (KMAX >= 3) { PHASE(ph_post(p, smem)); grid.sync(); }
    if constexpr (KMAX >= 4) { PHASE(ph_dn_prep(p, smem)); grid.sync(); }
    if constexpr (KMAX >= 5) { PHASE(ph_attn_mfma<(KMAX == 5 ? PROBE_MODE : 0)>(p, smem)); grid.sync(); }
    if constexpr (KMAX >= 6) { PHASE(ph_dn_gate(p)); grid.sync(); }
    if constexpr (KMAX >= 7) { PHASE(ph_gemm_out(p, smem)); grid.sync(); }
    if constexpr (KMAX >= 8) { PHASE(ph_route(p, smem)); grid.sync(); }
    if constexpr (KMAX >= 9) { PHASE(ph_moe_up(p, smem)); grid.sync(); }
    if constexpr (KMAX >= 10) { PHASE(ph_moe_down(p, smem)); grid.sync(); }
    if constexpr (KMAX >= 11) { PHASE(ph_combine(p, smem)); }
}
__global__ void __launch_bounds__(NTHREADS) mega(P p_arg) {
    cg::grid_group grid = cg::this_grid();
    char* smem = dyn_smem;
    kargp_t ka = (kargp_t)__builtin_amdgcn_kernarg_segment_ptr();
    if constexpr (PROBE_K >= 0) {
        run_phases<PROBE_K>(grid, ka, smem);
        P p; load_params(p, ka);
        if (blockIdx.x == 0 && threadIdx.x < 256) ((int*)(p.ws + WS_CTL))[threadIdx.x] = 0;
        grid.sync();
    }
    run_phases<99>(grid, ka, smem);
}

extern "C" void kernel_launch(void* const* d_in, const int* in_sizes, int n_in, void* d_out, int out_size, void* d_ws, size_t ws_size, hipStream_t stream) {
    if (n_in != 26 || out_size != NTOK * ND || ws_size < WS_END) { fprintf(stderr, "kernel_launch: unexpected shapes (n_in %d out %d ws %zu need %zu)\n", n_in, out_size, ws_size, (size_t)WS_END); return; }
    static int grid_blocks = 0;
    if (!grid_blocks) {
        int dev = 0, cus = 0, per_cu = 0;
        (void)hipGetDevice(&dev);
        (void)hipDeviceGetAttribute(&cus, hipDeviceAttributeMultiprocessorCount, dev);
        (void)hipFuncSetAttribute((const void*)mega, hipFuncAttributeMaxDynamicSharedMemorySize, MEGA_LDS);
        (void)hipOccupancyMaxActiveBlocksPerMultiprocessor(&per_cu, (const void*)mega, NTHREADS, MEGA_LDS);
        if (per_cu < 1) { fprintf(stderr, "kernel_launch: occupancy query says %d blocks/CU\n", per_cu); per_cu = 1; }
        grid_blocks = cus * per_cu;
    }
    P p{};
    const float** fp = (const float**)&p;
    for (int i = 0; i < 26; ++i) fp[i] = (const float*)d_in[i];
    p.pos = (const int*)d_in[2];
    p.out = (float*)d_out; p.ws = (unsigned char*)d_ws;
    (void)hipMemsetAsync((char*)d_ws + WS_CTL, 0, 4096, stream);
    void* args[] = {&p};
    hipError_t e = hipLaunchCooperativeKernel((const void*)mega, dim3(grid_blocks), dim3(NTHREADS), args, MEGA_LDS, stream);
    if (e != hipSuccess) fprintf(stderr, "cooperative launch failed: %s (grid %d)\n", hipGetErrorString(e), grid_blocks);
}
```

```cpp
#include <hip/hip_runtime.h>
#include <hip/hip_cooperative_groups.h>
#include <cstdio>
#include <cstdint>

typedef unsigned short bf16_t;
typedef short bf16x8 __attribute__((ext_vector_type(8)));
typedef float f32x16 __attribute__((ext_vector_type(16)));
typedef float f32x4 __attribute__((ext_vector_type(4)));

constexpr int NB = 8, NT = 2048, ND = 1024, NTOK = NB * NT;
constexpr int NPROJ = 3072;
constexpr int PC_QATT = 0, PC_KVLAT = 512, PC_QIDX = 640, PC_DNQKV = 896, PC_DNZ = 2432, PC_KIDX = 2944, PC_WIDX = 2976, PC_BETA = 2984, PC_A = 2988;
constexpr int W_IN_SRC = 2992;
constexpr int NE = 32, EFF = 512;
constexpr int KSPLIT = 16;
constexpr int NTHREADS = 512, NWAVES = 8;
constexpr float EPS = 1e-6f;
constexpr float LOG2E = 1.4426950408889634f;

constexpr size_t MiB = 1ull << 20;
constexpr size_t WS_CTL = 0;
constexpr size_t WS_MODF = WS_CTL + 256 * 1024;
constexpr size_t WS_MODP = WS_CTL + 1 * MiB;
constexpr size_t WS_WIN = WS_MODP + 3 * MiB;
constexpr size_t WS_WOUT = WS_WIN + 6 * MiB;
constexpr size_t WS_W13 = WS_WOUT + 2 * MiB;
constexpr size_t WS_W2 = WS_W13 + 64 * MiB;
constexpr size_t WS_PROJ = WS_W2 + 32 * MiB;
constexpr size_t WS_ACT = WS_PROJ;
constexpr size_t WS_YBUF = WS_PROJ + 32 * MiB;
constexpr size_t WS_QN = WS_PROJ + 96 * MiB;
constexpr size_t WS_K = WS_QN + 16 * MiB;
constexpr size_t WS_KI = WS_K + 2 * MiB;
constexpr size_t WS_WI = WS_KI + 1 * MiB;
constexpr size_t WS_DBG = WS_WI + 512 * 1024;
constexpr size_t WS_DQ = WS_DBG + 512 * 1024;
constexpr size_t WS_DK = WS_DQ + 16 * MiB;
constexpr size_t WS_H2 = WS_DQ;
constexpr size_t WS_DKT = WS_DK + 16 * MiB;
constexpr size_t WS_DVT = WS_DKT + 16 * MiB;
constexpr size_t WS_END = WS_DVT + 16 * MiB;
constexpr size_t WS_LIST = WS_K;
constexpr size_t WS_TOKINFO = WS_KI;
constexpr size_t WS_VT = WS_WIN;
constexpr size_t WS_POSMM = WS_WIN + 2 * MiB;
constexpr size_t DO_WN = 0, DO_U = 16 * MiB, DO_DNO = 32 * MiB, DO_PP = 48 * MiB, DO_EG = 56 * MiB, DO_LL = DO_EG + 256 * 1024, DO_GC = DO_LL + 256 * 1024;

struct P {
    const float* x; const float* c; const int* pos; const float* ada_w; const float* ada_b; const float* norm1_g; const float* norm2_g;
    const float* w_in; const float* q_norm_g; const float* k_norm_g; const float* kv_norm_g; const float* w_kv_up; const float* idx_k_norm_g;
    const float* rel_bias; const float* conv_w; const float* a_log; const float* dt_bias; const float* dn_norm_g; const float* w_out;
    const float* rg_w; const float* rg_b; const float* re_w; const float* re_b; const float* w1; const float* w3; const float* w2;
    float* out; unsigned char* ws;
};

__device__ __forceinline__ float bf2f(bf16_t h) { return __uint_as_float(((unsigned)h) << 16); }
__device__ __forceinline__ bf16_t f2bf(float f) { unsigned u = __float_as_uint(f); u += 0x7fffu + ((u >> 16) & 1u); return (bf16_t)(u >> 16); }
__device__ __forceinline__ unsigned pack2(float a, float b) { unsigned r; asm volatile("v_cvt_pk_bf16_f32 %0, %1, %2" : "=v"(r) : "v"(a), "v"(b)); return r; }
template <int CTRL> __device__ __forceinline__ float dpp_f(float v) { return __int_as_float(__builtin_amdgcn_update_dpp(0, __float_as_int(v), CTRL, 0xF, 0xF, false)); }
template <int CTRL> __device__ __forceinline__ int dpp_i(int v) { return __builtin_amdgcn_update_dpp(0, v, CTRL, 0xF, 0xF, false); }
__device__ __forceinline__ float wave_sum(float v) {
    v += dpp_f<0xB1>(v); v += dpp_f<0x4E>(v); v += dpp_f<0x141>(v); v += dpp_f<0x140>(v);
    v += __shfl_xor(v, 16); v += __shfl_xor(v, 32);
    return v;
}
__device__ __forceinline__ float wave_max(float v) {
#pragma unroll
    for (int o = 32; o >= 1; o >>= 1) v = fmaxf(v, __shfl_xor(v, o));
    return v;
}
__device__ __forceinline__ int wave_isum(int v) {
#pragma unroll
    for (int o = 32; o >= 1; o >>= 1) v += __shfl_xor(v, o);
    return v;
}
__device__ __forceinline__ int tid_opaque() { int t = threadIdx.x; asm volatile("" : "+v"(t)); return t; }
__device__ __forceinline__ float silu_f(float x) { return x / (1.f + __expf(-x)); }
__device__ __forceinline__ float sigmoid_f(float x) { return 1.f / (1.f + __expf(-x)); }
__device__ __forceinline__ float mod_val(const P& p, int b, int which, int d) {
    const float* mp = (const float*)(p.ws + WS_MODP);
    const int col = which * ND + d;
    float s = p.ada_b[col];
#pragma unroll
    for (int ks = 0; ks < KSPLIT; ++ks) s += mp[(size_t)(ks * NB + b) * (6 * ND) + col];
    return s;
}

__device__ __forceinline__ void ph_mod_partial(const P& p, char* smem) {
    const int tid = tid_opaque();
    const int lane = tid & 63, wave = tid >> 6;
    float* sc = (float*)smem;
    for (int i = tid; i < NB * ND; i += NTHREADS) sc[i] = silu_f(p.c[i]);
    __syncthreads();
    float* mp = (float*)(p.ws + WS_MODP);
    const int nitem = 96 * KSPLIT;
    for (int it = blockIdx.x * NWAVES + wave; it < nitem; it += gridDim.x * NWAVES) {
        const int cg = it % 96, ks = it / 96;
        const int col = cg * 64 + lane;
        float acc[NB];
#pragma unroll
        for (int b = 0; b < NB; ++b) acc[b] = 0.f;
#pragma unroll 8
        for (int kk = 0; kk < ND / KSPLIT; ++kk) {
            const int k = ks * (ND / KSPLIT) + kk;
            const float w = p.ada_w[(size_t)k * (6 * ND) + col];
#pragma unroll
            for (int b = 0; b < NB; ++b) acc[b] += sc[b * ND + k] * w;
        }
#pragma unroll
        for (int b = 0; b < NB; ++b) mp[(size_t)(ks * NB + b) * (6 * ND) + col] = acc[b];
    }
    __syncthreads();
}

__device__ __forceinline__ int win_src_col(int n) {
    if (n < 896) return n;
    if (n < 2944) return n + 40;
    if (n < 2976) return n - 2944 + 896;
    if (n < 2984) return n - 2976 + 928;
    if (n < 2992) return n;
    return -1;
}
__device__ __forceinline__ void conv_tile_wave(const int lane, float* tile, const float* src0, int nsrc, int mode, int n0, int k0, bf16_t* dst, int K, int sc0) {
    if (mode == 1) {
        const int col = win_src_col(n0 + lane);
#pragma unroll 8
        for (int k = 0; k < 64; ++k) tile[k * 65 + lane] = (col >= 0) ? src0[(size_t)(k0 + k) * nsrc + col] : 0.f;
    } else {
        const int kr = lane >> 4, c4 = lane & 15;
        const float* src = src0; const int col = sc0 + c4 * 4;
        f32x4 v[16];
#pragma unroll
        for (int i = 0; i < 16; ++i) v[i] = *(const f32x4*)(src + (size_t)(k0 + i * 4 + kr) * nsrc + col);
#pragma unroll
        for (int i = 0; i < 16; ++i) { float* t = tile + (i * 4 + kr) * 65 + c4 * 4; t[0] = v[i][0]; t[1] = v[i][1]; t[2] = v[i][2]; t[3] = v[i][3]; }
    }
    __threadfence_block();
    {
        const int kc = lane & 7, nr = lane >> 3;
#pragma unroll
        for (int i = 0; i < 8; ++i) {
            const int n = i * 8 + nr;
            unsigned w[4];
#pragma unroll
            for (int j = 0; j < 4; ++j) w[j] = pack2(tile[(kc * 8 + 2 * j) * 65 + n], tile[(kc * 8 + 2 * j + 1) * 65 + n]);
            *(uint4*)(dst + (size_t)(n0 + n) * K + k0 + kc * 8) = make_uint4(w[0], w[1], w[2], w[3]);
        }
    }
    __threadfence_block();
}
__device__ __forceinline__ void ph_convert(const P& p, char* smem) {
    const int tid = tid_opaque();
    const int lane = tid & 63, wave = tid >> 6;
    float* tile = (float*)smem + wave * (64 * 65);
    bf16_t* Wt_in = (bf16_t*)(p.ws + WS_WIN); bf16_t* Wt_out = (bf16_t*)(p.ws + WS_WOUT);
    bf16_t* Wt13 = (bf16_t*)(p.ws + WS_W13); bf16_t* Wt2 = (bf16_t*)(p.ws + WS_W2);
    const int T0 = 48 * 16, T1 = 16 * 16, T2 = NE * 256, T3 = NE * 128;
    const int total = T0 + T1 + T2 + T3;
    for (int t = blockIdx.x * NWAVES + wave; t < total; t += gridDim.x * NWAVES) {
        if (t < T0) { const int nt = t / 16, kt = t % 16; conv_tile_wave(lane, tile, p.w_in, W_IN_SRC, 1, nt * 64, kt * 64, Wt_in, ND, 0); }
        else if (t < T0 + T1) { const int u = t - T0; const int nt = u / 16, kt = u % 16; conv_tile_wave(lane, tile, p.w_out, ND, 0, nt * 64, kt * 64, Wt_out, ND, nt * 64); }
        else if (t < T0 + T1 + T2) { const int u = t - T0 - T1; const int e = u / 256, v = u % 256; const int nt = v / 16, kt = v % 16;
            const int pn = nt >> 2, within = nt & 3;
            const float* srcw = ((within >= 2) ? p.w3 : p.w1) + (size_t)e * ND * EFF;
            conv_tile_wave(lane, tile, srcw, EFF, 0, nt * 64, kt * 64, Wt13 + (size_t)e * 1024 * ND, ND, pn * 128 + (within & 1) * 64); }
        else { const int u = t - T0 - T1 - T2; const int e = u / 128, v = u % 128; const int nt = v / 8, kt = v % 8;
            conv_tile_wave(lane, tile, p.w2 + (size_t)e * EFF * ND, ND, 0, nt * 64, kt * 64, Wt2 + (size_t)e * ND * EFF, EFF, nt * 64); }
    }
}

__device__ __forceinline__ void ph_norm1(const P& p, char* smem) {
    const int tid = tid_opaque();
    float* sA = (float*)smem; float* sB = sA + ND;
    const int lane = tid & 63, wave = tid >> 6;
    bf16_t* h = (bf16_t*)p.out;
    {
        float* mf = (float*)(p.ws + WS_MODF);
        for (int i = blockIdx.x * NTHREADS + tid; i < NB * 6 * ND; i += gridDim.x * NTHREADS) mf[i] = mod_val(p, i / (6 * ND), (i % (6 * ND)) / ND, i % ND);
    }
    int curb = -1;
    for (int tile = blockIdx.x; tile < NTOK / 64; tile += gridDim.x) {
        const int b = tile / (NT / 64);
        if (b != curb) {
            __syncthreads();
            for (int d = tid; d < ND; d += NTHREADS) { sA[d] = p.norm1_g[d] * (1.f + mod_val(p, b, 1, d)); sB[d] = mod_val(p, b, 0, d); }
            __syncthreads();
            curb = b;
        }
        for (int i = 0; i < 8; ++i) {
            const int tok = tile * 64 + wave * 8 + i;
            const float* xr = p.x + (size_t)tok * ND;
            f32x4 v[4]; float ss = 0.f;
#pragma unroll
            for (int j = 0; j < 4; ++j) { v[j] = *(const f32x4*)(xr + j * 256 + lane * 4); ss += v[j][0] * v[j][0] + v[j][1] * v[j][1] + v[j][2] * v[j][2] + v[j][3] * v[j][3]; }
            ss = wave_sum(ss);
            const float rstd = rsqrtf(ss * (1.f / ND) + EPS);
#pragma unroll
            for (int j = 0; j < 4; ++j) {
                const int d = j * 256 + lane * 4;
                const float o0 = v[j][0] * rstd * sA[d] + sB[d], o1 = v[j][1] * rstd * sA[d + 1] + sB[d + 1], o2 = v[j][2] * rstd * sA[d + 2] + sB[d + 2], o3 = v[j][3] * rstd * sA[d + 3] + sB[d + 3];
                *(uint2*)(h + (size_t)tok * ND + d) = make_uint2(pack2(o0, o1), pack2(o2, o3));
            }
        }
    }
}

namespace pg8 {
#define PG8_LAS __attribute__((address_space(3)))
typedef unsigned u32x4 __attribute__((ext_vector_type(4)));
constexpr int BM = 256, BK = 64, HALF = 128, HTB = HALF * BK * 2  , STAGE_BYTES = 8 * HTB;
__device__ __forceinline__ int lds_byte(int r, int c) { const int st = (r >> 4) * 2 + (c >> 5), rr = r & 15, cc = c & 31, ob = rr * 64 + cc * 2; return st * 1024 + (ob ^ (((ob >> 9) & 1) << 5)); }
__device__ __forceinline__ void stage_rc(int b, int& R, int& C) { const int st = b / 1024, sb = b % 1024, swz = sb ^ (((sb >> 9) & 1) << 5); R = (st >> 1) * 16 + swz / 64; C = (st & 1) * 32 + (swz % 64) / 2; }
__device__ __forceinline__ int perm32(int rho) { const int n = rho >> 4, i = rho & 15; return 8 * (i >> 2) + 4 * n + (i & 3); }
struct AO { unsigned h0p0, h0p1, h1p0, h1p1; };
template <class Src, class Epi>
__device__ __forceinline__ void gemm_phase(const int tid, PG8_LAS unsigned char* lds, const int K, const Src& S, const Epi& E) {
    const int wid = __builtin_amdgcn_readfirstlane(tid >> 6), lane = tid & 63, wr = wid >> 2, wc = wid & 3, fr = lane & 15, fq = lane >> 4;
    const int nt = K / BK;
    int R0, C0, R1, C1; stage_rc(tid * 16, R0, C0); stage_rc(tid * 16 + 8192, R1, C1);
    unsigned voffB[2];
    { const int Rb0 = Epi::PERM ? ((R0 & ~31) + perm32(R0 & 31)) : R0, Rb1 = Epi::PERM ? ((R1 & ~31) + perm32(R1 & 31)) : R1;
      voffB[0] = (unsigned)(Rb0 * K + C0) * 2u; voffB[1] = (unsigned)(Rb1 * K + C1) * 2u; }
    const size_t kstep = (size_t)(BK * 2);
    const size_t hstepB = (size_t)HALF * K * 2;
    const unsigned ldsw = (unsigned)wid * 1024u;
    const int aoff = lds_byte(wr * 64 + fr, fq * 8), boff = lds_byte(wc * 32 + fr, fq * 8);
#define PG8_SA(b, h) (((b) * 2 + (h)) * HTB)
#define PG8_SB(b, h) ((4 + (b) * 2 + (h)) * HTB)
#define PG8_STAGE2(bufoff, gbase, o0, o1) do { \
        __builtin_amdgcn_global_load_lds((const unsigned*)((const char*)(gbase) + (o0)), (PG8_LAS unsigned*)(lds + (bufoff) + ldsw), 16, 0, 0); \
        __builtin_amdgcn_global_load_lds((const unsigned*)((const char*)(gbase) + (o1)), (PG8_LAS unsigned*)(lds + (bufoff) + ldsw + 8192), 16, 0, 0); } while (0)
#define PG8_STAGEB(bufoff, gbase) PG8_STAGE2(bufoff, gbase, voffB[0], voffB[1])
#define PG8_STAGEA0(bufoff, gbase, AOV) PG8_STAGE2(bufoff, gbase, AOV.h0p0, AOV.h0p1)
#define PG8_STAGEA1(bufoff, gbase, AOV) PG8_STAGE2(bufoff, gbase, AOV.h1p0, AOV.h1p1)
#define PG8_LDA(dst, b, h) do { _Pragma("unroll") for (int m = 0; m < 4; ++m) _Pragma("unroll") for (int k = 0; k < 2; ++k) dst[m][k] = *(const PG8_LAS bf16x8*)(lds + PG8_SA(b, h) + aoff + m * 2048 + k * 1024); } while (0)
#define PG8_LDB(dst, b, h) do { _Pragma("unroll") for (int n = 0; n < 2; ++n) _Pragma("unroll") for (int k = 0; k < 2; ++k) dst[n][k] = *(const PG8_LAS bf16x8*)(lds + PG8_SB(b, h) + boff + n * 2048 + k * 1024); } while (0)
#define PG8_MMA(ai, bj, At, Bt) do { __builtin_amdgcn_s_setprio(1); _Pragma("unroll") for (int m = 0; m < 4; ++m) _Pragma("unroll") for (int n = 0; n < 2; ++n) _Pragma("unroll") for (int k = 0; k < 2; ++k) \
        acc[ai][bj][m][n] = __builtin_amdgcn_mfma_f32_16x16x32_bf16(Bt[n][k], At[m][k], acc[ai][bj][m][n], 0, 0, 0); __builtin_amdgcn_s_setprio(0); } while (0)
#define PG8_WAIT_V(n) asm volatile("s_waitcnt vmcnt(" #n ")" ::: "memory")
#define PG8_WAIT_L(n) asm volatile("s_waitcnt lgkmcnt(" #n ")" ::: "memory")
#define PG8_BAR __builtin_amdgcn_s_barrier()
#define PG8_SCHED __builtin_amdgcn_sched_barrier(0)
    typename Src::Unit cur, nxt; int ui = 0;
    if (!S.next(0, cur)) return;
    f32x4 acc[2][2][4][2];
#pragma unroll
    for (int a = 0; a < 2; ++a)
#pragma unroll
        for (int b = 0; b < 2; ++b)
#pragma unroll
            for (int m = 0; m < 4; ++m)
#pragma unroll
                for (int n = 0; n < 2; ++n) acc[a][b][m][n] = (f32x4){0.f, 0.f, 0.f, 0.f};
    bf16x8 At[4][2], B0[2][2], B1[2][2];
    AO aoC, aoN;
    S.a_off(cur, R0, C0, R1, C1, aoC);
    const char* cB = S.b_base(cur);
    PG8_STAGEB(PG8_SB(0, 0), cB); PG8_STAGEA0(PG8_SA(0, 0), S.a_base(cur, 0), aoC); PG8_STAGEB(PG8_SB(0, 1), cB + hstepB); PG8_STAGEA1(PG8_SA(0, 1), S.a_base(cur, 0), aoC);
    if (wr == 1) PG8_BAR;
    PG8_WAIT_V(4); PG8_BAR;
    PG8_STAGEB(PG8_SB(1, 0), cB + kstep); PG8_STAGEA0(PG8_SA(1, 0), S.a_base(cur, 1), aoC); PG8_STAGEB(PG8_SB(1, 1), cB + hstepB + kstep);
    PG8_WAIT_V(6); PG8_BAR;
    for (;;) {
        const bool has_next = S.next(ui + 1, nxt);
        const char* nB = cB;
        if (has_next) { S.a_off(nxt, R0, C0, R1, C1, aoN); nB = S.b_base(nxt); }
        else aoN = aoC;
        for (int t = 0; t < nt; t += 2) {
            const bool last = (t == nt - 2);
            const char* a1 = S.a_base(cur, t + 1);
            const char* a2 = last ? S.a_base(has_next ? nxt : cur, 0) : S.a_base(cur, t + 2);
            const char* a3 = last ? S.a_base(has_next ? nxt : cur, 1) : S.a_base(cur, t + 3);
            const char* b2 = last ? nB : cB + (size_t)(t + 2) * kstep; const char* b3 = b2 + kstep;
            const AO ao2 = last ? aoN : aoC;
            PG8_LDB(B0, 0, 0); PG8_SCHED; PG8_LDA(At, 0, 0); PG8_STAGEA1(PG8_SA(1, 1), a1, aoC);
            PG8_WAIT_L(8); PG8_BAR; PG8_WAIT_L(0); PG8_MMA(0, 0, At, B0); PG8_BAR; PG8_SCHED;
            PG8_LDB(B1, 0, 1); PG8_STAGEB(PG8_SB(0, 0), b2);
            PG8_BAR; PG8_WAIT_L(0); PG8_MMA(0, 1, At, B1); PG8_BAR;
            PG8_LDA(At, 0, 1); PG8_STAGEA0(PG8_SA(0, 0), a2, ao2);
            PG8_BAR; PG8_WAIT_L(0); PG8_MMA(1, 0, At, B0); PG8_BAR; PG8_SCHED;
            PG8_STAGEB(PG8_SB(0, 1), b2 + hstepB);
            PG8_WAIT_V(6); PG8_BAR; PG8_MMA(1, 1, At, B1); PG8_BAR;
            PG8_LDB(B0, 1, 0); PG8_SCHED; PG8_LDA(At, 1, 0); PG8_STAGEA1(PG8_SA(0, 1), a2, ao2);
            PG8_WAIT_L(8); PG8_BAR; PG8_WAIT_L(0); PG8_MMA(0, 0, At, B0); PG8_BAR; PG8_SCHED;
            PG8_LDB(B1, 1, 1); PG8_STAGEB(PG8_SB(1, 0), b3);
            PG8_BAR; PG8_WAIT_L(0); PG8_MMA(0, 1, At, B1); PG8_BAR;
            PG8_LDA(At, 1, 1); PG8_STAGEA0(PG8_SA(1, 0), a3, ao2);
            PG8_BAR; PG8_WAIT_L(0); PG8_MMA(1, 0, At, B0); PG8_BAR; PG8_SCHED;
            PG8_STAGEB(PG8_SB(1, 1), b3 + hstepB);
            PG8_WAIT_V(6); PG8_BAR; PG8_MMA(1, 1, At, B1); PG8_BAR;
        }
        E(acc, cur, wr, wc, fr, fq);
        if (!has_next) break;
#pragma unroll
        for (int a = 0; a < 2; ++a)
#pragma unroll
            for (int b = 0; b < 2; ++b)
#pragma unroll
                for (int m = 0; m < 4; ++m)
#pragma unroll
                    for (int n = 0; n < 2; ++n) acc[a][b][m][n] = (f32x4){0.f, 0.f, 0.f, 0.f};
        cur = nxt; cB = nB; ++ui; aoC = aoN;
    }
    PG8_WAIT_V(0);
    if (wr == 0) PG8_BAR;
    PG8_BAR;
#undef PG8_SA
#undef PG8_SB
#undef PG8_STAGE2
#undef PG8_STAGEB
#undef PG8_STAGEA0
#undef PG8_STAGEA1
#undef PG8_LDA
#undef PG8_LDB
#undef PG8_MMA
#undef PG8_WAIT_V
#undef PG8_WAIT_L
#undef PG8_BAR
#undef PG8_SCHED
}
struct DenseSrc {
    struct Unit { int pm, pn; };
    const char* A0; const char* A1; const char* Bt; int lda, K, nM, nN, G, c, ksplit;
    __device__ __forceinline__ bool next(int i, Unit& u) const {
        const int nwg = nM * nN; const long L = (long)i * G + c; if (L >= nwg) return false;
        int wgid = (int)L; { const int q = nwg / 8, r = nwg % 8, xcd = wgid % 8, off = wgid / 8; wgid = (xcd < r ? xcd * (q + 1) : r * (q + 1) + (xcd - r) * q) + off; }
        const int nig = 8 * nN, gid = wgid / nig, fm = gid * 8, gsz = (nM - fm) < 8 ? (nM - fm) : 8;
        u.pm = fm + ((wgid % nig) % gsz); u.pn = (wgid % nig) / gsz; return true;
    }
    __device__ __forceinline__ void a_off(const Unit& u, int R0, int C0, int R1, int C1, AO& ao) const {
        ao.h0p0 = (unsigned)(((u.pm * 256 + R0) * lda + C0) * 2); ao.h0p1 = (unsigned)(((u.pm * 256 + R1) * lda + C1) * 2);
        ao.h1p0 = (unsigned)(((u.pm * 256 + 128 + R0) * lda + C0) * 2); ao.h1p1 = (unsigned)(((u.pm * 256 + 128 + R1) * lda + C1) * 2);
    }
    __device__ __forceinline__ const char* a_base(const Unit&, int kt) const { return (kt < ksplit) ? A0 + (size_t)kt * 128 : A1 + (size_t)(kt - ksplit) * 128; }
    __device__ __forceinline__ const char* b_base(const Unit& u) const { return Bt + (size_t)u.pn * 256 * K * 2; }
};
}

struct EpiProj {
    static constexpr bool PERM = true;
    bf16_t* O; int ldc;
    __device__ __forceinline__ void operator()(const f32x4 (&acc)[2][2][4][2], const pg8::DenseSrc::Unit& u, int wr, int wc, int fr, int fq) const {
        const int row0 = u.pm * 256 + wr * 64 + fr, col0 = u.pn * 256 + wc * 32 + 8 * fq;
#pragma unroll
        for (int ai = 0; ai < 2; ++ai)
#pragma unroll
            for (int m = 0; m < 4; ++m) { bf16_t* rowp = O + (size_t)(row0 + ai * 128 + m * 16) * ldc + col0;
#pragma unroll
                for (int bj = 0; bj < 2; ++bj) { const f32x4 v0 = acc[ai][bj][m][0], v1 = acc[ai][bj][m][1];
                    *(uint4*)(rowp + bj * 128) = make_uint4(pack2(v0[0], v0[1]), pack2(v0[2], v0[3]), pack2(v1[0], v1[1]), pack2(v1[2], v1[3])); } }
    }
};
__device__ __forceinline__ void ph_gemm1(const P& p, char* smem) {
    const int tid = tid_opaque();
    pg8::DenseSrc S; S.A0 = (const char*)p.out; S.A1 = S.A0; S.Bt = (const char*)(p.ws + WS_WIN); S.lda = ND; S.K = ND; S.nM = NTOK / 256; S.nN = NPROJ / 256; S.G = gridDim.x; S.c = blockIdx.x; S.ksplit = ND / 64;
    EpiProj E; E.O = (bf16_t*)(p.ws + WS_PROJ); E.ldc = NPROJ;
    pg8::gemm_phase(tid, (PG8_LAS unsigned char*)smem, ND, S, E);
}

__device__ __forceinline__ void ph_post(const P& p, char* smem) {
    const int tid = tid_opaque();
    float* sW = (float*)smem;
    for (int i = tid; i < 128 * 128; i += NTHREADS) sW[i] = p.w_kv_up[i];
    __syncthreads();
    const int lane = tid & 63, wave = tid >> 6;
    const bf16_t* proj = (const bf16_t*)(p.ws + WS_PROJ);
    bf16_t* qn = (bf16_t*)(p.ws + WS_QN); bf16_t* Kb = (bf16_t*)(p.ws + WS_K); bf16_t* kib = (bf16_t*)(p.ws + WS_KI);
    float* wi = (float*)(p.ws + WS_WI); float* dbeta = (float*)(p.ws + WS_DBG); float* dg = dbeta + NTOK * 4;
    bf16_t* dq = (bf16_t*)(p.ws + WS_DQ); bf16_t* dk = (bf16_t*)(p.ws + WS_DK); bf16_t* dkT = (bf16_t*)(p.ws + WS_DKT); bf16_t* dvT = (bf16_t*)(p.ws + WS_DVT);
    bf16_t* Vt = (bf16_t*)(p.ws + WS_VT);
    {
        const int g = blockIdx.x * NTHREADS + tid;
        if (g < NB * 64) { int mn = 0x7fffffff, mx = -0x7fffffff; for (int i = 0; i < 32; ++i) { const int v = p.pos[g * 32 + i]; mn = min(mn, v); mx = max(mx, v); } int* pm = (int*)(p.ws + WS_POSMM); pm[g * 2] = mn; pm[g * 2 + 1] = mx; }
    }
    for (int tg = blockIdx.x * NWAVES + wave; tg < NTOK / 8; tg += gridDim.x * NWAVES) {
      for (int ti = 0; ti < 8; ++ti) {
        const int tok = tg * 8 + ti;
        const int t = tok % NT;
        const bf16_t* pr = proj + (size_t)tok * NPROJ;
        {
            const uint4 raw = *(const uint4*)(pr + PC_QATT + lane * 8);
            const unsigned w[4] = {raw.x, raw.y, raw.z, raw.w};
            float v[8]; float ss = 0.f;
#pragma unroll
            for (int j = 0; j < 4; ++j) { v[2 * j] = __uint_as_float(w[j] << 16); v[2 * j + 1] = __uint_as_float(w[j] & 0xffff0000u); }
#pragma unroll
            for (int j = 0; j < 8; ++j) ss += v[j] * v[j];
            ss += __shfl_xor(ss, 1); ss += __shfl_xor(ss, 2); ss += __shfl_xor(ss, 4);
            const float rs = rsqrtf(ss * (1.f / 64.f) + EPS) * (0.125f * LOG2E);
            const int d0 = (lane & 7) * 8;
            unsigned o[4];
#pragma unroll
            for (int j = 0; j < 4; ++j) o[j] = pack2(v[2 * j] * rs * p.q_norm_g[d0 + 2 * j], v[2 * j + 1] * rs * p.q_norm_g[d0 + 2 * j + 1]);
            *(uint4*)(qn + (size_t)tok * 512 + lane * 8) = make_uint4(o[0], o[1], o[2], o[3]);
        }
        {
            const unsigned raw = *(const unsigned*)(pr + PC_KVLAT + lane * 2);
            float a0 = __uint_as_float(raw << 16), a1 = __uint_as_float(raw & 0xffff0000u);
            float ss = wave_sum(a0 * a0 + a1 * a1);
            const float rs = rsqrtf(ss * (1.f / 128.f) + EPS);
            a0 *= rs * p.kv_norm_g[lane * 2]; a1 *= rs * p.kv_norm_g[lane * 2 + 1];
            float k = 0.f, v = 0.f;
#pragma unroll 8
            for (int i = 0; i < 64; ++i) {
                const float x0 = __shfl(a0, i), x1 = __shfl(a1, i);
                k += x0 * sW[(2 * i) * 128 + lane] + x1 * sW[(2 * i + 1) * 128 + lane];
                v += x0 * sW[(2 * i) * 128 + 64 + lane] + x1 * sW[(2 * i + 1) * 128 + 64 + lane];
            }
            const float ks = wave_sum(k * k);
            k *= rsqrtf(ks * (1.f / 64.f) + EPS) * p.k_norm_g[lane];
            Kb[(size_t)tok * 64 + lane] = f2bf(k);
            Vt[((size_t)(tok / NT) * 64 + lane) * NT + t] = f2bf(v);
        }
        {
            float a = (lane < 32) ? bf2f(pr[PC_KIDX + lane]) : 0.f;
            const float ss = wave_sum(a * a);
            a *= rsqrtf(ss * (1.f / 32.f) + EPS);
            if (lane < 32) kib[(size_t)tok * 32 + lane] = f2bf(a * p.idx_k_norm_g[lane]);
            if (lane < 8) wi[(size_t)tok * 8 + lane] = bf2f(pr[PC_WIDX + lane]) * 0.35355339059327373f * 0.17677669529663687f;
            if (lane < 4) {
                dbeta[(size_t)tok * 4 + lane] = sigmoid_f(bf2f(pr[PC_BETA + lane]));
                const float z = bf2f(pr[PC_A + lane]) + p.dt_bias[lane];
                const float sp = (z > 20.f) ? z : log1pf(__expf(z));
                dg[(size_t)tok * 4 + lane] = -__expf(p.a_log[lane]) * sp;
            }
        }
      }
        {
            const int tok0 = tg * 8, t0 = tok0 % NT, bb = tok0 / NT;
#pragma unroll 1
            for (int j = 0; j < 12; ++j) {
                const int ch = j * 128 + lane * 2;
                float w0[11], w1[11];
#pragma unroll
                for (int i = 0; i < 11; ++i) {
                    unsigned raw = 0u;
                    if (t0 - 3 + i >= 0) raw = *(const unsigned*)(proj + (size_t)(tok0 - 3 + i) * NPROJ + PC_DNQKV + ch);
                    w0[i] = __uint_as_float(raw << 16); w1[i] = __uint_as_float(raw & 0xffff0000u);
                }
                float c0[4], c1[4];
#pragma unroll
                for (int tap = 0; tap < 4; ++tap) { c0[tap] = p.conv_w[tap * 1536 + ch]; c1[tap] = p.conv_w[tap * 1536 + ch + 1]; }
                float y0[8], y1[8];
#pragma unroll
                for (int i = 0; i < 8; ++i) {
                    float a0 = 0.f, a1 = 0.f;
#pragma unroll
                    for (int tap = 0; tap < 4; ++tap) { a0 += c0[tap] * w0[i + tap]; a1 += c1[tap] * w1[i + tap]; }
                    y0[i] = silu_f(a0); y1[i] = silu_f(a1);
                    if (j < 8) {
                        const float ss = wave_sum(y0[i] * y0[i] + y1[i] * y1[i]);
                        float rs = rsqrtf(ss + EPS);
                        if (j < 4) rs *= 0.08838834764831845f;
                        y0[i] *= rs; y1[i] *= rs;
                    }
                }
                if (j < 8) {
                    bf16_t* dst = (j < 4) ? dq : dk;
#pragma unroll
                    for (int i = 0; i < 8; ++i) *(unsigned*)(dst + (size_t)(tok0 + i) * 512 + (j & 3) * 128 + lane * 2) = pack2(y0[i], y1[i]);
                }
                if (j >= 4) {
                    bf16_t* dstT = ((j < 8) ? dkT : dvT) + ((size_t)(bb * 4 + (j & 3)) * 128 + lane * 2) * NT + t0;
                    *(uint4*)dstT = make_uint4(pack2(y0[0], y0[1]), pack2(y0[2], y0[3]), pack2(y0[4], y0[5]), pack2(y0[6], y0[7]));
                    *(uint4*)(dstT + NT) = make_uint4(pack2(y1[0], y1[1]), pack2(y1[2], y1[3]), pack2(y1[4], y1[5]), pack2(y1[6], y1[7]));
                }
            }
        }
    }
}

__device__ __forceinline__ unsigned f2sortable(float f) { const unsigned u = __float_as_uint(f); return (u & 0x80000000u) ? ~u : (u | 0x80000000u); }
__device__ __forceinline__ float sum8_f(float v) { v += dpp_f<0xB1>(v); v += dpp_f<0x4E>(v); v += dpp_f<0x141>(v); return v; }
__device__ __forceinline__ int sum16_i(int v) { v += dpp_i<0xB1>(v); v += dpp_i<0x4E>(v); v += dpp_i<0x141>(v); v += __shfl_xor(v, 32); return v; }
__device__ __forceinline__ int pi32(int r) { return (r & 0x13) | ((r & 4) << 1) | ((r & 8) >> 1); }
__device__ __forceinline__ constexpr int key_of_reg(int r) { return (r & 3) + 4 * ((r >> 2) & 1) + 16 * (r >> 3); }
struct KiFrag { bf16x8 a0, a1; };
__device__ __forceinline__ void idx_scores(f32x16& sc, const KiFrag& f, bf16x8 qi0, bf16x8 qi1, float wl) {
    f32x16 z;
#pragma unroll
    for (int r = 0; r < 16; ++r) z[r] = 0.f;
    z = __builtin_amdgcn_mfma_f32_32x32x16_bf16(f.a0, qi0, z, 0, 0, 0);
    z = __builtin_amdgcn_mfma_f32_32x32x16_bf16(f.a1, qi1, z, 0, 0, 0);
#pragma unroll
    for (int r = 0; r < 16; ++r) sc[r] = sum8_f(fmaxf(z[r], 0.f) * wl);
}
constexpr int AT_SBL = 0, AT_POSMAX = 4352, AT_ITEM = 6400, AT_BUF = 6656;
constexpr int AT_KI_ROW = 80, AT_P1_BUF = 256 * AT_KI_ROW;
constexpr int AT_K = 0, AT_VT = 64 * 144, AT_KI = 2 * 64 * 144, AT_PK = AT_KI + 64 * AT_KI_ROW, AT_P2_BUF = AT_PK + 256;
constexpr int ATTM_LDS = AT_BUF + 2 * (AT_P1_BUF > AT_P2_BUF ? AT_P1_BUF : AT_P2_BUF);
__device__ __forceinline__ KiFrag ki_lds(const char* buf, int row, int hf) {
    KiFrag f; const char* r = buf + row * AT_KI_ROW + 16 * hf;
    f.a0 = *(const bf16x8*)r; f.a1 = *(const bf16x8*)(r + 32); return f;
}
__device__ __forceinline__ void attn_pass1(const P& p, char* smem, int b, int tb, int tid, float& tauf, int& cut) {
    const int lane = tid & 63, wave = tid >> 6;
    const int hf = lane >> 5, cq = (lane & 31) >> 3, ch = lane & 7, prow = pi32(lane & 31);
    const int t0 = tb * 32 + wave * 4, tq = t0 + cq, tok = b * NT + tq;
    const bf16_t* proj = (const bf16_t*)(p.ws + WS_PROJ);
    const bf16_t* ki_b = (const bf16_t*)(p.ws + WS_KI) + (size_t)b * NT * 32;
    const bf16x8 qi0 = *(const bf16x8*)(proj + (size_t)tok * NPROJ + PC_QIDX + ch * 32 + 8 * hf);
    const bf16x8 qi1 = *(const bf16x8*)(proj + (size_t)tok * NPROJ + PC_QIDX + ch * 32 + 16 + 8 * hf);
    const float wl = ((const float*)(p.ws + WS_WI))[(size_t)tok * 8 + ch];
    char* bufs = smem + AT_BUF;
    float keep[8][16];
#pragma unroll
    for (int s = 0; s < 8; ++s)
#pragma unroll
        for (int r = 0; r < 16; ++r) keep[s][r] = -INFINITY;
    {
#pragma unroll
        for (int i = 0; i < 2; ++i) { const int x = tid + 512 * i; *(uint4*)(bufs + (x >> 2) * AT_KI_ROW + (x & 3) * 16) = *(const uint4*)(ki_b + (size_t)(x >> 2) * 32 + (x & 3) * 8); }
    }
    __syncthreads();
#pragma unroll
    for (int g = 0; g < 8; ++g) {
        if (g * 8 <= tb) {
            const bool more = (g + 1) * 8 <= tb;
            uint4 n0 = make_uint4(0, 0, 0, 0), n1 = n0;
            if (more) {
                n0 = *(const uint4*)(ki_b + (size_t)((g + 1) * 256 + (tid >> 2)) * 32 + (tid & 3) * 8);
                n1 = *(const uint4*)(ki_b + (size_t)((g + 1) * 256 + 128 + (tid >> 2)) * 32 + (tid & 3) * 8);
            }
            const char* buf = bufs + (g & 1) * AT_P1_BUF;
#pragma unroll
            for (int kk = 0; kk < 8; ++kk) {
                const int kt = g * 8 + kk;
                if (kt <= tb) {
                    const KiFrag f = ki_lds(buf, kk * 32 + prow, hf);
                    f32x16 sc;
                    idx_scores(sc, f, qi0, qi1, wl);
                    if (kt == tb) {
#pragma unroll
                        for (int r = 0; r < 16; ++r) sc[r] = (kt * 32 + key_of_reg(r) + 8 * hf <= tq) ? sc[r] : -INFINITY;
                    }
                    if (ch == kk) {
#pragma unroll
                        for (int r = 0; r < 16; ++r) keep[g][r] = sc[r];
                    }
                    __builtin_amdgcn_sched_barrier(0);
                }
            }
            if (more) {
                char* nb = bufs + ((g + 1) & 1) * AT_P1_BUF;
                *(uint4*)(nb + (tid >> 2) * AT_KI_ROW + (tid & 3) * 16) = n0;
                *(uint4*)(nb + (128 + (tid >> 2)) * AT_KI_ROW + (tid & 3) * 16) = n1;
            }
            __syncthreads();
        }
    }
    unsigned u[8][16];
#pragma unroll
    for (int s = 0; s < 8; ++s)
#pragma unroll
        for (int r = 0; r < 16; ++r) u[s][r] = f2sortable(keep[s][r]);
    unsigned prefix = 0u;
    for (int bit = 31; bit >= 0; --bit) {
        const unsigned cand = prefix | (1u << bit);
        int cnt = 0;
#pragma unroll
        for (int s = 0; s < 8; ++s) {
            if (s * 8 <= tb) {
#pragma unroll
                for (int r = 0; r < 16; ++r) cnt += (u[s][r] >= cand) ? 1 : 0;
            }
        }
        cnt = sum16_i(cnt);
        if (cnt >= 256) prefix = cand;
    }
    int ngt = 0, neq = 0;
#pragma unroll
    for (int s = 0; s < 8; ++s)
#pragma unroll
        for (int r = 0; r < 16; ++r) { ngt += (u[s][r] > prefix) ? 1 : 0; neq += (u[s][r] == prefix) ? 1 : 0; asm volatile("" : "+v"(ngt), "+v"(neq)); }
    ngt = sum16_i(ngt); neq = sum16_i(neq);
    const int need = 256 - ngt;
    if (__any(need < neq)) {
        int lo = 0, hi = NT - 1;
        for (int it = 0; it < 11; ++it) {
            const int mid = (lo + hi) >> 1;
            int cnt = 0;
            unsigned pf = prefix; asm volatile("" : "+v"(pf));
#pragma unroll
            for (int s = 0; s < 8; ++s)
#pragma unroll
                for (int r = 0; r < 16; ++r) { cnt += (u[s][r] == pf && ((s * 8 + ch) * 32 + key_of_reg(r) + 8 * hf) <= mid) ? 1 : 0; asm volatile("" : "+v"(cnt)); }
            cnt = sum16_i(cnt);
            if (cnt >= need) hi = mid; else lo = mid + 1;
        }
        if (need < neq) cut = lo;
    }
    { const unsigned pu = prefix; tauf = __uint_as_float((pu & 0x80000000u) ? (pu & 0x7fffffffu) : ~pu); }
}
__device__ __forceinline__ void attn_pass2(const P& p, char* smem, int b, int tb, int tid, float tauf, int cut) {
    const int lane = tid & 63, wave = tid >> 6;
    const int hf = lane >> 5, l31 = lane & 31, cq = l31 >> 3, ch = lane & 7, prow = pi32(l31);
    const int t0 = tb * 32 + wave * 4, tq = t0 + cq, tok = b * NT + tq;
    const bf16_t* proj = (const bf16_t*)(p.ws + WS_PROJ);
    bf16_t* qn = (bf16_t*)(p.ws + WS_QN);
    const bf16_t* ki_b = (const bf16_t*)(p.ws + WS_KI) + (size_t)b * NT * 32;
    const bf16_t* K_b = (const bf16_t*)(p.ws + WS_K) + (size_t)b * NT * 64;
    const bf16_t* Vt_b = (const bf16_t*)(p.ws + WS_VT) + (size_t)b * 64 * NT;
    const float* sbl = (const float*)(smem + AT_SBL); const int* posmax = (const int*)(smem + AT_POSMAX) + b * 64;
    char* bufs = smem + AT_BUF;
    const bf16x8 qi0 = *(const bf16x8*)(proj + (size_t)tok * NPROJ + PC_QIDX + ch * 32 + 8 * hf);
    const bf16x8 qi1 = *(const bf16x8*)(proj + (size_t)tok * NPROJ + PC_QIDX + ch * 32 + 16 + 8 * hf);
    const float wl = ((const float*)(p.ws + WS_WI))[(size_t)tok * 8 + ch];
    bf16x8 qb[4];
#pragma unroll
    for (int ks = 0; ks < 4; ++ks) qb[ks] = *(const bf16x8*)(qn + (size_t)tok * 512 + ch * 64 + ks * 16 + 8 * hf);
    const int pq = p.pos[tok];
    int pqmin = pq;
    pqmin = min(pqmin, __shfl_xor(pqmin, 8)); pqmin = min(pqmin, __shfl_xor(pqmin, 16));
    pqmin = __builtin_amdgcn_readfirstlane(pqmin);
    const float bias_far = sbl[128 * 8 + ch];
    const bool anycut = __any(cut != 0x7fffffff);
    f32x16 o0, o1;
#pragma unroll
    for (int r = 0; r < 16; ++r) { o0[r] = 0.f; o1[r] = 0.f; }
    float m = -INFINITY, l = 0.f;
    const int nt64 = (tb + 2) >> 1;
    uint4 rk, rv, rki = make_uint4(0, 0, 0, 0); int rpos = 0;
#define AT_LOAD(j) { rk = *(const uint4*)(K_b + (size_t)((j) * 64 + (tid >> 3)) * 64 + (tid & 7) * 8); \
                     rv = *(const uint4*)(Vt_b + (size_t)(tid >> 3) * NT + (j) * 64 + (tid & 7) * 8); \
                     if (tid < 256) rki = *(const uint4*)(ki_b + (size_t)((j) * 64 + (tid >> 2)) * 32 + (tid & 3) * 8); \
                     else if (tid < 320) rpos = p.pos[b * NT + (j) * 64 + tid - 256]; }
#define AT_STORE(bp) { char* sb_ = (bp); *(uint4*)(sb_ + AT_K + (tid >> 3) * 144 + (tid & 7) * 16) = rk; *(uint4*)(sb_ + AT_VT + (tid >> 3) * 144 + (tid & 7) * 16) = rv; \
                       if (tid < 256) *(uint4*)(sb_ + AT_KI + (tid >> 2) * AT_KI_ROW + (tid & 3) * 16) = rki; else if (tid < 320) ((int*)(sb_ + AT_PK))[tid - 256] = rpos; }
    AT_LOAD(0) AT_STORE(bufs)
    __syncthreads();
#pragma unroll 1
    for (int j = 0; j < nt64; ++j) {
        if (j + 1 < nt64) AT_LOAD(j + 1)
        const char* buf = bufs + (j & 1) * AT_P2_BUF;
#pragma unroll
        for (int sub = 0; sub < 2; ++sub) {
            const int kt = 2 * j + sub;
            if (kt <= tb) {
                const KiFrag kf = ki_lds(buf + AT_KI, sub * 32 + prow, hf);
                f32x16 sc;
                idx_scores(sc, kf, qi0, qi1, wl);
                const bool far = (pqmin - posmax[kt] >= 128);
                f32x16 s;
#pragma unroll
                for (int r = 0; r < 16; ++r) s[r] = far ? bias_far : 0.f;
                {
                    const char* kr = buf + AT_K + (sub * 32 + prow) * 144 + 16 * hf;
#pragma unroll
                    for (int ks = 0; ks < 4; ++ks) s = __builtin_amdgcn_mfma_f32_32x32x16_bf16(*(const bf16x8*)(kr + ks * 32), qb[ks], s, 0, 0, 0);
                }
                const int kbase = kt * 32 + 8 * hf;
                if (!far) {
                    const int* pk = (const int*)(buf + AT_PK) + sub * 32 + 8 * hf;
#pragma unroll
                    for (int r = 0; r < 16; ++r) {
                        int n = pq - pk[key_of_reg(r)];
                        n = n < 0 ? 0 : (n > 128 ? 128 : n);
                        s[r] += sbl[n * 8 + ch];
                    }
                }
                if (anycut) {
#pragma unroll
                    for (int r = 0; r < 16; ++r) { const bool ok = (sc[r] > tauf) || (sc[r] == tauf && (kbase + key_of_reg(r)) <= cut); s[r] = ok ? s[r] : -INFINITY; }
                } else {
#pragma unroll
                    for (int r = 0; r < 16; ++r) s[r] = (sc[r] >= tauf) ? s[r] : -INFINITY;
                }
                if (kt == tb) {
#pragma unroll
                    for (int r = 0; r < 16; ++r) s[r] = (kbase + key_of_reg(r) <= tq) ? s[r] : -INFINITY;
                }
                float mx = s[0];
#pragma unroll
                for (int r = 1; r < 16; ++r) mx = fmaxf(mx, s[r]);
                mx = fmaxf(mx, __shfl_xor(mx, 32));
                const float mnew = fmaxf(m, mx);
                const float msafe = (mnew == -INFINITY) ? 0.f : mnew;
                const float alpha = __builtin_amdgcn_exp2f(m - msafe);
                m = mnew;
                float ps = 0.f;
#pragma unroll
                for (int r = 0; r < 16; ++r) { s[r] = __builtin_amdgcn_exp2f(s[r] - msafe); ps += s[r]; }
                l = l * alpha + ps;
                if (__any(alpha != 1.f)) {
#pragma unroll
                    for (int r = 0; r < 16; ++r) { o0[r] *= alpha; o1[r] *= alpha; }
                }
                union { uint4 u; bf16x8 f; } pb0, pb1;
                pb0.u = make_uint4(pack2(s[0], s[1]), pack2(s[2], s[3]), pack2(s[4], s[5]), pack2(s[6], s[7]));
                pb1.u = make_uint4(pack2(s[8], s[9]), pack2(s[10], s[11]), pack2(s[12], s[13]), pack2(s[14], s[15]));
                const char* vr = buf + AT_VT + l31 * 144 + sub * 64 + 16 * hf;
                o0 = __builtin_amdgcn_mfma_f32_32x32x16_bf16(*(const bf16x8*)vr, pb0.f, o0, 0, 0, 0);
                o0 = __builtin_amdgcn_mfma_f32_32x32x16_bf16(*(const bf16x8*)(vr + 32), pb1.f, o0, 0, 0, 0);
                o1 = __builtin_amdgcn_mfma_f32_32x32x16_bf16(*(const bf16x8*)(vr + 32 * 144), pb0.f, o1, 0, 0, 0);
                o1 = __builtin_amdgcn_mfma_f32_32x32x16_bf16(*(const bf16x8*)(vr + 32 * 144 + 32), pb1.f, o1, 0, 0, 0);
            }
        }
        if (j + 1 < nt64) AT_STORE(bufs + ((j + 1) & 1) * AT_P2_BUF)
        __syncthreads();
    }
#undef AT_LOAD
#undef AT_STORE
    l += __shfl_xor(l, 32);
    const float inv = 1.f / l;
    bf16_t* orow = qn + (size_t)tok * 512 + ch * 64;
#pragma unroll
    for (int gq = 0; gq < 4; ++gq) {
        *(uint2*)(orow + gq * 8 + 4 * hf) = make_uint2(pack2(o0[gq * 4] * inv, o0[gq * 4 + 1] * inv), pack2(o0[gq * 4 + 2] * inv, o0[gq * 4 + 3] * inv));
        *(uint2*)(orow + 32 + gq * 8 + 4 * hf) = make_uint2(pack2(o1[gq * 4] * inv, o1[gq * 4 + 1] * inv), pack2(o1[gq * 4 + 2] * inv, o1[gq * 4 + 3] * inv));
    }
}
__device__ __forceinline__ void dn_scan_block(const P& p, char* smem, int bh, int tid);
template <int MODE>
__device__ __forceinline__ void ph_attn_mfma(const P& p, char* smem) {
    const int tid = tid_opaque();
    float* sbl = (float*)(smem + AT_SBL);
    for (int i = tid; i < 129 * 8; i += NTHREADS) {
        const int n = i >> 3, h = i & 7; int bk;
        if (n < 16) bk = n;
        else { const float v = logf((float)n / 16.f) / 2.0794415416798357f * 16.f; bk = 16 + (int)v; if (bk > 31) bk = 31; }
        sbl[i] = p.rel_bias[bk * 8 + h] * LOG2E;
    }
    ((int*)(smem + AT_POSMAX))[tid] = ((const int*)(p.ws + WS_POSMM))[tid * 2 + 1];
    __syncthreads();
    if (MODE != 2 && blockIdx.x < NB * 4) {
        int tid0 = tid; asm volatile("" : "+v"(tid0));
        dn_scan_block(p, smem + AT_BUF, blockIdx.x, tid0);
        __syncthreads();
    }
    int* qctr = (int*)(p.ws + WS_CTL) + 64;
    if (MODE != 1) for (;;) {
        int tid1 = tid; asm volatile("" : "+v"(tid1));
        if (tid1 == 0) *(int*)(smem + AT_ITEM) = atomicAdd(qctr, 1);
        __syncthreads();
        const int item = *(const int*)(smem + AT_ITEM);
        if (item >= NB * 64) break;
        const int b = item & 7, tb = 63 - (item >> 3);
        float tauf = -INFINITY; int cut = 0x7fffffff;
        if (tb >= 8) attn_pass1(p, smem, b, tb, tid1, tauf, cut);
        int tid2 = tid; asm volatile("" : "+v"(tid2));
        attn_pass2(p, smem, b, tb, tid2, tauf, cut);
    }
}

__device__ __forceinline__ constexpr int sig16(int x) { return (x & ~12) | ((x & 4) << 1) | ((x & 8) >> 1); }
constexpr int PREP_WAVE_LDS = 2 * 64 * 72 * 2 + 4 * 64 * 4;
constexpr int PREP_LDS = NWAVES * PREP_WAVE_LDS;
__device__ __forceinline__ void ph_dn_prep(const P& p, char* smem) {
    const int tid = tid_opaque();
    const int wave = tid >> 6;
    char* wl = smem + wave * PREP_WAVE_LDS;
    float* sA = (float*)wl;
    bf16_t* sTw = (bf16_t*)wl; bf16_t* sTu = sTw + 64 * 72;
    float* sG = (float*)(wl + 2 * 64 * 72 * 2); float* sB = sG + 64; float* sE = sB + 64; float* sL = sE + 64;
    const bf16_t* dq = (const bf16_t*)(p.ws + WS_DQ); const bf16_t* dk = (const bf16_t*)(p.ws + WS_DK);
    const bf16_t* dkT = (const bf16_t*)(p.ws + WS_DKT); const bf16_t* dvT = (const bf16_t*)(p.ws + WS_DVT);
    const float* dbeta = (const float*)(p.ws + WS_DBG); const float* dg = dbeta + NTOK * 4;
    unsigned char* dob = (unsigned char*)p.out;
    bf16_t* PPg = (bf16_t*)(dob + DO_PP); float* GCg = (float*)(dob + DO_GC); float* EGg = (float*)(dob + DO_EG); float* LLg = (float*)(dob + DO_LL);
    for (int item = blockIdx.x * NWAVES + wave; item < NB * 4 * 32; item += gridDim.x * NWAVES) {
        int lane = tid & 63; asm volatile("" : "+v"(lane));
        const int hf = lane >> 5, l31 = lane & 31;
        const int bh = item >> 5, c = item & 31, b = bh >> 2, hh = bh & 3;
        const int tok0 = b * NT + c * 64;
        bf16_t* WN = (bf16_t*)(dob + DO_WN) + (size_t)item * 64 * 128; bf16_t* Ug = (bf16_t*)(dob + DO_U) + (size_t)item * 64 * 128;
        bf16_t* PP = PPg + (size_t)item * 64 * 64;
        float G, beta, eG;
        {
            const float g = dg[(size_t)(tok0 + lane) * 4 + hh];
            beta = dbeta[(size_t)(tok0 + lane) * 4 + hh];
            G = g;
#pragma unroll
            for (int o = 1; o < 64; o <<= 1) { const float n = __shfl_up(G, o); if (lane >= o) G += n; }
            const float Gl = __shfl(G, 63);
            eG = __expf(G);
            sG[lane] = G; sB[lane] = beta; sE[lane] = eG; sL[lane] = __expf(Gl - G);
            EGg[item * 64 + lane] = eG; LLg[item * 64 + lane] = __expf(Gl - G);
            if (lane == 0) GCg[item] = __expf(Gl);
        }
        f32x16 kk00, kk10, kk11, qk00, qk10, qk11;
#pragma unroll
        for (int r = 0; r < 16; ++r) { kk00[r] = 0.f; kk10[r] = 0.f; kk11[r] = 0.f; qk00[r] = 0.f; qk10[r] = 0.f; qk11[r] = 0.f; }
        {
            const bf16_t* kr0 = dk + (size_t)(tok0 + l31) * 512 + hh * 128 + 8 * hf; const bf16_t* kr1 = kr0 + 32 * 512;
            const bf16_t* qr0 = dq + (size_t)(tok0 + l31) * 512 + hh * 128 + 8 * hf; const bf16_t* qr1 = qr0 + 32 * 512;
#pragma unroll
            for (int s = 0; s < 8; ++s) {
                const bf16x8 k0 = *(const bf16x8*)(kr0 + s * 16), k1 = *(const bf16x8*)(kr1 + s * 16), q0 = *(const bf16x8*)(qr0 + s * 16), q1 = *(const bf16x8*)(qr1 + s * 16);
                kk00 = __builtin_amdgcn_mfma_f32_32x32x16_bf16(k0, k0, kk00, 0, 0, 0);
                kk10 = __builtin_amdgcn_mfma_f32_32x32x16_bf16(k1, k0, kk10, 0, 0, 0);
                kk11 = __builtin_amdgcn_mfma_f32_32x32x16_bf16(k1, k1, kk11, 0, 0, 0);
                qk00 = __builtin_amdgcn_mfma_f32_32x32x16_bf16(q0, k0, qk00, 0, 0, 0);
                qk10 = __builtin_amdgcn_mfma_f32_32x32x16_bf16(q1, k0, qk10, 0, 0, 0);
                qk11 = __builtin_amdgcn_mfma_f32_32x32x16_bf16(q1, k1, qk11, 0, 0, 0);
            }
        }
        __threadfence_block();
        {
            const float Gc0 = sG[l31], Gc1 = sG[32 + l31];
            float* sA0 = sA + (4 * hf) * 64 + l31;
            bf16_t* PP0 = PP + (4 * hf) * 64 + sig16(l31);
            const float* sGr = sG + 4 * hf; const float* sBr = sB + 4 * hf;
            const int jrel = l31 - 4 * hf;
#pragma unroll
            for (int r = 0; r < 16; ++r) {
                const int ro = (r & 3) + 8 * (r >> 2);
                const float Gi0 = sGr[ro], Gi1 = sGr[32 + ro], Bi0 = sBr[ro], Bi1 = sBr[32 + ro];
                {
                    const float dec = (jrel <= ro) ? __expf(Gi0 - Gc0) : 0.f;
                    sA0[ro * 64] = (jrel < ro) ? Bi0 * kk00[r] * dec : 0.f;
                    PP0[ro * 64] = f2bf(qk00[r] * dec);
                    PP0[ro * 64 + 32] = 0;
                }
                {
                    const float dec = __expf(Gi1 - Gc0);
                    sA0[(32 + ro) * 64] = Bi1 * kk10[r] * dec;
                    PP0[(32 + ro) * 64] = f2bf(qk10[r] * dec);
                }
                {
                    const float dec = (jrel <= ro) ? __expf(Gi1 - Gc1) : 0.f;
                    sA0[(32 + ro) * 64 + 32] = (jrel < ro) ? Bi1 * kk11[r] * dec : 0.f;
                    PP0[(32 + ro) * 64 + 32] = f2bf(qk11[r] * dec);
                }
            }
        }
        __threadfence_block();
        float x[64];
#pragma unroll
        for (int i = 0; i < 64; ++i) x[i] = (i == lane) ? 1.f : 0.f;
#pragma unroll
        for (int i = 1; i < 64; ++i) {
            float acc = x[i];
#pragma unroll
            for (int m4 = 0; m4 < i; m4 += 4) {
                const f32x4 a = *(const f32x4*)(sA + i * 64 + m4);
                acc -= a[0] * x[m4];
                if (m4 + 1 < i) acc -= a[1] * x[m4 + 1];
                if (m4 + 2 < i) acc -= a[2] * x[m4 + 2];
                if (m4 + 3 < i) acc -= a[3] * x[m4 + 3];
            }
            x[i] = acc;
            __builtin_amdgcn_sched_barrier(0);
        }
        __threadfence_block();
        {
            const float sw = beta * eG;
#pragma unroll
            for (int i = 0; i < 64; ++i) { sTw[i * 72 + lane] = f2bf(x[i] * sw); sTu[i * 72 + lane] = f2bf(x[i] * beta); }
        }
        __threadfence_block();
        {
            bf16x8 tw[2][4], tu[2][4];
#pragma unroll
            for (int mt = 0; mt < 2; ++mt)
#pragma unroll
                for (int s = 0; s < 4; ++s) { tw[mt][s] = *(const bf16x8*)(sTw + (mt * 32 + l31) * 72 + s * 16 + 8 * hf); tu[mt][s] = *(const bf16x8*)(sTu + (mt * 32 + l31) * 72 + s * 16 + 8 * hf); }
            const bf16_t* kTb = dkT + ((size_t)bh * 128 + l31) * NT + c * 64 + 8 * hf;
            const bf16_t* vTb = dvT + ((size_t)bh * 128 + l31) * NT + c * 64 + 8 * hf;
#pragma unroll 1
            for (int nt = 0; nt < 4; ++nt) {
                f32x16 w0, w1, u0, u1;
#pragma unroll
                for (int r = 0; r < 16; ++r) { w0[r] = 0.f; w1[r] = 0.f; u0[r] = 0.f; u1[r] = 0.f; }
#pragma unroll
                for (int s = 0; s < 4; ++s) {
                    const bf16x8 kb = *(const bf16x8*)(kTb + (size_t)nt * 32 * NT + s * 16), vb = *(const bf16x8*)(vTb + (size_t)nt * 32 * NT + s * 16);
                    w0 = __builtin_amdgcn_mfma_f32_32x32x16_bf16(tw[0][s], kb, w0, 0, 0, 0);
                    w1 = __builtin_amdgcn_mfma_f32_32x32x16_bf16(tw[1][s], kb, w1, 0, 0, 0);
                    u0 = __builtin_amdgcn_mfma_f32_32x32x16_bf16(tu[0][s], vb, u0, 0, 0, 0);
                    u1 = __builtin_amdgcn_mfma_f32_32x32x16_bf16(tu[1][s], vb, u1, 0, 0, 0);
                }
                bf16_t* WN0 = WN + (4 * hf) * 128 + nt * 32 + sig16(l31); bf16_t* U0 = Ug + (4 * hf) * 128 + nt * 32 + l31;
#pragma unroll
                for (int r = 0; r < 16; ++r) {
                    const int ro = (r & 3) + 8 * (r >> 2);
                    WN0[ro * 128] = f2bf(-w0[r]); WN0[(32 + ro) * 128] = f2bf(-w1[r]);
                    U0[ro * 128] = f2bf(u0[r]); U0[(32 + ro) * 128] = f2bf(u1[r]);
                }
            }
        }
        __threadfence_block();
    }
}

__device__ __forceinline__ bf16x8 pack_frag(const f32x16& t, int s) {
    bf16x8 f;
#pragma unroll
    for (int j = 0; j < 8; ++j) f[j] = (short)f2bf(t[8 * s + j]);
    return f;
}
__device__ __forceinline__ bf16x8 pack_frag_scaled(const f32x16& t, int s, const f32x4& sc0, const f32x4& sc1) {
    bf16x8 f;
#pragma unroll
    for (int j = 0; j < 4; ++j) { f[j] = (short)f2bf(t[8 * s + j] * sc0[j]); f[4 + j] = (short)f2bf(t[8 * s + 4 + j] * sc1[j]); }
    return f;
}
__device__ __forceinline__ bf16x8 load_perm_frag(const bf16_t* ptr) {
    const uint2 lo = *(const uint2*)ptr, hi = *(const uint2*)(ptr + 8);
    union { uint4 u; bf16x8 f; } cv; cv.u = make_uint4(lo.x, lo.y, hi.x, hi.y); return cv.f;
}
constexpr int SC_WN = 0, SC_Q = 16384, SC_KT = 32768, SC_PP = SC_KT + 128 * 144, SC_U = SC_PP + 64 * 144, SC_EG = SC_U + 16384, SC_LL = SC_EG + 256, SC_GC = SC_LL + 256, SC_BYTES = SC_GC + 16;
constexpr int SCAN_LDS = 2 * SC_BYTES;
#define SCAN_DECL uint4 wn0, wn1, wn2, wn3, q0, q1, q2, q3, kt0, kt1, kt2, kt3, pp0, pp1, u0, u1, u2, u3; float egv = 0.f, gcv = 0.f;
#define SCAN_LD4(i, WNR, UR, QR, KTR) { const int x = hl + 256 * (i); WNR = WNp[x]; UR = Up[x]; \
        QR = *(const uint4*)(dqb + (size_t)(x >> 4) * 512 + (x & 15) * 8); \
        KTR = *(const uint4*)(ktb + (size_t)(x >> 3) * NT + (x & 7) * 8); }
#define SCAN_LOAD(c) { const int ci = bh * 32 + (c); \
        const uint4* WNp = (const uint4*)(dob + DO_WN + (size_t)ci * 16384); const uint4* Up = (const uint4*)(dob + DO_U + (size_t)ci * 16384); const uint4* PPp = (const uint4*)(dob + DO_PP + (size_t)ci * 8192); \
        const bf16_t* dqb = dqh + (size_t)(c) * 64 * 512; const bf16_t* ktb = dkTh + (c) * 64; \
        SCAN_LD4(0, wn0, u0, q0, kt0) SCAN_LD4(1, wn1, u1, q1, kt1) SCAN_LD4(2, wn2, u2, q2, kt2) SCAN_LD4(3, wn3, u3, q3, kt3) \
        pp0 = PPp[hl]; pp1 = PPp[hl + 256]; \
        if (hl < 64) egv = ((const float*)(dob + DO_EG))[ci * 64 + hl]; else if (hl < 128) egv = ((const float*)(dob + DO_LL))[ci * 64 + hl - 64]; \
        if (hl == 128) gcv = ((const float*)(dob + DO_GC))[ci]; }
#define SCAN_ST4(i, WNR, UR, QR, KTR) { const int x = hl + 256 * (i); \
        { const int r = x >> 4, cc = x & 15; *(uint4*)(sbuf + SC_WN + r * 256 + ((cc ^ (r & 15)) << 4)) = WNR; } \
        *(uint4*)(sbuf + SC_U + x * 16) = UR; \
        { const int r = x >> 4, cc = x & 15, a = cc >> 1, g = cc & 1; char* row = sbuf + SC_Q + r * 256; \
          *(uint2*)(row + (((2 * a) ^ (r & 15)) << 4) + g * 8) = make_uint2(QR.x, QR.y); \
          *(uint2*)(row + (((2 * a + 1) ^ (r & 15)) << 4) + g * 8) = make_uint2(QR.z, QR.w); } \
        { const int d = x >> 3, cc = x & 7, a = cc >> 1, g = cc & 1; char* row = sbuf + SC_KT + d * 144; \
          *(uint2*)(row + (2 * a) * 16 + g * 8) = make_uint2(KTR.x, KTR.y); \
          *(uint2*)(row + (2 * a + 1) * 16 + g * 8) = make_uint2(KTR.z, KTR.w); } }
#define SCAN_STORE(bufptr) { char* sbuf = (bufptr); \
        SCAN_ST4(0, wn0, u0, q0, kt0) SCAN_ST4(1, wn1, u1, q1, kt1) SCAN_ST4(2, wn2, u2, q2, kt2) SCAN_ST4(3, wn3, u3, q3, kt3) \
        *(uint4*)(sbuf + SC_PP + (hl >> 3) * 144 + (hl & 7) * 16) = pp0; \
        *(uint4*)(sbuf + SC_PP + ((hl + 256) >> 3) * 144 + (hl & 7) * 16) = pp1; \
        if (hl < 128) ((float*)(sbuf + SC_EG))[hl] = egv; \
        if (hl == 128) *(float*)(sbuf + SC_GC) = gcv; }
__device__ __forceinline__ void dn_scan_block(const P& p, char* smem, int bh, int tid) {
    const int wave = tid >> 6, lane = tid & 63;
    const int hf = lane >> 5, l31 = lane & 31;
    const int b = bh >> 2, hh = bh & 3;
    const bool helper = wave >= 4;
    const int hl = tid - 256, sl = wave;
    bf16_t* dno = (bf16_t*)((unsigned char*)p.out + DO_DNO);
    if (helper) {
        const unsigned char* dob = (const unsigned char*)p.out;
        const bf16_t* dqh = (const bf16_t*)(p.ws + WS_DQ) + (size_t)b * NT * 512 + hh * 128; const bf16_t* dkTh = (const bf16_t*)(p.ws + WS_DKT) + (size_t)bh * 128 * NT;
        SCAN_DECL
        SCAN_LOAD(0) SCAN_STORE(smem) SCAN_LOAD(1)
        __syncthreads();
#pragma unroll 1
        for (int c = 0; c < NT / 64; ++c) {
            if (c + 1 < NT / 64) SCAN_STORE(smem + ((c + 1) & 1) * SC_BYTES)
            if (c + 2 < NT / 64) SCAN_LOAD(c + 2)
            __syncthreads();
        }
        return;
    }
    f32x16 S[4];
#pragma unroll
    for (int T = 0; T < 4; ++T)
#pragma unroll
        for (int r = 0; r < 16; ++r) S[T][r] = 0.f;
    __syncthreads();
#pragma unroll 1
    for (int c = 0; c < NT / 64; ++c) {
        char* buf = smem + (c & 1) * SC_BYTES;
        {
            const int tok0 = b * NT + c * 64;
            const int sw = l31 & 15;
            const char* wnr = buf + SC_WN + l31 * 256; const char* qr = buf + SC_Q + l31 * 256;
            const char* ktr = buf + SC_KT + l31 * 144 + 16 * hf; const char* ppr = buf + SC_PP + l31 * 144 + 16 * hf;
            const bf16_t* ur = (const bf16_t*)(buf + SC_U) + sl * 32 + l31;
            const float* egs = (const float*)(buf + SC_EG); const float* lls = (const float*)(buf + SC_LL);
            const float gc = *(const float*)(buf + SC_GC);
            bf16x8 SB[4][2];
#pragma unroll
            for (int T = 0; T < 4; ++T) { SB[T][0] = pack_frag(S[T], 0); SB[T][1] = pack_frag(S[T], 1); }
            f32x16 D[2], O[2];
#pragma unroll
            for (int mt = 0; mt < 2; ++mt)
#pragma unroll
                for (int r = 0; r < 16; ++r) { D[mt][r] = bf2f(ur[(mt * 32 + (r & 3) + 8 * (r >> 2) + 4 * hf) * 128]); O[mt][r] = 0.f; }
#pragma unroll
            for (int mt = 0; mt < 2; ++mt)
#pragma unroll
                for (int T = 0; T < 4; ++T)
#pragma unroll
                    for (int s = 0; s < 2; ++s) {
                        const int co = (((2 * (2 * T + s) + hf) ^ sw) << 4) + mt * 32 * 256;
                        const bf16x8 wa = *(const bf16x8*)(wnr + co);
                        const bf16x8 qa = *(const bf16x8*)(qr + co);
                        D[mt] = __builtin_amdgcn_mfma_f32_32x32x16_bf16(wa, SB[T][s], D[mt], 0, 0, 0);
                        O[mt] = __builtin_amdgcn_mfma_f32_32x32x16_bf16(qa, SB[T][s], O[mt], 0, 0, 0);
                    }
            __builtin_amdgcn_sched_barrier(0);
            bf16x8 DB[2][2], DL[2][2];
#pragma unroll
            for (int mt = 0; mt < 2; ++mt) {
#pragma unroll
                for (int g4 = 0; g4 < 4; ++g4) {
                    const f32x4 eg = *(const f32x4*)(egs + mt * 32 + g4 * 8 + 4 * hf);
#pragma unroll
                    for (int j = 0; j < 4; ++j) O[mt][g4 * 4 + j] *= eg[j];
                }
                const f32x4 l0 = *(const f32x4*)(lls + mt * 32 + 0 + 4 * hf), l1 = *(const f32x4*)(lls + mt * 32 + 8 + 4 * hf);
                const f32x4 l2 = *(const f32x4*)(lls + mt * 32 + 16 + 4 * hf), l3 = *(const f32x4*)(lls + mt * 32 + 24 + 4 * hf);
                DB[mt][0] = pack_frag(D[mt], 0); DB[mt][1] = pack_frag(D[mt], 1);
                DL[mt][0] = pack_frag_scaled(D[mt], 0, l0, l1); DL[mt][1] = pack_frag_scaled(D[mt], 1, l2, l3);
            }
#pragma unroll
            for (int mt = 0; mt < 2; ++mt)
#pragma unroll
                for (int ks = 0; ks < 4; ++ks) {
                    const bf16x8 pa = *(const bf16x8*)(ppr + mt * 32 * 144 + ks * 32);
                    O[mt] = __builtin_amdgcn_mfma_f32_32x32x16_bf16(pa, DB[ks >> 1][ks & 1], O[mt], 0, 0, 0);
                }
            __builtin_amdgcn_sched_barrier(0);
            {
                bf16_t* orow = dno + (size_t)tok0 * 512 + hh * 128 + sl * 32 + l31;
#pragma unroll
                for (int mt = 0; mt < 2; ++mt)
#pragma unroll
                    for (int r = 0; r < 16; ++r) orow[(size_t)(mt * 32 + (r & 3) + 8 * (r >> 2) + 4 * hf) * 512] = f2bf(O[mt][r]);
            }
#pragma unroll
            for (int T = 0; T < 4; ++T) {
#pragma unroll
                for (int r = 0; r < 16; ++r) S[T][r] *= gc;
#pragma unroll
                for (int ks = 0; ks < 4; ++ks) {
                    const bf16x8 ka = *(const bf16x8*)(ktr + T * 32 * 144 + ks * 32);
                    S[T] = __builtin_amdgcn_mfma_f32_32x32x16_bf16(ka, DL[ks >> 1][ks & 1], S[T], 0, 0, 0);
                }
            }
        }
        __syncthreads();
    }
}

__device__ __forceinline__ void ph_dn_gate(const P& p) {
    const int tid = tid_opaque();
    const int lane = tid & 63, wave = tid >> 6;
    const bf16_t* dno = (const bf16_t*)((const unsigned char*)p.out + DO_DNO); const bf16_t* proj = (const bf16_t*)(p.ws + WS_PROJ); bf16_t* dnn = (bf16_t*)(p.ws + WS_DK);
    for (int tok = blockIdx.x * NWAVES + wave; tok < NTOK; tok += gridDim.x * NWAVES) {
#pragma unroll
        for (int hh = 0; hh < 4; ++hh) {
            const unsigned orw = *(const unsigned*)(dno + (size_t)tok * 512 + hh * 128 + lane * 2);
            const float o0 = __uint_as_float(orw << 16), o1 = __uint_as_float(orw & 0xffff0000u);
            const float ss = wave_sum(o0 * o0 + o1 * o1);
            const float rs = rsqrtf(ss * (1.f / 128.f) + EPS);
            const unsigned zr = *(const unsigned*)(proj + (size_t)tok * NPROJ + PC_DNZ + hh * 128 + lane * 2);
            const float z0 = __uint_as_float(zr << 16), z1 = __uint_as_float(zr & 0xffff0000u);
            *(unsigned*)(dnn + (size_t)tok * 512 + hh * 128 + lane * 2) = pack2(o0 * rs * p.dn_norm_g[lane * 2] * silu_f(z0), o1 * rs * p.dn_norm_g[lane * 2 + 1] * silu_f(z1));
        }
    }
}

struct EpiOut {
    static constexpr bool PERM = false;
    const float* x; float* out; const float* modf;
    __device__ __forceinline__ void operator()(const f32x4 (&acc)[2][2][4][2], const pg8::DenseSrc::Unit& u, int wr, int wc, int fr, int fq) const {
        const int row0 = u.pm * 256 + wr * 64 + fr, col0 = u.pn * 256 + wc * 32 + 4 * fq;
        const float* gate = modf + (size_t)((u.pm * 256) / NT) * (6 * ND) + 2 * ND;
        f32x4 gv[2][2];
#pragma unroll
        for (int bj = 0; bj < 2; ++bj)
#pragma unroll
            for (int n = 0; n < 2; ++n) gv[bj][n] = *(const f32x4*)(gate + col0 + bj * 128 + n * 16);
#pragma unroll
        for (int ai = 0; ai < 2; ++ai)
#pragma unroll
            for (int m = 0; m < 4; ++m) { const size_t ro = (size_t)(row0 + ai * 128 + m * 16) * ND + col0;
#pragma unroll
                for (int bj = 0; bj < 2; ++bj)
#pragma unroll
                    for (int n = 0; n < 2; ++n) { const f32x4 xv = *(const f32x4*)(x + ro + bj * 128 + n * 16); *(f32x4*)(out + ro + bj * 128 + n * 16) = xv + gv[bj][n] * acc[ai][bj][m][n]; } }
    }
};
__device__ __forceinline__ void ph_gemm_out(const P& p, char* smem) {
    const int tid = tid_opaque();
    pg8::DenseSrc S; S.A0 = (const char*)(p.ws + WS_QN); S.A1 = (const char*)(p.ws + WS_DK); S.Bt = (const char*)(p.ws + WS_WOUT); S.lda = 512; S.K = ND; S.nM = NTOK / 256; S.nN = ND / 256; S.G = gridDim.x; S.c = blockIdx.x; S.ksplit = 8;
    EpiOut E; E.x = p.x; E.out = p.out; E.modf = (const float*)(p.ws + WS_MODF);
    pg8::gemm_phase(tid, (PG8_LAS unsigned char*)smem, ND, S, E);
}

constexpr int ROUTE_LDS = 1024 * 37 * 4 + 2 * 1024 * 4 + 2048;
__device__ __forceinline__ void ph_route(const P& p, char* smem) {
    const int tid = tid_opaque();
    float* sW = (float*)smem;
    float* sA = sW + 1024 * 37; float* sB = sA + 1024;
    int* s_cnt = (int*)(sB + 1024);
    int* s_base = s_cnt + 32; int* s_tok = s_base + 32;
    const int lane = tid & 63, wave = tid >> 6;
    for (int i = tid; i < 4 * 1024; i += NTHREADS) sW[(i >> 2) * 37 + (i & 3)] = p.rg_w[i];
    for (int i = tid; i < 32 * 1024; i += NTHREADS) sW[(i >> 5) * 37 + 4 + (i & 31)] = p.re_w[i];
    bf16_t* h2 = (bf16_t*)(p.ws + WS_H2);
    int* cnt = (int*)(p.ws + WS_CTL); int* list = (int*)(p.ws + WS_LIST); int* tokinfo = (int*)(p.ws + WS_TOKINFO);
    int curb = -1;
    for (int tile = blockIdx.x; tile < NTOK / 64; tile += gridDim.x) {
        const int b = tile / (NT / 64);
        __syncthreads();
        if (b != curb) {
            for (int d = tid; d < ND; d += NTHREADS) { sA[d] = p.norm2_g[d] * (1.f + mod_val(p, b, 4, d)); sB[d] = mod_val(p, b, 3, d); }
            curb = b;
        }
        if (tid < 32) s_cnt[tid] = 0;
        __syncthreads();
        for (int i2 = 0; i2 < 4; ++i2) {
            const int tokA = tile * 64 + wave * 8 + i2 * 2, tokB = tokA + 1;
            const float* xa = p.out + (size_t)tokA * ND; const float* xb = xa + ND;
            float va[16], vb[16]; float sa = 0.f, sb = 0.f;
#pragma unroll
            for (int j = 0; j < 16; ++j) { va[j] = xa[j * 64 + lane]; vb[j] = xb[j * 64 + lane]; sa += va[j] * va[j]; sb += vb[j] * vb[j]; }
            sa = wave_sum(sa); sb = wave_sum(sb);
            const float ra = rsqrtf(sa * (1.f / ND) + EPS), rb = rsqrtf(sb * (1.f / ND) + EPS);
#pragma unroll
            for (int j = 0; j < 16; ++j) {
                const int d = j * 64 + lane;
                va[j] = va[j] * ra * sA[d] + sB[d]; vb[j] = vb[j] * rb * sA[d] + sB[d];
                h2[(size_t)tokA * ND + d] = f2bf(va[j]); h2[(size_t)tokB * ND + d] = f2bf(vb[j]);
            }
            float la = 0.f, lb = 0.f;
#pragma unroll 4
            for (int o = 0; o < 36; ++o) {
                float a = 0.f, c = 0.f;
#pragma unroll
                for (int j = 0; j < 16; ++j) { const float w = sW[(j * 64 + lane) * 37 + o]; a += va[j] * w; c += vb[j] * w; }
                a = wave_sum(a); c = wave_sum(c);
                if (lane == o) { la = a; lb = c; }
            }
            const float bias = (lane < 4) ? p.rg_b[lane] : ((lane < 36) ? p.re_b[lane - 4] : 0.f);
            la += bias; lb += bias;
#pragma unroll
            for (int which = 0; which < 2; ++which) {
                const float mylogit = which ? lb : la; const int tok = which ? tokB : tokA;
                float gl[4];
#pragma unroll
                for (int j = 0; j < 4; ++j) gl[j] = __shfl(mylogit, j);
                int gsel = 0; float gm = gl[0];
#pragma unroll
                for (int j = 1; j < 4; ++j) if (gl[j] > gm) { gm = gl[j]; gsel = j; }
                float gs = 0.f;
#pragma unroll
                for (int j = 0; j < 4; ++j) gs += __expf(gl[j] - gm);
                const float gtop = 1.f / gs;
                float el[8];
#pragma unroll
                for (int j = 0; j < 8; ++j) el[j] = __shfl(mylogit, 4 + gsel * 8 + j);
                int e1 = 0; float m1 = el[0];
#pragma unroll
                for (int j = 1; j < 8; ++j) if (el[j] > m1) { m1 = el[j]; e1 = j; }
                int e2 = -1; float m2 = -INFINITY;
#pragma unroll
                for (int j = 0; j < 8; ++j) if (j != e1 && el[j] > m2) { m2 = el[j]; e2 = j; }
                const float r2 = __expf(m2 - m1);
                const float w1v = gtop / (1.f + r2), w2v = gtop * r2 / (1.f + r2);
                if (lane == 0) {
                    const int ea = gsel * 8 + e1, eb = gsel * 8 + e2;
                    const int pa = atomicAdd(&s_cnt[ea], 1), pb = atomicAdd(&s_cnt[eb], 1);
                    int* st = s_tok + (tok & 63) * 4; st[0] = ea; st[1] = pa; st[2] = eb; st[3] = pb;
                    int* ti = tokinfo + (size_t)tok * 8; ti[4] = __float_as_int(w1v); ti[5] = __float_as_int(w2v);
                }
            }
        }
        __syncthreads();
        if (tid < 32) s_base[tid] = atomicAdd(&cnt[tid], s_cnt[tid]);
        __syncthreads();
        if (tid < 64) {
            const int tok = tile * 64 + tid; const int* st = s_tok + tid * 4;
            const int ea = st[0], pa = s_base[ea] + st[1], eb = st[2], pb = s_base[eb] + st[3];
            list[ea * NTOK + pa] = tok; list[eb * NTOK + pb] = tok;
            int* ti = tokinfo + (size_t)tok * 8; ti[0] = ea; ti[1] = pa; ti[2] = eb; ti[3] = pb;
        }
    }
}

struct MoeIdx { int rowoff[NE + 1]; int tileoff[NE + 1]; };
__device__ __forceinline__ void moe_index(const int tid, const P& p, MoeIdx* mi) {
    if (tid == 0) {
        const int* cnt = (const int*)(p.ws + WS_CTL);
        int r = 0, t = 0;
        for (int e = 0; e < NE; ++e) { mi->rowoff[e] = r; mi->tileoff[e] = t; const int c = cnt[e]; r += c; t += (c + 255) >> 8; }
        mi->rowoff[NE] = r; mi->tileoff[NE] = t;
    }
    __syncthreads();
}
struct MoeSrc {
    struct Unit { int e, ml, pn, nrows, row0; };
    const MoeIdx* mi; const int* list; const char* Ab; const char* Bt; size_t bstride; int K, G, c; bool gather;
    __device__ __forceinline__ bool next(int i, Unit& u) const {
        const int L = i * G + c; if (L >= mi->tileoff[NE] * 4) return false;
        const int mt = L >> 2; u.pn = L & 3;
        int e = 0; while (mi->tileoff[e + 1] <= mt) ++e;
        u.e = e; u.ml = mt - mi->tileoff[e]; u.row0 = mi->rowoff[e] + u.ml * 256;
        u.nrows = min(256, mi->rowoff[e + 1] - u.row0);
        return true;
    }
    __device__ __forceinline__ unsigned one(const Unit& u, int r, int C) const {
        const int rr = min(r, u.nrows - 1);
        const int arow = gather ? list[u.e * NTOK + u.ml * 256 + rr] : (u.row0 + rr);
        return (unsigned)((arow * K + C) * 2);
    }
    __device__ __forceinline__ void a_off(const Unit& u, int R0, int C0, int R1, int C1, pg8::AO& ao) const {
        ao.h0p0 = one(u, R0, C0); ao.h0p1 = one(u, R1, C1); ao.h1p0 = one(u, 128 + R0, C0); ao.h1p1 = one(u, 128 + R1, C1);
    }
    __device__ __forceinline__ const char* a_base(const Unit&, int kt) const { return Ab + (size_t)kt * 128; }
    __device__ __forceinline__ const char* b_base(const Unit& u) const { return Bt + (size_t)u.e * bstride + (size_t)u.pn * 256 * K * 2; }
};
constexpr int L_MOE = pg8::STAGE_BYTES + (int)sizeof(MoeIdx) + 16;

struct EpiUp {
    static constexpr bool PERM = true;
    bf16_t* act;
    __device__ __forceinline__ void operator()(const f32x4 (&acc)[2][2][4][2], const MoeSrc::Unit& u, int wr, int wc, int fr, int fq) const {
        const int col0 = u.pn * 128 + wc * 32 + 8 * fq;
#pragma unroll
        for (int ai = 0; ai < 2; ++ai)
#pragma unroll
            for (int m = 0; m < 4; ++m) {
                const int r = ai * 128 + wr * 64 + m * 16 + fr;
                if (r < u.nrows) {
                    const f32x4 g0 = acc[ai][0][m][0], g1 = acc[ai][0][m][1], u0 = acc[ai][1][m][0], u1 = acc[ai][1][m][1];
                    *(uint4*)(act + (size_t)(u.row0 + r) * EFF + col0) = make_uint4(pack2(silu_f(g0[0]) * u0[0], silu_f(g0[1]) * u0[1]), pack2(silu_f(g0[2]) * u0[2], silu_f(g0[3]) * u0[3]),
                                                                                     pack2(silu_f(g1[0]) * u1[0], silu_f(g1[1]) * u1[1]), pack2(silu_f(g1[2]) * u1[2], silu_f(g1[3]) * u1[3]));
                }
            }
    }
};
__device__ __forceinline__ void ph_moe_up(const P& p, char* smem) {
    const int tid = tid_opaque();
    MoeIdx* mi = (MoeIdx*)(smem + pg8::STAGE_BYTES);
    moe_index(tid, p, mi);
    MoeSrc S; S.mi = mi; S.list = (const int*)(p.ws + WS_LIST); S.Ab = (const char*)(p.ws + WS_H2); S.Bt = (const char*)(p.ws + WS_W13); S.bstride = (size_t)1024 * ND * 2; S.K = ND; S.G = gridDim.x; S.c = blockIdx.x; S.gather = true;
    EpiUp E; E.act = (bf16_t*)(p.ws + WS_ACT);
    pg8::gemm_phase(tid, (PG8_LAS unsigned char*)smem, ND, S, E);
}

struct EpiDown {
    static constexpr bool PERM = true;
    bf16_t* yb;
    __device__ __forceinline__ void operator()(const f32x4 (&acc)[2][2][4][2], const MoeSrc::Unit& u, int wr, int wc, int fr, int fq) const {
        const int col0 = u.pn * 256 + wc * 32 + 8 * fq;
#pragma unroll
        for (int ai = 0; ai < 2; ++ai)
#pragma unroll
            for (int m = 0; m < 4; ++m) {
                const int r = ai * 128 + wr * 64 + m * 16 + fr;
                if (r < u.nrows) {
#pragma unroll
                    for (int bj = 0; bj < 2; ++bj) { const f32x4 v0 = acc[ai][bj][m][0], v1 = acc[ai][bj][m][1];
                        *(uint4*)(yb + (size_t)(u.row0 + r) * ND + col0 + bj * 128) = make_uint4(pack2(v0[0], v0[1]), pack2(v0[2], v0[3]), pack2(v1[0], v1[1]), pack2(v1[2], v1[3])); }
                }
            }
    }
};
__device__ __forceinline__ void ph_moe_down(const P& p, char* smem) {
    const int tid = tid_opaque();
    MoeIdx* mi = (MoeIdx*)(smem + pg8::STAGE_BYTES);
    moe_index(tid, p, mi);
    MoeSrc S; S.mi = mi; S.list = nullptr; S.Ab = (const char*)(p.ws + WS_ACT); S.Bt = (const char*)(p.ws + WS_W2); S.bstride = (size_t)ND * EFF * 2; S.K = EFF; S.G = gridDim.x; S.c = blockIdx.x; S.gather = false;
    EpiDown E; E.yb = (bf16_t*)(p.ws + WS_YBUF);
    pg8::gemm_phase(tid, (PG8_LAS unsigned char*)smem, EFF, S, E);
}

__device__ __forceinline__ void ph_combine(const P& p, char* smem) {
    const int tid = tid_opaque();
    MoeIdx* mi = (MoeIdx*)smem;
    float* sG = (float*)(mi + 1);
    moe_index(tid, p, mi);
    const int lane = tid & 63, wave = tid >> 6;
    const bf16_t* yb = (const bf16_t*)(p.ws + WS_YBUF); const int* tokinfo = (const int*)(p.ws + WS_TOKINFO);
    int curb = -1;
    for (int tile = blockIdx.x; tile < NTOK / 64; tile += gridDim.x) {
        const int b = tile / (NT / 64);
        if (b != curb) {
            __syncthreads();
            for (int d = tid; d < ND; d += NTHREADS) sG[d] = mod_val(p, b, 5, d);
            __syncthreads();
            curb = b;
        }
        for (int i = 0; i < 8; ++i) {
            const int tok = tile * 64 + wave * 8 + i;
            const int* ti = tokinfo + (size_t)tok * 8;
            const int ra = mi->rowoff[ti[0]] + ti[1], rb = mi->rowoff[ti[2]] + ti[3];
            const float wa = __int_as_float(ti[4]), wb = __int_as_float(ti[5]);
#pragma unroll
            for (int j = 0; j < 4; ++j) {
                const int d = j * 256 + lane * 4;
                const uint2 ya = *(const uint2*)(yb + (size_t)ra * ND + d), ybv = *(const uint2*)(yb + (size_t)rb * ND + d);
                f32x4 xv = *(const f32x4*)(p.out + (size_t)tok * ND + d);
                xv[0] += sG[d] * (wa * __uint_as_float(ya.x << 16) + wb * __uint_as_float(ybv.x << 16));
                xv[1] += sG[d + 1] * (wa * __uint_as_float(ya.x & 0xffff0000u) + wb * __uint_as_float(ybv.x & 0xffff0000u));
                xv[2] += sG[d + 2] * (wa * __uint_as_float(ya.y << 16) + wb * __uint_as_float(ybv.y << 16));
                xv[3] += sG[d + 3] * (wa * __uint_as_float(ya.y & 0xffff0000u) + wb * __uint_as_float(ybv.y & 0xffff0000u));
                *(f32x4*)(p.out + (size_t)tok * ND + d) = xv;
            }
        }
    }
}

namespace cg = cooperative_groups;
extern __shared__ __attribute__((aligned(16))) char dyn_smem[];
constexpr int cmax(int a, int b) { return a > b ? a : b; }
constexpr int L_G1 = pg8::STAGE_BYTES;
constexpr int MEGA_LDS = cmax(cmax(cmax(ROUTE_LDS, PREP_LDS), cmax(cmax(AT_BUF + SCAN_LDS, ATTM_LDS), L_G1)), L_MOE);
typedef const unsigned long long __attribute__((address_space(4)))* kargp_t;
__device__ __forceinline__ void load_params(P& p, kargp_t ka) {
    asm volatile("" : "+s"(ka));
    typedef __attribute__((address_space(1))) char* gptr_t;
    const void** d = (const void**)&p;
#pragma unroll
    for (int i = 0; i < (int)(sizeof(P) / 8); ++i) d[i] = (const void*)(gptr_t)ka[i];
}
#define PHASE(call) do { P p; load_params(p, ka); call; } while (0)
#ifndef PROBE_MODE
#define PROBE_MODE 0
#endif
#ifndef PROBE_K
#define PROBE_K -1
#endif
template <int KMAX>
__device__ __forceinline__ void run_phases(cg::grid_group& grid, kargp_t ka, char* smem) {
    if constexpr (KMAX >= 0) { PHASE(ph_mod_partial(p, smem)); PHASE(ph_convert(p, smem)); grid.sync(); }
    if constexpr (KMAX >= 1) { PHASE(ph_norm1(p, smem)); grid.sync(); }
    if constexpr (KMAX >= 2) { PHASE(ph_gemm1(p, smem)); grid.sync(); }
    if constexpr (KMAX >= 3) { PHASE(ph_post(p, smem)); grid.sync(); }
    if constexpr (KMAX >= 4) { PHASE(ph_dn_prep(p, smem)); grid.sync(); }
    if constexpr (KMAX >= 5) { PHASE(ph_attn_mfma<(KMAX == 5 ? PROBE_MODE : 0)>(p, smem)); grid.sync(); }
    if constexpr (KMAX >= 6) { PHASE(ph_dn_gate(p)); grid.sync(); }
    if constexpr (KMAX >= 7) { PHASE(ph_gemm_out(p, smem)); grid.sync(); }
    if constexpr (KMAX >= 8) { PHASE(ph_route(p, smem)); grid.sync(); }
    if constexpr (KMAX >= 9) { PHASE(ph_moe_up(p, smem)); grid.sync(); }
    if constexpr (KMAX >= 10) { PHASE(ph_moe_down(p, smem)); grid.sync(); }
    if constexpr (KMAX >= 11) { PHASE(ph_combine(p, smem)); }
}
__global__ void __launch_bounds__(NTHREADS) mega(P p_arg) {
    cg::grid_group grid = cg::this_grid();
    char* smem = dyn_smem;
    kargp_t ka = (kargp_t)__builtin_amdgcn_kernarg_segment_ptr();
    if constexpr (PROBE_K >= 0) {
        run_phases<PROBE_K>(grid, ka, smem);
        P p; load_params(p, ka);
        if (blockIdx.x == 0 && threadIdx.x < 256) ((int*)(p.ws + WS_CTL))[threadIdx.x] = 0;
        grid.sync();
    }
    run_phases<99>(grid, ka, smem);
}

extern "C" void kernel_launch(void* const* d_in, const int* in_sizes, int n_in, void* d_out, int out_size, void* d_ws, size_t ws_size, hipStream_t stream) {
    if (n_in != 26 || out_size != NTOK * ND || ws_size < WS_END) { fprintf(stderr, "kernel_launch: unexpected shapes (n_in %d out %d ws %zu need %zu)\n", n_in, out_size, ws_size, (size_t)WS_END); return; }
    static int grid_blocks = 0;
    if (!grid_blocks) {
        int dev = 0, cus = 0, per_cu = 0;
        (void)hipGetDevice(&dev);
        (void)hipDeviceGetAttribute(&cus, hipDeviceAttributeMultiprocessorCount, dev);
        (void)hipFuncSetAttribute((const void*)mega, hipFuncAttributeMaxDynamicSharedMemorySize, MEGA_LDS);
        (void)hipOccupancyMaxActiveBlocksPerMultiprocessor(&per_cu, (const void*)mega, NTHREADS, MEGA_LDS);
        if (per_cu < 1) { fprintf(stderr, "kernel_launch: occupancy query says %d blocks/CU\n", per_cu); per_cu = 1; }
        grid_blocks = cus * per_cu;
    }
    P p{};
    const float** fp = (const float**)&p;
    for (int i = 0; i < 26; ++i) fp[i] = (const float*)d_in[i];
    p.pos = (const int*)d_in[2];
    p.out = (float*)d_out; p.ws = (unsigned char*)d_ws;
    (void)hipMemsetAsync((char*)d_ws + WS_CTL, 0, 4096, stream);
    void* args[] = {&p};
    hipError_t e = hipLaunchCooperativeKernel((const void*)mega, dim3(grid_blocks), dim3(NTHREADS), args, MEGA_LDS, stream);
    if (e != hipSuccess) fprintf(stderr, "cooperative launch failed: %s (grid %d)\n", hipGetErrorString(e), grid_blocks);
}
```

```cpp
#include <hip/hip_runtime.h>
#include <hip/hip_cooperative_groups.h>
#include <cstdio>
#include <cstdint>

typedef unsigned short bf16_t;
typedef short bf16x8 __attribute__((ext_vector_type(8)));
typedef float f32x16 __attribute__((ext_vector_type(16)));
typedef float f32x4 __attribute__((ext_vector_type(4)));

constexpr int NB = 8, NT = 2048, ND = 1024, NTOK = NB * NT;
constexpr int NPROJ = 3072;
constexpr int PC_QATT = 0, PC_KVLAT = 512, PC_QIDX = 640, PC_DNQKV = 896, PC_DNZ = 2432, PC_KIDX = 2944, PC_WIDX = 2976, PC_BETA = 2984, PC_A = 2988;
constexpr int W_IN_SRC = 2992;
constexpr int NE = 32, EFF = 512;
constexpr int KSPLIT = 16;
constexpr int NTHREADS = 512, NWAVES = 8;
constexpr float EPS = 1e-6f;
constexpr float LOG2E = 1.4426950408889634f;

constexpr size_t MiB = 1ull << 20;
constexpr size_t WS_CTL = 0;
constexpr size_t WS_BAR = WS_CTL + 16 * 1024;
constexpr size_t WS_MODF = WS_CTL + 256 * 1024;
constexpr size_t WS_MODP = WS_CTL + 1 * MiB;
constexpr size_t WS_WIN = WS_MODP + 3 * MiB;
constexpr size_t WS_WOUT = WS_WIN + 6 * MiB;
constexpr size_t WS_W13 = WS_WOUT + 2 * MiB;
constexpr size_t WS_W2 = WS_W13 + 64 * MiB;
constexpr size_t WS_PROJ = WS_W2 + 32 * MiB;
constexpr size_t WS_ACT = WS_PROJ;
constexpr size_t WS_YBUF = WS_PROJ + 32 * MiB;
constexpr size_t WS_QN = WS_PROJ + 96 * MiB;
constexpr size_t WS_K = WS_QN + 16 * MiB;
constexpr size_t WS_KI = WS_K + 2 * MiB;
constexpr size_t WS_WI = WS_KI + 1 * MiB;
constexpr size_t WS_DBG = WS_WI + 512 * 1024;
constexpr size_t WS_DQ = WS_DBG + 512 * 1024;
constexpr size_t WS_DK = WS_DQ + 16 * MiB;
constexpr size_t WS_H2 = WS_DQ;
constexpr size_t WS_DKT = WS_DK + 16 * MiB;
constexpr size_t WS_DVT = WS_DKT + 16 * MiB;
constexpr size_t WS_END = WS_DVT + 16 * MiB;
constexpr size_t WS_LIST = WS_K;
constexpr size_t WS_TOKINFO = WS_KI;
constexpr size_t WS_VT = WS_WIN;
constexpr size_t WS_POSMM = WS_WIN + 2 * MiB;
constexpr size_t DO_WN = 0, DO_U = 16 * MiB, DO_DNO = 32 * MiB, DO_PP = 48 * MiB, DO_EG = 56 * MiB, DO_LL = DO_EG + 256 * 1024, DO_GC = DO_LL + 256 * 1024;

struct P {
    const float* x; const float* c; const int* pos; const float* ada_w; const float* ada_b; const float* norm1_g; const float* norm2_g;
    const float* w_in; const float* q_norm_g; const float* k_norm_g; const float* kv_norm_g; const float* w_kv_up; const float* idx_k_norm_g;
    const float* rel_bias; const float* conv_w; const float* a_log; const float* dt_bias; const float* dn_norm_g; const float* w_out;
    const float* rg_w; const float* rg_b; const float* re_w; const float* re_b; const float* w1; const float* w3; const float* w2;
    float* out; unsigned char* ws;
};

__device__ __forceinline__ float bf2f(bf16_t h) { return __uint_as_float(((unsigned)h) << 16); }
__device__ __forceinline__ bf16_t f2bf(float f) { unsigned u = __float_as_uint(f); u += 0x7fffu + ((u >> 16) & 1u); return (bf16_t)(u >> 16); }
__device__ __forceinline__ unsigned pack2(float a, float b) { unsigned r; asm volatile("v_cvt_pk_bf16_f32 %0, %1, %2" : "=v"(r) : "v"(a), "v"(b)); return r; }
template <int CTRL> __device__ __forceinline__ float dpp_f(float v) { return __int_as_float(__builtin_amdgcn_update_dpp(0, __float_as_int(v), CTRL, 0xF, 0xF, false)); }
template <int CTRL> __device__ __forceinline__ int dpp_i(int v) { return __builtin_amdgcn_update_dpp(0, v, CTRL, 0xF, 0xF, false); }
__device__ __forceinline__ float wave_sum(float v) {
    v += dpp_f<0xB1>(v); v += dpp_f<0x4E>(v); v += dpp_f<0x141>(v); v += dpp_f<0x140>(v);
    v += __shfl_xor(v, 16); v += __shfl_xor(v, 32);
    return v;
}
__device__ __forceinline__ float wave_max(float v) {
#pragma unroll
    for (int o = 32; o >= 1; o >>= 1) v = fmaxf(v, __shfl_xor(v, o));
    return v;
}
__device__ __forceinline__ int wave_isum(int v) {
#pragma unroll
    for (int o = 32; o >= 1; o >>= 1) v += __shfl_xor(v, o);
    return v;
}
__device__ __forceinline__ int tid_opaque() { int t = threadIdx.x; asm volatile("" : "+v"(t)); return t; }
__device__ __forceinline__ float silu_f(float x) { return x / (1.f + __expf(-x)); }
__device__ __forceinline__ float sigmoid_f(float x) { return 1.f / (1.f + __expf(-x)); }
__device__ __forceinline__ float mod_val(const P& p, int b, int which, int d) {
    const float* mp = (const float*)(p.ws + WS_MODP);
    const int col = which * ND + d;
    float s = p.ada_b[col];
#pragma unroll
    for (int ks = 0; ks < KSPLIT; ++ks) s += mp[(size_t)(ks * NB + b) * (6 * ND) + col];
    return s;
}

__device__ __forceinline__ void ph_mod_partial(const P& p, char* smem) {
    const int tid = tid_opaque();
    const int lane = tid & 63, wave = tid >> 6;
    float* sc = (float*)smem;
    for (int i = tid; i < NB * ND; i += NTHREADS) sc[i] = silu_f(p.c[i]);
    __syncthreads();
    float* mp = (float*)(p.ws + WS_MODP);
    const int nitem = 96 * KSPLIT;
    for (int it = blockIdx.x * NWAVES + wave; it < nitem; it += gridDim.x * NWAVES) {
        const int cg = it % 96, ks = it / 96;
        const int col = cg * 64 + lane;
        float acc[NB];
#pragma unroll
        for (int b = 0; b < NB; ++b) acc[b] = 0.f;
#pragma unroll 8
        for (int kk = 0; kk < ND / KSPLIT; ++kk) {
            const int k = ks * (ND / KSPLIT) + kk;
            const float w = p.ada_w[(size_t)k * (6 * ND) + col];
#pragma unroll
            for (int b = 0; b < NB; ++b) acc[b] += sc[b * ND + k] * w;
        }
#pragma unroll
        for (int b = 0; b < NB; ++b) mp[(size_t)(ks * NB + b) * (6 * ND) + col] = acc[b];
    }
    __syncthreads();
}

__device__ __forceinline__ int win_src_col(int n) {
    if (n < 896) return n;
    if (n < 2944) return n + 40;
    if (n < 2976) return n - 2944 + 896;
    if (n < 2984) return n - 2976 + 928;
    if (n < 2992) return n;
    return -1;
}
__device__ __forceinline__ void conv_tile_wave(const int lane, float* tile, const float* src0, int nsrc, int mode, int n0, int k0, bf16_t* dst, int K, int sc0) {
    if (mode == 1) {
        const int col = win_src_col(n0 + lane);
#pragma unroll 8
        for (int k = 0; k < 64; ++k) tile[k * 65 + lane] = (col >= 0) ? src0[(size_t)(k0 + k) * nsrc + col] : 0.f;
    } else {
        const int kr = lane >> 4, c4 = lane & 15;
        const float* src = src0; const int col = sc0 + c4 * 4;
        f32x4 v[16];
#pragma unroll
        for (int i = 0; i < 16; ++i) v[i] = *(const f32x4*)(src + (size_t)(k0 + i * 4 + kr) * nsrc + col);
#pragma unroll
        for (int i = 0; i < 16; ++i) { float* t = tile + (i * 4 + kr) * 65 + c4 * 4; t[0] = v[i][0]; t[1] = v[i][1]; t[2] = v[i][2]; t[3] = v[i][3]; }
    }
    __threadfence_block();
    {
        const int kc = lane & 7, nr = lane >> 3;
#pragma unroll
        for (int i = 0; i < 8; ++i) {
            const int n = i * 8 + nr;
            unsigned w[4];
#pragma unroll
            for (int j = 0; j < 4; ++j) w[j] = pack2(tile[(kc * 8 + 2 * j) * 65 + n], tile[(kc * 8 + 2 * j + 1) * 65 + n]);
            *(uint4*)(dst + (size_t)(n0 + n) * K + k0 + kc * 8) = make_uint4(w[0], w[1], w[2], w[3]);
        }
    }
    __threadfence_block();
}
__device__ __forceinline__ void ph_convert(const P& p, char* smem) {
    const int tid = tid_opaque();
    const int lane = tid & 63, wave = tid >> 6;
    float* tile = (float*)smem + wave * (64 * 65);
    bf16_t* Wt_in = (bf16_t*)(p.ws + WS_WIN); bf16_t* Wt_out = (bf16_t*)(p.ws + WS_WOUT);
    bf16_t* Wt13 = (bf16_t*)(p.ws + WS_W13); bf16_t* Wt2 = (bf16_t*)(p.ws + WS_W2);
    const int T0 = 48 * 16, T1 = 16 * 16, T2 = NE * 256, T3 = NE * 128;
    const int total = T0 + T1 + T2 + T3;
    for (int t = blockIdx.x * NWAVES + wave; t < total; t += gridDim.x * NWAVES) {
        if (t < T0) { const int nt = t / 16, kt = t % 16; conv_tile_wave(lane, tile, p.w_in, W_IN_SRC, 1, nt * 64, kt * 64, Wt_in, ND, 0); }
        else if (t < T0 + T1) { const int u = t - T0; const int nt = u / 16, kt = u % 16; conv_tile_wave(lane, tile, p.w_out, ND, 0, nt * 64, kt * 64, Wt_out, ND, nt * 64); }
        else if (t < T0 + T1 + T2) { const int u = t - T0 - T1; const int e = u / 256, v = u % 256; const int nt = v / 16, kt = v % 16;
            const int pn = nt >> 2, within = nt & 3;
            const float* srcw = ((within >= 2) ? p.w3 : p.w1) + (size_t)e * ND * EFF;
            conv_tile_wave(lane, tile, srcw, EFF, 0, nt * 64, kt * 64, Wt13 + (size_t)e * 1024 * ND, ND, pn * 128 + (within & 1) * 64); }
        else { const int u = t - T0 - T1 - T2; const int e = u / 128, v = u % 128; const int nt = v / 8, kt = v % 8;
            conv_tile_wave(lane, tile, p.w2 + (size_t)e * EFF * ND, ND, 0, nt * 64, kt * 64, Wt2 + (size_t)e * ND * EFF, EFF, nt * 64); }
    }
}

__device__ __forceinline__ void ph_norm1(const P& p, char* smem) {
    const int tid = tid_opaque();
    float* sA = (float*)smem; float* sB = sA + ND;
    const int lane = tid & 63, wave = tid >> 6;
    bf16_t* h = (bf16_t*)p.out;
    {
        float* mf = (float*)(p.ws + WS_MODF);
        for (int i = blockIdx.x * NTHREADS + tid; i < NB * 6 * ND; i += gridDim.x * NTHREADS) mf[i] = mod_val(p, i / (6 * ND), (i % (6 * ND)) / ND, i % ND);
    }
    int curb = -1;
    for (int tile = blockIdx.x; tile < NTOK / 64; tile += gridDim.x) {
        const int b = tile / (NT / 64);
        if (b != curb) {
            __syncthreads();
            for (int d = tid; d < ND; d += NTHREADS) { sA[d] = p.norm1_g[d] * (1.f + mod_val(p, b, 1, d)); sB[d] = mod_val(p, b, 0, d); }
            __syncthreads();
            curb = b;
        }
        for (int i4 = 0; i4 < 2; ++i4) {
            const int tokb = tile * 64 + wave * 8 + i4 * 4;
            f32x4 v[4][4];
#pragma unroll
            for (int q = 0; q < 4; ++q)
#pragma unroll
                for (int j = 0; j < 4; ++j) v[q][j] = *(const f32x4*)(p.x + (size_t)(tokb + q) * ND + j * 256 + lane * 4);
#pragma unroll
            for (int q = 0; q < 4; ++q) {
                float ss = 0.f;
#pragma unroll
                for (int j = 0; j < 4; ++j) ss += v[q][j][0] * v[q][j][0] + v[q][j][1] * v[q][j][1] + v[q][j][2] * v[q][j][2] + v[q][j][3] * v[q][j][3];
                ss = wave_sum(ss);
                const float rstd = rsqrtf(ss * (1.f / ND) + EPS);
#pragma unroll
                for (int j = 0; j < 4; ++j) {
                    const int d = j * 256 + lane * 4;
                    const float o0 = v[q][j][0] * rstd * sA[d] + sB[d], o1 = v[q][j][1] * rstd * sA[d + 1] + sB[d + 1], o2 = v[q][j][2] * rstd * sA[d + 2] + sB[d + 2], o3 = v[q][j][3] * rstd * sA[d + 3] + sB[d + 3];
                    *(uint2*)(h + (size_t)(tokb + q) * ND + d) = make_uint2(pack2(o0, o1), pack2(o2, o3));
                }
            }
        }
    }
}

namespace pg8 {
#define PG8_LAS __attribute__((address_space(3)))
typedef unsigned u32x4 __attribute__((ext_vector_type(4)));
constexpr int BM = 256, BK = 64, HALF = 128, HTB = HALF * BK * 2  , STAGE_BYTES = 8 * HTB;
__device__ __forceinline__ int lds_byte(int r, int c) { const int st = (r >> 4) * 2 + (c >> 5), rr = r & 15, cc = c & 31, ob = rr * 64 + cc * 2; return st * 1024 + (ob ^ (((ob >> 9) & 1) << 5)); }
__device__ __forceinline__ void stage_rc(int b, int& R, int& C) { const int st = b / 1024, sb = b % 1024, swz = sb ^ (((sb >> 9) & 1) << 5); R = (st >> 1) * 16 + swz / 64; C = (st & 1) * 32 + (swz % 64) / 2; }
__device__ __forceinline__ int perm32(int rho) { const int n = rho >> 4, i = rho & 15; return 8 * (i >> 2) + 4 * n + (i & 3); }
struct AO { unsigned h0p0, h0p1, h1p0, h1p1; };
template <class Src, class Epi>
__device__ __forceinline__ void gemm_phase(const int tid, PG8_LAS unsigned char* lds, const int K, const Src& S, const Epi& E) {
    const int wid = __builtin_amdgcn_readfirstlane(tid >> 6), lane = tid & 63, wr = wid >> 2, wc = wid & 3, fr = lane & 15, fq = lane >> 4;
    const int nt = K / BK;
    int R0, C0, R1, C1; stage_rc(tid * 16, R0, C0); stage_rc(tid * 16 + 8192, R1, C1);
    unsigned voffB[2];
    { const int Rb0 = Epi::PERM ? ((R0 & ~31) + perm32(R0 & 31)) : R0, Rb1 = Epi::PERM ? ((R1 & ~31) + perm32(R1 & 31)) : R1;
      voffB[0] = (unsigned)(Rb0 * K + C0) * 2u; voffB[1] = (unsigned)(Rb1 * K + C1) * 2u; }
    const size_t kstep = (size_t)(BK * 2);
    const size_t hstepB = (size_t)HALF * K * 2;
    const unsigned ldsw = (unsigned)wid * 1024u;
    const int aoff = lds_byte(wr * 64 + fr, fq * 8), boff = lds_byte(wc * 32 + fr, fq * 8);
#define PG8_SA(b, h) (((b) * 2 + (h)) * HTB)
#define PG8_SB(b, h) ((4 + (b) * 2 + (h)) * HTB)
#define PG8_STAGE2(bufoff, gbase, o0, o1) do { \
        __builtin_amdgcn_global_load_lds((const unsigned*)((const char*)(gbase) + (o0)), (PG8_LAS unsigned*)(lds + (bufoff) + ldsw), 16, 0, 0); \
        __builtin_amdgcn_global_load_lds((const unsigned*)((const char*)(gbase) + (o1)), (PG8_LAS unsigned*)(lds + (bufoff) + ldsw + 8192), 16, 0, 0); } while (0)
#define PG8_STAGEB(bufoff, gbase) PG8_STAGE2(bufoff, gbase, voffB[0], voffB[1])
#define PG8_STAGEA0(bufoff, gbase, AOV) PG8_STAGE2(bufoff, gbase, AOV.h0p0, AOV.h0p1)
#define PG8_STAGEA1(bufoff, gbase, AOV) PG8_STAGE2(bufoff, gbase, AOV.h1p0, AOV.h1p1)
#define PG8_LDA(dst, b, h) do { _Pragma("unroll") for (int m = 0; m < 4; ++m) _Pragma("unroll") for (int k = 0; k < 2; ++k) dst[m][k] = *(const PG8_LAS bf16x8*)(lds + PG8_SA(b, h) + aoff + m * 2048 + k * 1024); } while (0)
#define PG8_LDB(dst, b, h) do { _Pragma("unroll") for (int n = 0; n < 2; ++n) _Pragma("unroll") for (int k = 0; k < 2; ++k) dst[n][k] = *(const PG8_LAS bf16x8*)(lds + PG8_SB(b, h) + boff + n * 2048 + k * 1024); } while (0)
#define PG8_MMA(ai, bj, At, Bt) do { __builtin_amdgcn_s_setprio(1); _Pragma("unroll") for (int m = 0; m < 4; ++m) _Pragma("unroll") for (int n = 0; n < 2; ++n) _Pragma("unroll") for (int k = 0; k < 2; ++k) \
        acc[ai][bj][m][n] = __builtin_amdgcn_mfma_f32_16x16x32_bf16(Bt[n][k], At[m][k], acc[ai][bj][m][n], 0, 0, 0); __builtin_amdgcn_s_setprio(0); } while (0)
#define PG8_WAIT_V(n) asm volatile("s_waitcnt vmcnt(" #n ")" ::: "memory")
#define PG8_WAIT_L(n) asm volatile("s_waitcnt lgkmcnt(" #n ")" ::: "memory")
#define PG8_BAR __builtin_amdgcn_s_barrier()
#define PG8_SCHED __builtin_amdgcn_sched_barrier(0)
    typename Src::Unit cur, nxt; int ui = 0;
    if (!S.next(0, cur)) return;
    f32x4 acc[2][2][4][2];
#pragma unroll
    for (int a = 0; a < 2; ++a)
#pragma unroll
        for (int b = 0; b < 2; ++b)
#pragma unroll
            for (int m = 0; m < 4; ++m)
#pragma unroll
                for (int n = 0; n < 2; ++n) acc[a][b][m][n] = (f32x4){0.f, 0.f, 0.f, 0.f};
    bf16x8 At[4][2], B0[2][2], B1[2][2];
    AO aoC, aoN;
    S.a_off(cur, R0, C0, R1, C1, aoC);
    const char* cB = S.b_base(cur);
    PG8_STAGEB(PG8_SB(0, 0), cB); PG8_STAGEA0(PG8_SA(0, 0), S.a_base(cur, 0), aoC); PG8_STAGEB(PG8_SB(0, 1), cB + hstepB); PG8_STAGEA1(PG8_SA(0, 1), S.a_base(cur, 0), aoC);
    if (wr == 1) PG8_BAR;
    PG8_WAIT_V(4); PG8_BAR;
    PG8_STAGEB(PG8_SB(1, 0), cB + kstep); PG8_STAGEA0(PG8_SA(1, 0), S.a_base(cur, 1), aoC); PG8_STAGEB(PG8_SB(1, 1), cB + hstepB + kstep);
    PG8_WAIT_V(6); PG8_BAR;
    for (;;) {
        const bool has_next = S.next(ui + 1, nxt);
        const char* nB = cB;
        if (has_next) { S.a_off(nxt, R0, C0, R1, C1, aoN); nB = S.b_base(nxt); }
        else aoN = aoC;
        for (int t = 0; t < nt; t += 2) {
            const bool last = (t == nt - 2);
            const char* a1 = S.a_base(cur, t + 1);
            const char* a2 = last ? S.a_base(has_next ? nxt : cur, 0) : S.a_base(cur, t + 2);
            const char* a3 = last ? S.a_base(has_next ? nxt : cur, 1) : S.a_base(cur, t + 3);
            const char* b2 = last ? nB : cB + (size_t)(t + 2) * kstep; const char* b3 = b2 + kstep;
            const AO ao2 = last ? aoN : aoC;
            PG8_LDB(B0, 0, 0); PG8_SCHED; PG8_LDA(At, 0, 0); PG8_STAGEA1(PG8_SA(1, 1), a1, aoC);
            PG8_WAIT_L(8); PG8_BAR; PG8_WAIT_L(0); PG8_MMA(0, 0, At, B0); PG8_BAR; PG8_SCHED;
            PG8_LDB(B1, 0, 1); PG8_STAGEB(PG8_SB(0, 0), b2);
            PG8_BAR; PG8_WAIT_L(0); PG8_MMA(0, 1, At, B1); PG8_BAR;
            PG8_LDA(At, 0, 1); PG8_STAGEA0(PG8_SA(0, 0), a2, ao2);
            PG8_BAR; PG8_WAIT_L(0); PG8_MMA(1, 0, At, B0); PG8_BAR; PG8_SCHED;
            PG8_STAGEB(PG8_SB(0, 1), b2 + hstepB);
            PG8_WAIT_V(6); PG8_BAR; PG8_MMA(1, 1, At, B1); PG8_BAR;
            PG8_LDB(B0, 1, 0); PG8_SCHED; PG8_LDA(At, 1, 0); PG8_STAGEA1(PG8_SA(0, 1), a2, ao2);
            PG8_WAIT_L(8); PG8_BAR; PG8_WAIT_L(0); PG8_MMA(0, 0, At, B0); PG8_BAR; PG8_SCHED;
            PG8_LDB(B1, 1, 1); PG8_STAGEB(PG8_SB(1, 0), b3);
            PG8_BAR; PG8_WAIT_L(0); PG8_MMA(0, 1, At, B1); PG8_BAR;
            PG8_LDA(At, 1, 1); PG8_STAGEA0(PG8_SA(1, 0), a3, ao2);
            PG8_BAR; PG8_WAIT_L(0); PG8_MMA(1, 0, At, B0); PG8_BAR; PG8_SCHED;
            PG8_STAGEB(PG8_SB(1, 1), b3 + hstepB);
            PG8_WAIT_V(6); PG8_BAR; PG8_MMA(1, 1, At, B1); PG8_BAR;
        }
        E(acc, cur, wr, wc, fr, fq);
        if (!has_next) break;
#pragma unroll
        for (int a = 0; a < 2; ++a)
#pragma unroll
            for (int b = 0; b < 2; ++b)
#pragma unroll
                for (int m = 0; m < 4; ++m)
#pragma unroll
                    for (int n = 0; n < 2; ++n) acc[a][b][m][n] = (f32x4){0.f, 0.f, 0.f, 0.f};
        cur = nxt; cB = nB; ++ui; aoC = aoN;
    }
    PG8_WAIT_V(0);
    if (wr == 0) PG8_BAR;
    PG8_BAR;
#undef PG8_SA
#undef PG8_SB
#undef PG8_STAGE2
#undef PG8_STAGEB
#undef PG8_STAGEA0
#undef PG8_STAGEA1
#undef PG8_LDA
#undef PG8_LDB
#undef PG8_MMA
#undef PG8_WAIT_V
#undef PG8_WAIT_L
#undef PG8_BAR
#undef PG8_SCHED
}
struct DenseSrc {
    struct Unit { int pm, pn; };
    const char* A0; const char* A1; const char* Bt; int lda, K, nM, nN, G, c, ksplit;
    __device__ __forceinline__ bool next(int i, Unit& u) const {
        const int nwg = nM * nN; const long L = (long)i * G + c; if (L >= nwg) return false;
        int wgid = (int)L; { const int q = nwg / 8, r = nwg % 8, xcd = wgid % 8, off = wgid / 8; wgid = (xcd < r ? xcd * (q + 1) : r * (q + 1) + (xcd - r) * q) + off; }
        const int nig = 8 * nN, gid = wgid / nig, fm = gid * 8, gsz = (nM - fm) < 8 ? (nM - fm) : 8;
        u.pm = fm + ((wgid % nig) % gsz); u.pn = (wgid % nig) / gsz; return true;
    }
    __device__ __forceinline__ void a_off(const Unit& u, int R0, int C0, int R1, int C1, AO& ao) const {
        ao.h0p0 = (unsigned)(((u.pm * 256 + R0) * lda + C0) * 2); ao.h0p1 = (unsigned)(((u.pm * 256 + R1) * lda + C1) * 2);
        ao.h1p0 = (unsigned)(((u.pm * 256 + 128 + R0) * lda + C0) * 2); ao.h1p1 = (unsigned)(((u.pm * 256 + 128 + R1) * lda + C1) * 2);
    }
    __device__ __forceinline__ const char* a_base(const Unit&, int kt) const { return (kt < ksplit) ? A0 + (size_t)kt * 128 : A1 + (size_t)(kt - ksplit) * 128; }
    __device__ __forceinline__ const char* b_base(const Unit& u) const { return Bt + (size_t)u.pn * 256 * K * 2; }
};
}

struct EpiProj {
    static constexpr bool PERM = true;
    bf16_t* O; int ldc;
    __device__ __forceinline__ void operator()(const f32x4 (&acc)[2][2][4][2], const pg8::DenseSrc::Unit& u, int wr, int wc, int fr, int fq) const {
        const int row0 = u.pm * 256 + wr * 64 + fr, col0 = u.pn * 256 + wc * 32 + 8 * fq;
#pragma unroll
        for (int ai = 0; ai < 2; ++ai)
#pragma unroll
            for (int m = 0; m < 4; ++m) { bf16_t* rowp = O + (size_t)(row0 + ai * 128 + m * 16) * ldc + col0;
#pragma unroll
                for (int bj = 0; bj < 2; ++bj) { const f32x4 v0 = acc[ai][bj][m][0], v1 = acc[ai][bj][m][1];
                    *(uint4*)(rowp + bj * 128) = make_uint4(pack2(v0[0], v0[1]), pack2(v0[2], v0[3]), pack2(v1[0], v1[1]), pack2(v1[2], v1[3])); } }
    }
};
__device__ __forceinline__ void ph_gemm1(const P& p, char* smem) {
    const int tid = tid_opaque();
    pg8::DenseSrc S; S.A0 = (const char*)p.out; S.A1 = S.A0; S.Bt = (const char*)(p.ws + WS_WIN); S.lda = ND; S.K = ND; S.nM = NTOK / 256; S.nN = NPROJ / 256; S.G = gridDim.x; S.c = blockIdx.x; S.ksplit = ND / 64;
    EpiProj E; E.O = (bf16_t*)(p.ws + WS_PROJ); E.ldc = NPROJ;
    pg8::gemm_phase(tid, (PG8_LAS unsigned char*)smem, ND, S, E);
}

__device__ __forceinline__ void ph_post(const P& p, char* smem) {
    const int tid = tid_opaque();
    float* sW = (float*)smem;
    {
        f32x4 t[8];
#pragma unroll
        for (int i = 0; i < 8; ++i) t[i] = *(const f32x4*)(p.w_kv_up + (size_t)(tid + i * NTHREADS) * 4);
#pragma unroll
        for (int i = 0; i < 8; ++i) *(f32x4*)(sW + (size_t)(tid + i * NTHREADS) * 4) = t[i];
    }
    __syncthreads();
    const int lane = tid & 63, wave = tid >> 6;
    const bf16_t* proj = (const bf16_t*)(p.ws + WS_PROJ);
    bf16_t* qn = (bf16_t*)(p.ws + WS_QN); bf16_t* Kb = (bf16_t*)(p.ws + WS_K); bf16_t* kib = (bf16_t*)(p.ws + WS_KI);
    float* wi = (float*)(p.ws + WS_WI); float* dbeta = (float*)(p.ws + WS_DBG); float* dg = dbeta + NTOK * 4;
    bf16_t* dq = (bf16_t*)(p.ws + WS_DQ); bf16_t* dk = (bf16_t*)(p.ws + WS_DK); bf16_t* dkT = (bf16_t*)(p.ws + WS_DKT); bf16_t* dvT = (bf16_t*)(p.ws + WS_DVT);
    bf16_t* Vt = (bf16_t*)(p.ws + WS_VT);
    {
        const int g = blockIdx.x * NTHREADS + tid;
        if (g < NB * 64) { int mn = 0x7fffffff, mx = -0x7fffffff; for (int i = 0; i < 32; ++i) { const int v = p.pos[g * 32 + i]; mn = min(mn, v); mx = max(mx, v); } int* pm = (int*)(p.ws + WS_POSMM); pm[g * 2] = mn; pm[g * 2 + 1] = mx; }
    }
    for (int tg = blockIdx.x * NWAVES + wave; tg < NTOK / 8; tg += gridDim.x * NWAVES) {
        const int tok0 = tg * 8, t0 = tok0 % NT, bb = tok0 / NT;
        uint4 rq[8]; unsigned rkv[8]; unsigned rms[8];
#pragma unroll
        for (int ti = 0; ti < 8; ++ti) {
            const bf16_t* pr = proj + (size_t)(tok0 + ti) * NPROJ;
            rq[ti] = *(const uint4*)(pr + PC_QATT + lane * 8);
            rkv[ti] = *(const unsigned*)(pr + PC_KVLAT + lane * 2);
            rms[ti] = (lane < 48) ? (unsigned)pr[PC_KIDX + lane] : 0u;
        }
        float vall[8];
#pragma unroll
        for (int ti = 0; ti < 8; ++ti) {
            const int tok = tok0 + ti;
            {
                const unsigned w[4] = {rq[ti].x, rq[ti].y, rq[ti].z, rq[ti].w};
                float v[8]; float ss = 0.f;
#pragma unroll
                for (int j = 0; j < 4; ++j) { v[2 * j] = __uint_as_float(w[j] << 16); v[2 * j + 1] = __uint_as_float(w[j] & 0xffff0000u); }
#pragma unroll
                for (int j = 0; j < 8; ++j) ss += v[j] * v[j];
                ss += dpp_f<0xB1>(ss); ss += dpp_f<0x4E>(ss); ss += dpp_f<0x141>(ss);
                const float rs = rsqrtf(ss * (1.f / 64.f) + EPS) * (0.125f * LOG2E);
                const int d0 = (lane & 7) * 8;
                unsigned o[4];
#pragma unroll
                for (int j = 0; j < 4; ++j) o[j] = pack2(v[2 * j] * rs * p.q_norm_g[d0 + 2 * j], v[2 * j + 1] * rs * p.q_norm_g[d0 + 2 * j + 1]);
                *(uint4*)(qn + (size_t)tok * 512 + lane * 8) = make_uint4(o[0], o[1], o[2], o[3]);
            }
            {
                float a0 = __uint_as_float(rkv[ti] << 16), a1 = __uint_as_float(rkv[ti] & 0xffff0000u);
                float ss = wave_sum(a0 * a0 + a1 * a1);
                const float rs = rsqrtf(ss * (1.f / 128.f) + EPS);
                a0 *= rs * p.kv_norm_g[lane * 2]; a1 *= rs * p.kv_norm_g[lane * 2 + 1];
                float k = 0.f, v = 0.f;
#pragma unroll 8
                for (int i = 0; i < 64; ++i) {
                    const float x0 = __shfl(a0, i), x1 = __shfl(a1, i);
                    k += x0 * sW[(2 * i) * 128 + lane] + x1 * sW[(2 * i + 1) * 128 + lane];
                    v += x0 * sW[(2 * i) * 128 + 64 + lane] + x1 * sW[(2 * i + 1) * 128 + 64 + lane];
                }
                const float ks = wave_sum(k * k);
                k *= rsqrtf(ks * (1.f / 64.f) + EPS) * p.k_norm_g[lane];
                Kb[(size_t)tok * 64 + lane] = f2bf(k);
                vall[ti] = v;
            }
            {
                const float raw = bf2f((bf16_t)rms[ti]);
                float a = (lane < 32) ? raw : 0.f;
                const float ss = wave_sum(a * a);
                a *= rsqrtf(ss * (1.f / 32.f) + EPS);
                if (lane < 32) kib[(size_t)tok * 32 + lane] = f2bf(a * p.idx_k_norm_g[lane]);
                else if (lane < 40) wi[(size_t)tok * 8 + lane - 32] = raw * 0.35355339059327373f * 0.17677669529663687f;
                else if (lane < 44) dbeta[(size_t)tok * 4 + lane - 40] = sigmoid_f(raw);
                else if (lane < 48) {
                    const float z = raw + p.dt_bias[lane - 44];
                    const float sp = (z > 20.f) ? z : log1pf(__expf(z));
                    dg[(size_t)tok * 4 + lane - 44] = -__expf(p.a_log[lane - 44]) * sp;
                }
            }
        }
        *(uint4*)(Vt + ((size_t)bb * 64 + lane) * NT + t0) = make_uint4(pack2(vall[0], vall[1]), pack2(vall[2], vall[3]), pack2(vall[4], vall[5]), pack2(vall[6], vall[7]));
#pragma unroll 1
        for (int jg = 0; jg < 4; ++jg) {
            unsigned raw[3][11];
#pragma unroll
            for (int jj = 0; jj < 3; ++jj)
#pragma unroll
                for (int i = 0; i < 11; ++i) {
                    raw[jj][i] = 0u;
                    if (t0 - 3 + i >= 0) raw[jj][i] = *(const unsigned*)(proj + (size_t)(tok0 - 3 + i) * NPROJ + PC_DNQKV + (jg * 3 + jj) * 128 + lane * 2);
                }
#pragma unroll
            for (int jj = 0; jj < 3; ++jj) {
                const int j = jg * 3 + jj;
                const int ch = j * 128 + lane * 2;
                float c0[4], c1[4];
#pragma unroll
                for (int tap = 0; tap < 4; ++tap) { c0[tap] = p.conv_w[tap * 1536 + ch]; c1[tap] = p.conv_w[tap * 1536 + ch + 1]; }
                float y0[8], y1[8];
#pragma unroll
                for (int i = 0; i < 8; ++i) {
                    float a0 = 0.f, a1 = 0.f;
#pragma unroll
                    for (int tap = 0; tap < 4; ++tap) { a0 += c0[tap] * __uint_as_float(raw[jj][i + tap] << 16); a1 += c1[tap] * __uint_as_float(raw[jj][i + tap] & 0xffff0000u); }
                    y0[i] = silu_f(a0); y1[i] = silu_f(a1);
                    if (j < 8) {
                        const float ss = wave_sum(y0[i] * y0[i] + y1[i] * y1[i]);
                        float rs = rsqrtf(ss + EPS);
                        if (j < 4) rs *= 0.08838834764831845f;
                        y0[i] *= rs; y1[i] *= rs;
                    }
                }
                if (j < 8) {
                    bf16_t* dst = (j < 4) ? dq : dk;
#pragma unroll
                    for (int i = 0; i < 8; ++i) *(unsigned*)(dst + (size_t)(tok0 + i) * 512 + (j & 3) * 128 + lane * 2) = pack2(y0[i], y1[i]);
                }
                if (j >= 4) {
                    bf16_t* dstT = ((j < 8) ? dkT : dvT) + ((size_t)(bb * 4 + (j & 3)) * 128 + lane * 2) * NT + t0;
                    *(uint4*)dstT = make_uint4(pack2(y0[0], y0[1]), pack2(y0[2], y0[3]), pack2(y0[4], y0[5]), pack2(y0[6], y0[7]));
                    *(uint4*)(dstT + NT) = make_uint4(pack2(y1[0], y1[1]), pack2(y1[2], y1[3]), pack2(y1[4], y1[5]), pack2(y1[6], y1[7]));
                }
            }
        }
    }
}

__device__ __forceinline__ unsigned f2sortable(float f) { const unsigned u = __float_as_uint(f); return (u & 0x80000000u) ? ~u : (u | 0x80000000u); }
__device__ __forceinline__ float sum8_f(float v) { v += dpp_f<0xB1>(v); v += dpp_f<0x4E>(v); v += dpp_f<0x141>(v); return v; }
__device__ __forceinline__ int sum16_i(int v) { v += dpp_i<0xB1>(v); v += dpp_i<0x4E>(v); v += dpp_i<0x141>(v); v += __shfl_xor(v, 32); return v; }
__device__ __forceinline__ int pi32(int r) { return (r & 0x13) | ((r & 4) << 1) | ((r & 8) >> 1); }
__device__ __forceinline__ constexpr int key_of_reg(int r) { return (r & 3) + 4 * ((r >> 2) & 1) + 16 * (r >> 3); }
struct KiFrag { bf16x8 a0, a1; };
__device__ __forceinline__ void idx_scores(f32x16& sc, const KiFrag& f, bf16x8 qi0, bf16x8 qi1, float wl) {
    f32x16 z;
#pragma unroll
    for (int r = 0; r < 16; ++r) z[r] = 0.f;
    z = __builtin_amdgcn_mfma_f32_32x32x16_bf16(f.a0, qi0, z, 0, 0, 0);
    z = __builtin_amdgcn_mfma_f32_32x32x16_bf16(f.a1, qi1, z, 0, 0, 0);
#pragma unroll
    for (int r = 0; r < 16; ++r) sc[r] = sum8_f(fmaxf(z[r], 0.f) * wl);
}
constexpr int AT_SBL = 0, AT_POSMAX = 4352, AT_ITEM = 6400, AT_BUF = 6656;
constexpr int AT_KI_ROW = 80, AT_P1_BUF = 256 * AT_KI_ROW;
constexpr int AT2_K = 0, AT2_VT = 128 * 144, AT2_KI = AT2_VT + 64 * 272, AT2_PK = AT2_KI + 128 * AT_KI_ROW, AT2_BUF = AT2_PK + 512;
constexpr int ATTM_LDS = AT_BUF + 2 * (AT_P1_BUF > AT2_BUF ? AT_P1_BUF : AT2_BUF);
__device__ __forceinline__ KiFrag ki_lds(const char* buf, int row, int hf) {
    KiFrag f; const char* r = buf + row * AT_KI_ROW + 16 * hf;
    f.a0 = *(const bf16x8*)r; f.a1 = *(const bf16x8*)(r + 32); return f;
}
__device__ __forceinline__ void attn_pass1(const P& p, char* smem, int b, int tb, int tid, float& tauf, int& cut) {
    const int lane = tid & 63, wave = tid >> 6;
    const int hf = lane >> 5, cq = (lane & 31) >> 3, ch = lane & 7, prow = pi32(lane & 31);
    const int t0 = tb * 32 + wave * 4, tq = t0 + cq, tok = b * NT + tq;
    const bf16_t* proj = (const bf16_t*)(p.ws + WS_PROJ);
    const bf16_t* ki_b = (const bf16_t*)(p.ws + WS_KI) + (size_t)b * NT * 32;
    const bf16x8 qi0 = *(const bf16x8*)(proj + (size_t)tok * NPROJ + PC_QIDX + ch * 32 + 8 * hf);
    const bf16x8 qi1 = *(const bf16x8*)(proj + (size_t)tok * NPROJ + PC_QIDX + ch * 32 + 16 + 8 * hf);
    const float wl = ((const float*)(p.ws + WS_WI))[(size_t)tok * 8 + ch];
    char* bufs = smem + AT_BUF;
    float keep[8][16];
#pragma unroll
    for (int s = 0; s < 8; ++s)
#pragma unroll
        for (int r = 0; r < 16; ++r) keep[s][r] = -INFINITY;
    {
#pragma unroll
        for (int i = 0; i < 2; ++i) { const int x = tid + 512 * i; *(uint4*)(bufs + (x >> 2) * AT_KI_ROW + (x & 3) * 16) = *(const uint4*)(ki_b + (size_t)(x >> 2) * 32 + (x & 3) * 8); }
    }
    __syncthreads();
#pragma unroll
    for (int g = 0; g < 8; ++g) {
        if (g * 8 <= tb) {
            const bool more = (g + 1) * 8 <= tb;
            uint4 n0 = make_uint4(0, 0, 0, 0), n1 = n0;
            if (more) {
                n0 = *(const uint4*)(ki_b + (size_t)((g + 1) * 256 + (tid >> 2)) * 32 + (tid & 3) * 8);
                n1 = *(const uint4*)(ki_b + (size_t)((g + 1) * 256 + 128 + (tid >> 2)) * 32 + (tid & 3) * 8);
            }
            const char* buf = bufs + (g & 1) * AT_P1_BUF;
#pragma unroll
            for (int kk = 0; kk < 8; ++kk) {
                const int kt = g * 8 + kk;
                if (kt <= tb) {
                    const KiFrag f = ki_lds(buf, kk * 32 + prow, hf);
                    f32x16 sc;
                    idx_scores(sc, f, qi0, qi1, wl);
                    if (kt == tb) {
#pragma unroll
                        for (int r = 0; r < 16; ++r) sc[r] = (kt * 32 + key_of_reg(r) + 8 * hf <= tq) ? sc[r] : -INFINITY;
                    }
                    if (ch == kk) {
#pragma unroll
                        for (int r = 0; r < 16; ++r) keep[g][r] = sc[r];
                    }
                    __builtin_amdgcn_sched_barrier(0);
                }
            }
            if (more) {
                char* nb = bufs + ((g + 1) & 1) * AT_P1_BUF;
                *(uint4*)(nb + (tid >> 2) * AT_KI_ROW + (tid & 3) * 16) = n0;
                *(uint4*)(nb + (128 + (tid >> 2)) * AT_KI_ROW + (tid & 3) * 16) = n1;
            }
            __syncthreads();
        }
    }
    unsigned u[8][16];
#pragma unroll
    for (int s = 0; s < 8; ++s)
#pragma unroll
        for (int r = 0; r < 16; ++r) u[s][r] = f2sortable(keep[s][r]);
    unsigned prefix = 0u;
    for (int bit = 31; bit >= 0; --bit) {
        const unsigned cand = prefix | (1u << bit);
        int cnt = 0;
#pragma unroll
        for (int s = 0; s < 8; ++s) {
            if (s * 8 <= tb) {
#pragma unroll
                for (int r = 0; r < 16; ++r) cnt += (u[s][r] >= cand) ? 1 : 0;
            }
        }
        cnt = sum16_i(cnt);
        if (cnt >= 256) prefix = cand;
    }
    int ngt = 0, neq = 0;
#pragma unroll
    for (int s = 0; s < 8; ++s)
#pragma unroll
        for (int r = 0; r < 16; ++r) { ngt += (u[s][r] > prefix) ? 1 : 0; neq += (u[s][r] == prefix) ? 1 : 0; asm volatile("" : "+v"(ngt), "+v"(neq)); }
    ngt = sum16_i(ngt); neq = sum16_i(neq);
    const int need = 256 - ngt;
    if (__any(need < neq)) {
        int lo = 0, hi = NT - 1;
        for (int it = 0; it < 11; ++it) {
            const int mid = (lo + hi) >> 1;
            int cnt = 0;
            unsigned pf = prefix; asm volatile("" : "+v"(pf));
#pragma unroll
            for (int s = 0; s < 8; ++s)
#pragma unroll
                for (int r = 0; r < 16; ++r) { cnt += (u[s][r] == pf && ((s * 8 + ch) * 32 + key_of_reg(r) + 8 * hf) <= mid) ? 1 : 0; asm volatile("" : "+v"(cnt)); }
            cnt = sum16_i(cnt);
            if (cnt >= need) hi = mid; else lo = mid + 1;
        }
        if (need < neq) cut = lo;
    }
    { const unsigned pu = prefix; tauf = __uint_as_float((pu & 0x80000000u) ? (pu & 0x7fffffffu) : ~pu); }
}
__device__ __forceinline__ float xhalf_max(float v) { auto rr = __builtin_amdgcn_permlane32_swap(__float_as_uint(v), __float_as_uint(v), false, false); return fmaxf(__uint_as_float(rr[0]), __uint_as_float(rr[1])); }
__device__ __forceinline__ void attn_pass2(const P& p, char* smem, int b, int tb, int tid, float tauf, int cut) {
    const int lane = tid & 63, wave = tid >> 6;
    const int hf = lane >> 5, l31 = lane & 31, cq = l31 >> 3, ch = lane & 7, prow = pi32(l31);
    const int t0 = tb * 32 + wave * 4, tq = t0 + cq, tok = b * NT + tq;
    const bf16_t* proj = (const bf16_t*)(p.ws + WS_PROJ);
    bf16_t* qn = (bf16_t*)(p.ws + WS_QN);
    const bf16_t* ki_b = (const bf16_t*)(p.ws + WS_KI) + (size_t)b * NT * 32;
    const bf16_t* K_b = (const bf16_t*)(p.ws + WS_K) + (size_t)b * NT * 64;
    const bf16_t* Vt_b = (const bf16_t*)(p.ws + WS_VT) + (size_t)b * 64 * NT;
    const float* sbl = (const float*)(smem + AT_SBL); const int* posmax = (const int*)(smem + AT_POSMAX) + b * 64;
    char* bufs = smem + AT_BUF;
    const bf16x8 qi0 = *(const bf16x8*)(proj + (size_t)tok * NPROJ + PC_QIDX + ch * 32 + 8 * hf);
    const bf16x8 qi1 = *(const bf16x8*)(proj + (size_t)tok * NPROJ + PC_QIDX + ch * 32 + 16 + 8 * hf);
    const float wl = ((const float*)(p.ws + WS_WI))[(size_t)tok * 8 + ch];
    bf16x8 qb[4];
#pragma unroll
    for (int ks = 0; ks < 4; ++ks) qb[ks] = *(const bf16x8*)(qn + (size_t)tok * 512 + ch * 64 + ks * 16 + 8 * hf);
    const int pq = p.pos[tok];
    int pqmin = pq;
    pqmin = min(pqmin, __shfl_xor(pqmin, 8)); pqmin = min(pqmin, __shfl_xor(pqmin, 16));
    pqmin = __builtin_amdgcn_readfirstlane(pqmin);
    const float bias_far = sbl[128 * 8 + ch];
    const bool anycut = __any(cut != 0x7fffffff);
    f32x16 o0, o1;
#pragma unroll
    for (int r = 0; r < 16; ++r) { o0[r] = 0.f; o1[r] = 0.f; }
    float m = -INFINITY, l = 0.f;
    const int nt128 = (tb + 4) >> 2;
    uint4 rk0, rk1, rv0, rv1, rki; int rpos = 0;
#define AT_LOAD(j) { const int kb_ = (j) * 128; \
        rk0 = *(const uint4*)(K_b + (size_t)(kb_ + (tid >> 3)) * 64 + (tid & 7) * 8); rk1 = *(const uint4*)(K_b + (size_t)(kb_ + 64 + (tid >> 3)) * 64 + (tid & 7) * 8); \
        rv0 = *(const uint4*)(Vt_b + (size_t)(tid >> 4) * NT + kb_ + (tid & 15) * 8); rv1 = *(const uint4*)(Vt_b + (size_t)(32 + (tid >> 4)) * NT + kb_ + (tid & 15) * 8); \
        rki = *(const uint4*)(ki_b + (size_t)(kb_ + (tid >> 2)) * 32 + (tid & 3) * 8); \
        if (tid < 128) rpos = p.pos[b * NT + kb_ + tid]; }
#define AT_STORE(bp) { char* sb_ = (bp); \
        *(uint4*)(sb_ + AT2_K + (tid >> 3) * 144 + (tid & 7) * 16) = rk0; *(uint4*)(sb_ + AT2_K + (64 + (tid >> 3)) * 144 + (tid & 7) * 16) = rk1; \
        *(uint4*)(sb_ + AT2_VT + (tid >> 4) * 272 + (tid & 15) * 16) = rv0; *(uint4*)(sb_ + AT2_VT + (32 + (tid >> 4)) * 272 + (tid & 15) * 16) = rv1; \
        *(uint4*)(sb_ + AT2_KI + (tid >> 2) * AT_KI_ROW + (tid & 3) * 16) = rki; \
        if (tid < 128) ((int*)(sb_ + AT2_PK))[tid] = rpos; }
    AT_LOAD(0) AT_STORE(bufs)
    __syncthreads();
#pragma unroll 1
    for (int j = 0; j < nt128; ++j) {
        if (j + 1 < nt128) AT_LOAD(j + 1)
        const char* buf = bufs + (j & 1) * AT2_BUF;
#pragma unroll
        for (int st = 0; st < 2; ++st) {
            const int kt0 = 4 * j + 2 * st;
            if (kt0 <= tb) {
                const bool have1 = (kt0 + 1 <= tb);
                const int krow = st * 64;
                f32x16 sc0, sc1, s0, s1;
                idx_scores(sc0, ki_lds(buf + AT2_KI, krow + prow, hf), qi0, qi1, wl);
                const bool far0 = (pqmin - posmax[kt0] >= 128);
#pragma unroll
                for (int r = 0; r < 16; ++r) s0[r] = far0 ? bias_far : 0.f;
                {
                    const char* kr = buf + AT2_K + (krow + prow) * 144 + 16 * hf;
#pragma unroll
                    for (int ks = 0; ks < 4; ++ks) s0 = __builtin_amdgcn_mfma_f32_32x32x16_bf16(*(const bf16x8*)(kr + ks * 32), qb[ks], s0, 0, 0, 0);
                }
                bool far1 = true;
                if (have1) {
                    idx_scores(sc1, ki_lds(buf + AT2_KI, krow + 32 + prow, hf), qi0, qi1, wl);
                    far1 = (pqmin - posmax[kt0 + 1] >= 128);
#pragma unroll
                    for (int r = 0; r < 16; ++r) s1[r] = far1 ? bias_far : 0.f;
                    const char* kr = buf + AT2_K + (krow + 32 + prow) * 144 + 16 * hf;
#pragma unroll
                    for (int ks = 0; ks < 4; ++ks) s1 = __builtin_amdgcn_mfma_f32_32x32x16_bf16(*(const bf16x8*)(kr + ks * 32), qb[ks], s1, 0, 0, 0);
                } else {
#pragma unroll
                    for (int r = 0; r < 16; ++r) { s1[r] = -INFINITY; sc1[r] = -INFINITY; }
                }
                const int kbase0 = kt0 * 32 + 8 * hf, kbase1 = kbase0 + 32;
                if (!far0) {
                    const int* pk = (const int*)(buf + AT2_PK) + krow + 8 * hf;
#pragma unroll
                    for (int r = 0; r < 16; ++r) { int n = pq - pk[key_of_reg(r)]; n = n < 0 ? 0 : (n > 128 ? 128 : n); s0[r] += sbl[n * 8 + ch]; }
                }
                if (!far1) {
                    const int* pk = (const int*)(buf + AT2_PK) + krow + 32 + 8 * hf;
#pragma unroll
                    for (int r = 0; r < 16; ++r) { int n = pq - pk[key_of_reg(r)]; n = n < 0 ? 0 : (n > 128 ? 128 : n); s1[r] += sbl[n * 8 + ch]; }
                }
                if (anycut) {
#pragma unroll
                    for (int r = 0; r < 16; ++r) {
                        const bool ok0 = (sc0[r] > tauf) || (sc0[r] == tauf && (kbase0 + key_of_reg(r)) <= cut); s0[r] = ok0 ? s0[r] : -INFINITY;
                        const bool ok1 = (sc1[r] > tauf) || (sc1[r] == tauf && (kbase1 + key_of_reg(r)) <= cut); s1[r] = ok1 ? s1[r] : -INFINITY;
                    }
                } else {
#pragma unroll
                    for (int r = 0; r < 16; ++r) { s0[r] = (sc0[r] >= tauf) ? s0[r] : -INFINITY; s1[r] = (sc1[r] >= tauf) ? s1[r] : -INFINITY; }
                }
                if (kt0 + 1 >= tb) {
#pragma unroll
                    for (int r = 0; r < 16; ++r) { s0[r] = (kbase0 + key_of_reg(r) <= tq) ? s0[r] : -INFINITY; s1[r] = (kbase1 + key_of_reg(r) <= tq) ? s1[r] : -INFINITY; }
                }
                float mx = fmaxf(s0[0], s1[0]);
#pragma unroll
                for (int r = 1; r < 16; ++r) mx = fmaxf(mx, fmaxf(s0[r], s1[r]));
                mx = xhalf_max(mx);
                if (!__all(mx - m <= 8.f)) {
                    const float mnew = fmaxf(m, mx);
                    const float msafe = (mnew == -INFINITY) ? 0.f : mnew;
                    const float alpha = __builtin_amdgcn_exp2f(m - msafe);
                    m = mnew; l *= alpha;
#pragma unroll
                    for (int r = 0; r < 16; ++r) { o0[r] *= alpha; o1[r] *= alpha; }
                }
                const float mref = (m == -INFINITY) ? 0.f : m;
                float ps = 0.f;
#pragma unroll
                for (int r = 0; r < 16; ++r) { s0[r] = __builtin_amdgcn_exp2f(s0[r] - mref); s1[r] = __builtin_amdgcn_exp2f(s1[r] - mref); ps += s0[r] + s1[r]; }
                l += ps;
                union { uint4 u; bf16x8 f; } pb0, pb1, pb2, pb3;
                pb0.u = make_uint4(pack2(s0[0], s0[1]), pack2(s0[2], s0[3]), pack2(s0[4], s0[5]), pack2(s0[6], s0[7]));
                pb1.u = make_uint4(pack2(s0[8], s0[9]), pack2(s0[10], s0[11]), pack2(s0[12], s0[13]), pack2(s0[14], s0[15]));
                pb2.u = make_uint4(pack2(s1[0], s1[1]), pack2(s1[2], s1[3]), pack2(s1[4], s1[5]), pack2(s1[6], s1[7]));
                pb3.u = make_uint4(pack2(s1[8], s1[9]), pack2(s1[10], s1[11]), pack2(s1[12], s1[13]), pack2(s1[14], s1[15]));
                const char* vr = buf + AT2_VT + l31 * 272 + st * 128 + 16 * hf;
                o0 = __builtin_amdgcn_mfma_f32_32x32x16_bf16(*(const bf16x8*)vr, pb0.f, o0, 0, 0, 0);
                o1 = __builtin_amdgcn_mfma_f32_32x32x16_bf16(*(const bf16x8*)(vr + 32 * 272), pb0.f, o1, 0, 0, 0);
                o0 = __builtin_amdgcn_mfma_f32_32x32x16_bf16(*(const bf16x8*)(vr + 32), pb1.f, o0, 0, 0, 0);
                o1 = __builtin_amdgcn_mfma_f32_32x32x16_bf16(*(const bf16x8*)(vr + 32 * 272 + 32), pb1.f, o1, 0, 0, 0);
                o0 = __builtin_amdgcn_mfma_f32_32x32x16_bf16(*(const bf16x8*)(vr + 64), pb2.f, o0, 0, 0, 0);
                o1 = __builtin_amdgcn_mfma_f32_32x32x16_bf16(*(const bf16x8*)(vr + 32 * 272 + 64), pb2.f, o1, 0, 0, 0);
                o0 = __builtin_amdgcn_mfma_f32_32x32x16_bf16(*(const bf16x8*)(vr + 96), pb3.f, o0, 0, 0, 0);
                o1 = __builtin_amdgcn_mfma_f32_32x32x16_bf16(*(const bf16x8*)(vr + 32 * 272 + 96), pb3.f, o1, 0, 0, 0);
            }
        }
        if (j + 1 < nt128) AT_STORE(bufs + ((j + 1) & 1) * AT2_BUF)
        __syncthreads();
    }
#undef AT_LOAD
#undef AT_STORE
    l += __shfl_xor(l, 32);
    const float inv = 1.f / l;
    bf16_t* orow = qn + (size_t)tok * 512 + ch * 64;
#pragma unroll
    for (int gq = 0; gq < 4; ++gq) {
        *(uint2*)(orow + gq * 8 + 4 * hf) = make_uint2(pack2(o0[gq * 4] * inv, o0[gq * 4 + 1] * inv), pack2(o0[gq * 4 + 2] * inv, o0[gq * 4 + 3] * inv));
        *(uint2*)(orow + 32 + gq * 8 + 4 * hf) = make_uint2(pack2(o1[gq * 4] * inv, o1[gq * 4 + 1] * inv), pack2(o1[gq * 4 + 2] * inv, o1[gq * 4 + 3] * inv));
    }
}
__device__ __forceinline__ void dn_scan_block(const P& p, char* smem, int bh, int tid);
template <int MODE>
__device__ __forceinline__ void ph_attn_mfma(const P& p, char* smem) {
    const int tid = tid_opaque();
    float* sbl = (float*)(smem + AT_SBL);
    for (int i = tid; i < 129 * 8; i += NTHREADS) {
        const int n = i >> 3, h = i & 7; int bk;
        if (n < 16) bk = n;
        else { const float v = logf((float)n / 16.f) / 2.0794415416798357f * 16.f; bk = 16 + (int)v; if (bk > 31) bk = 31; }
        sbl[i] = p.rel_bias[bk * 8 + h] * LOG2E;
    }
    ((int*)(smem + AT_POSMAX))[tid] = ((const int*)(p.ws + WS_POSMM))[tid * 2 + 1];
    __syncthreads();
    if (MODE != 2 && blockIdx.x < NB * 4) {
        int tid0 = tid; asm volatile("" : "+v"(tid0));
        dn_scan_block(p, smem + AT_BUF, blockIdx.x, tid0);
        __syncthreads();
    }
    int* qctr = (int*)(p.ws + WS_CTL) + 64;
    if (MODE != 1) for (;;) {
        int tid1 = tid; asm volatile("" : "+v"(tid1));
        if (tid1 == 0) *(int*)(smem + AT_ITEM) = atomicAdd(qctr, 1);
        __syncthreads();
        const int item = *(const int*)(smem + AT_ITEM);
        if (item >= NB * 64) break;
        const int b = item & 7, tb = 63 - (item >> 3);
        float tauf = -INFINITY; int cut = 0x7fffffff;
        if (tb >= 8) attn_pass1(p, smem, b, tb, tid1, tauf, cut);
        int tid2 = tid; asm volatile("" : "+v"(tid2));
        attn_pass2(p, smem, b, tb, tid2, tauf, cut);
    }
}

__device__ __forceinline__ constexpr int sig16(int x) { return (x & ~12) | ((x & 4) << 1) | ((x & 8) >> 1); }
constexpr int PREP_WAVE_LDS = 2 * 64 * 72 * 2 + 4 * 64 * 4;
constexpr int PREP_LDS = NWAVES * PREP_WAVE_LDS;
__device__ __forceinline__ void ph_dn_prep(const P& p, char* smem) {
    const int tid = tid_opaque();
    const int wave = tid >> 6;
    char* wl = smem + wave * PREP_WAVE_LDS;
    float* sA = (float*)wl;
    bf16_t* sTw = (bf16_t*)wl; bf16_t* sTu = sTw + 64 * 72;
    float* sG = (float*)(wl + 2 * 64 * 72 * 2); float* sB = sG + 64; float* sE = sB + 64; float* sL = sE + 64;
    const bf16_t* dq = (const bf16_t*)(p.ws + WS_DQ); const bf16_t* dk = (const bf16_t*)(p.ws + WS_DK);
    const bf16_t* dkT = (const bf16_t*)(p.ws + WS_DKT); const bf16_t* dvT = (const bf16_t*)(p.ws + WS_DVT);
    const float* dbeta = (const float*)(p.ws + WS_DBG); const float* dg = dbeta + NTOK * 4;
    unsigned char* dob = (unsigned char*)p.out;
    bf16_t* PPg = (bf16_t*)(dob + DO_PP); float* GCg = (float*)(dob + DO_GC); float* EGg = (float*)(dob + DO_EG); float* LLg = (float*)(dob + DO_LL);
    for (int item = blockIdx.x * NWAVES + wave; item < NB * 4 * 32; item += gridDim.x * NWAVES) {
        int lane = tid & 63; asm volatile("" : "+v"(lane));
        const int hf = lane >> 5, l31 = lane & 31;
        const int bh = item >> 5, c = item & 31, b = bh >> 2, hh = bh & 3;
        const int tok0 = b * NT + c * 64;
        bf16_t* WN = (bf16_t*)(dob + DO_WN) + (size_t)item * 64 * 128; bf16_t* Ug = (bf16_t*)(dob + DO_U) + (size_t)item * 64 * 128;
        bf16_t* PP = PPg + (size_t)item * 64 * 64;
        float G, beta, eG;
        {
            const float g = dg[(size_t)(tok0 + lane) * 4 + hh];
            beta = dbeta[(size_t)(tok0 + lane) * 4 + hh];
            G = g;
#pragma unroll
            for (int o = 1; o < 64; o <<= 1) { const float n = __shfl_up(G, o); if (lane >= o) G += n; }
            const float Gl = __shfl(G, 63);
            eG = __expf(G);
            sG[lane] = G; sB[lane] = beta; sE[lane] = eG; sL[lane] = __expf(Gl - G);
            EGg[item * 64 + lane] = eG; LLg[item * 64 + lane] = __expf(Gl - G);
            if (lane == 0) GCg[item] = __expf(Gl);
        }
        f32x16 kk00, kk10, kk11, qk00, qk10, qk11;
#pragma unroll
        for (int r = 0; r < 16; ++r) { kk00[r] = 0.f; kk10[r] = 0.f; kk11[r] = 0.f; qk00[r] = 0.f; qk10[r] = 0.f; qk11[r] = 0.f; }
        {
            const bf16_t* kr0 = dk + (size_t)(tok0 + l31) * 512 + hh * 128 + 8 * hf; const bf16_t* kr1 = kr0 + 32 * 512;
            const bf16_t* qr0 = dq + (size_t)(tok0 + l31) * 512 + hh * 128 + 8 * hf; const bf16_t* qr1 = qr0 + 32 * 512;
#pragma unroll
            for (int s = 0; s < 8; ++s) {
                const bf16x8 k0 = *(const bf16x8*)(kr0 + s * 16), k1 = *(const bf16x8*)(kr1 + s * 16), q0 = *(const bf16x8*)(qr0 + s * 16), q1 = *(const bf16x8*)(qr1 + s * 16);
                kk00 = __builtin_amdgcn_mfma_f32_32x32x16_bf16(k0, k0, kk00, 0, 0, 0);
                kk10 = __builtin_amdgcn_mfma_f32_32x32x16_bf16(k1, k0, kk10, 0, 0, 0);
                kk11 = __builtin_amdgcn_mfma_f32_32x32x16_bf16(k1, k1, kk11, 0, 0, 0);
                qk00 = __builtin_amdgcn_mfma_f32_32x32x16_bf16(q0, k0, qk00, 0, 0, 0);
                qk10 = __builtin_amdgcn_mfma_f32_32x32x16_bf16(q1, k0, qk10, 0, 0, 0);
                qk11 = __builtin_amdgcn_mfma_f32_32x32x16_bf16(q1, k1, qk11, 0, 0, 0);
            }
        }
        __threadfence_block();
        {
            const float Gc0 = sG[l31], Gc1 = sG[32 + l31];
            float* sA0 = sA + (4 * hf) * 64 + l31;
            bf16_t* PP0 = PP + (4 * hf) * 64 + sig16(l31);
            const float* sGr = sG + 4 * hf; const float* sBr = sB + 4 * hf;
            const int jrel = l31 - 4 * hf;
#pragma unroll
            for (int r = 0; r < 16; ++r) {
                const int ro = (r & 3) + 8 * (r >> 2);
                const float Gi0 = sGr[ro], Gi1 = sGr[32 + ro], Bi0 = sBr[ro], Bi1 = sBr[32 + ro];
                {
                    const float dec = (jrel <= ro) ? __expf(Gi0 - Gc0) : 0.f;
                    sA0[ro * 64] = (jrel < ro) ? Bi0 * kk00[r] * dec : 0.f;
                    PP0[ro * 64] = f2bf(qk00[r] * dec);
                    PP0[ro * 64 + 32] = 0;
                }
                {
                    const float dec = __expf(Gi1 - Gc0);
                    sA0[(32 + ro) * 64] = Bi1 * kk10[r] * dec;
                    PP0[(32 + ro) * 64] = f2bf(qk10[r] * dec);
                }
                {
                    const float dec = (jrel <= ro) ? __expf(Gi1 - Gc1) : 0.f;
                    sA0[(32 + ro) * 64 + 32] = (jrel < ro) ? Bi1 * kk11[r] * dec : 0.f;
                    PP0[(32 + ro) * 64 + 32] = f2bf(qk11[r] * dec);
                }
            }
        }
        __threadfence_block();
        float x[64];
#pragma unroll
        for (int i = 0; i < 64; ++i) x[i] = (i == lane) ? 1.f : 0.f;
#pragma unroll
        for (int i = 1; i < 64; ++i) {
            float acc = x[i];
#pragma unroll
            for (int m4 = 0; m4 < i; m4 += 4) {
                const f32x4 a = *(const f32x4*)(sA + i * 64 + m4);
                acc -= a[0] * x[m4];
                if (m4 + 1 < i) acc -= a[1] * x[m4 + 1];
                if (m4 + 2 < i) acc -= a[2] * x[m4 + 2];
                if (m4 + 3 < i) acc -= a[3] * x[m4 + 3];
            }
            x[i] = acc;
            __builtin_amdgcn_sched_barrier(0);
        }
        __threadfence_block();
        {
            const float sw = beta * eG;
#pragma unroll
            for (int i = 0; i < 64; ++i) { sTw[i * 72 + lane] = f2bf(x[i] * sw); sTu[i * 72 + lane] = f2bf(x[i] * beta); }
        }
        __threadfence_block();
        {
            bf16x8 tw[2][4], tu[2][4];
#pragma unroll
            for (int mt = 0; mt < 2; ++mt)
#pragma unroll
                for (int s = 0; s < 4; ++s) { tw[mt][s] = *(const bf16x8*)(sTw + (mt * 32 + l31) * 72 + s * 16 + 8 * hf); tu[mt][s] = *(const bf16x8*)(sTu + (mt * 32 + l31) * 72 + s * 16 + 8 * hf); }
            const bf16_t* kTb = dkT + ((size_t)bh * 128 + l31) * NT + c * 64 + 8 * hf;
            const bf16_t* vTb = dvT + ((size_t)bh * 128 + l31) * NT + c * 64 + 8 * hf;
#pragma unroll 1
            for (int nt = 0; nt < 4; ++nt) {
                f32x16 w0, w1, u0, u1;
#pragma unroll
                for (int r = 0; r < 16; ++r) { w0[r] = 0.f; w1[r] = 0.f; u0[r] = 0.f; u1[r] = 0.f; }
#pragma unroll
                for (int s = 0; s < 4; ++s) {
                    const bf16x8 kb = *(const bf16x8*)(kTb + (size_t)nt * 32 * NT + s * 16), vb = *(const bf16x8*)(vTb + (size_t)nt * 32 * NT + s * 16);
                    w0 = __builtin_amdgcn_mfma_f32_32x32x16_bf16(tw[0][s], kb, w0, 0, 0, 0);
                    w1 = __builtin_amdgcn_mfma_f32_32x32x16_bf16(tw[1][s], kb, w1, 0, 0, 0);
                    u0 = __builtin_amdgcn_mfma_f32_32x32x16_bf16(tu[0][s], vb, u0, 0, 0, 0);
                    u1 = __builtin_amdgcn_mfma_f32_32x32x16_bf16(tu[1][s], vb, u1, 0, 0, 0);
                }
                bf16_t* WN0 = WN + (4 * hf) * 128 + nt * 32 + sig16(l31); bf16_t* U0 = Ug + (4 * hf) * 128 + nt * 32 + l31;
#pragma unroll
                for (int r = 0; r < 16; ++r) {
                    const int ro = (r & 3) + 8 * (r >> 2);
                    WN0[ro * 128] = f2bf(-w0[r]); WN0[(32 + ro) * 128] = f2bf(-w1[r]);
                    U0[ro * 128] = f2bf(u0[r]); U0[(32 + ro) * 128] = f2bf(u1[r]);
                }
            }
        }
        __threadfence_block();
    }
}

__device__ __forceinline__ bf16x8 pack_frag(const f32x16& t, int s) {
    bf16x8 f;
#pragma unroll
    for (int j = 0; j < 8; ++j) f[j] = (short)f2bf(t[8 * s + j]);
    return f;
}
__device__ __forceinline__ bf16x8 pack_frag_scaled(const f32x16& t, int s, const f32x4& sc0, const f32x4& sc1) {
    bf16x8 f;
#pragma unroll
    for (int j = 0; j < 4; ++j) { f[j] = (short)f2bf(t[8 * s + j] * sc0[j]); f[4 + j] = (short)f2bf(t[8 * s + 4 + j] * sc1[j]); }
    return f;
}
__device__ __forceinline__ bf16x8 load_perm_frag(const bf16_t* ptr) {
    const uint2 lo = *(const uint2*)ptr, hi = *(const uint2*)(ptr + 8);
    union { uint4 u; bf16x8 f; } cv; cv.u = make_uint4(lo.x, lo.y, hi.x, hi.y); return cv.f;
}
constexpr int SC_WN = 0, SC_Q = 16384, SC_KT = 32768, SC_PP = SC_KT + 128 * 144, SC_U = SC_PP + 64 * 144, SC_EG = SC_U + 16384, SC_LL = SC_EG + 256, SC_GC = SC_LL + 256, SC_BYTES = SC_GC + 16;
constexpr int SCAN_LDS = 2 * SC_BYTES;
#define SCAN_DECL uint4 wn0, wn1, wn2, wn3, q0, q1, q2, q3, kt0, kt1, kt2, kt3, pp0, pp1, u0, u1, u2, u3; float egv = 0.f, gcv = 0.f;
#define SCAN_LD4(i, WNR, UR, QR, KTR) { const int x = hl + 256 * (i); WNR = WNp[x]; UR = Up[x]; \
        QR = *(const uint4*)(dqb + (size_t)(x >> 4) * 512 + (x & 15) * 8); \
        KTR = *(const uint4*)(ktb + (size_t)(x >> 3) * NT + (x & 7) * 8); }
#define SCAN_LOAD(c) { const int ci = bh * 32 + (c); \
        const uint4* WNp = (const uint4*)(dob + DO_WN + (size_t)ci * 16384); const uint4* Up = (const uint4*)(dob + DO_U + (size_t)ci * 16384); const uint4* PPp = (const uint4*)(dob + DO_PP + (size_t)ci * 8192); \
        const bf16_t* dqb = dqh + (size_t)(c) * 64 * 512; const bf16_t* ktb = dkTh + (c) * 64; \
        SCAN_LD4(0, wn0, u0, q0, kt0) SCAN_LD4(1, wn1, u1, q1, kt1) SCAN_LD4(2, wn2, u2, q2, kt2) SCAN_LD4(3, wn3, u3, q3, kt3) \
        pp0 = PPp[hl]; pp1 = PPp[hl + 256]; \
        if (hl < 64) egv = ((const float*)(dob + DO_EG))[ci * 64 + hl]; else if (hl < 128) egv = ((const float*)(dob + DO_LL))[ci * 64 + hl - 64]; \
        if (hl == 128) gcv = ((const float*)(dob + DO_GC))[ci]; }
#define SCAN_ST4(i, WNR, UR, QR, KTR) { const int x = hl + 256 * (i); \
        { const int r = x >> 4, cc = x & 15; *(uint4*)(sbuf + SC_WN + r * 256 + ((cc ^ (r & 15)) << 4)) = WNR; } \
        *(uint4*)(sbuf + SC_U + x * 16) = UR; \
        { const int r = x >> 4, cc = x & 15, a = cc >> 1, g = cc & 1; char* row = sbuf + SC_Q + r * 256; \
          *(uint2*)(row + (((2 * a) ^ (r & 15)) << 4) + g * 8) = make_uint2(QR.x, QR.y); \
          *(uint2*)(row + (((2 * a + 1) ^ (r & 15)) << 4) + g * 8) = make_uint2(QR.z, QR.w); } \
        { const int d = x >> 3, cc = x & 7, a = cc >> 1, g = cc & 1; char* row = sbuf + SC_KT + d * 144; \
          *(uint2*)(row + (2 * a) * 16 + g * 8) = make_uint2(KTR.x, KTR.y); \
          *(uint2*)(row + (2 * a + 1) * 16 + g * 8) = make_uint2(KTR.z, KTR.w); } }
#define SCAN_STORE(bufptr) { char* sbuf = (bufptr); \
        SCAN_ST4(0, wn0, u0, q0, kt0) SCAN_ST4(1, wn1, u1, q1, kt1) SCAN_ST4(2, wn2, u2, q2, kt2) SCAN_ST4(3, wn3, u3, q3, kt3) \
        *(uint4*)(sbuf + SC_PP + (hl >> 3) * 144 + (hl & 7) * 16) = pp0; \
        *(uint4*)(sbuf + SC_PP + ((hl + 256) >> 3) * 144 + (hl & 7) * 16) = pp1; \
        if (hl < 128) ((float*)(sbuf + SC_EG))[hl] = egv; \
        if (hl == 128) *(float*)(sbuf + SC_GC) = gcv; }
__device__ __forceinline__ void dn_scan_block(const P& p, char* smem, int bh, int tid) {
    const int wave = tid >> 6, lane = tid & 63;
    const int hf = lane >> 5, l31 = lane & 31;
    const int b = bh >> 2, hh = bh & 3;
    const bool helper = wave >= 4;
    const int hl = tid - 256, sl = wave;
    bf16_t* dno = (bf16_t*)((unsigned char*)p.out + DO_DNO);
    if (helper) {
        const unsigned char* dob = (const unsigned char*)p.out;
        const bf16_t* dqh = (const bf16_t*)(p.ws + WS_DQ) + (size_t)b * NT * 512 + hh * 128; const bf16_t* dkTh = (const bf16_t*)(p.ws + WS_DKT) + (size_t)bh * 128 * NT;
        SCAN_DECL
        SCAN_LOAD(0) SCAN_STORE(smem) SCAN_LOAD(1)
        __syncthreads();
#pragma unroll 1
        for (int c = 0; c < NT / 64; ++c) {
            if (c + 1 < NT / 64) SCAN_STORE(smem + ((c + 1) & 1) * SC_BYTES)
            if (c + 2 < NT / 64) SCAN_LOAD(c + 2)
            __syncthreads();
        }
        return;
    }
    f32x16 S[4];
#pragma unroll
    for (int T = 0; T < 4; ++T)
#pragma unroll
        for (int r = 0; r < 16; ++r) S[T][r] = 0.f;
    __syncthreads();
#pragma unroll 1
    for (int c = 0; c < NT / 64; ++c) {
        char* buf = smem + (c & 1) * SC_BYTES;
        {
            const int tok0 = b * NT + c * 64;
            const int sw = l31 & 15;
            const char* wnr = buf + SC_WN + l31 * 256; const char* qr = buf + SC_Q + l31 * 256;
            const char* ktr = buf + SC_KT + l31 * 144 + 16 * hf; const char* ppr = buf + SC_PP + l31 * 144 + 16 * hf;
            const bf16_t* ur = (const bf16_t*)(buf + SC_U) + sl * 32 + l31;
            const float* egs = (const float*)(buf + SC_EG); const float* lls = (const float*)(buf + SC_LL);
            const float gc = *(const float*)(buf + SC_GC);
            bf16x8 SB[4][2];
#pragma unroll
            for (int T = 0; T < 4; ++T) { SB[T][0] = pack_frag(S[T], 0); SB[T][1] = pack_frag(S[T], 1); }
            f32x16 D[2], O[2];
#pragma unroll
            for (int mt = 0; mt < 2; ++mt)
#pragma unroll
                for (int r = 0; r < 16; ++r) { D[mt][r] = bf2f(ur[(mt * 32 + (r & 3) + 8 * (r >> 2) + 4 * hf) * 128]); O[mt][r] = 0.f; }
#pragma unroll
            for (int mt = 0; mt < 2; ++mt)
#pragma unroll
                for (int T = 0; T < 4; ++T)
#pragma unroll
                    for (int s = 0; s < 2; ++s) {
                        const int co = (((2 * (2 * T + s) + hf) ^ sw) << 4) + mt * 32 * 256;
                        const bf16x8 wa = *(const bf16x8*)(wnr + co);
                        const bf16x8 qa = *(const bf16x8*)(qr + co);
                        D[mt] = __builtin_amdgcn_mfma_f32_32x32x16_bf16(wa, SB[T][s], D[mt], 0, 0, 0);
                        O[mt] = __builtin_amdgcn_mfma_f32_32x32x16_bf16(qa, SB[T][s], O[mt], 0, 0, 0);
                    }
            __builtin_amdgcn_sched_barrier(0);
            bf16x8 DB[2][2], DL[2][2];
#pragma unroll
            for (int mt = 0; mt < 2; ++mt) {
#pragma unroll
                for (int g4 = 0; g4 < 4; ++g4) {
                    const f32x4 eg = *(const f32x4*)(egs + mt * 32 + g4 * 8 + 4 * hf);
#pragma unroll
                    for (int j = 0; j < 4; ++j) O[mt][g4 * 4 + j] *= eg[j];
                }
                const f32x4 l0 = *(const f32x4*)(lls + mt * 32 + 0 + 4 * hf), l1 = *(const f32x4*)(lls + mt * 32 + 8 + 4 * hf);
                const f32x4 l2 = *(const f32x4*)(lls + mt * 32 + 16 + 4 * hf), l3 = *(const f32x4*)(lls + mt * 32 + 24 + 4 * hf);
                DB[mt][0] = pack_frag(D[mt], 0); DB[mt][1] = pack_frag(D[mt], 1);
                DL[mt][0] = pack_frag_scaled(D[mt], 0, l0, l1); DL[mt][1] = pack_frag_scaled(D[mt], 1, l2, l3);
            }
#pragma unroll
            for (int mt = 0; mt < 2; ++mt)
#pragma unroll
                for (int ks = 0; ks < 4; ++ks) {
                    const bf16x8 pa = *(const bf16x8*)(ppr + mt * 32 * 144 + ks * 32);
                    O[mt] = __builtin_amdgcn_mfma_f32_32x32x16_bf16(pa, DB[ks >> 1][ks & 1], O[mt], 0, 0, 0);
                }
            __builtin_amdgcn_sched_barrier(0);
            {
                bf16_t* orow = dno + (size_t)tok0 * 512 + hh * 128 + sl * 32 + l31;
#pragma unroll
                for (int mt = 0; mt < 2; ++mt)
#pragma unroll
                    for (int r = 0; r < 16; ++r) orow[(size_t)(mt * 32 + (r & 3) + 8 * (r >> 2) + 4 * hf) * 512] = f2bf(O[mt][r]);
            }
#pragma unroll
            for (int T = 0; T < 4; ++T) {
#pragma unroll
                for (int r = 0; r < 16; ++r) S[T][r] *= gc;
#pragma unroll
                for (int ks = 0; ks < 4; ++ks) {
                    const bf16x8 ka = *(const bf16x8*)(ktr + T * 32 * 144 + ks * 32);
                    S[T] = __builtin_amdgcn_mfma_f32_32x32x16_bf16(ka, DL[ks >> 1][ks & 1], S[T], 0, 0, 0);
                }
            }
        }
        __syncthreads();
    }
}

__device__ __forceinline__ void ph_dn_gate(const P& p) {
    const int tid = tid_opaque();
    const int lane = tid & 63, wave = tid >> 6;
    const bf16_t* dno = (const bf16_t*)((const unsigned char*)p.out + DO_DNO); const bf16_t* proj = (const bf16_t*)(p.ws + WS_PROJ); bf16_t* dnn = (bf16_t*)(p.ws + WS_DK);
    for (int tok = blockIdx.x * NWAVES + wave; tok < NTOK; tok += gridDim.x * NWAVES) {
#pragma unroll
        for (int hh = 0; hh < 4; ++hh) {
            const unsigned orw = *(const unsigned*)(dno + (size_t)tok * 512 + hh * 128 + lane * 2);
            const float o0 = __uint_as_float(orw << 16), o1 = __uint_as_float(orw & 0xffff0000u);
            const float ss = wave_sum(o0 * o0 + o1 * o1);
            const float rs = rsqrtf(ss * (1.f / 128.f) + EPS);
            const unsigned zr = *(const unsigned*)(proj + (size_t)tok * NPROJ + PC_DNZ + hh * 128 + lane * 2);
            const float z0 = __uint_as_float(zr << 16), z1 = __uint_as_float(zr & 0xffff0000u);
            *(unsigned*)(dnn + (size_t)tok * 512 + hh * 128 + lane * 2) = pack2(o0 * rs * p.dn_norm_g[lane * 2] * silu_f(z0), o1 * rs * p.dn_norm_g[lane * 2 + 1] * silu_f(z1));
        }
    }
}

struct EpiOut {
    static constexpr bool PERM = false;
    const float* x; float* out; const float* modf;
    __device__ __forceinline__ void operator()(const f32x4 (&acc)[2][2][4][2], const pg8::DenseSrc::Unit& u, int wr, int wc, int fr, int fq) const {
        const int row0 = u.pm * 256 + wr * 64 + fr, col0 = u.pn * 256 + wc * 32 + 4 * fq;
        const float* gate = modf + (size_t)((u.pm * 256) / NT) * (6 * ND) + 2 * ND;
        f32x4 gv[2][2];
#pragma unroll
        for (int bj = 0; bj < 2; ++bj)
#pragma unroll
            for (int n = 0; n < 2; ++n) gv[bj][n] = *(const f32x4*)(gate + col0 + bj * 128 + n * 16);
#pragma unroll
        for (int ai = 0; ai < 2; ++ai)
#pragma unroll
            for (int m = 0; m < 4; ++m) { const size_t ro = (size_t)(row0 + ai * 128 + m * 16) * ND + col0;
#pragma unroll
                for (int bj = 0; bj < 2; ++bj)
#pragma unroll
                    for (int n = 0; n < 2; ++n) { const f32x4 xv = *(const f32x4*)(x + ro + bj * 128 + n * 16); *(f32x4*)(out + ro + bj * 128 + n * 16) = xv + gv[bj][n] * acc[ai][bj][m][n]; } }
    }
};
__device__ __forceinline__ void ph_gemm_out(const P& p, char* smem) {
    const int tid = tid_opaque();
    pg8::DenseSrc S; S.A0 = (const char*)(p.ws + WS_QN); S.A1 = (const char*)(p.ws + WS_DK); S.Bt = (const char*)(p.ws + WS_WOUT); S.lda = 512; S.K = ND; S.nM = NTOK / 256; S.nN = ND / 256; S.G = gridDim.x; S.c = blockIdx.x; S.ksplit = 8;
    EpiOut E; E.x = p.x; E.out = p.out; E.modf = (const float*)(p.ws + WS_MODF);
    pg8::gemm_phase(tid, (PG8_LAS unsigned char*)smem, ND, S, E);
}

constexpr int ROUTE_LDS = 1024 * 37 * 4 + 2 * 1024 * 4 + 2048;
__device__ __forceinline__ void ph_route(const P& p, char* smem) {
    const int tid = tid_opaque();
    float* sW = (float*)smem;
    float* sA = sW + 1024 * 37; float* sB = sA + 1024;
    int* s_cnt = (int*)(sB + 1024);
    int* s_base = s_cnt + 32; int* s_tok = s_base + 32;
    const int lane = tid & 63, wave = tid >> 6;
    {
        f32x4 tg[2], te[16];
#pragma unroll
        for (int i = 0; i < 2; ++i) tg[i] = *(const f32x4*)(p.rg_w + (size_t)(tid + i * NTHREADS) * 4);
#pragma unroll
        for (int i = 0; i < 16; ++i) te[i] = *(const f32x4*)(p.re_w + (size_t)(tid + i * NTHREADS) * 4);
#pragma unroll
        for (int i = 0; i < 2; ++i) { float* d = sW + (tid + i * NTHREADS) * 37; d[0] = tg[i][0]; d[1] = tg[i][1]; d[2] = tg[i][2]; d[3] = tg[i][3]; }
#pragma unroll
        for (int i = 0; i < 16; ++i) { const int x = tid + i * NTHREADS; float* d = sW + (x >> 3) * 37 + 4 + (x & 7) * 4; d[0] = te[i][0]; d[1] = te[i][1]; d[2] = te[i][2]; d[3] = te[i][3]; }
    }
    bf16_t* h2 = (bf16_t*)(p.ws + WS_H2);
    int* cnt = (int*)(p.ws + WS_CTL); int* list = (int*)(p.ws + WS_LIST); int* tokinfo = (int*)(p.ws + WS_TOKINFO);
    int curb = -1;
    for (int tile = blockIdx.x; tile < NTOK / 64; tile += gridDim.x) {
        const int b = tile / (NT / 64);
        __syncthreads();
        if (b != curb) {
            { const float* mf = (const float*)(p.ws + WS_MODF) + (size_t)b * (6 * ND); for (int d = tid; d < ND; d += NTHREADS) { sA[d] = p.norm2_g[d] * (1.f + mf[4 * ND + d]); sB[d] = mf[3 * ND + d]; } }
            curb = b;
        }
        if (tid < 32) s_cnt[tid] = 0;
        __syncthreads();
        for (int i2 = 0; i2 < 4; ++i2) {
            const int tokA = tile * 64 + wave * 8 + i2 * 2, tokB = tokA + 1;
            const float* xa = p.out + (size_t)tokA * ND; const float* xb = xa + ND;
            float va[16], vb[16]; float sa = 0.f, sb = 0.f;
#pragma unroll
            for (int j = 0; j < 16; ++j) { va[j] = xa[j * 64 + lane]; vb[j] = xb[j * 64 + lane]; sa += va[j] * va[j]; sb += vb[j] * vb[j]; }
            sa = wave_sum(sa); sb = wave_sum(sb);
            const float ra = rsqrtf(sa * (1.f / ND) + EPS), rb = rsqrtf(sb * (1.f / ND) + EPS);
#pragma unroll
            for (int j = 0; j < 16; ++j) {
                const int d = j * 64 + lane;
                va[j] = va[j] * ra * sA[d] + sB[d]; vb[j] = vb[j] * rb * sA[d] + sB[d];
                h2[(size_t)tokA * ND + d] = f2bf(va[j]); h2[(size_t)tokB * ND + d] = f2bf(vb[j]);
            }
            float la = 0.f, lb = 0.f;
#pragma unroll 4
            for (int o = 0; o < 36; ++o) {
                float a = 0.f, c = 0.f;
#pragma unroll
                for (int j = 0; j < 16; ++j) { const float w = sW[(j * 64 + lane) * 37 + o]; a += va[j] * w; c += vb[j] * w; }
                a = wave_sum(a); c = wave_sum(c);
                if (lane == o) { la = a; lb = c; }
            }
            const float bias = (lane < 4) ? p.rg_b[lane] : ((lane < 36) ? p.re_b[lane - 4] : 0.f);
            la += bias; lb += bias;
#pragma unroll
            for (int which = 0; which < 2; ++which) {
                const float mylogit = which ? lb : la; const int tok = which ? tokB : tokA;
                float gl[4];
#pragma unroll
                for (int j = 0; j < 4; ++j) gl[j] = __shfl(mylogit, j);
                int gsel = 0; float gm = gl[0];
#pragma unroll
                for (int j = 1; j < 4; ++j) if (gl[j] > gm) { gm = gl[j]; gsel = j; }
                float gs = 0.f;
#pragma unroll
                for (int j = 0; j < 4; ++j) gs += __expf(gl[j] - gm);
                const float gtop = 1.f / gs;
                float el[8];
#pragma unroll
                for (int j = 0; j < 8; ++j) el[j] = __shfl(mylogit, 4 + gsel * 8 + j);
                int e1 = 0; float m1 = el[0];
#pragma unroll
                for (int j = 1; j < 8; ++j) if (el[j] > m1) { m1 = el[j]; e1 = j; }
                int e2 = -1; float m2 = -INFINITY;
#pragma unroll
                for (int j = 0; j < 8; ++j) if (j != e1 && el[j] > m2) { m2 = el[j]; e2 = j; }
                const float r2 = __expf(m2 - m1);
                const float w1v = gtop / (1.f + r2), w2v = gtop * r2 / (1.f + r2);
                if (lane == 0) {
                    const int ea = gsel * 8 + e1, eb = gsel * 8 + e2;
                    const int pa = atomicAdd(&s_cnt[ea], 1), pb = atomicAdd(&s_cnt[eb], 1);
                    int* st = s_tok + (tok & 63) * 4; st[0] = ea; st[1] = pa; st[2] = eb; st[3] = pb;
                    int* ti = tokinfo + (size_t)tok * 8; ti[4] = __float_as_int(w1v); ti[5] = __float_as_int(w2v);
                }
            }
        }
        __syncthreads();
        if (tid < 32) s_base[tid] = atomicAdd(&cnt[tid], s_cnt[tid]);
        __syncthreads();
        if (tid < 64) {
            const int tok = tile * 64 + tid; const int* st = s_tok + tid * 4;
            const int ea = st[0], pa = s_base[ea] + st[1], eb = st[2], pb = s_base[eb] + st[3];
            list[ea * NTOK + pa] = tok; list[eb * NTOK + pb] = tok;
            int* ti = tokinfo + (size_t)tok * 8; ti[0] = ea; ti[1] = pa; ti[2] = eb; ti[3] = pb;
        }
    }
}

struct MoeIdx { int rowoff[NE + 1]; int tileoff[NE + 1]; };
__device__ __forceinline__ void moe_index(const int tid, const P& p, MoeIdx* mi) {
    if (tid == 0) {
        const int* cnt = (const int*)(p.ws + WS_CTL);
        int r = 0, t = 0;
        for (int e = 0; e < NE; ++e) { mi->rowoff[e] = r; mi->tileoff[e] = t; const int c = cnt[e]; r += c; t += (c + 255) >> 8; }
        mi->rowoff[NE] = r; mi->tileoff[NE] = t;
    }
    __syncthreads();
}
struct MoeSrc {
    struct Unit { int e, ml, pn, nrows, row0; };
    const MoeIdx* mi; const int* list; const char* Ab; const char* Bt; size_t bstride; int K, G, c; bool gather;
    __device__ __forceinline__ bool next(int i, Unit& u) const {
        const int L = i * G + c; if (L >= mi->tileoff[NE] * 4) return false;
        const int mt = L >> 2; u.pn = L & 3;
        int e = 0; while (mi->tileoff[e + 1] <= mt) ++e;
        u.e = e; u.ml = mt - mi->tileoff[e]; u.row0 = mi->rowoff[e] + u.ml * 256;
        u.nrows = min(256, mi->rowoff[e + 1] - u.row0);
        return true;
    }
    __device__ __forceinline__ unsigned one(const Unit& u, int r, int C) const {
        const int rr = min(r, u.nrows - 1);
        const int arow = gather ? list[u.e * NTOK + u.ml * 256 + rr] : (u.row0 + rr);
        return (unsigned)((arow * K + C) * 2);
    }
    __device__ __forceinline__ void a_off(const Unit& u, int R0, int C0, int R1, int C1, pg8::AO& ao) const {
        ao.h0p0 = one(u, R0, C0); ao.h0p1 = one(u, R1, C1); ao.h1p0 = one(u, 128 + R0, C0); ao.h1p1 = one(u, 128 + R1, C1);
    }
    __device__ __forceinline__ const char* a_base(const Unit&, int kt) const { return Ab + (size_t)kt * 128; }
    __device__ __forceinline__ const char* b_base(const Unit& u) const { return Bt + (size_t)u.e * bstride + (size_t)u.pn * 256 * K * 2; }
};
constexpr int L_MOE = pg8::STAGE_BYTES + (int)sizeof(MoeIdx) + 16;

struct EpiUp {
    static constexpr bool PERM = true;
    bf16_t* act;
    __device__ __forceinline__ void operator()(const f32x4 (&acc)[2][2][4][2], const MoeSrc::Unit& u, int wr, int wc, int fr, int fq) const {
        const int col0 = u.pn * 128 + wc * 32 + 8 * fq;
#pragma unroll
        for (int ai = 0; ai < 2; ++ai)
#pragma unroll
            for (int m = 0; m < 4; ++m) {
                const int r = ai * 128 + wr * 64 + m * 16 + fr;
                if (r < u.nrows) {
                    const f32x4 g0 = acc[ai][0][m][0], g1 = acc[ai][0][m][1], u0 = acc[ai][1][m][0], u1 = acc[ai][1][m][1];
                    *(uint4*)(act + (size_t)(u.row0 + r) * EFF + col0) = make_uint4(pack2(silu_f(g0[0]) * u0[0], silu_f(g0[1]) * u0[1]), pack2(silu_f(g0[2]) * u0[2], silu_f(g0[3]) * u0[3]),
                                                                                     pack2(silu_f(g1[0]) * u1[0], silu_f(g1[1]) * u1[1]), pack2(silu_f(g1[2]) * u1[2], silu_f(g1[3]) * u1[3]));
                }
            }
    }
};
__device__ __forceinline__ void ph_moe_up(const P& p, char* smem) {
    const int tid = tid_opaque();
    MoeIdx* mi = (MoeIdx*)(smem + pg8::STAGE_BYTES);
    moe_index(tid, p, mi);
    MoeSrc S; S.mi = mi; S.list = (const int*)(p.ws + WS_LIST); S.Ab = (const char*)(p.ws + WS_H2); S.Bt = (const char*)(p.ws + WS_W13); S.bstride = (size_t)1024 * ND * 2; S.K = ND; S.G = gridDim.x; S.c = blockIdx.x; S.gather = true;
    EpiUp E; E.act = (bf16_t*)(p.ws + WS_ACT);
    pg8::gemm_phase(tid, (PG8_LAS unsigned char*)smem, ND, S, E);
}

struct EpiDown {
    static constexpr bool PERM = true;
    bf16_t* yb;
    __device__ __forceinline__ void operator()(const f32x4 (&acc)[2][2][4][2], const MoeSrc::Unit& u, int wr, int wc, int fr, int fq) const {
        const int col0 = u.pn * 256 + wc * 32 + 8 * fq;
#pragma unroll
        for (int ai = 0; ai < 2; ++ai)
#pragma unroll
            for (int m = 0; m < 4; ++m) {
                const int r = ai * 128 + wr * 64 + m * 16 + fr;
                if (r < u.nrows) {
#pragma unroll
                    for (int bj = 0; bj < 2; ++bj) { const f32x4 v0 = acc[ai][bj][m][0], v1 = acc[ai][bj][m][1];
                        *(uint4*)(yb + (size_t)(u.row0 + r) * ND + col0 + bj * 128) = make_uint4(pack2(v0[0], v0[1]), pack2(v0[2], v0[3]), pack2(v1[0], v1[1]), pack2(v1[2], v1[3])); }
                }
            }
    }
};
__device__ __forceinline__ void ph_moe_down(const P& p, char* smem) {
    const int tid = tid_opaque();
    MoeIdx* mi = (MoeIdx*)(smem + pg8::STAGE_BYTES);
    moe_index(tid, p, mi);
    MoeSrc S; S.mi = mi; S.list = nullptr; S.Ab = (const char*)(p.ws + WS_ACT); S.Bt = (const char*)(p.ws + WS_W2); S.bstride = (size_t)ND * EFF * 2; S.K = EFF; S.G = gridDim.x; S.c = blockIdx.x; S.gather = false;
    EpiDown E; E.yb = (bf16_t*)(p.ws + WS_YBUF);
    pg8::gemm_phase(tid, (PG8_LAS unsigned char*)smem, EFF, S, E);
}

__device__ __forceinline__ void ph_combine(const P& p, char* smem) {
    const int tid = tid_opaque();
    MoeIdx* mi = (MoeIdx*)smem;
    float* sG = (float*)(mi + 1);
    moe_index(tid, p, mi);
    const int lane = tid & 63, wave = tid >> 6;
    const bf16_t* yb = (const bf16_t*)(p.ws + WS_YBUF); const int* tokinfo = (const int*)(p.ws + WS_TOKINFO);
    int curb = -1;
    for (int tile = blockIdx.x; tile < NTOK / 64; tile += gridDim.x) {
        const int b = tile / (NT / 64);
        if (b != curb) {
            __syncthreads();
            { const float* mf = (const float*)(p.ws + WS_MODF) + (size_t)b * (6 * ND) + 5 * ND; for (int d = tid; d < ND; d += NTHREADS) sG[d] = mf[d]; }
            __syncthreads();
            curb = b;
        }
        for (int i = 0; i < 8; ++i) {
            const int tok = tile * 64 + wave * 8 + i;
            const int* ti = tokinfo + (size_t)tok * 8;
            const int ra = mi->rowoff[ti[0]] + ti[1], rb = mi->rowoff[ti[2]] + ti[3];
            const float wa = __int_as_float(ti[4]), wb = __int_as_float(ti[5]);
#pragma unroll
            for (int j = 0; j < 4; ++j) {
                const int d = j * 256 + lane * 4;
                const uint2 ya = *(const uint2*)(yb + (size_t)ra * ND + d), ybv = *(const uint2*)(yb + (size_t)rb * ND + d);
                f32x4 xv = *(const f32x4*)(p.out + (size_t)tok * ND + d);
                xv[0] += sG[d] * (wa * __uint_as_float(ya.x << 16) + wb * __uint_as_float(ybv.x << 16));
                xv[1] += sG[d + 1] * (wa * __uint_as_float(ya.x & 0xffff0000u) + wb * __uint_as_float(ybv.x & 0xffff0000u));
                xv[2] += sG[d + 2] * (wa * __uint_as_float(ya.y << 16) + wb * __uint_as_float(ybv.y << 16));
                xv[3] += sG[d + 3] * (wa * __uint_as_float(ya.y & 0xffff0000u) + wb * __uint_as_float(ybv.y & 0xffff0000u));
                *(f32x4*)(p.out + (size_t)tok * ND + d) = xv;
            }
        }
    }
}

#define XB_TMO      128
#define XB_XCNT(j)  (256  + 64 * (j))
#define XB_XSUB(j)  (1280 + 64 * (j))
#define XB_XGEN(j)  (2304 + 64 * (j))
#define XB_TOP      3328
#define XB_TOPGEN   3392
#define XCD_BAR_WORDS 3456
#define XB_SPIN_CAP (1u << 20)
#define LAS __attribute__((address_space(3)))
__device__ __forceinline__ unsigned xb_ld(unsigned* p)              { return __hip_atomic_load(p, __ATOMIC_RELAXED, __HIP_MEMORY_SCOPE_AGENT); }
__device__ __forceinline__ unsigned xb_add(unsigned* p, unsigned v) { return __hip_atomic_fetch_add(p, v, __ATOMIC_RELAXED, __HIP_MEMORY_SCOPE_AGENT); }
__device__ __forceinline__ unsigned xb_xcc_id() { return (unsigned)__builtin_amdgcn_s_getreg((3 << 11) | 20) & 0xFu; }
#define XB_SPIN(cond, bar) do { unsigned _sp = 0; while (cond) { __builtin_amdgcn_s_sleep(1); \
    if ((++_sp & 255u) == 0u) { if (xb_ld(&(bar)[XB_TMO])) break; if (_sp > XB_SPIN_CAP) { atomicAdd(&(bar)[XB_TMO], 1u); break; } } } } while (0)
struct XcdBarrier { unsigned* bar; unsigned x; volatile LAS unsigned* st; };
__device__ __forceinline__ XcdBarrier xcd_barrier_post(unsigned* bar, volatile LAS unsigned* st) {
    XcdBarrier b; b.bar = bar; b.x = xb_xcc_id(); b.st = st;
    if (threadIdx.x == 0) (void)xb_add(&bar[XB_XCNT(b.x)], 1u);
    return b;
}
__device__ __forceinline__ void xcd_barrier_complete(unsigned* bar, unsigned x, unsigned& nloc, unsigned& nx) {
    const unsigned G = gridDim.x * gridDim.y * gridDim.z;
    unsigned sum, cnt, mine, sp = 0u;
    for (;;) {
        sum = 0u; cnt = 0u; mine = 0u;
#pragma unroll
        for (unsigned j = 0; j < 16; ++j) { const unsigned c = xb_ld(&bar[XB_XCNT(j)]); sum += c; cnt += (c > 0u) ? 1u : 0u; mine = (j == x) ? c : mine; }
        if (sum == G) break;
        __builtin_amdgcn_s_sleep(1);
        if ((++sp & 255u) == 0u) { if (xb_ld(&bar[XB_TMO])) break; if (sp > XB_SPIN_CAP) { atomicAdd(&bar[XB_TMO], 1u); break; } }
    }
    nloc = mine > 0u ? mine : 1u; nx = cnt > 0u ? cnt : 1u;
}
__device__ __forceinline__ void xcd_barrier(const XcdBarrier& b) {
    asm volatile("s_waitcnt vmcnt(0)" ::: "memory");
    __syncthreads();
    if (threadIdx.x == 0) {
        unsigned* bar = b.bar;
        __builtin_amdgcn_s_waitcnt(0);
        unsigned nloc = b.st[0], nx = b.st[1];
        if (nloc == 0u) { xcd_barrier_complete(bar, b.x, nloc, nx); b.st[0] = nloc; b.st[1] = nx; }
        const unsigned old = xb_add(&bar[XB_XSUB(b.x)], 1u);
        const unsigned gen = old / nloc;
        if (old + 1u == (gen + 1u) * nloc) {
            __builtin_amdgcn_fence(__ATOMIC_RELEASE, "agent");
            asm volatile("s_waitcnt vmcnt(0)" ::: "memory");
            const unsigned og = xb_add(&bar[XB_TOP], 1u);
            const unsigned tg = og / nx;
            if (og + 1u == (tg + 1u) * nx) xb_add(&bar[XB_TOPGEN], 1u);
            else XB_SPIN(xb_ld(&bar[XB_TOPGEN]) == tg, bar);
            __builtin_amdgcn_fence(__ATOMIC_ACQUIRE, "agent");
            xb_add(&bar[XB_XGEN(b.x)], 1u);
            asm volatile("s_waitcnt vmcnt(0)" ::: "memory");
        } else {
            XB_SPIN(xb_ld(&bar[XB_XGEN(b.x)]) == gen, bar);
            __builtin_amdgcn_fence(__ATOMIC_ACQUIRE, "agent");
            asm volatile("s_waitcnt vmcnt(0)" ::: "memory");
        }
    }
    __syncthreads();
}

namespace cg = cooperative_groups;
extern __shared__ __attribute__((aligned(16))) char dyn_smem[];
constexpr int cmax(int a, int b) { return a > b ? a : b; }
constexpr int L_G1 = pg8::STAGE_BYTES;
constexpr int MEGA_LDS = cmax(cmax(cmax(ROUTE_LDS, PREP_LDS), cmax(cmax(AT_BUF + SCAN_LDS, ATTM_LDS), L_G1)), L_MOE);
typedef const unsigned long long __attribute__((address_space(4)))* kargp_t;
__device__ __forceinline__ void load_params(P& p, kargp_t ka) {
    asm volatile("" : "+s"(ka));
    typedef __attribute__((address_space(1))) char* gptr_t;
    const void** d = (const void**)&p;
#pragma unroll
    for (int i = 0; i < (int)(sizeof(P) / 8); ++i) d[i] = (const void*)(gptr_t)ka[i];
}
#define PHASE(call) do { P p; load_params(p, ka); call; } while (0)
#ifndef PROBE_MODE
#define PROBE_MODE 0
#endif
#ifndef PROBE_K
#define PROBE_K -1
#endif
template <int KMAX>
__device__ __forceinline__ void run_phases(cg::grid_group& grid, const XcdBarrier& xb, kargp_t ka, char* smem) {
    if constexpr (KMAX >= 0) { PHASE(ph_mod_partial(p, smem)); PHASE(ph_convert(p, smem)); grid.sync(); }
    if constexpr (KMAX >= 1) { PHASE(ph_norm1(p, smem)); xcd_barrier(xb); }
    if constexpr (KMAX >= 2) { PHASE(ph_gemm1(p, smem)); xcd_barrier(xb); }
    if constexpr (KMAX >= 3) { PHASE(ph_post(p, smem)); xcd_barrier(xb); }
    if constexpr (KMAX >= 4) { PHASE(ph_dn_prep(p, smem)); xcd_barrier(xb); }
    if constexpr (KMAX >= 5) { PHASE(ph_attn_mfma<(KMAX == 5 ? PROBE_MODE : 0)>(p, smem)); xcd_barrier(xb); }
    if constexpr (KMAX >= 6) { PHASE(ph_dn_gate(p)); xcd_barrier(xb); }
    if constexpr (KMAX >= 7) { PHASE(ph_gemm_out(p, smem)); xcd_barrier(xb); }
    if constexpr (KMAX >= 8) { PHASE(ph_route(p, smem)); xcd_barrier(xb); }
    if constexpr (KMAX >= 9) { PHASE(ph_moe_up(p, smem)); xcd_barrier(xb); }
    if constexpr (KMAX >= 10) { PHASE(ph_moe_down(p, smem)); xcd_barrier(xb); }
    if constexpr (KMAX >= 11) { PHASE(ph_combine(p, smem)); }
}
__global__ void __launch_bounds__(NTHREADS) mega(P p_arg) {
    cg::grid_group grid = cg::this_grid();
    char* smem = dyn_smem;
    kargp_t ka = (kargp_t)__builtin_amdgcn_kernarg_segment_ptr();
    volatile LAS unsigned* xst = (volatile LAS unsigned*)(smem + MEGA_LDS);
    if (threadIdx.x < 4) xst[threadIdx.x] = 0u;
    __syncthreads();
    XcdBarrier xb;
    { P p; load_params(p, ka); xb = xcd_barrier_post((unsigned*)(p.ws + WS_BAR), xst); }
    if constexpr (PROBE_K >= 0) {
        run_phases<PROBE_K>(grid, xb, ka, smem);
        if (PROBE_MODE == 20) { for (int i = 0; i < 20; ++i) xcd_barrier(xb); }
        P p; load_params(p, ka);
        if (blockIdx.x == 0 && threadIdx.x < 256) ((int*)(p.ws + WS_CTL))[threadIdx.x] = 0;
        xcd_barrier(xb);
    }
    run_phases<99>(grid, xb, ka, smem);
}

extern "C" void kernel_launch(void* const* d_in, const int* in_sizes, int n_in, void* d_out, int out_size, void* d_ws, size_t ws_size, hipStream_t stream) {
    if (n_in != 26 || out_size != NTOK * ND || ws_size < WS_END) { fprintf(stderr, "kernel_launch: unexpected shapes (n_in %d out %d ws %zu need %zu)\n", n_in, out_size, ws_size, (size_t)WS_END); return; }
    static int grid_blocks = 0;
    if (!grid_blocks) {
        int dev = 0, cus = 0, per_cu = 0;
        (void)hipGetDevice(&dev);
        (void)hipDeviceGetAttribute(&cus, hipDeviceAttributeMultiprocessorCount, dev);
        (void)hipFuncSetAttribute((const void*)mega, hipFuncAttributeMaxDynamicSharedMemorySize, MEGA_LDS + 16);
        (void)hipOccupancyMaxActiveBlocksPerMultiprocessor(&per_cu, (const void*)mega, NTHREADS, MEGA_LDS + 16);
        if (per_cu < 1) { fprintf(stderr, "kernel_launch: occupancy query says %d blocks/CU\n", per_cu); per_cu = 1; }
        grid_blocks = cus * per_cu;
    }
    P p{};
    const float** fp = (const float**)&p;
    for (int i = 0; i < 26; ++i) fp[i] = (const float*)d_in[i];
    p.pos = (const int*)d_in[2];
    p.out = (float*)d_out; p.ws = (unsigned char*)d_ws;
    (void)hipMemsetAsync((char*)d_ws + WS_CTL, 0, 32768, stream);
    void* args[] = {&p};
    hipError_t e = hipLaunchCooperativeKernel((const void*)mega, dim3(grid_blocks), dim3(NTHREADS), args, MEGA_LDS + 16, stream);
    if (e != hipSuccess) fprintf(stderr, "cooperative launch failed: %s (grid %d)\n", hipGetErrorString(e), grid_blocks);
}
```

```cpp
#include <hip/hip_runtime.h>
#include <hip/hip_cooperative_groups.h>
#include <cstdio>
#include <cstdint>

typedef unsigned short bf16_t;
typedef short bf16x8 __attribute__((ext_vector_type(8)));
typedef float f32x16 __attribute__((ext_vector_type(16)));
typedef float f32x4 __attribute__((ext_vector_type(4)));

constexpr int NB = 8, NT = 2048, ND = 1024, NTOK = NB * NT;
constexpr int NPROJ = 3072;
constexpr int PC_QATT = 0, PC_KVLAT = 512, PC_QIDX = 640, PC_DNQKV = 896, PC_DNZ = 2432, PC_KIDX = 2944, PC_WIDX = 2976, PC_BETA = 2984, PC_A = 2988;
constexpr int W_IN_SRC = 2992;
constexpr int NE = 32, EFF = 512;
constexpr int KSPLIT = 16;
constexpr int NTHREADS = 512, NWAVES = 8;
constexpr float EPS = 1e-6f;
constexpr float LOG2E = 1.4426950408889634f;

constexpr size_t MiB = 1ull << 20;
constexpr size_t WS_CTL = 0;
constexpr size_t WS_BAR = WS_CTL + 16 * 1024;
constexpr size_t WS_MODF = WS_CTL + 256 * 1024;
constexpr size_t WS_MODP = WS_CTL + 1 * MiB;
constexpr size_t WS_WIN = WS_MODP + 3 * MiB;
constexpr size_t WS_WOUT = WS_WIN + 6 * MiB;
constexpr size_t WS_W13 = WS_WOUT + 2 * MiB;
constexpr size_t WS_W2 = WS_W13 + 64 * MiB;
constexpr size_t WS_PROJ = WS_W2 + 32 * MiB;
constexpr size_t WS_ACT = WS_PROJ;
constexpr size_t WS_YBUF = WS_PROJ + 32 * MiB;
constexpr size_t WS_QN = WS_PROJ + 96 * MiB;
constexpr size_t WS_K = WS_QN + 16 * MiB;
constexpr size_t WS_KI = WS_K + 2 * MiB;
constexpr size_t WS_WI = WS_KI + 1 * MiB;
constexpr size_t WS_DBG = WS_WI + 512 * 1024;
constexpr size_t WS_DQ = WS_DBG + 512 * 1024;
constexpr size_t WS_DK = WS_DQ + 16 * MiB;
constexpr size_t WS_H2 = WS_DQ;
constexpr size_t WS_DKT = WS_DK + 16 * MiB;
constexpr size_t WS_DVT = WS_DKT + 16 * MiB;
constexpr size_t WS_END = WS_DVT + 16 * MiB;
constexpr size_t WS_LIST = WS_K;
constexpr size_t WS_TOKINFO = WS_KI;
constexpr size_t WS_VT = WS_WIN;
constexpr size_t WS_POSMM = WS_WIN + 2 * MiB;
constexpr size_t DO_WN = 0, DO_U = 16 * MiB, DO_DNO = 32 * MiB, DO_PP = 48 * MiB, DO_EG = 56 * MiB, DO_LL = DO_EG + 256 * 1024, DO_GC = DO_LL + 256 * 1024;

struct P {
    const float* x; const float* c; const int* pos; const float* ada_w; const float* ada_b; const float* norm1_g; const float* norm2_g;
    const float* w_in; const float* q_norm_g; const float* k_norm_g; const float* kv_norm_g; const float* w_kv_up; const float* idx_k_norm_g;
    const float* rel_bias; const float* conv_w; const float* a_log; const float* dt_bias; const float* dn_norm_g; const float* w_out;
    const float* rg_w; const float* rg_b; const float* re_w; const float* re_b; const float* w1; const float* w3; const float* w2;
    float* out; unsigned char* ws;
};

__device__ __forceinline__ float bf2f(bf16_t h) { return __uint_as_float(((unsigned)h) << 16); }
__device__ __forceinline__ bf16_t f2bf(float f) { unsigned u = __float_as_uint(f); u += 0x7fffu + ((u >> 16) & 1u); return (bf16_t)(u >> 16); }
__device__ __forceinline__ unsigned pack2(float a, float b) { unsigned r; asm volatile("v_cvt_pk_bf16_f32 %0, %1, %2" : "=v"(r) : "v"(a), "v"(b)); return r; }
template <int CTRL> __device__ __forceinline__ float dpp_f(float v) { return __int_as_float(__builtin_amdgcn_update_dpp(0, __float_as_int(v), CTRL, 0xF, 0xF, false)); }
template <int CTRL> __device__ __forceinline__ int dpp_i(int v) { return __builtin_amdgcn_update_dpp(0, v, CTRL, 0xF, 0xF, false); }
__device__ __forceinline__ float wave_sum(float v) {
    v += dpp_f<0xB1>(v); v += dpp_f<0x4E>(v); v += dpp_f<0x141>(v); v += dpp_f<0x140>(v);
    v += __shfl_xor(v, 16); v += __shfl_xor(v, 32);
    return v;
}
__device__ __forceinline__ float wave_max(float v) {
#pragma unroll
    for (int o = 32; o >= 1; o >>= 1) v = fmaxf(v, __shfl_xor(v, o));
    return v;
}
__device__ __forceinline__ int wave_isum(int v) {
#pragma unroll
    for (int o = 32; o >= 1; o >>= 1) v += __shfl_xor(v, o);
    return v;
}
__device__ __forceinline__ int tid_opaque() { int t = threadIdx.x; asm volatile("" : "+v"(t)); return t; }
__device__ __forceinline__ float silu_f(float x) { return x / (1.f + __expf(-x)); }
__device__ __forceinline__ float sigmoid_f(float x) { return 1.f / (1.f + __expf(-x)); }
__device__ __forceinline__ float mod_val(const P& p, int b, int which, int d) {
    const float* mp = (const float*)(p.ws + WS_MODP);
    const int col = which * ND + d;
    float s = p.ada_b[col];
#pragma unroll
    for (int ks = 0; ks < KSPLIT; ++ks) s += mp[(size_t)(ks * NB + b) * (6 * ND) + col];
    return s;
}

__device__ __forceinline__ void ph_mod_partial(const P& p, char* smem) {
    const int tid = tid_opaque();
    const int lane = tid & 63, wave = tid >> 6;
    float* sc = (float*)smem;
    for (int i = tid; i < NB * ND; i += NTHREADS) sc[i] = silu_f(p.c[i]);
    __syncthreads();
    float* mp = (float*)(p.ws + WS_MODP);
    const int nitem = 96 * KSPLIT;
    for (int it = blockIdx.x * NWAVES + wave; it < nitem; it += gridDim.x * NWAVES) {
        const int cg = it % 96, ks = it / 96;
        const int col = cg * 64 + lane;
        float acc[NB];
#pragma unroll
        for (int b = 0; b < NB; ++b) acc[b] = 0.f;
#pragma unroll 8
        for (int kk = 0; kk < ND / KSPLIT; ++kk) {
            const int k = ks * (ND / KSPLIT) + kk;
            const float w = p.ada_w[(size_t)k * (6 * ND) + col];
#pragma unroll
            for (int b = 0; b < NB; ++b) acc[b] += sc[b * ND + k] * w;
        }
#pragma unroll
        for (int b = 0; b < NB; ++b) mp[(size_t)(ks * NB + b) * (6 * ND) + col] = acc[b];
    }
    __syncthreads();
}

__device__ __forceinline__ int win_src_col(int n) {
    if (n < 896) return n;
    if (n < 2944) return n + 40;
    if (n < 2976) return n - 2944 + 896;
    if (n < 2984) return n - 2976 + 928;
    if (n < 2992) return n;
    return -1;
}
__device__ __forceinline__ void conv_tile_wave(const int lane, float* tile, const float* src0, int nsrc, int mode, int n0, int k0, bf16_t* dst, int K, int sc0) {
    if (mode == 1) {
        const int col = win_src_col(n0 + lane);
#pragma unroll 8
        for (int k = 0; k < 64; ++k) tile[k * 65 + lane] = (col >= 0) ? src0[(size_t)(k0 + k) * nsrc + col] : 0.f;
    } else {
        const int kr = lane >> 4, c4 = lane & 15;
        const float* src = src0; const int col = sc0 + c4 * 4;
        f32x4 v[16];
#pragma unroll
        for (int i = 0; i < 16; ++i) v[i] = *(const f32x4*)(src + (size_t)(k0 + i * 4 + kr) * nsrc + col);
#pragma unroll
        for (int i = 0; i < 16; ++i) { float* t = tile + (i * 4 + kr) * 65 + c4 * 4; t[0] = v[i][0]; t[1] = v[i][1]; t[2] = v[i][2]; t[3] = v[i][3]; }
    }
    __threadfence_block();
    {
        const int kc = lane & 7, nr = lane >> 3;
#pragma unroll
        for (int i = 0; i < 8; ++i) {
            const int n = i * 8 + nr;
            unsigned w[4];
#pragma unroll
            for (int j = 0; j < 4; ++j) w[j] = pack2(tile[(kc * 8 + 2 * j) * 65 + n], tile[(kc * 8 + 2 * j + 1) * 65 + n]);
            *(uint4*)(dst + (size_t)(n0 + n) * K + k0 + kc * 8) = make_uint4(w[0], w[1], w[2], w[3]);
        }
    }
    __threadfence_block();
}
__device__ __forceinline__ void ph_convert(const P& p, char* smem) {
    const int tid = tid_opaque();
    const int lane = tid & 63, wave = tid >> 6;
    float* tile = (float*)smem + wave * (64 * 65);
    bf16_t* Wt_in = (bf16_t*)(p.ws + WS_WIN); bf16_t* Wt_out = (bf16_t*)(p.ws + WS_WOUT);
    bf16_t* Wt13 = (bf16_t*)(p.ws + WS_W13); bf16_t* Wt2 = (bf16_t*)(p.ws + WS_W2);
    const int T0 = 48 * 16, T1 = 16 * 16, T2 = NE * 256, T3 = NE * 128;
    const int total = T0 + T1 + T2 + T3;
    for (int t = blockIdx.x * NWAVES + wave; t < total; t += gridDim.x * NWAVES) {
        if (t < T0) { const int nt = t / 16, kt = t % 16; conv_tile_wave(lane, tile, p.w_in, W_IN_SRC, 1, nt * 64, kt * 64, Wt_in, ND, 0); }
        else if (t < T0 + T1) { const int u = t - T0; const int nt = u / 16, kt = u % 16; conv_tile_wave(lane, tile, p.w_out, ND, 0, nt * 64, kt * 64, Wt_out, ND, nt * 64); }
        else if (t < T0 + T1 + T2) { const int u = t - T0 - T1; const int e = u / 256, v = u % 256; const int nt = v / 16, kt = v % 16;
            const int pn = nt >> 2, within = nt & 3;
            const float* srcw = ((within >= 2) ? p.w3 : p.w1) + (size_t)e * ND * EFF;
            conv_tile_wave(lane, tile, srcw, EFF, 0, nt * 64, kt * 64, Wt13 + (size_t)e * 1024 * ND, ND, pn * 128 + (within & 1) * 64); }
        else { const int u = t - T0 - T1 - T2; const int e = u / 128, v = u % 128; const int nt = v / 8, kt = v % 8;
            conv_tile_wave(lane, tile, p.w2 + (size_t)e * EFF * ND, ND, 0, nt * 64, kt * 64, Wt2 + (size_t)e * ND * EFF, EFF, nt * 64); }
    }
}

__device__ __forceinline__ void ph_norm1(const P& p, char* smem) {
    const int tid = tid_opaque();
    float* sA = (float*)smem; float* sB = sA + ND;
    const int lane = tid & 63, wave = tid >> 6;
    bf16_t* h = (bf16_t*)p.out;
    {
        float* mf = (float*)(p.ws + WS_MODF);
        for (int i = blockIdx.x * NTHREADS + tid; i < NB * 6 * ND; i += gridDim.x * NTHREADS) mf[i] = mod_val(p, i / (6 * ND), (i % (6 * ND)) / ND, i % ND);
    }
    int curb = -1;
    for (int tile = blockIdx.x; tile < NTOK / 64; tile += gridDim.x) {
        const int b = tile / (NT / 64);
        if (b != curb) {
            __syncthreads();
            for (int d = tid; d < ND; d += NTHREADS) { sA[d] = p.norm1_g[d] * (1.f + mod_val(p, b, 1, d)); sB[d] = mod_val(p, b, 0, d); }
            __syncthreads();
            curb = b;
        }
        for (int i4 = 0; i4 < 2; ++i4) {
            const int tokb = tile * 64 + wave * 8 + i4 * 4;
            f32x4 v[4][4];
#pragma unroll
            for (int q = 0; q < 4; ++q)
#pragma unroll
                for (int j = 0; j < 4; ++j) v[q][j] = *(const f32x4*)(p.x + (size_t)(tokb + q) * ND + j * 256 + lane * 4);
#pragma unroll
            for (int q = 0; q < 4; ++q) {
                float ss = 0.f;
#pragma unroll
                for (int j = 0; j < 4; ++j) ss += v[q][j][0] * v[q][j][0] + v[q][j][1] * v[q][j][1] + v[q][j][2] * v[q][j][2] + v[q][j][3] * v[q][j][3];
                ss = wave_sum(ss);
                const float rstd = rsqrtf(ss * (1.f / ND) + EPS);
#pragma unroll
                for (int j = 0; j < 4; ++j) {
                    const int d = j * 256 + lane * 4;
                    const float o0 = v[q][j][0] * rstd * sA[d] + sB[d], o1 = v[q][j][1] * rstd * sA[d + 1] + sB[d + 1], o2 = v[q][j][2] * rstd * sA[d + 2] + sB[d + 2], o3 = v[q][j][3] * rstd * sA[d + 3] + sB[d + 3];
                    *(uint2*)(h + (size_t)(tokb + q) * ND + d) = make_uint2(pack2(o0, o1), pack2(o2, o3));
                }
            }
        }
    }
}

namespace pg8 {
#define PG8_LAS __attribute__((address_space(3)))
typedef unsigned u32x4 __attribute__((ext_vector_type(4)));
constexpr int BM = 256, BK = 64, HALF = 128, HTB = HALF * BK * 2  , STAGE_BYTES = 8 * HTB;
__device__ __forceinline__ int lds_byte(int r, int c) { const int st = (r >> 4) * 2 + (c >> 5), rr = r & 15, cc = c & 31, ob = rr * 64 + cc * 2; return st * 1024 + (ob ^ (((ob >> 9) & 1) << 5)); }
__device__ __forceinline__ void stage_rc(int b, int& R, int& C) { const int st = b / 1024, sb = b % 1024, swz = sb ^ (((sb >> 9) & 1) << 5); R = (st >> 1) * 16 + swz / 64; C = (st & 1) * 32 + (swz % 64) / 2; }
__device__ __forceinline__ int perm32(int rho) { const int n = rho >> 4, i = rho & 15; return 8 * (i >> 2) + 4 * n + (i & 3); }
struct AO { unsigned h0p0, h0p1, h1p0, h1p1; };
template <class Src, class Epi>
__device__ __forceinline__ void gemm_phase(const int tid, PG8_LAS unsigned char* lds, const int K, const Src& S, const Epi& E) {
    const int wid = __builtin_amdgcn_readfirstlane(tid >> 6), lane = tid & 63, wr = wid >> 2, wc = wid & 3, fr = lane & 15, fq = lane >> 4;
    const int nt = K / BK;
    int R0, C0, R1, C1; stage_rc(tid * 16, R0, C0); stage_rc(tid * 16 + 8192, R1, C1);
    unsigned voffB[2];
    { const int Rb0 = Epi::PERM ? ((R0 & ~31) + perm32(R0 & 31)) : R0, Rb1 = Epi::PERM ? ((R1 & ~31) + perm32(R1 & 31)) : R1;
      voffB[0] = (unsigned)(Rb0 * K + C0) * 2u; voffB[1] = (unsigned)(Rb1 * K + C1) * 2u; }
    const size_t kstep = (size_t)(BK * 2);
    const size_t hstepB = (size_t)HALF * K * 2;
    const unsigned ldsw = (unsigned)wid * 1024u;
    const int aoff = lds_byte(wr * 64 + fr, fq * 8), boff = lds_byte(wc * 32 + fr, fq * 8);
#define PG8_SA(b, h) (((b) * 2 + (h)) * HTB)
#define PG8_SB(b, h) ((4 + (b) * 2 + (h)) * HTB)
#define PG8_STAGE2(bufoff, gbase, o0, o1) do { \
        __builtin_amdgcn_global_load_lds((const unsigned*)((const char*)(gbase) + (o0)), (PG8_LAS unsigned*)(lds + (bufoff) + ldsw), 16, 0, 0); \
        __builtin_amdgcn_global_load_lds((const unsigned*)((const char*)(gbase) + (o1)), (PG8_LAS unsigned*)(lds + (bufoff) + ldsw + 8192), 16, 0, 0); } while (0)
#define PG8_STAGEB(bufoff, gbase) PG8_STAGE2(bufoff, gbase, voffB[0], voffB[1])
#define PG8_STAGEA0(bufoff, gbase, AOV) PG8_STAGE2(bufoff, gbase, AOV.h0p0, AOV.h0p1)
#define PG8_STAGEA1(bufoff, gbase, AOV) PG8_STAGE2(bufoff, gbase, AOV.h1p0, AOV.h1p1)
#define PG8_LDA(dst, b, h) do { _Pragma("unroll") for (int m = 0; m < 4; ++m) _Pragma("unroll") for (int k = 0; k < 2; ++k) dst[m][k] = *(const PG8_LAS bf16x8*)(lds + PG8_SA(b, h) + aoff + m * 2048 + k * 1024); } while (0)
#define PG8_LDB(dst, b, h) do { _Pragma("unroll") for (int n = 0; n < 2; ++n) _Pragma("unroll") for (int k = 0; k < 2; ++k) dst[n][k] = *(const PG8_LAS bf16x8*)(lds + PG8_SB(b, h) + boff + n * 2048 + k * 1024); } while (0)
#define PG8_MMA(ai, bj, At, Bt) do { __builtin_amdgcn_s_setprio(1); _Pragma("unroll") for (int m = 0; m < 4; ++m) _Pragma("unroll") for (int n = 0; n < 2; ++n) _Pragma("unroll") for (int k = 0; k < 2; ++k) \
        acc[ai][bj][m][n] = __builtin_amdgcn_mfma_f32_16x16x32_bf16(Bt[n][k], At[m][k], acc[ai][bj][m][n], 0, 0, 0); __builtin_amdgcn_s_setprio(0); } while (0)
#define PG8_WAIT_V(n) asm volatile("s_waitcnt vmcnt(" #n ")" ::: "memory")
#define PG8_WAIT_L(n) asm volatile("s_waitcnt lgkmcnt(" #n ")" ::: "memory")
#define PG8_BAR __builtin_amdgcn_s_barrier()
#define PG8_SCHED __builtin_amdgcn_sched_barrier(0)
    typename Src::Unit cur, nxt; int ui = 0;
    if (!S.next(0, cur)) return;
    f32x4 acc[2][2][4][2];
#pragma unroll
    for (int a = 0; a < 2; ++a)
#pragma unroll
        for (int b = 0; b < 2; ++b)
#pragma unroll
            for (int m = 0; m < 4; ++m)
#pragma unroll
                for (int n = 0; n < 2; ++n) acc[a][b][m][n] = (f32x4){0.f, 0.f, 0.f, 0.f};
    bf16x8 At[4][2], B0[2][2], B1[2][2];
    AO aoC, aoN;
    S.a_off(cur, R0, C0, R1, C1, aoC);
    const char* cB = S.b_base(cur);
    PG8_STAGEB(PG8_SB(0, 0), cB); PG8_STAGEA0(PG8_SA(0, 0), S.a_base(cur, 0), aoC); PG8_STAGEB(PG8_SB(0, 1), cB + hstepB); PG8_STAGEA1(PG8_SA(0, 1), S.a_base(cur, 0), aoC);
    if (wr == 1) PG8_BAR;
    PG8_WAIT_V(4); PG8_BAR;
    PG8_STAGEB(PG8_SB(1, 0), cB + kstep); PG8_STAGEA0(PG8_SA(1, 0), S.a_base(cur, 1), aoC); PG8_STAGEB(PG8_SB(1, 1), cB + hstepB + kstep);
    PG8_WAIT_V(6); PG8_BAR;
    for (;;) {
        const bool has_next = S.next(ui + 1, nxt);
        const char* nB = cB;
        if (has_next) { S.a_off(nxt, R0, C0, R1, C1, aoN); nB = S.b_base(nxt); }
        else aoN = aoC;
        for (int t = 0; t < nt; t += 2) {
            const bool last = (t == nt - 2);
            const char* a1 = S.a_base(cur, t + 1);
            const char* a2 = last ? S.a_base(has_next ? nxt : cur, 0) : S.a_base(cur, t + 2);
            const char* a3 = last ? S.a_base(has_next ? nxt : cur, 1) : S.a_base(cur, t + 3);
            const char* b2 = last ? nB : cB + (size_t)(t + 2) * kstep; const char* b3 = b2 + kstep;
            const AO ao2 = last ? aoN : aoC;
            PG8_LDB(B0, 0, 0); PG8_SCHED; PG8_LDA(At, 0, 0); PG8_STAGEA1(PG8_SA(1, 1), a1, aoC);
            PG8_WAIT_L(8); PG8_BAR; PG8_WAIT_L(0); PG8_MMA(0, 0, At, B0); PG8_BAR; PG8_SCHED;
            PG8_LDB(B1, 0, 1); PG8_STAGEB(PG8_SB(0, 0), b2);
            PG8_BAR; PG8_WAIT_L(0); PG8_MMA(0, 1, At, B1); PG8_BAR;
            PG8_LDA(At, 0, 1); PG8_STAGEA0(PG8_SA(0, 0), a2, ao2);
            PG8_BAR; PG8_WAIT_L(0); PG8_MMA(1, 0, At, B0); PG8_BAR; PG8_SCHED;
            PG8_STAGEB(PG8_SB(0, 1), b2 + hstepB);
            PG8_WAIT_V(6); PG8_BAR; PG8_MMA(1, 1, At, B1); PG8_BAR;
            PG8_LDB(B0, 1, 0); PG8_SCHED; PG8_LDA(At, 1, 0); PG8_STAGEA1(PG8_SA(0, 1), a2, ao2);
            PG8_WAIT_L(8); PG8_BAR; PG8_WAIT_L(0); PG8_MMA(0, 0, At, B0); PG8_BAR; PG8_SCHED;
            PG8_LDB(B1, 1, 1); PG8_STAGEB(PG8_SB(1, 0), b3);
            PG8_BAR; PG8_WAIT_L(0); PG8_MMA(0, 1, At, B1); PG8_BAR;
            PG8_LDA(At, 1, 1); PG8_STAGEA0(PG8_SA(1, 0), a3, ao2);
            PG8_BAR; PG8_WAIT_L(0); PG8_MMA(1, 0, At, B0); PG8_BAR; PG8_SCHED;
            PG8_STAGEB(PG8_SB(1, 1), b3 + hstepB);
            PG8_WAIT_V(6); PG8_BAR; PG8_MMA(1, 1, At, B1); PG8_BAR;
        }
        E(acc, cur, wr, wc, fr, fq);
        if (!has_next) break;
#pragma unroll
        for (int a = 0; a < 2; ++a)
#pragma unroll
            for (int b = 0; b < 2; ++b)
#pragma unroll
                for (int m = 0; m < 4; ++m)
#pragma unroll
                    for (int n = 0; n < 2; ++n) acc[a][b][m][n] = (f32x4){0.f, 0.f, 0.f, 0.f};
        cur = nxt; cB = nB; ++ui; aoC = aoN;
    }
    PG8_WAIT_V(0);
    if (wr == 0) PG8_BAR;
    PG8_BAR;
#undef PG8_SA
#undef PG8_SB
#undef PG8_STAGE2
#undef PG8_STAGEB
#undef PG8_STAGEA0
#undef PG8_STAGEA1
#undef PG8_LDA
#undef PG8_LDB
#undef PG8_MMA
#undef PG8_WAIT_V
#undef PG8_WAIT_L
#undef PG8_BAR
#undef PG8_SCHED
}
struct DenseSrc {
    struct Unit { int pm, pn; };
    const char* A0; const char* A1; const char* Bt; int lda, K, nM, nN, G, c, ksplit;
    __device__ __forceinline__ bool next(int i, Unit& u) const {
        const int nwg = nM * nN; const long L = (long)i * G + c; if (L >= nwg) return false;
        int wgid = (int)L; { const int q = nwg / 8, r = nwg % 8, xcd = wgid % 8, off = wgid / 8; wgid = (xcd < r ? xcd * (q + 1) : r * (q + 1) + (xcd - r) * q) + off; }
        const int nig = 8 * nN, gid = wgid / nig, fm = gid * 8, gsz = (nM - fm) < 8 ? (nM - fm) : 8;
        u.pm = fm + ((wgid % nig) % gsz); u.pn = (wgid % nig) / gsz; return true;
    }
    __device__ __forceinline__ void a_off(const Unit& u, int R0, int C0, int R1, int C1, AO& ao) const {
        ao.h0p0 = (unsigned)(((u.pm * 256 + R0) * lda + C0) * 2); ao.h0p1 = (unsigned)(((u.pm * 256 + R1) * lda + C1) * 2);
        ao.h1p0 = (unsigned)(((u.pm * 256 + 128 + R0) * lda + C0) * 2); ao.h1p1 = (unsigned)(((u.pm * 256 + 128 + R1) * lda + C1) * 2);
    }
    __device__ __forceinline__ const char* a_base(const Unit&, int kt) const { return (kt < ksplit) ? A0 + (size_t)kt * 128 : A1 + (size_t)(kt - ksplit) * 128; }
    __device__ __forceinline__ const char* b_base(const Unit& u) const { return Bt + (size_t)u.pn * 256 * K * 2; }
};
}

struct EpiProj {
    static constexpr bool PERM = true;
    bf16_t* O; int ldc;
    __device__ __forceinline__ void operator()(const f32x4 (&acc)[2][2][4][2], const pg8::DenseSrc::Unit& u, int wr, int wc, int fr, int fq) const {
        const int row0 = u.pm * 256 + wr * 64 + fr, col0 = u.pn * 256 + wc * 32 + 8 * fq;
#pragma unroll
        for (int ai = 0; ai < 2; ++ai)
#pragma unroll
            for (int m = 0; m < 4; ++m) { bf16_t* rowp = O + (size_t)(row0 + ai * 128 + m * 16) * ldc + col0;
#pragma unroll
                for (int bj = 0; bj < 2; ++bj) { const f32x4 v0 = acc[ai][bj][m][0], v1 = acc[ai][bj][m][1];
                    *(uint4*)(rowp + bj * 128) = make_uint4(pack2(v0[0], v0[1]), pack2(v0[2], v0[3]), pack2(v1[0], v1[1]), pack2(v1[2], v1[3])); } }
    }
};
__device__ __forceinline__ void ph_gemm1(const P& p, char* smem) {
    const int tid = tid_opaque();
    pg8::DenseSrc S; S.A0 = (const char*)p.out; S.A1 = S.A0; S.Bt = (const char*)(p.ws + WS_WIN); S.lda = ND; S.K = ND; S.nM = NTOK / 256; S.nN = NPROJ / 256; S.G = gridDim.x; S.c = blockIdx.x; S.ksplit = ND / 64;
    EpiProj E; E.O = (bf16_t*)(p.ws + WS_PROJ); E.ldc = NPROJ;
    pg8::gemm_phase(tid, (PG8_LAS unsigned char*)smem, ND, S, E);
}

__device__ __forceinline__ void ph_post(const P& p, char* smem) {
    const int tid = tid_opaque();
    float* sW = (float*)smem;
    {
        f32x4 t[8];
#pragma unroll
        for (int i = 0; i < 8; ++i) t[i] = *(const f32x4*)(p.w_kv_up + (size_t)(tid + i * NTHREADS) * 4);
#pragma unroll
        for (int i = 0; i < 8; ++i) *(f32x4*)(sW + (size_t)(tid + i * NTHREADS) * 4) = t[i];
    }
    __syncthreads();
    const int lane = tid & 63, wave = tid >> 6;
    const bf16_t* proj = (const bf16_t*)(p.ws + WS_PROJ);
    bf16_t* qn = (bf16_t*)(p.ws + WS_QN); bf16_t* Kb = (bf16_t*)(p.ws + WS_K); bf16_t* kib = (bf16_t*)(p.ws + WS_KI);
    float* wi = (float*)(p.ws + WS_WI); float* dbeta = (float*)(p.ws + WS_DBG); float* dg = dbeta + NTOK * 4;
    bf16_t* dq = (bf16_t*)(p.ws + WS_DQ); bf16_t* dk = (bf16_t*)(p.ws + WS_DK); bf16_t* dkT = (bf16_t*)(p.ws + WS_DKT); bf16_t* dvT = (bf16_t*)(p.ws + WS_DVT);
    bf16_t* Vt = (bf16_t*)(p.ws + WS_VT);
    {
        const int g = blockIdx.x * NTHREADS + tid;
        if (g < NB * 64) { int mn = 0x7fffffff, mx = -0x7fffffff; for (int i = 0; i < 32; ++i) { const int v = p.pos[g * 32 + i]; mn = min(mn, v); mx = max(mx, v); } int* pm = (int*)(p.ws + WS_POSMM); pm[g * 2] = mn; pm[g * 2 + 1] = mx; }
    }
    for (int tg = blockIdx.x * NWAVES + wave; tg < NTOK / 8; tg += gridDim.x * NWAVES) {
        const int tok0 = tg * 8, t0 = tok0 % NT, bb = tok0 / NT;
        uint4 rq[8]; unsigned rkv[8]; unsigned rms[8];
#pragma unroll
        for (int ti = 0; ti < 8; ++ti) {
            const bf16_t* pr = proj + (size_t)(tok0 + ti) * NPROJ;
            rq[ti] = *(const uint4*)(pr + PC_QATT + lane * 8);
            rkv[ti] = *(const unsigned*)(pr + PC_KVLAT + lane * 2);
            rms[ti] = (lane < 48) ? (unsigned)pr[PC_KIDX + lane] : 0u;
        }
        float vall[8];
#pragma unroll
        for (int ti = 0; ti < 8; ++ti) {
            const int tok = tok0 + ti;
            {
                const unsigned w[4] = {rq[ti].x, rq[ti].y, rq[ti].z, rq[ti].w};
                float v[8]; float ss = 0.f;
#pragma unroll
                for (int j = 0; j < 4; ++j) { v[2 * j] = __uint_as_float(w[j] << 16); v[2 * j + 1] = __uint_as_float(w[j] & 0xffff0000u); }
#pragma unroll
                for (int j = 0; j < 8; ++j) ss += v[j] * v[j];
                ss += dpp_f<0xB1>(ss); ss += dpp_f<0x4E>(ss); ss += dpp_f<0x141>(ss);
                const float rs = rsqrtf(ss * (1.f / 64.f) + EPS) * (0.125f * LOG2E);
                const int d0 = (lane & 7) * 8;
                unsigned o[4];
#pragma unroll
                for (int j = 0; j < 4; ++j) o[j] = pack2(v[2 * j] * rs * p.q_norm_g[d0 + 2 * j], v[2 * j + 1] * rs * p.q_norm_g[d0 + 2 * j + 1]);
                *(uint4*)(qn + (size_t)tok * 512 + lane * 8) = make_uint4(o[0], o[1], o[2], o[3]);
            }
            {
                float a0 = __uint_as_float(rkv[ti] << 16), a1 = __uint_as_float(rkv[ti] & 0xffff0000u);
                float ss = wave_sum(a0 * a0 + a1 * a1);
                const float rs = rsqrtf(ss * (1.f / 128.f) + EPS);
                a0 *= rs * p.kv_norm_g[lane * 2]; a1 *= rs * p.kv_norm_g[lane * 2 + 1];
                float k = 0.f, v = 0.f;
#pragma unroll 8
                for (int i = 0; i < 64; ++i) {
                    const float x0 = __shfl(a0, i), x1 = __shfl(a1, i);
                    k += x0 * sW[(2 * i) * 128 + lane] + x1 * sW[(2 * i + 1) * 128 + lane];
                    v += x0 * sW[(2 * i) * 128 + 64 + lane] + x1 * sW[(2 * i + 1) * 128 + 64 + lane];
                }
                const float ks = wave_sum(k * k);
                k *= rsqrtf(ks * (1.f / 64.f) + EPS) * p.k_norm_g[lane];
                Kb[(size_t)tok * 64 + lane] = f2bf(k);
                vall[ti] = v;
            }
            {
                const float raw = bf2f((bf16_t)rms[ti]);
                float a = (lane < 32) ? raw : 0.f;
                const float ss = wave_sum(a * a);
                a *= rsqrtf(ss * (1.f / 32.f) + EPS);
                if (lane < 32) kib[(size_t)tok * 32 + lane] = f2bf(a * p.idx_k_norm_g[lane]);
                else if (lane < 40) wi[(size_t)tok * 8 + lane - 32] = raw * 0.35355339059327373f * 0.17677669529663687f;
                else if (lane < 44) dbeta[(size_t)tok * 4 + lane - 40] = sigmoid_f(raw);
                else if (lane < 48) {
                    const float z = raw + p.dt_bias[lane - 44];
                    const float sp = (z > 20.f) ? z : log1pf(__expf(z));
                    dg[(size_t)tok * 4 + lane - 44] = -__expf(p.a_log[lane - 44]) * sp;
                }
            }
        }
        *(uint4*)(Vt + ((size_t)bb * 64 + lane) * NT + t0) = make_uint4(pack2(vall[0], vall[1]), pack2(vall[2], vall[3]), pack2(vall[4], vall[5]), pack2(vall[6], vall[7]));
#pragma unroll 1
        for (int jg = 0; jg < 4; ++jg) {
            unsigned raw[3][11];
#pragma unroll
            for (int jj = 0; jj < 3; ++jj)
#pragma unroll
                for (int i = 0; i < 11; ++i) {
                    raw[jj][i] = 0u;
                    if (t0 - 3 + i >= 0) raw[jj][i] = *(const unsigned*)(proj + (size_t)(tok0 - 3 + i) * NPROJ + PC_DNQKV + (jg * 3 + jj) * 128 + lane * 2);
                }
#pragma unroll
            for (int jj = 0; jj < 3; ++jj) {
                const int j = jg * 3 + jj;
                const int ch = j * 128 + lane * 2;
                float c0[4], c1[4];
#pragma unroll
                for (int tap = 0; tap < 4; ++tap) { c0[tap] = p.conv_w[tap * 1536 + ch]; c1[tap] = p.conv_w[tap * 1536 + ch + 1]; }
                float y0[8], y1[8];
#pragma unroll
                for (int i = 0; i < 8; ++i) {
                    float a0 = 0.f, a1 = 0.f;
#pragma unroll
                    for (int tap = 0; tap < 4; ++tap) { a0 += c0[tap] * __uint_as_float(raw[jj][i + tap] << 16); a1 += c1[tap] * __uint_as_float(raw[jj][i + tap] & 0xffff0000u); }
                    y0[i] = silu_f(a0); y1[i] = silu_f(a1);
                    if (j < 8) {
                        const float ss = wave_sum(y0[i] * y0[i] + y1[i] * y1[i]);
                        float rs = rsqrtf(ss + EPS);
                        if (j < 4) rs *= 0.08838834764831845f;
                        y0[i] *= rs; y1[i] *= rs;
                    }
                }
                if (j < 8) {
                    bf16_t* dst = (j < 4) ? dq : dk;
#pragma unroll
                    for (int i = 0; i < 8; ++i) *(unsigned*)(dst + (size_t)(tok0 + i) * 512 + (j & 3) * 128 + lane * 2) = pack2(y0[i], y1[i]);
                }
                if (j >= 4) {
                    bf16_t* dstT = ((j < 8) ? dkT : dvT) + ((size_t)(bb * 4 + (j & 3)) * 128 + lane * 2) * NT + t0;
                    *(uint4*)dstT = make_uint4(pack2(y0[0], y0[1]), pack2(y0[2], y0[3]), pack2(y0[4], y0[5]), pack2(y0[6], y0[7]));
                    *(uint4*)(dstT + NT) = make_uint4(pack2(y1[0], y1[1]), pack2(y1[2], y1[3]), pack2(y1[4], y1[5]), pack2(y1[6], y1[7]));
                }
            }
        }
    }
}

__device__ __forceinline__ unsigned f2sortable(float f) { const unsigned u = __float_as_uint(f); return (u & 0x80000000u) ? ~u : (u | 0x80000000u); }
__device__ __forceinline__ float sum8_f(float v) { v += dpp_f<0xB1>(v); v += dpp_f<0x4E>(v); v += dpp_f<0x141>(v); return v; }
__device__ __forceinline__ int sum16_i(int v) { v += dpp_i<0xB1>(v); v += dpp_i<0x4E>(v); v += dpp_i<0x141>(v); v += __shfl_xor(v, 32); return v; }
__device__ __forceinline__ int pi32(int r) { return (r & 0x13) | ((r & 4) << 1) | ((r & 8) >> 1); }
__device__ __forceinline__ constexpr int key_of_reg(int r) { return (r & 3) + 4 * ((r >> 2) & 1) + 16 * (r >> 3); }
struct KiFrag { bf16x8 a0, a1; };
__device__ __forceinline__ float xhalf_sum(float v) { auto rr = __builtin_amdgcn_permlane32_swap(__float_as_uint(v), __float_as_uint(v), false, false); return __uint_as_float(rr[0]) + __uint_as_float(rr[1]); }
__device__ __forceinline__ void idx_scores4(float (&sc)[4], const KiFrag& f, bf16x8 qi0, bf16x8 qi1, const float (&wv)[16]) {
    f32x16 z;
#pragma unroll
    for (int r = 0; r < 16; ++r) z[r] = 0.f;
    z = __builtin_amdgcn_mfma_f32_32x32x16_bf16(qi0, f.a0, z, 0, 0, 0);
    z = __builtin_amdgcn_mfma_f32_32x32x16_bf16(qi1, f.a1, z, 0, 0, 0);
#pragma unroll
    for (int q = 0; q < 4; ++q) {
        float a = wv[4 * q] * fmaxf(z[4 * q], 0.f);
        a += wv[4 * q + 1] * fmaxf(z[4 * q + 1], 0.f);
        a += wv[4 * q + 2] * fmaxf(z[4 * q + 2], 0.f);
        a += wv[4 * q + 3] * fmaxf(z[4 * q + 3], 0.f);
        sc[q] = xhalf_sum(a);
    }
}
constexpr int AT_SBL = 0, AT_POSMAX = 4352, AT_ITEM = 6400, AT_BUF = 6656;
constexpr int AT_KI_ROW = 80, AT_P1_BUF = 256 * AT_KI_ROW;
constexpr int AT2_K = 0, AT2_VT = 128 * 144, AT2_KI = AT2_VT + 64 * 272, AT2_PK = AT2_KI + 128 * AT_KI_ROW, AT2_BUF = AT2_PK + 512;
constexpr int ATTM_LDS = AT_BUF + 2 * (AT_P1_BUF > AT2_BUF ? AT_P1_BUF : AT2_BUF);
__device__ __forceinline__ KiFrag ki_lds(const char* buf, int row, int hf) {
    KiFrag f; const char* r = buf + row * AT_KI_ROW + 16 * hf;
    f.a0 = *(const bf16x8*)r; f.a1 = *(const bf16x8*)(r + 32); return f;
}
struct SelQ { float tau[4]; int cut[4]; };
struct IdxOps { bf16x8 qi0, qi1; float wv[16]; };
__device__ __forceinline__ IdxOps idx_ops(const P& p, int b, int t0, int lane) {
    const int hf = lane >> 5, cq = (lane & 31) >> 3, ch = lane & 7;
    const int tok = b * NT + t0 + cq;
    const bf16_t* proj = (const bf16_t*)(p.ws + WS_PROJ);
    IdxOps o;
    o.qi0 = *(const bf16x8*)(proj + (size_t)tok * NPROJ + PC_QIDX + ch * 32 + 8 * hf);
    o.qi1 = *(const bf16x8*)(proj + (size_t)tok * NPROJ + PC_QIDX + ch * 32 + 16 + 8 * hf);
    const float* wi = (const float*)(p.ws + WS_WI) + (size_t)(b * NT + t0) * 8 + 4 * hf;
#pragma unroll
    for (int r = 0; r < 16; ++r) o.wv[r] = wi[(r >> 2) * 8 + (r & 3)];
    return o;
}
__device__ __forceinline__ void attn_pass1(const P& p, char* smem, int b, int tb, int tid, SelQ& sel) {
    const int lane = tid & 63, wave = tid >> 6;
    const int hf = lane >> 5, l31 = lane & 31;
    const int t0 = tb * 32 + wave * 4;
    const bf16_t* ki_b = (const bf16_t*)(p.ws + WS_KI) + (size_t)b * NT * 32;
    const IdxOps io = idx_ops(p, b, t0, lane);
    char* bufs = smem + AT_BUF;
    float keep[32][4];
#pragma unroll
    for (int s = 0; s < 32; ++s)
#pragma unroll
        for (int q = 0; q < 4; ++q) keep[s][q] = -INFINITY;
    {
#pragma unroll
        for (int i = 0; i < 2; ++i) { const int x = tid + 512 * i; *(uint4*)(bufs + (x >> 2) * AT_KI_ROW + (x & 3) * 16) = *(const uint4*)(ki_b + (size_t)(x >> 2) * 32 + (x & 3) * 8); }
    }
    __syncthreads();
#pragma unroll
    for (int g = 0; g < 8; ++g) {
        if (g * 8 <= tb) {
            const bool more = (g + 1) * 8 <= tb;
            uint4 n0 = make_uint4(0, 0, 0, 0), n1 = n0;
            if (more) {
                n0 = *(const uint4*)(ki_b + (size_t)((g + 1) * 256 + (tid >> 2)) * 32 + (tid & 3) * 8);
                n1 = *(const uint4*)(ki_b + (size_t)((g + 1) * 256 + 128 + (tid >> 2)) * 32 + (tid & 3) * 8);
            }
            const char* buf = bufs + (g & 1) * AT_P1_BUF;
#pragma unroll
            for (int kk = 0; kk < 8; ++kk) {
                const int kt = g * 8 + kk;
                if (kt <= tb) {
                    const KiFrag f = ki_lds(buf, kk * 32 + l31, hf);
                    float sc[4];
                    idx_scores4(sc, f, io.qi0, io.qi1, io.wv);
                    if (kt == tb) {
#pragma unroll
                        for (int q = 0; q < 4; ++q) sc[q] = (kt * 32 + l31 <= t0 + q) ? sc[q] : -INFINITY;
                    }
#pragma unroll
                    for (int q = 0; q < 4; ++q) keep[kt >> 1][q] = (hf == (kt & 1)) ? sc[q] : keep[kt >> 1][q];
                    __builtin_amdgcn_sched_barrier(0);
                }
            }
            if (more) {
                char* nb = bufs + ((g + 1) & 1) * AT_P1_BUF;
                *(uint4*)(nb + (tid >> 2) * AT_KI_ROW + (tid & 3) * 16) = n0;
                *(uint4*)(nb + (128 + (tid >> 2)) * AT_KI_ROW + (tid & 3) * 16) = n1;
            }
            __syncthreads();
        }
    }
    unsigned u[32][4];
#pragma unroll
    for (int s = 0; s < 32; ++s)
#pragma unroll
        for (int q = 0; q < 4; ++q) u[s][q] = f2sortable(keep[s][q]);
    unsigned prefix[4] = {0u, 0u, 0u, 0u}; bool exact[4] = {false, false, false, false};
    for (int bit = 31; bit >= 0; --bit) {
        unsigned cand[4];
#pragma unroll
        for (int q = 0; q < 4; ++q) cand[q] = prefix[q] | (1u << bit);
        int c0 = 0, c1 = 0, c2 = 0, c3 = 0;
#pragma unroll
        for (int g8 = 0; g8 < 4; ++g8) {
            if (g8 * 16 <= tb) {
#pragma unroll
                for (int s = g8 * 8; s < g8 * 8 + 8; ++s)
                    asm volatile("v_cmp_ge_u32_e64 s[70:71], %4, %8\n\tv_cmp_ge_u32_e64 s[72:73], %5, %9\n\tv_cmp_ge_u32_e64 s[74:75], %6, %10\n\tv_cmp_ge_u32_e64 s[76:77], %7, %11\n\t"
                                 "v_addc_co_u32_e64 %0, s[70:71], 0, %0, s[70:71]\n\tv_addc_co_u32_e64 %1, s[72:73], 0, %1, s[72:73]\n\tv_addc_co_u32_e64 %2, s[74:75], 0, %2, s[74:75]\n\tv_addc_co_u32_e64 %3, s[76:77], 0, %3, s[76:77]"
                                 : "+v"(c0), "+v"(c1), "+v"(c2), "+v"(c3)
                                 : "v"(u[s][0]), "v"(u[s][1]), "v"(u[s][2]), "v"(u[s][3]), "s"(cand[0]), "s"(cand[1]), "s"(cand[2]), "s"(cand[3])
                                 : "s70", "s71", "s72", "s73", "s74", "s75", "s76", "s77");
            }
        }
        int cnt[4] = {c0, c1, c2, c3};
#pragma unroll
        for (int q = 0; q < 4; ++q) { int v = cnt[q]; v += dpp_i<0xB1>(v); v += dpp_i<0x4E>(v); v += dpp_i<0x141>(v); v += dpp_i<0x140>(v);
            v += __builtin_amdgcn_update_dpp(0, v, 0x142, 0xA, 0xF, false); v += __builtin_amdgcn_update_dpp(0, v, 0x143, 0xC, 0xF, false); cnt[q] = __builtin_amdgcn_readlane(v, 63); }
#pragma unroll
        for (int q = 0; q < 4; ++q) {
            const int cq_ = cnt[q];
            if (!exact[q] && cq_ >= 256) { prefix[q] = cand[q]; if (cq_ == 256) exact[q] = true; }
        }
        if (exact[0] && exact[1] && exact[2] && exact[3]) break;
    }
#pragma unroll
    for (int q = 0; q < 4; ++q) {
        int cutq = 0x7fffffff;
        if (!exact[q]) {
            const unsigned pf = prefix[q];
            int ngt = 0, neq = 0;
#pragma unroll
            for (int s = 0; s < 32; ++s)
                { ngt += __builtin_popcountll(__ballot(u[s][q] > pf)); neq += __builtin_popcountll(__ballot(u[s][q] == pf)); }
            const int need = 256 - ngt;
            if (need < neq) {
                int lo = 0, hi = NT - 1;
                for (int it = 0; it < 11; ++it) {
                    const int mid = (lo + hi) >> 1;
                    int cnt = 0;
#pragma unroll
                    for (int s = 0; s < 32; ++s)
                        cnt += __builtin_popcountll(__ballot(u[s][q] == pf && ((2 * s + hf) * 32 + l31) <= mid));
                    if (cnt >= need) hi = mid; else lo = mid + 1;
                }
                cutq = lo;
            }
        }
        sel.tau[q] = __uint_as_float((prefix[q] & 0x80000000u) ? (prefix[q] & 0x7fffffffu) : ~prefix[q]);
        sel.cut[q] = cutq;
    }
}
__device__ __forceinline__ float xhalf_max(float v) { auto rr = __builtin_amdgcn_permlane32_swap(__float_as_uint(v), __float_as_uint(v), false, false); return fmaxf(__uint_as_float(rr[0]), __uint_as_float(rr[1])); }
__device__ __forceinline__ void attn_pass2(const P& p, char* smem, int b, int tb, int tid, const SelQ& sel) {
    const int lane = tid & 63, wave = tid >> 6;
    const int hf = lane >> 5, l31 = lane & 31, cq = l31 >> 3, ch = lane & 7, prow = pi32(l31);
    const int t0 = tb * 32 + wave * 4, tq = t0 + cq, tok = b * NT + tq;
    const bf16_t* proj = (const bf16_t*)(p.ws + WS_PROJ);
    bf16_t* qn = (bf16_t*)(p.ws + WS_QN);
    const bf16_t* ki_b = (const bf16_t*)(p.ws + WS_KI) + (size_t)b * NT * 32;
    const bf16_t* K_b = (const bf16_t*)(p.ws + WS_K) + (size_t)b * NT * 64;
    const bf16_t* Vt_b = (const bf16_t*)(p.ws + WS_VT) + (size_t)b * 64 * NT;
    const float* sbl = (const float*)(smem + AT_SBL); const int* posmax = (const int*)(smem + AT_POSMAX) + b * 64;
    char* bufs = smem + AT_BUF;
    const IdxOps io = idx_ops(p, b, t0, lane);
    bf16x8 qb[4];
#pragma unroll
    for (int ks = 0; ks < 4; ++ks) qb[ks] = *(const bf16x8*)(qn + (size_t)tok * 512 + ch * 64 + ks * 16 + 8 * hf);
    const int pq = p.pos[tok];
    int pqmin = pq;
    pqmin = min(pqmin, __shfl_xor(pqmin, 8)); pqmin = min(pqmin, __shfl_xor(pqmin, 16));
    pqmin = __builtin_amdgcn_readfirstlane(pqmin);
    const float bias_far = sbl[128 * 8 + ch];
    const bool anycut = (sel.cut[0] & sel.cut[1] & sel.cut[2] & sel.cut[3]) != 0x7fffffff;
    f32x16 o0, o1;
#pragma unroll
    for (int r = 0; r < 16; ++r) { o0[r] = 0.f; o1[r] = 0.f; }
    float m = -INFINITY, l = 0.f;
    const int nt128 = (tb + 4) >> 2;
    uint4 rk0, rk1, rv0, rv1, rki; int rpos = 0;
#define AT_LOAD(j) { const int kb_ = (j) * 128; \
        rk0 = *(const uint4*)(K_b + (size_t)(kb_ + (tid >> 3)) * 64 + (tid & 7) * 8); rk1 = *(const uint4*)(K_b + (size_t)(kb_ + 64 + (tid >> 3)) * 64 + (tid & 7) * 8); \
        rv0 = *(const uint4*)(Vt_b + (size_t)(tid >> 4) * NT + kb_ + (tid & 15) * 8); rv1 = *(const uint4*)(Vt_b + (size_t)(32 + (tid >> 4)) * NT + kb_ + (tid & 15) * 8); \
        rki = *(const uint4*)(ki_b + (size_t)(kb_ + (tid >> 2)) * 32 + (tid & 3) * 8); \
        if (tid < 128) rpos = p.pos[b * NT + kb_ + tid]; }
#define AT_STORE(bp) { char* sb_ = (bp); \
        *(uint4*)(sb_ + AT2_K + (tid >> 3) * 144 + (tid & 7) * 16) = rk0; *(uint4*)(sb_ + AT2_K + (64 + (tid >> 3)) * 144 + (tid & 7) * 16) = rk1; \
        *(uint4*)(sb_ + AT2_VT + (tid >> 4) * 272 + (tid & 15) * 16) = rv0; *(uint4*)(sb_ + AT2_VT + (32 + (tid >> 4)) * 272 + (tid & 15) * 16) = rv1; \
        *(uint4*)(sb_ + AT2_KI + (tid >> 2) * AT_KI_ROW + (tid & 3) * 16) = rki; \
        if (tid < 128) ((int*)(sb_ + AT2_PK))[tid] = rpos; }
    AT_LOAD(0) AT_STORE(bufs)
    __syncthreads();
#pragma unroll 1
    for (int j = 0; j < nt128; ++j) {
        if (j + 1 < nt128) AT_LOAD(j + 1)
        const char* buf = bufs + (j & 1) * AT2_BUF;
#pragma unroll
        for (int st = 0; st < 2; ++st) {
            const int kt0 = 4 * j + 2 * st;
            if (kt0 <= tb) {
                const bool have1 = (kt0 + 1 <= tb);
                const int krow = st * 64;
                f32x16 s0, s1;
                float sc0[4], sc1[4];
                idx_scores4(sc0, ki_lds(buf + AT2_KI, krow + l31, hf), io.qi0, io.qi1, io.wv);
                const bool far0 = (pqmin - posmax[kt0] >= 128);
#pragma unroll
                for (int r = 0; r < 16; ++r) s0[r] = far0 ? bias_far : 0.f;
                {
                    const char* kr = buf + AT2_K + (krow + prow) * 144 + 16 * hf;
#pragma unroll
                    for (int ks = 0; ks < 4; ++ks) s0 = __builtin_amdgcn_mfma_f32_32x32x16_bf16(*(const bf16x8*)(kr + ks * 32), qb[ks], s0, 0, 0, 0);
                }
                bool far1 = true;
                if (have1) {
                    idx_scores4(sc1, ki_lds(buf + AT2_KI, krow + 32 + l31, hf), io.qi0, io.qi1, io.wv);
                    far1 = (pqmin - posmax[kt0 + 1] >= 128);
#pragma unroll
                    for (int r = 0; r < 16; ++r) s1[r] = far1 ? bias_far : 0.f;
                    const char* kr = buf + AT2_K + (krow + 32 + prow) * 144 + 16 * hf;
#pragma unroll
                    for (int ks = 0; ks < 4; ++ks) s1 = __builtin_amdgcn_mfma_f32_32x32x16_bf16(*(const bf16x8*)(kr + ks * 32), qb[ks], s1, 0, 0, 0);
                } else {
#pragma unroll
                    for (int r = 0; r < 16; ++r) s1[r] = -INFINITY;
#pragma unroll
                    for (int q = 0; q < 4; ++q) sc1[q] = -INFINITY;
                }
                if (!far0) {
                    const int* pk = (const int*)(buf + AT2_PK) + krow + 8 * hf;
#pragma unroll
                    for (int r = 0; r < 16; ++r) { int n = pq - pk[key_of_reg(r)]; n = n < 0 ? 0 : (n > 128 ? 128 : n); s0[r] += sbl[n * 8 + ch]; }
                }
                if (!far1) {
                    const int* pk = (const int*)(buf + AT2_PK) + krow + 32 + 8 * hf;
#pragma unroll
                    for (int r = 0; r < 16; ++r) { int n = pq - pk[key_of_reg(r)]; n = n < 0 ? 0 : (n > 128 ? 128 : n); s1[r] += sbl[n * 8 + ch]; }
                }
                unsigned mw0, mw1;
                {
                    unsigned M0[4], M1[4];
                    const int key0 = kt0 * 32 + l31, key1 = key0 + 32;
                    const bool diag = (kt0 + 1 >= tb);
#pragma unroll
                    for (int q = 0; q < 4; ++q) {
                        bool ok0 = anycut ? ((sc0[q] > sel.tau[q]) || (sc0[q] == sel.tau[q] && key0 <= sel.cut[q])) : (sc0[q] >= sel.tau[q]);
                        bool ok1 = anycut ? ((sc1[q] > sel.tau[q]) || (sc1[q] == sel.tau[q] && key1 <= sel.cut[q])) : (sc1[q] >= sel.tau[q]);
                        if (diag) { ok0 = ok0 && (key0 <= t0 + q); ok1 = ok1 && (key1 <= t0 + q); }
                        M0[q] = (unsigned)__ballot(ok0); M1[q] = (unsigned)__ballot(ok1);
                    }
                    mw0 = (cq == 0) ? M0[0] : (cq == 1) ? M0[1] : (cq == 2) ? M0[2] : M0[3];
                    mw1 = (cq == 0) ? M1[0] : (cq == 1) ? M1[1] : (cq == 2) ? M1[2] : M1[3];
                    mw0 >>= 8 * hf; mw1 >>= 8 * hf;
                }
#pragma unroll
                for (int r = 0; r < 16; ++r) {
                    const int t0m = ((int)(mw0 << (31 - key_of_reg(r)))) >> 31, t1m = ((int)(mw1 << (31 - key_of_reg(r)))) >> 31;
                    s0[r] = __int_as_float((__float_as_int(s0[r]) & t0m) | (int)(0xff800000u & ~(unsigned)t0m));
                    s1[r] = __int_as_float((__float_as_int(s1[r]) & t1m) | (int)(0xff800000u & ~(unsigned)t1m));
                }
                float mx = fmaxf(s0[0], s1[0]);
#pragma unroll
                for (int r = 1; r < 16; ++r) mx = fmaxf(mx, fmaxf(s0[r], s1[r]));
                mx = xhalf_max(mx);
                if (!__all(mx - m <= 8.f)) {
                    const float mnew = fmaxf(m, mx);
                    const float msafe = (mnew == -INFINITY) ? 0.f : mnew;
                    const float alpha = __builtin_amdgcn_exp2f(m - msafe);
                    m = mnew; l *= alpha;
#pragma unroll
                    for (int r = 0; r < 16; ++r) { o0[r] *= alpha; o1[r] *= alpha; }
                }
                const float mref = (m == -INFINITY) ? 0.f : m;
                float ps = 0.f;
#pragma unroll
                for (int r = 0; r < 16; ++r) { s0[r] = __builtin_amdgcn_exp2f(s0[r] - mref); s1[r] = __builtin_amdgcn_exp2f(s1[r] - mref); ps += s0[r] + s1[r]; }
                l += ps;
                union { uint4 u; bf16x8 f; } pb0, pb1, pb2, pb3;
                pb0.u = make_uint4(pack2(s0[0], s0[1]), pack2(s0[2], s0[3]), pack2(s0[4], s0[5]), pack2(s0[6], s0[7]));
                pb1.u = make_uint4(pack2(s0[8], s0[9]), pack2(s0[10], s0[11]), pack2(s0[12], s0[13]), pack2(s0[14], s0[15]));
                pb2.u = make_uint4(pack2(s1[0], s1[1]), pack2(s1[2], s1[3]), pack2(s1[4], s1[5]), pack2(s1[6], s1[7]));
                pb3.u = make_uint4(pack2(s1[8], s1[9]), pack2(s1[10], s1[11]), pack2(s1[12], s1[13]), pack2(s1[14], s1[15]));
                const char* vr = buf + AT2_VT + l31 * 272 + st * 128 + 16 * hf;
                o0 = __builtin_amdgcn_mfma_f32_32x32x16_bf16(*(const bf16x8*)vr, pb0.f, o0, 0, 0, 0);
                o1 = __builtin_amdgcn_mfma_f32_32x32x16_bf16(*(const bf16x8*)(vr + 32 * 272), pb0.f, o1, 0, 0, 0);
                o0 = __builtin_amdgcn_mfma_f32_32x32x16_bf16(*(const bf16x8*)(vr + 32), pb1.f, o0, 0, 0, 0);
                o1 = __builtin_amdgcn_mfma_f32_32x32x16_bf16(*(const bf16x8*)(vr + 32 * 272 + 32), pb1.f, o1, 0, 0, 0);
                o0 = __builtin_amdgcn_mfma_f32_32x32x16_bf16(*(const bf16x8*)(vr + 64), pb2.f, o0, 0, 0, 0);
                o1 = __builtin_amdgcn_mfma_f32_32x32x16_bf16(*(const bf16x8*)(vr + 32 * 272 + 64), pb2.f, o1, 0, 0, 0);
                o0 = __builtin_amdgcn_mfma_f32_32x32x16_bf16(*(const bf16x8*)(vr + 96), pb3.f, o0, 0, 0, 0);
                o1 = __builtin_amdgcn_mfma_f32_32x32x16_bf16(*(const bf16x8*)(vr + 32 * 272 + 96), pb3.f, o1, 0, 0, 0);
            }
        }
        if (j + 1 < nt128) AT_STORE(bufs + ((j + 1) & 1) * AT2_BUF)
        __syncthreads();
    }
#undef AT_LOAD
#undef AT_STORE
    l += __shfl_xor(l, 32);
    const float inv = 1.f / l;
    bf16_t* orow = qn + (size_t)tok * 512 + ch * 64;
#pragma unroll
    for (int gq = 0; gq < 4; ++gq) {
        *(uint2*)(orow + gq * 8 + 4 * hf) = make_uint2(pack2(o0[gq * 4] * inv, o0[gq * 4 + 1] * inv), pack2(o0[gq * 4 + 2] * inv, o0[gq * 4 + 3] * inv));
        *(uint2*)(orow + 32 + gq * 8 + 4 * hf) = make_uint2(pack2(o1[gq * 4] * inv, o1[gq * 4 + 1] * inv), pack2(o1[gq * 4 + 2] * inv, o1[gq * 4 + 3] * inv));
    }
}
__device__ __forceinline__ void dn_scan_block(const P& p, char* smem, int bh, int tid);
template <int MODE>
__device__ __forceinline__ void ph_attn_mfma(const P& p, char* smem) {
    const int tid = tid_opaque();
    float* sbl = (float*)(smem + AT_SBL);
    for (int i = tid; i < 129 * 8; i += NTHREADS) {
        const int n = i >> 3, h = i & 7; int bk;
        if (n < 16) bk = n;
        else { const float v = logf((float)n / 16.f) / 2.0794415416798357f * 16.f; bk = 16 + (int)v; if (bk > 31) bk = 31; }
        sbl[i] = p.rel_bias[bk * 8 + h] * LOG2E;
    }
    ((int*)(smem + AT_POSMAX))[tid] = ((const int*)(p.ws + WS_POSMM))[tid * 2 + 1];
    __syncthreads();
    if (MODE != 2 && blockIdx.x < NB * 4) {
        int tid0 = tid; asm volatile("" : "+v"(tid0));
        dn_scan_block(p, smem + AT_BUF, blockIdx.x, tid0);
        __syncthreads();
    }
    int* qctr = (int*)(p.ws + WS_CTL) + 64;
    if (MODE != 1) for (;;) {
        int tid1 = tid; asm volatile("" : "+v"(tid1));
        if (tid1 == 0) *(int*)(smem + AT_ITEM) = atomicAdd(qctr, 1);
        __syncthreads();
        const int item = *(const int*)(smem + AT_ITEM);
        if (item >= NB * 64) break;
        const int b = item & 7, tb = 63 - (item >> 3);
        SelQ sel;
#pragma unroll
        for (int q = 0; q < 4; ++q) { sel.tau[q] = -INFINITY; sel.cut[q] = 0x7fffffff; }
        if (tb >= 8) attn_pass1(p, smem, b, tb, tid1, sel);
        int tid2 = tid; asm volatile("" : "+v"(tid2));
        attn_pass2(p, smem, b, tb, tid2, sel);
    }
}

__device__ __forceinline__ constexpr int sig16(int x) { return (x & ~12) | ((x & 4) << 1) | ((x & 8) >> 1); }
constexpr int PREP_WAVE_LDS = 2 * 64 * 72 * 2 + 4 * 64 * 4;
constexpr int PREP_LDS = NWAVES * PREP_WAVE_LDS;
__device__ __forceinline__ void ph_dn_prep(const P& p, char* smem) {
    const int tid = tid_opaque();
    const int wave = tid >> 6;
    char* wl = smem + wave * PREP_WAVE_LDS;
    float* sA = (float*)wl;
    bf16_t* sTw = (bf16_t*)wl; bf16_t* sTu = sTw + 64 * 72;
    float* sG = (float*)(wl + 2 * 64 * 72 * 2); float* sB = sG + 64; float* sE = sB + 64; float* sL = sE + 64;
    const bf16_t* dq = (const bf16_t*)(p.ws + WS_DQ); const bf16_t* dk = (const bf16_t*)(p.ws + WS_DK);
    const bf16_t* dkT = (const bf16_t*)(p.ws + WS_DKT); const bf16_t* dvT = (const bf16_t*)(p.ws + WS_DVT);
    const float* dbeta = (const float*)(p.ws + WS_DBG); const float* dg = dbeta + NTOK * 4;
    unsigned char* dob = (unsigned char*)p.out;
    bf16_t* PPg = (bf16_t*)(dob + DO_PP); float* GCg = (float*)(dob + DO_GC); float* EGg = (float*)(dob + DO_EG); float* LLg = (float*)(dob + DO_LL);
    for (int item = blockIdx.x * NWAVES + wave; item < NB * 4 * 32; item += gridDim.x * NWAVES) {
        int lane = tid & 63; asm volatile("" : "+v"(lane));
        const int hf = lane >> 5, l31 = lane & 31;
        const int bh = item >> 5, c = item & 31, b = bh >> 2, hh = bh & 3;
        const int tok0 = b * NT + c * 64;
        bf16_t* WN = (bf16_t*)(dob + DO_WN) + (size_t)item * 64 * 128; bf16_t* Ug = (bf16_t*)(dob + DO_U) + (size_t)item * 64 * 128;
        bf16_t* PP = PPg + (size_t)item * 64 * 64;
        float G, beta, eG;
        {
            const float g = dg[(size_t)(tok0 + lane) * 4 + hh];
            beta = dbeta[(size_t)(tok0 + lane) * 4 + hh];
            G = g;
#pragma unroll
            for (int o = 1; o < 64; o <<= 1) { const float n = __shfl_up(G, o); if (lane >= o) G += n; }
            const float Gl = __shfl(G, 63);
            eG = __expf(G);
            sG[lane] = G; sB[lane] = beta; sE[lane] = eG; sL[lane] = __expf(Gl - G);
            EGg[item * 64 + lane] = eG; LLg[item * 64 + lane] = __expf(Gl - G);
            if (lane == 0) GCg[item] = __expf(Gl);
        }
        f32x16 kk00, kk10, kk11, qk00, qk10, qk11;
#pragma unroll
        for (int r = 0; r < 16; ++r) { kk00[r] = 0.f; kk10[r] = 0.f; kk11[r] = 0.f; qk00[r] = 0.f; qk10[r] = 0.f; qk11[r] = 0.f; }
        {
            const bf16_t* kr0 = dk + (size_t)(tok0 + l31) * 512 + hh * 128 + 8 * hf; const bf16_t* kr1 = kr0 + 32 * 512;
            const bf16_t* qr0 = dq + (size_t)(tok0 + l31) * 512 + hh * 128 + 8 * hf; const bf16_t* qr1 = qr0 + 32 * 512;
#pragma unroll
            for (int s = 0; s < 8; ++s) {
                const bf16x8 k0 = *(const bf16x8*)(kr0 + s * 16), k1 = *(const bf16x8*)(kr1 + s * 16), q0 = *(const bf16x8*)(qr0 + s * 16), q1 = *(const bf16x8*)(qr1 + s * 16);
                kk00 = __builtin_amdgcn_mfma_f32_32x32x16_bf16(k0, k0, kk00, 0, 0, 0);
                kk10 = __builtin_amdgcn_mfma_f32_32x32x16_bf16(k1, k0, kk10, 0, 0, 0);
                kk11 = __builtin_amdgcn_mfma_f32_32x32x16_bf16(k1, k1, kk11, 0, 0, 0);
                qk00 = __builtin_amdgcn_mfma_f32_32x32x16_bf16(q0, k0, qk00, 0, 0, 0);
                qk10 = __builtin_amdgcn_mfma_f32_32x32x16_bf16(q1, k0, qk10, 0, 0, 0);
                qk11 = __builtin_amdgcn_mfma_f32_32x32x16_bf16(q1, k1, qk11, 0, 0, 0);
            }
        }
        __threadfence_block();
        {
            const float Gc0 = sG[l31], Gc1 = sG[32 + l31];
            float* sA0 = sA + (4 * hf) * 64 + l31;
            bf16_t* PP0 = PP + (4 * hf) * 64 + sig16(l31);
            const float* sGr = sG + 4 * hf; const float* sBr = sB + 4 * hf;
            const int jrel = l31 - 4 * hf;
#pragma unroll
            for (int r = 0; r < 16; ++r) {
                const int ro = (r & 3) + 8 * (r >> 2);
                const float Gi0 = sGr[ro], Gi1 = sGr[32 + ro], Bi0 = sBr[ro], Bi1 = sBr[32 + ro];
                {
                    const float dec = (jrel <= ro) ? __expf(Gi0 - Gc0) : 0.f;
                    sA0[ro * 64] = (jrel < ro) ? Bi0 * kk00[r] * dec : 0.f;
                    PP0[ro * 64] = f2bf(qk00[r] * dec);
                    PP0[ro * 64 + 32] = 0;
                }
                {
                    const float dec = __expf(Gi1 - Gc0);
                    sA0[(32 + ro) * 64] = Bi1 * kk10[r] * dec;
                    PP0[(32 + ro) * 64] = f2bf(qk10[r] * dec);
                }
                {
                    const float dec = (jrel <= ro) ? __expf(Gi1 - Gc1) : 0.f;
                    sA0[(32 + ro) * 64 + 32] = (jrel < ro) ? Bi1 * kk11[r] * dec : 0.f;
                    PP0[(32 + ro) * 64 + 32] = f2bf(qk11[r] * dec);
                }
            }
        }
        __threadfence_block();
        float x[64];
#pragma unroll
        for (int i = 0; i < 64; ++i) x[i] = (i == lane) ? 1.f : 0.f;
#pragma unroll
        for (int i = 1; i < 64; ++i) {
            float acc = x[i];
#pragma unroll
            for (int m4 = 0; m4 < i; m4 += 4) {
                const f32x4 a = *(const f32x4*)(sA + i * 64 + m4);
                acc -= a[0] * x[m4];
                if (m4 + 1 < i) acc -= a[1] * x[m4 + 1];
                if (m4 + 2 < i) acc -= a[2] * x[m4 + 2];
                if (m4 + 3 < i) acc -= a[3] * x[m4 + 3];
            }
            x[i] = acc;
            __builtin_amdgcn_sched_barrier(0);
        }
        __threadfence_block();
        {
            const float sw = beta * eG;
#pragma unroll
            for (int i = 0; i < 64; ++i) { sTw[i * 72 + lane] = f2bf(x[i] * sw); sTu[i * 72 + lane] = f2bf(x[i] * beta); }
        }
        __threadfence_block();
        {
            bf16x8 tw[2][4], tu[2][4];
#pragma unroll
            for (int mt = 0; mt < 2; ++mt)
#pragma unroll
                for (int s = 0; s < 4; ++s) { tw[mt][s] = *(const bf16x8*)(sTw + (mt * 32 + l31) * 72 + s * 16 + 8 * hf); tu[mt][s] = *(const bf16x8*)(sTu + (mt * 32 + l31) * 72 + s * 16 + 8 * hf); }
            const bf16_t* kTb = dkT + ((size_t)bh * 128 + l31) * NT + c * 64 + 8 * hf;
            const bf16_t* vTb = dvT + ((size_t)bh * 128 + l31) * NT + c * 64 + 8 * hf;
#pragma unroll 1
            for (int nt = 0; nt < 4; ++nt) {
                f32x16 w0, w1, u0, u1;
#pragma unroll
                for (int r = 0; r < 16; ++r) { w0[r] = 0.f; w1[r] = 0.f; u0[r] = 0.f; u1[r] = 0.f; }
#pragma unroll
                for (int s = 0; s < 4; ++s) {
                    const bf16x8 kb = *(const bf16x8*)(kTb + (size_t)nt * 32 * NT + s * 16), vb = *(const bf16x8*)(vTb + (size_t)nt * 32 * NT + s * 16);
                    w0 = __builtin_amdgcn_mfma_f32_32x32x16_bf16(tw[0][s], kb, w0, 0, 0, 0);
                    w1 = __builtin_amdgcn_mfma_f32_32x32x16_bf16(tw[1][s], kb, w1, 0, 0, 0);
                    u0 = __builtin_amdgcn_mfma_f32_32x32x16_bf16(tu[0][s], vb, u0, 0, 0, 0);
                    u1 = __builtin_amdgcn_mfma_f32_32x32x16_bf16(tu[1][s], vb, u1, 0, 0, 0);
                }
                bf16_t* WN0 = WN + (4 * hf) * 128 + nt * 32 + sig16(l31); bf16_t* U0 = Ug + (4 * hf) * 128 + nt * 32 + l31;
#pragma unroll
                for (int r = 0; r < 16; ++r) {
                    const int ro = (r & 3) + 8 * (r >> 2);
                    WN0[ro * 128] = f2bf(-w0[r]); WN0[(32 + ro) * 128] = f2bf(-w1[r]);
                    U0[ro * 128] = f2bf(u0[r]); U0[(32 + ro) * 128] = f2bf(u1[r]);
                }
            }
        }
        __threadfence_block();
    }
}

__device__ __forceinline__ bf16x8 pack_frag(const f32x16& t, int s) {
    bf16x8 f;
#pragma unroll
    for (int j = 0; j < 8; ++j) f[j] = (short)f2bf(t[8 * s + j]);
    return f;
}
__device__ __forceinline__ bf16x8 pack_frag_scaled(const f32x16& t, int s, const f32x4& sc0, const f32x4& sc1) {
    bf16x8 f;
#pragma unroll
    for (int j = 0; j < 4; ++j) { f[j] = (short)f2bf(t[8 * s + j] * sc0[j]); f[4 + j] = (short)f2bf(t[8 * s + 4 + j] * sc1[j]); }
    return f;
}
__device__ __forceinline__ bf16x8 load_perm_frag(const bf16_t* ptr) {
    const uint2 lo = *(const uint2*)ptr, hi = *(const uint2*)(ptr + 8);
    union { uint4 u; bf16x8 f; } cv; cv.u = make_uint4(lo.x, lo.y, hi.x, hi.y); return cv.f;
}
constexpr int SC_WN = 0, SC_Q = 16384, SC_KT = 32768, SC_PP = SC_KT + 128 * 144, SC_U = SC_PP + 64 * 144, SC_EG = SC_U + 16384, SC_LL = SC_EG + 256, SC_GC = SC_LL + 256, SC_BYTES = SC_GC + 16;
constexpr int SCAN_LDS = 2 * SC_BYTES;
#define SCAN_DECL uint4 wn0, wn1, wn2, wn3, q0, q1, q2, q3, kt0, kt1, kt2, kt3, pp0, pp1, u0, u1, u2, u3; float egv = 0.f, gcv = 0.f;
#define SCAN_LD4(i, WNR, UR, QR, KTR) { const int x = hl + 256 * (i); WNR = WNp[x]; UR = Up[x]; \
        QR = *(const uint4*)(dqb + (size_t)(x >> 4) * 512 + (x & 15) * 8); \
        KTR = *(const uint4*)(ktb + (size_t)(x >> 3) * NT + (x & 7) * 8); }
#define SCAN_LOAD(c) { const int ci = bh * 32 + (c); \
        const uint4* WNp = (const uint4*)(dob + DO_WN + (size_t)ci * 16384); const uint4* Up = (const uint4*)(dob + DO_U + (size_t)ci * 16384); const uint4* PPp = (const uint4*)(dob + DO_PP + (size_t)ci * 8192); \
        const bf16_t* dqb = dqh + (size_t)(c) * 64 * 512; const bf16_t* ktb = dkTh + (c) * 64; \
        SCAN_LD4(0, wn0, u0, q0, kt0) SCAN_LD4(1, wn1, u1, q1, kt1) SCAN_LD4(2, wn2, u2, q2, kt2) SCAN_LD4(3, wn3, u3, q3, kt3) \
        pp0 = PPp[hl]; pp1 = PPp[hl + 256]; \
        if (hl < 64) egv = ((const float*)(dob + DO_EG))[ci * 64 + hl]; else if (hl < 128) egv = ((const float*)(dob + DO_LL))[ci * 64 + hl - 64]; \
        if (hl == 128) gcv = ((const float*)(dob + DO_GC))[ci]; }
#define SCAN_ST4(i, WNR, UR, QR, KTR) { const int x = hl + 256 * (i); \
        { const int r = x >> 4, cc = x & 15; *(uint4*)(sbuf + SC_WN + r * 256 + ((cc ^ (r & 15)) << 4)) = WNR; } \
        *(uint4*)(sbuf + SC_U + x * 16) = UR; \
        { const int r = x >> 4, cc = x & 15, a = cc >> 1, g = cc & 1; char* row = sbuf + SC_Q + r * 256; \
          *(uint2*)(row + (((2 * a) ^ (r & 15)) << 4) + g * 8) = make_uint2(QR.x, QR.y); \
          *(uint2*)(row + (((2 * a + 1) ^ (r & 15)) << 4) + g * 8) = make_uint2(QR.z, QR.w); } \
        { const int d = x >> 3, cc = x & 7, a = cc >> 1, g = cc & 1; char* row = sbuf + SC_KT + d * 144; \
          *(uint2*)(row + (2 * a) * 16 + g * 8) = make_uint2(KTR.x, KTR.y); \
          *(uint2*)(row + (2 * a + 1) * 16 + g * 8) = make_uint2(KTR.z, KTR.w); } }
#define SCAN_STORE(bufptr) { char* sbuf = (bufptr); \
        SCAN_ST4(0, wn0, u0, q0, kt0) SCAN_ST4(1, wn1, u1, q1, kt1) SCAN_ST4(2, wn2, u2, q2, kt2) SCAN_ST4(3, wn3, u3, q3, kt3) \
        *(uint4*)(sbuf + SC_PP + (hl >> 3) * 144 + (hl & 7) * 16) = pp0; \
        *(uint4*)(sbuf + SC_PP + ((hl + 256) >> 3) * 144 + (hl & 7) * 16) = pp1; \
        if (hl < 128) ((float*)(sbuf + SC_EG))[hl] = egv; \
        if (hl == 128) *(float*)(sbuf + SC_GC) = gcv; }
__device__ __forceinline__ void dn_scan_block(const P& p, char* smem, int bh, int tid) {
    const int wave = tid >> 6, lane = tid & 63;
    const int hf = lane >> 5, l31 = lane & 31;
    const int b = bh >> 2, hh = bh & 3;
    const bool helper = wave >= 4;
    const int hl = tid - 256, sl = wave;
    bf16_t* dno = (bf16_t*)((unsigned char*)p.out + DO_DNO);
    if (helper) {
        const unsigned char* dob = (const unsigned char*)p.out;
        const bf16_t* dqh = (const bf16_t*)(p.ws + WS_DQ) + (size_t)b * NT * 512 + hh * 128; const bf16_t* dkTh = (const bf16_t*)(p.ws + WS_DKT) + (size_t)bh * 128 * NT;
        SCAN_DECL
        SCAN_LOAD(0) SCAN_STORE(smem) SCAN_LOAD(1)
        __syncthreads();
#pragma unroll 1
        for (int c = 0; c < NT / 64; ++c) {
            if (c + 1 < NT / 64) SCAN_STORE(smem + ((c + 1) & 1) * SC_BYTES)
            if (c + 2 < NT / 64) SCAN_LOAD(c + 2)
            __syncthreads();
        }
        return;
    }
    f32x16 S[4];
#pragma unroll
    for (int T = 0; T < 4; ++T)
#pragma unroll
        for (int r = 0; r < 16; ++r) S[T][r] = 0.f;
    __syncthreads();
#pragma unroll 1
    for (int c = 0; c < NT / 64; ++c) {
        char* buf = smem + (c & 1) * SC_BYTES;
        {
            const int tok0 = b * NT + c * 64;
            const int sw = l31 & 15;
            const char* wnr = buf + SC_WN + l31 * 256; const char* qr = buf + SC_Q + l31 * 256;
            const char* ktr = buf + SC_KT + l31 * 144 + 16 * hf; const char* ppr = buf + SC_PP + l31 * 144 + 16 * hf;
            const bf16_t* ur = (const bf16_t*)(buf + SC_U) + sl * 32 + l31;
            const float* egs = (const float*)(buf + SC_EG); const float* lls = (const float*)(buf + SC_LL);
            const float gc = *(const float*)(buf + SC_GC);
            bf16x8 SB[4][2];
#pragma unroll
            for (int T = 0; T < 4; ++T) { SB[T][0] = pack_frag(S[T], 0); SB[T][1] = pack_frag(S[T], 1); }
            f32x16 D[2], O[2];
#pragma unroll
            for (int mt = 0; mt < 2; ++mt)
#pragma unroll
                for (int r = 0; r < 16; ++r) { D[mt][r] = bf2f(ur[(mt * 32 + (r & 3) + 8 * (r >> 2) + 4 * hf) * 128]); O[mt][r] = 0.f; }
#pragma unroll
            for (int mt = 0; mt < 2; ++mt)
#pragma unroll
                for (int T = 0; T < 4; ++T)
#pragma unroll
                    for (int s = 0; s < 2; ++s) {
                        const int co = (((2 * (2 * T + s) + hf) ^ sw) << 4) + mt * 32 * 256;
                        const bf16x8 wa = *(const bf16x8*)(wnr + co);
                        const bf16x8 qa = *(const bf16x8*)(qr + co);
                        D[mt] = __builtin_amdgcn_mfma_f32_32x32x16_bf16(wa, SB[T][s], D[mt], 0, 0, 0);
                        O[mt] = __builtin_amdgcn_mfma_f32_32x32x16_bf16(qa, SB[T][s], O[mt], 0, 0, 0);
                    }
            __builtin_amdgcn_sched_barrier(0);
            bf16x8 DB[2][2], DL[2][2];
#pragma unroll
            for (int mt = 0; mt < 2; ++mt) {
#pragma unroll
                for (int g4 = 0; g4 < 4; ++g4) {
                    const f32x4 eg = *(const f32x4*)(egs + mt * 32 + g4 * 8 + 4 * hf);
#pragma unroll
                    for (int j = 0; j < 4; ++j) O[mt][g4 * 4 + j] *= eg[j];
                }
                const f32x4 l0 = *(const f32x4*)(lls + mt * 32 + 0 + 4 * hf), l1 = *(const f32x4*)(lls + mt * 32 + 8 + 4 * hf);
                const f32x4 l2 = *(const f32x4*)(lls + mt * 32 + 16 + 4 * hf), l3 = *(const f32x4*)(lls + mt * 32 + 24 + 4 * hf);
                DB[mt][0] = pack_frag(D[mt], 0); DB[mt][1] = pack_frag(D[mt], 1);
                DL[mt][0] = pack_frag_scaled(D[mt], 0, l0, l1); DL[mt][1] = pack_frag_scaled(D[mt], 1, l2, l3);
            }
#pragma unroll
            for (int mt = 0; mt < 2; ++mt)
#pragma unroll
                for (int ks = 0; ks < 4; ++ks) {
                    const bf16x8 pa = *(const bf16x8*)(ppr + mt * 32 * 144 + ks * 32);
                    O[mt] = __builtin_amdgcn_mfma_f32_32x32x16_bf16(pa, DB[ks >> 1][ks & 1], O[mt], 0, 0, 0);
                }
            __builtin_amdgcn_sched_barrier(0);
            {
                bf16_t* orow = dno + (size_t)tok0 * 512 + hh * 128 + sl * 32 + l31;
#pragma unroll
                for (int mt = 0; mt < 2; ++mt)
#pragma unroll
                    for (int r = 0; r < 16; ++r) orow[(size_t)(mt * 32 + (r & 3) + 8 * (r >> 2) + 4 * hf) * 512] = f2bf(O[mt][r]);
            }
#pragma unroll
            for (int T = 0; T < 4; ++T) {
#pragma unroll
                for (int r = 0; r < 16; ++r) S[T][r] *= gc;
#pragma unroll
                for (int ks = 0; ks < 4; ++ks) {
                    const bf16x8 ka = *(const bf16x8*)(ktr + T * 32 * 144 + ks * 32);
                    S[T] = __builtin_amdgcn_mfma_f32_32x32x16_bf16(ka, DL[ks >> 1][ks & 1], S[T], 0, 0, 0);
                }
            }
        }
        __syncthreads();
    }
}

__device__ __forceinline__ void ph_dn_gate(const P& p) {
    const int tid = tid_opaque();
    const int lane = tid & 63, wave = tid >> 6;
    const bf16_t* dno = (const bf16_t*)((const unsigned char*)p.out + DO_DNO); const bf16_t* proj = (const bf16_t*)(p.ws + WS_PROJ); bf16_t* dnn = (bf16_t*)(p.ws + WS_DK);
    for (int tok = blockIdx.x * NWAVES + wave; tok < NTOK; tok += gridDim.x * NWAVES) {
#pragma unroll
        for (int hh = 0; hh < 4; ++hh) {
            const unsigned orw = *(const unsigned*)(dno + (size_t)tok * 512 + hh * 128 + lane * 2);
            const float o0 = __uint_as_float(orw << 16), o1 = __uint_as_float(orw & 0xffff0000u);
            const float ss = wave_sum(o0 * o0 + o1 * o1);
            const float rs = rsqrtf(ss * (1.f / 128.f) + EPS);
            const unsigned zr = *(const unsigned*)(proj + (size_t)tok * NPROJ + PC_DNZ + hh * 128 + lane * 2);
            const float z0 = __uint_as_float(zr << 16), z1 = __uint_as_float(zr & 0xffff0000u);
            *(unsigned*)(dnn + (size_t)tok * 512 + hh * 128 + lane * 2) = pack2(o0 * rs * p.dn_norm_g[lane * 2] * silu_f(z0), o1 * rs * p.dn_norm_g[lane * 2 + 1] * silu_f(z1));
        }
    }
}

struct EpiOut {
    static constexpr bool PERM = false;
    const float* x; float* out; const float* modf;
    __device__ __forceinline__ void operator()(const f32x4 (&acc)[2][2][4][2], const pg8::DenseSrc::Unit& u, int wr, int wc, int fr, int fq) const {
        const int row0 = u.pm * 256 + wr * 64 + fr, col0 = u.pn * 256 + wc * 32 + 4 * fq;
        const float* gate = modf + (size_t)((u.pm * 256) / NT) * (6 * ND) + 2 * ND;
        f32x4 gv[2][2];
#pragma unroll
        for (int bj = 0; bj < 2; ++bj)
#pragma unroll
            for (int n = 0; n < 2; ++n) gv[bj][n] = *(const f32x4*)(gate + col0 + bj * 128 + n * 16);
#pragma unroll
        for (int ai = 0; ai < 2; ++ai)
#pragma unroll
            for (int m = 0; m < 4; ++m) { const size_t ro = (size_t)(row0 + ai * 128 + m * 16) * ND + col0;
#pragma unroll
                for (int bj = 0; bj < 2; ++bj)
#pragma unroll
                    for (int n = 0; n < 2; ++n) { const f32x4 xv = *(const f32x4*)(x + ro + bj * 128 + n * 16); *(f32x4*)(out + ro + bj * 128 + n * 16) = xv + gv[bj][n] * acc[ai][bj][m][n]; } }
    }
};
__device__ __forceinline__ void ph_gemm_out(const P& p, char* smem) {
    const int tid = tid_opaque();
    pg8::DenseSrc S; S.A0 = (const char*)(p.ws + WS_QN); S.A1 = (const char*)(p.ws + WS_DK); S.Bt = (const char*)(p.ws + WS_WOUT); S.lda = 512; S.K = ND; S.nM = NTOK / 256; S.nN = ND / 256; S.G = gridDim.x; S.c = blockIdx.x; S.ksplit = 8;
    EpiOut E; E.x = p.x; E.out = p.out; E.modf = (const float*)(p.ws + WS_MODF);
    pg8::gemm_phase(tid, (PG8_LAS unsigned char*)smem, ND, S, E);
}

constexpr int ROUTE_LDS = 1024 * 37 * 4 + 2 * 1024 * 4 + 2048;
__device__ __forceinline__ void ph_route(const P& p, char* smem) {
    const int tid = tid_opaque();
    float* sW = (float*)smem;
    float* sA = sW + 1024 * 37; float* sB = sA + 1024;
    int* s_cnt = (int*)(sB + 1024);
    int* s_base = s_cnt + 32; int* s_tok = s_base + 32;
    const int lane = tid & 63, wave = tid >> 6;
    {
        f32x4 tg[2], te[16];
#pragma unroll
        for (int i = 0; i < 2; ++i) tg[i] = *(const f32x4*)(p.rg_w + (size_t)(tid + i * NTHREADS) * 4);
#pragma unroll
        for (int i = 0; i < 16; ++i) te[i] = *(const f32x4*)(p.re_w + (size_t)(tid + i * NTHREADS) * 4);
#pragma unroll
        for (int i = 0; i < 2; ++i) { float* d = sW + (tid + i * NTHREADS) * 37; d[0] = tg[i][0]; d[1] = tg[i][1]; d[2] = tg[i][2]; d[3] = tg[i][3]; }
#pragma unroll
        for (int i = 0; i < 16; ++i) { const int x = tid + i * NTHREADS; float* d = sW + (x >> 3) * 37 + 4 + (x & 7) * 4; d[0] = te[i][0]; d[1] = te[i][1]; d[2] = te[i][2]; d[3] = te[i][3]; }
    }
    bf16_t* h2 = (bf16_t*)(p.ws + WS_H2);
    int* cnt = (int*)(p.ws + WS_CTL); int* list = (int*)(p.ws + WS_LIST); int* tokinfo = (int*)(p.ws + WS_TOKINFO);
    int curb = -1;
    for (int tile = blockIdx.x; tile < NTOK / 64; tile += gridDim.x) {
        const int b = tile / (NT / 64);
        __syncthreads();
        if (b != curb) {
            { const float* mf = (const float*)(p.ws + WS_MODF) + (size_t)b * (6 * ND); for (int d = tid; d < ND; d += NTHREADS) { sA[d] = p.norm2_g[d] * (1.f + mf[4 * ND + d]); sB[d] = mf[3 * ND + d]; } }
            curb = b;
        }
        if (tid < 32) s_cnt[tid] = 0;
        __syncthreads();
        for (int i2 = 0; i2 < 4; ++i2) {
            const int tokA = tile * 64 + wave * 8 + i2 * 2, tokB = tokA + 1;
            const float* xa = p.out + (size_t)tokA * ND; const float* xb = xa + ND;
            float va[16], vb[16]; float sa = 0.f, sb = 0.f;
#pragma unroll
            for (int j = 0; j < 16; ++j) { va[j] = xa[j * 64 + lane]; vb[j] = xb[j * 64 + lane]; sa += va[j] * va[j]; sb += vb[j] * vb[j]; }
            sa = wave_sum(sa); sb = wave_sum(sb);
            const float ra = rsqrtf(sa * (1.f / ND) + EPS), rb = rsqrtf(sb * (1.f / ND) + EPS);
#pragma unroll
            for (int j = 0; j < 16; ++j) {
                const int d = j * 64 + lane;
                va[j] = va[j] * ra * sA[d] + sB[d]; vb[j] = vb[j] * rb * sA[d] + sB[d];
                h2[(size_t)tokA * ND + d] = f2bf(va[j]); h2[(size_t)tokB * ND + d] = f2bf(vb[j]);
            }
            float la = 0.f, lb = 0.f;
#pragma unroll 4
            for (int o = 0; o < 36; ++o) {
                float a = 0.f, c = 0.f;
#pragma unroll
                for (int j = 0; j < 16; ++j) { const float w = sW[(j * 64 + lane) * 37 + o]; a += va[j] * w; c += vb[j] * w; }
                a = wave_sum(a); c = wave_sum(c);
                if (lane == o) { la = a; lb = c; }
            }
            const float bias = (lane < 4) ? p.rg_b[lane] : ((lane < 36) ? p.re_b[lane - 4] : 0.f);
            la += bias; lb += bias;
#pragma unroll
            for (int which = 0; which < 2; ++which) {
                const float mylogit = which ? lb : la; const int tok = which ? tokB : tokA;
                float gl[4];
#pragma unroll
                for (int j = 0; j < 4; ++j) gl[j] = __shfl(mylogit, j);
                int gsel = 0; float gm = gl[0];
#pragma unroll
                for (int j = 1; j < 4; ++j) if (gl[j] > gm) { gm = gl[j]; gsel = j; }
                float gs = 0.f;
#pragma unroll
                for (int j = 0; j < 4; ++j) gs += __expf(gl[j] - gm);
                const float gtop = 1.f / gs;
                float el[8];
#pragma unroll
                for (int j = 0; j < 8; ++j) el[j] = __shfl(mylogit, 4 + gsel * 8 + j);
                int e1 = 0; float m1 = el[0];
#pragma unroll
                for (int j = 1; j < 8; ++j) if (el[j] > m1) { m1 = el[j]; e1 = j; }
                int e2 = -1; float m2 = -INFINITY;
#pragma unroll
                for (int j = 0; j < 8; ++j) if (j != e1 && el[j] > m2) { m2 = el[j]; e2 = j; }
                const float r2 = __expf(m2 - m1);
                const float w1v = gtop / (1.f + r2), w2v = gtop * r2 / (1.f + r2);
                if (lane == 0) {
                    const int ea = gsel * 8 + e1, eb = gsel * 8 + e2;
                    const int pa = atomicAdd(&s_cnt[ea], 1), pb = atomicAdd(&s_cnt[eb], 1);
                    int* st = s_tok + (tok & 63) * 4; st[0] = ea; st[1] = pa; st[2] = eb; st[3] = pb;
                    int* ti = tokinfo + (size_t)tok * 8; ti[4] = __float_as_int(w1v); ti[5] = __float_as_int(w2v);
                }
            }
        }
        __syncthreads();
        if (tid < 32) s_base[tid] = atomicAdd(&cnt[tid], s_cnt[tid]);
        __syncthreads();
        if (tid < 64) {
            const int tok = tile * 64 + tid; const int* st = s_tok + tid * 4;
            const int ea = st[0], pa = s_base[ea] + st[1], eb = st[2], pb = s_base[eb] + st[3];
            list[ea * NTOK + pa] = tok; list[eb * NTOK + pb] = tok;
            int* ti = tokinfo + (size_t)tok * 8; ti[0] = ea; ti[1] = pa; ti[2] = eb; ti[3] = pb;
        }
    }
}

struct MoeIdx { int rowoff[NE + 1]; int tileoff[NE + 1]; };
__device__ __forceinline__ void moe_index(const int tid, const P& p, MoeIdx* mi) {
    if (tid == 0) {
        const int* cnt = (const int*)(p.ws + WS_CTL);
        int r = 0, t = 0;
        for (int e = 0; e < NE; ++e) { mi->rowoff[e] = r; mi->tileoff[e] = t; const int c = cnt[e]; r += c; t += (c + 255) >> 8; }
        mi->rowoff[NE] = r; mi->tileoff[NE] = t;
    }
    __syncthreads();
}
struct MoeSrc {
    struct Unit { int e, ml, pn, nrows, row0; };
    const MoeIdx* mi; const int* list; const char* Ab; const char* Bt; size_t bstride; int K, G, c; bool gather;
    __device__ __forceinline__ bool next(int i, Unit& u) const {
        const int L = i * G + c; if (L >= mi->tileoff[NE] * 4) return false;
        const int mt = L >> 2; u.pn = L & 3;
        int e = 0; while (mi->tileoff[e + 1] <= mt) ++e;
        u.e = e; u.ml = mt - mi->tileoff[e]; u.row0 = mi->rowoff[e] + u.ml * 256;
        u.nrows = min(256, mi->rowoff[e + 1] - u.row0);
        return true;
    }
    __device__ __forceinline__ unsigned one(const Unit& u, int r, int C) const {
        const int rr = min(r, u.nrows - 1);
        const int arow = gather ? list[u.e * NTOK + u.ml * 256 + rr] : (u.row0 + rr);
        return (unsigned)((arow * K + C) * 2);
    }
    __device__ __forceinline__ void a_off(const Unit& u, int R0, int C0, int R1, int C1, pg8::AO& ao) const {
        ao.h0p0 = one(u, R0, C0); ao.h0p1 = one(u, R1, C1); ao.h1p0 = one(u, 128 + R0, C0); ao.h1p1 = one(u, 128 + R1, C1);
    }
    __device__ __forceinline__ const char* a_base(const Unit&, int kt) const { return Ab + (size_t)kt * 128; }
    __device__ __forceinline__ const char* b_base(const Unit& u) const { return Bt + (size_t)u.e * bstride + (size_t)u.pn * 256 * K * 2; }
};
constexpr int L_MOE = pg8::STAGE_BYTES + (int)sizeof(MoeIdx) + 16;

struct EpiUp {
    static constexpr bool PERM = true;
    bf16_t* act;
    __device__ __forceinline__ void operator()(const f32x4 (&acc)[2][2][4][2], const MoeSrc::Unit& u, int wr, int wc, int fr, int fq) const {
        const int col0 = u.pn * 128 + wc * 32 + 8 * fq;
#pragma unroll
        for (int ai = 0; ai < 2; ++ai)
#pragma unroll
            for (int m = 0; m < 4; ++m) {
                const int r = ai * 128 + wr * 64 + m * 16 + fr;
                if (r < u.nrows) {
                    const f32x4 g0 = acc[ai][0][m][0], g1 = acc[ai][0][m][1], u0 = acc[ai][1][m][0], u1 = acc[ai][1][m][1];
                    *(uint4*)(act + (size_t)(u.row0 + r) * EFF + col0) = make_uint4(pack2(silu_f(g0[0]) * u0[0], silu_f(g0[1]) * u0[1]), pack2(silu_f(g0[2]) * u0[2], silu_f(g0[3]) * u0[3]),
                                                                                     pack2(silu_f(g1[0]) * u1[0], silu_f(g1[1]) * u1[1]), pack2(silu_f(g1[2]) * u1[2], silu_f(g1[3]) * u1[3]));
                }
            }
    }
};
__device__ __forceinline__ void ph_moe_up(const P& p, char* smem) {
    const int tid = tid_opaque();
    MoeIdx* mi = (MoeIdx*)(smem + pg8::STAGE_BYTES);
    moe_index(tid, p, mi);
    MoeSrc S; S.mi = mi; S.list = (const int*)(p.ws + WS_LIST); S.Ab = (const char*)(p.ws + WS_H2); S.Bt = (const char*)(p.ws + WS_W13); S.bstride = (size_t)1024 * ND * 2; S.K = ND; S.G = gridDim.x; S.c = blockIdx.x; S.gather = true;
    EpiUp E; E.act = (bf16_t*)(p.ws + WS_ACT);
    pg8::gemm_phase(tid, (PG8_LAS unsigned char*)smem, ND, S, E);
}

struct EpiDown {
    static constexpr bool PERM = true;
    bf16_t* yb;
    __device__ __forceinline__ void operator()(const f32x4 (&acc)[2][2][4][2], const MoeSrc::Unit& u, int wr, int wc, int fr, int fq) const {
        const int col0 = u.pn * 256 + wc * 32 + 8 * fq;
#pragma unroll
        for (int ai = 0; ai < 2; ++ai)
#pragma unroll
            for (int m = 0; m < 4; ++m) {
                const int r = ai * 128 + wr * 64 + m * 16 + fr;
                if (r < u.nrows) {
#pragma unroll
                    for (int bj = 0; bj < 2; ++bj) { const f32x4 v0 = acc[ai][bj][m][0], v1 = acc[ai][bj][m][1];
                        *(uint4*)(yb + (size_t)(u.row0 + r) * ND + col0 + bj * 128) = make_uint4(pack2(v0[0], v0[1]), pack2(v0[2], v0[3]), pack2(v1[0], v1[1]), pack2(v1[2], v1[3])); }
                }
            }
    }
};
__device__ __forceinline__ void ph_moe_down(const P& p, char* smem) {
    const int tid = tid_opaque();
    MoeIdx* mi = (MoeIdx*)(smem + pg8::STAGE_BYTES);
    moe_index(tid, p, mi);
    MoeSrc S; S.mi = mi; S.list = nullptr; S.Ab = (const char*)(p.ws + WS_ACT); S.Bt = (const char*)(p.ws + WS_W2); S.bstride = (size_t)ND * EFF * 2; S.K = EFF; S.G = gridDim.x; S.c = blockIdx.x; S.gather = false;
    EpiDown E; E.yb = (bf16_t*)(p.ws + WS_YBUF);
    pg8::gemm_phase(tid, (PG8_LAS unsigned char*)smem, EFF, S, E);
}

__device__ __forceinline__ void ph_combine(const P& p, char* smem) {
    const int tid = tid_opaque();
    MoeIdx* mi = (MoeIdx*)smem;
    float* sG = (float*)(mi + 1);
    moe_index(tid, p, mi);
    const int lane = tid & 63, wave = tid >> 6;
    const bf16_t* yb = (const bf16_t*)(p.ws + WS_YBUF); const int* tokinfo = (const int*)(p.ws + WS_TOKINFO);
    int curb = -1;
    for (int tile = blockIdx.x; tile < NTOK / 64; tile += gridDim.x) {
        const int b = tile / (NT / 64);
        if (b != curb) {
            __syncthreads();
            { const float* mf = (const float*)(p.ws + WS_MODF) + (size_t)b * (6 * ND) + 5 * ND; for (int d = tid; d < ND; d += NTHREADS) sG[d] = mf[d]; }
            __syncthreads();
            curb = b;
        }
        for (int i = 0; i < 8; ++i) {
            const int tok = tile * 64 + wave * 8 + i;
            const int* ti = tokinfo + (size_t)tok * 8;
            const int ra = mi->rowoff[ti[0]] + ti[1], rb = mi->rowoff[ti[2]] + ti[3];
            const float wa = __int_as_float(ti[4]), wb = __int_as_float(ti[5]);
#pragma unroll
            for (int j = 0; j < 4; ++j) {
                const int d = j * 256 + lane * 4;
                const uint2 ya = *(const uint2*)(yb + (size_t)ra * ND + d), ybv = *(const uint2*)(yb + (size_t)rb * ND + d);
                f32x4 xv = *(const f32x4*)(p.out + (size_t)tok * ND + d);
                xv[0] += sG[d] * (wa * __uint_as_float(ya.x << 16) + wb * __uint_as_float(ybv.x << 16));
                xv[1] += sG[d + 1] * (wa * __uint_as_float(ya.x & 0xffff0000u) + wb * __uint_as_float(ybv.x & 0xffff0000u));
                xv[2] += sG[d + 2] * (wa * __uint_as_float(ya.y << 16) + wb * __uint_as_float(ybv.y << 16));
                xv[3] += sG[d + 3] * (wa * __uint_as_float(ya.y & 0xffff0000u) + wb * __uint_as_float(ybv.y & 0xffff0000u));
                *(f32x4*)(p.out + (size_t)tok * ND + d) = xv;
            }
        }
    }
}

#define XB_TMO      128
#define XB_XCNT(j)  (256  + 64 * (j))
#define XB_XSUB(j)  (1280 + 64 * (j))
#define XB_XGEN(j)  (2304 + 64 * (j))
#define XB_TOP      3328
#define XB_TOPGEN   3392
#define XCD_BAR_WORDS 3456
#define XB_SPIN_CAP (1u << 20)
#define LAS __attribute__((address_space(3)))
__device__ __forceinline__ unsigned xb_ld(unsigned* p)              { return __hip_atomic_load(p, __ATOMIC_RELAXED, __HIP_MEMORY_SCOPE_AGENT); }
__device__ __forceinline__ unsigned xb_add(unsigned* p, unsigned v) { return __hip_atomic_fetch_add(p, v, __ATOMIC_RELAXED, __HIP_MEMORY_SCOPE_AGENT); }
__device__ __forceinline__ unsigned xb_xcc_id() { return (unsigned)__builtin_amdgcn_s_getreg((3 << 11) | 20) & 0xFu; }
#define XB_SPIN(cond, bar) do { unsigned _sp = 0; while (cond) { __builtin_amdgcn_s_sleep(1); \
    if ((++_sp & 255u) == 0u) { if (xb_ld(&(bar)[XB_TMO])) break; if (_sp > XB_SPIN_CAP) { atomicAdd(&(bar)[XB_TMO], 1u); break; } } } } while (0)
struct XcdBarrier { unsigned* bar; unsigned x; volatile LAS unsigned* st; };
__device__ __forceinline__ XcdBarrier xcd_barrier_post(unsigned* bar, volatile LAS unsigned* st) {
    XcdBarrier b; b.bar = bar; b.x = xb_xcc_id(); b.st = st;
    if (threadIdx.x == 0) (void)xb_add(&bar[XB_XCNT(b.x)], 1u);
    return b;
}
__device__ __forceinline__ void xcd_barrier_complete(unsigned* bar, unsigned x, unsigned& nloc, unsigned& nx) {
    const unsigned G = gridDim.x * gridDim.y * gridDim.z;
    unsigned sum, cnt, mine, sp = 0u;
    for (;;) {
        sum = 0u; cnt = 0u; mine = 0u;
#pragma unroll
        for (unsigned j = 0; j < 16; ++j) { const unsigned c = xb_ld(&bar[XB_XCNT(j)]); sum += c; cnt += (c > 0u) ? 1u : 0u; mine = (j == x) ? c : mine; }
        if (sum == G) break;
        __builtin_amdgcn_s_sleep(1);
        if ((++sp & 255u) == 0u) { if (xb_ld(&bar[XB_TMO])) break; if (sp > XB_SPIN_CAP) { atomicAdd(&bar[XB_TMO], 1u); break; } }
    }
    nloc = mine > 0u ? mine : 1u; nx = cnt > 0u ? cnt : 1u;
}
__device__ __forceinline__ void xcd_barrier(const XcdBarrier& b) {
    asm volatile("s_waitcnt vmcnt(0)" ::: "memory");
    __syncthreads();
    if (threadIdx.x == 0) {
        unsigned* bar = b.bar;
        __builtin_amdgcn_s_waitcnt(0);
        unsigned nloc = b.st[0], nx = b.st[1];
        if (nloc == 0u) { xcd_barrier_complete(bar, b.x, nloc, nx); b.st[0] = nloc; b.st[1] = nx; }
        const unsigned old = xb_add(&bar[XB_XSUB(b.x)], 1u);
        const unsigned gen = old / nloc;
        if (old + 1u == (gen + 1u) * nloc) {
            __builtin_amdgcn_fence(__ATOMIC_RELEASE, "agent");
            asm volatile("s_waitcnt vmcnt(0)" ::: "memory");
            const unsigned og = xb_add(&bar[XB_TOP], 1u);
            const unsigned tg = og / nx;
            if (og + 1u == (tg + 1u) * nx) xb_add(&bar[XB_TOPGEN], 1u);
            else XB_SPIN(xb_ld(&bar[XB_TOPGEN]) == tg, bar);
            __builtin_amdgcn_fence(__ATOMIC_ACQUIRE, "agent");
            xb_add(&bar[XB_XGEN(b.x)], 1u);
            asm volatile("s_waitcnt vmcnt(0)" ::: "memory");
        } else {
            XB_SPIN(xb_ld(&bar[XB_XGEN(b.x)]) == gen, bar);
            __builtin_amdgcn_fence(__ATOMIC_ACQUIRE, "agent");
            asm volatile("s_waitcnt vmcnt(0)" ::: "memory");
        }
    }
    __syncthreads();
}

namespace cg = cooperative_groups;
extern __shared__ __attribute__((aligned(16))) char dyn_smem[];
constexpr int cmax(int a, int b) { return a > b ? a : b; }
constexpr int L_G1 = pg8::STAGE_BYTES;
constexpr int MEGA_LDS = cmax(cmax(cmax(ROUTE_LDS, PREP_LDS), cmax(cmax(AT_BUF + SCAN_LDS, ATTM_LDS), L_G1)), L_MOE);
typedef const unsigned long long __attribute__((address_space(4)))* kargp_t;
__device__ __forceinline__ void load_params(P& p, kargp_t ka) {
    asm volatile("" : "+s"(ka));
    typedef __attribute__((address_space(1))) char* gptr_t;
    const void** d = (const void**)&p;
#pragma unroll
    for (int i = 0; i < (int)(sizeof(P) / 8); ++i) d[i] = (const void*)(gptr_t)ka[i];
}
#define PHASE(call) do { P p; load_params(p, ka); call; } while (0)
#ifndef PROBE_MODE
#define PROBE_MODE 0
#endif
#ifndef PROBE_K
#define PROBE_K -1
#endif
template <int KMAX>
__device__ __forceinline__ void run_phases(cg::grid_group& grid, const XcdBarrier& xb, kargp_t ka, char* smem) {
    if constexpr (KMAX >= 0) { PHASE(ph_mod_partial(p, smem)); PHASE(ph_convert(p, smem)); grid.sync(); }
    if constexpr (KMAX >= 1) { PHASE(ph_norm1(p, smem)); xcd_barrier(xb); }
    if constexpr (KMAX >= 2) { PHASE(ph_gemm1(p, smem)); xcd_barrier(xb); }
    if constexpr (KMAX >= 3) { PHASE(ph_post(p, smem)); xcd_barrier(xb); }
    if constexpr (KMAX >= 4) { PHASE(ph_dn_prep(p, smem)); xcd_barrier(xb); }
    if constexpr (KMAX >= 5) { PHASE(ph_attn_mfma<(KMAX == 5 ? PROBE_MODE : 0)>(p, smem)); xcd_barrier(xb); }
    if constexpr (KMAX >= 6) { PHASE(ph_dn_gate(p)); xcd_barrier(xb); }
    if constexpr (KMAX >= 7) { PHASE(ph_gemm_out(p, smem)); xcd_barrier(xb); }
    if constexpr (KMAX >= 8) { PHASE(ph_route(p, smem)); xcd_barrier(xb); }
    if constexpr (KMAX >= 9) { PHASE(ph_moe_up(p, smem)); xcd_barrier(xb); }
    if constexpr (KMAX >= 10) { PHASE(ph_moe_down(p, smem)); xcd_barrier(xb); }
    if constexpr (KMAX >= 11) { PHASE(ph_combine(p, smem)); }
}
__global__ void __launch_bounds__(NTHREADS) mega(P p_arg) {
    cg::grid_group grid = cg::this_grid();
    char* smem = dyn_smem;
    kargp_t ka = (kargp_t)__builtin_amdgcn_kernarg_segment_ptr();
    volatile LAS unsigned* xst = (volatile LAS unsigned*)(smem + MEGA_LDS);
    if (threadIdx.x < 4) xst[threadIdx.x] = 0u;
    __syncthreads();
    XcdBarrier xb;
    { P p; load_params(p, ka); xb = xcd_barrier_post((unsigned*)(p.ws + WS_BAR), xst); }
    if constexpr (PROBE_K >= 0) {
        run_phases<PROBE_K>(grid, xb, ka, smem);
        if (PROBE_MODE == 20) { for (int i = 0; i < 20; ++i) xcd_barrier(xb); }
        P p; load_params(p, ka);
        if (blockIdx.x == 0 && threadIdx.x < 256) ((int*)(p.ws + WS_CTL))[threadIdx.x] = 0;
        xcd_barrier(xb);
    }
    run_phases<99>(grid, xb, ka, smem);
}

extern "C" void kernel_launch(void* const* d_in, const int* in_sizes, int n_in, void* d_out, int out_size, void* d_ws, size_t ws_size, hipStream_t stream) {
    if (n_in != 26 || out_size != NTOK * ND || ws_size < WS_END) { fprintf(stderr, "kernel_launch: unexpected shapes (n_in %d out %d ws %zu need %zu)\n", n_in, out_size, ws_size, (size_t)WS_END); return; }
    static int grid_blocks = 0;
    if (!grid_blocks) {
        int dev = 0, cus = 0, per_cu = 0;
        (void)hipGetDevice(&dev);
        (void)hipDeviceGetAttribute(&cus, hipDeviceAttributeMultiprocessorCount, dev);
        (void)hipFuncSetAttribute((const void*)mega, hipFuncAttributeMaxDynamicSharedMemorySize, MEGA_LDS + 16);
        (void)hipOccupancyMaxActiveBlocksPerMultiprocessor(&per_cu, (const void*)mega, NTHREADS, MEGA_LDS + 16);
        if (per_cu < 1) { fprintf(stderr, "kernel_launch: occupancy query says %d blocks/CU\n", per_cu); per_cu = 1; }
        grid_blocks = cus * per_cu;
    }
    P p{};
    const float** fp = (const float**)&p;
    for (int i = 0; i < 26; ++i) fp[i] = (const float*)d_in[i];
    p.pos = (const int*)d_in[2];
    p.out = (float*)d_out; p.ws = (unsigned char*)d_ws;
    (void)hipMemsetAsync((char*)d_ws + WS_CTL, 0, 32768, stream);
    void* args[] = {&p};
    hipError_t e = hipLaunchCooperativeKernel((const void*)mega, dim3(grid_blocks), dim3(NTHREADS), args, MEGA_LDS + 16, stream);
    if (e != hipSuccess) fprintf(stderr, "cooperative launch failed: %s (grid %d)\n", hipGetErrorString(e), grid_blocks);
}
```

```cpp
#include <hip/hip_runtime.h>
#include <hip/hip_cooperative_groups.h>
#include <cstdio>
#include <cstdint>

typedef unsigned short bf16_t;
typedef short bf16x8 __attribute__((ext_vector_type(8)));
typedef float f32x16 __attribute__((ext_vector_type(16)));
typedef float f32x4 __attribute__((ext_vector_type(4)));

constexpr int NB = 8, NT = 2048, ND = 1024, NTOK = NB * NT;
constexpr int NPROJ = 3072;
constexpr int PC_QATT = 0, PC_KVLAT = 512, PC_QIDX = 640, PC_DNQKV = 896, PC_DNZ = 2432, PC_KIDX = 2944, PC_WIDX = 2976, PC_BETA = 2984, PC_A = 2988;
constexpr int W_IN_SRC = 2992;
constexpr int NE = 32, EFF = 512;
constexpr int KSPLIT = 16;
constexpr int NTHREADS = 512, NWAVES = 8;
constexpr float EPS = 1e-6f;
constexpr float LOG2E = 1.4426950408889634f;

constexpr size_t MiB = 1ull << 20;
constexpr size_t WS_CTL = 0;
constexpr size_t WS_BAR = WS_CTL + 16 * 1024;
constexpr size_t WS_MODF = WS_CTL + 256 * 1024;
constexpr size_t WS_MODP = WS_CTL + 1 * MiB;
constexpr size_t WS_WIN = WS_MODP + 3 * MiB;
constexpr size_t WS_WOUT = WS_WIN + 6 * MiB;
constexpr size_t WS_W13 = WS_WOUT + 2 * MiB;
constexpr size_t WS_W2 = WS_W13 + 64 * MiB;
constexpr size_t WS_PROJ = WS_W2 + 32 * MiB;
constexpr size_t WS_ACT = WS_PROJ;
constexpr size_t WS_YBUF = WS_PROJ + 32 * MiB;
constexpr size_t WS_QN = WS_PROJ + 96 * MiB;
constexpr size_t WS_K = WS_QN + 16 * MiB;
constexpr size_t WS_KI = WS_K + 2 * MiB;
constexpr size_t WS_WI = WS_KI + 1 * MiB;
constexpr size_t WS_DBG = WS_WI + 512 * 1024;
constexpr size_t WS_DQ = WS_DBG + 512 * 1024;
constexpr size_t WS_DK = WS_DQ + 16 * MiB;
constexpr size_t WS_H2 = WS_DQ;
constexpr size_t WS_DKT = WS_DK + 16 * MiB;
constexpr size_t WS_DVT = WS_DKT + 16 * MiB;
constexpr size_t WS_END = WS_DVT + 16 * MiB;
constexpr size_t WS_LIST = WS_K;
constexpr size_t WS_TOKINFO = WS_KI;
constexpr size_t WS_VT = WS_WIN;
constexpr size_t WS_POSMM = WS_WIN + 2 * MiB;
constexpr size_t DO_WN = 0, DO_U = 16 * MiB, DO_DNO = 32 * MiB, DO_PP = 48 * MiB, DO_EG = 56 * MiB, DO_LL = DO_EG + 256 * 1024, DO_GC = DO_LL + 256 * 1024;

struct P {
    const float* x; const float* c; const int* pos; const float* ada_w; const float* ada_b; const float* norm1_g; const float* norm2_g;
    const float* w_in; const float* q_norm_g; const float* k_norm_g; const float* kv_norm_g; const float* w_kv_up; const float* idx_k_norm_g;
    const float* rel_bias; const float* conv_w; const float* a_log; const float* dt_bias; const float* dn_norm_g; const float* w_out;
    const float* rg_w; const float* rg_b; const float* re_w; const float* re_b; const float* w1; const float* w3; const float* w2;
    float* out; unsigned char* ws;
};

__device__ __forceinline__ float bf2f(bf16_t h) { return __uint_as_float(((unsigned)h) << 16); }
__device__ __forceinline__ bf16_t f2bf(float f) { unsigned u = __float_as_uint(f); u += 0x7fffu + ((u >> 16) & 1u); return (bf16_t)(u >> 16); }
__device__ __forceinline__ unsigned pack2(float a, float b) { unsigned r; asm volatile("v_cvt_pk_bf16_f32 %0, %1, %2" : "=v"(r) : "v"(a), "v"(b)); return r; }
template <int CTRL> __device__ __forceinline__ float dpp_f(float v) { return __int_as_float(__builtin_amdgcn_update_dpp(0, __float_as_int(v), CTRL, 0xF, 0xF, false)); }
template <int CTRL> __device__ __forceinline__ int dpp_i(int v) { return __builtin_amdgcn_update_dpp(0, v, CTRL, 0xF, 0xF, false); }
__device__ __forceinline__ float wave_sum(float v) {
    v += dpp_f<0xB1>(v); v += dpp_f<0x4E>(v); v += dpp_f<0x141>(v); v += dpp_f<0x140>(v);
    v += __int_as_float(__builtin_amdgcn_update_dpp(0, __float_as_int(v), 0x142, 0xA, 0xF, false));
    v += __int_as_float(__builtin_amdgcn_update_dpp(0, __float_as_int(v), 0x143, 0xC, 0xF, false));
    return __int_as_float(__builtin_amdgcn_readlane(__float_as_int(v), 63));
}
__device__ __forceinline__ float wave_max(float v) {
#pragma unroll
    for (int o = 32; o >= 1; o >>= 1) v = fmaxf(v, __shfl_xor(v, o));
    return v;
}
__device__ __forceinline__ int wave_isum(int v) {
#pragma unroll
    for (int o = 32; o >= 1; o >>= 1) v += __shfl_xor(v, o);
    return v;
}
__device__ __forceinline__ int tid_opaque() { int t = threadIdx.x; asm volatile("" : "+v"(t)); return t; }
__device__ __forceinline__ float relu_f(float x) { return __builtin_amdgcn_fmed3f(x, 0.f, __builtin_inff()); }
__device__ __forceinline__ float silu_f(float x) { return x / (1.f + __expf(-x)); }
__device__ __forceinline__ float sigmoid_f(float x) { return 1.f / (1.f + __expf(-x)); }
__device__ __forceinline__ float mod_val(const P& p, int b, int which, int d) {
    const float* mp = (const float*)(p.ws + WS_MODP);
    const int col = which * ND + d;
    float s = p.ada_b[col];
#pragma unroll
    for (int ks = 0; ks < KSPLIT; ++ks) s += mp[(size_t)(ks * NB + b) * (6 * ND) + col];
    return s;
}

__device__ __forceinline__ void ph_mod_partial(const P& p, char* smem) {
    const int tid = tid_opaque();
    const int lane = tid & 63, wave = tid >> 6;
    float* sc = (float*)smem;
    for (int i = tid; i < NB * ND; i += NTHREADS) sc[i] = silu_f(p.c[i]);
    __syncthreads();
    float* mp = (float*)(p.ws + WS_MODP);
    const int nitem = 96 * KSPLIT;
    for (int it = blockIdx.x * NWAVES + wave; it < nitem; it += gridDim.x * NWAVES) {
        const int cg = it % 96, ks = it / 96;
        const int col = cg * 64 + lane;
        float acc[NB];
#pragma unroll
        for (int b = 0; b < NB; ++b) acc[b] = 0.f;
#pragma unroll 32
        for (int kk = 0; kk < ND / KSPLIT; ++kk) {
            const int k = ks * (ND / KSPLIT) + kk;
            const float w = p.ada_w[(size_t)k * (6 * ND) + col];
#pragma unroll
            for (int b = 0; b < NB; ++b) acc[b] += sc[b * ND + k] * w;
        }
#pragma unroll
        for (int b = 0; b < NB; ++b) mp[(size_t)(ks * NB + b) * (6 * ND) + col] = acc[b];
    }
    __syncthreads();
}

__device__ __forceinline__ int win_src_col(int n) {
    if (n < 896) return n;
    if (n < 2944) return n + 40;
    if (n < 2976) return n - 2944 + 896;
    if (n < 2984) return n - 2976 + 928;
    if (n < 2992) return n;
    return -1;
}
__device__ __forceinline__ void conv_tile_wave(const int lane, float* tile, const float* src0, int nsrc, int mode, int n0, int k0, bf16_t* dst, int K, int sc0) {
    if (mode == 1) {
        const int col = win_src_col(n0 + lane);
#pragma unroll 8
        for (int k = 0; k < 64; ++k) tile[k * 65 + lane] = (col >= 0) ? src0[(size_t)(k0 + k) * nsrc + col] : 0.f;
    } else {
        const int kr = lane >> 4, c4 = lane & 15;
        const float* src = src0; const int col = sc0 + c4 * 4;
        f32x4 v[16];
#pragma unroll
        for (int i = 0; i < 16; ++i) v[i] = *(const f32x4*)(src + (size_t)(k0 + i * 4 + kr) * nsrc + col);
#pragma unroll
        for (int i = 0; i < 16; ++i) { float* t = tile + (i * 4 + kr) * 65 + c4 * 4; t[0] = v[i][0]; t[1] = v[i][1]; t[2] = v[i][2]; t[3] = v[i][3]; }
    }
    __threadfence_block();
    {
        const int kc = lane & 7, nr = lane >> 3;
#pragma unroll
        for (int i = 0; i < 8; ++i) {
            const int n = i * 8 + nr;
            unsigned w[4];
#pragma unroll
            for (int j = 0; j < 4; ++j) w[j] = pack2(tile[(kc * 8 + 2 * j) * 65 + n], tile[(kc * 8 + 2 * j + 1) * 65 + n]);
            *(uint4*)(dst + (size_t)(n0 + n) * K + k0 + kc * 8) = make_uint4(w[0], w[1], w[2], w[3]);
        }
    }
    __threadfence_block();
}
__device__ __forceinline__ void ph_convert(const P& p, char* smem) {
    const int tid = tid_opaque();
    const int lane = tid & 63, wave = tid >> 6;
    float* tile = (float*)smem + wave * (64 * 65);
    bf16_t* Wt_in = (bf16_t*)(p.ws + WS_WIN); bf16_t* Wt_out = (bf16_t*)(p.ws + WS_WOUT);
    bf16_t* Wt13 = (bf16_t*)(p.ws + WS_W13); bf16_t* Wt2 = (bf16_t*)(p.ws + WS_W2);
    const int T0 = 48 * 16, T1 = 16 * 16, T2 = NE * 256, T3 = NE * 128;
    const int total = T0 + T1 + T2 + T3;
    for (int t = blockIdx.x * NWAVES + wave; t < total; t += gridDim.x * NWAVES) {
        if (t < T0) { const int nt = t / 16, kt = t % 16; conv_tile_wave(lane, tile, p.w_in, W_IN_SRC, 1, nt * 64, kt * 64, Wt_in, ND, 0); }
        else if (t < T0 + T1) { const int u = t - T0; const int nt = u / 16, kt = u % 16; conv_tile_wave(lane, tile, p.w_out, ND, 0, nt * 64, kt * 64, Wt_out, ND, nt * 64); }
        else if (t < T0 + T1 + T2) { const int u = t - T0 - T1; const int e = u / 256, v = u % 256; const int kt = v / 16, j16 = v % 16;
            const int nt = ((j16 & 7) >> 1) * 4 + (j16 >> 3) * 2 + (j16 & 1);
            const int pn = nt >> 2, within = nt & 3;
            const float* srcw = ((within >= 2) ? p.w3 : p.w1) + (size_t)e * ND * EFF;
            conv_tile_wave(lane, tile, srcw, EFF, 0, nt * 64, kt * 64, Wt13 + (size_t)e * 1024 * ND, ND, pn * 128 + (within & 1) * 64); }
        else { const int u = t - T0 - T1 - T2; const int e = u / 128, v = u % 128; const int kt = v / 16, nt = v % 16;
            conv_tile_wave(lane, tile, p.w2 + (size_t)e * EFF * ND, ND, 0, nt * 64, kt * 64, Wt2 + (size_t)e * ND * EFF, EFF, nt * 64); }
    }
}

__device__ __forceinline__ void ph_norm1(const P& p, char* smem) {
    const int tid = tid_opaque();
    float* sA = (float*)smem; float* sB = sA + ND;
    const int lane = tid & 63, wave = tid >> 6;
    bf16_t* h = (bf16_t*)p.out;
    {
        float* mf = (float*)(p.ws + WS_MODF);
        for (int i = blockIdx.x * NTHREADS + tid; i < NB * 6 * ND; i += gridDim.x * NTHREADS) mf[i] = mod_val(p, i / (6 * ND), (i % (6 * ND)) / ND, i % ND);
    }
    int curb = -1;
    for (int tile = blockIdx.x; tile < NTOK / 64; tile += gridDim.x) {
        const int b = tile / (NT / 64);
        if (b != curb) {
            __syncthreads();
            for (int d = tid; d < ND; d += NTHREADS) { sA[d] = p.norm1_g[d] * (1.f + mod_val(p, b, 1, d)); sB[d] = mod_val(p, b, 0, d); }
            __syncthreads();
            curb = b;
        }
        for (int i4 = 0; i4 < 2; ++i4) {
            const int tokb = tile * 64 + wave * 8 + i4 * 4;
            f32x4 v[4][4];
#pragma unroll
            for (int q = 0; q < 4; ++q)
#pragma unroll
                for (int j = 0; j < 4; ++j) v[q][j] = *(const f32x4*)(p.x + (size_t)(tokb + q) * ND + j * 256 + lane * 4);
#pragma unroll
            for (int q = 0; q < 4; ++q) {
                float ss = 0.f;
#pragma unroll
                for (int j = 0; j < 4; ++j) ss += v[q][j][0] * v[q][j][0] + v[q][j][1] * v[q][j][1] + v[q][j][2] * v[q][j][2] + v[q][j][3] * v[q][j][3];
                ss = wave_sum(ss);
                const float rstd = rsqrtf(ss * (1.f / ND) + EPS);
#pragma unroll
                for (int j = 0; j < 4; ++j) {
                    const int d = j * 256 + lane * 4;
                    const float o0 = v[q][j][0] * rstd * sA[d] + sB[d], o1 = v[q][j][1] * rstd * sA[d + 1] + sB[d + 1], o2 = v[q][j][2] * rstd * sA[d + 2] + sB[d + 2], o3 = v[q][j][3] * rstd * sA[d + 3] + sB[d + 3];
                    *(uint2*)(h + (size_t)(tokb + q) * ND + d) = make_uint2(pack2(o0, o1), pack2(o2, o3));
                }
            }
        }
    }
}

namespace pg8 {
#define PG8_LAS __attribute__((address_space(3)))
typedef unsigned u32x4 __attribute__((ext_vector_type(4)));
constexpr int BM = 256, BK = 64, HALF = 128, HTB = HALF * BK * 2  , STAGE_BYTES = 8 * HTB;
__device__ __forceinline__ int lds_byte(int r, int c) { const int st = (r >> 4) * 2 + (c >> 5), rr = r & 15, cc = c & 31, ob = rr * 64 + cc * 2; return st * 1024 + (ob ^ (((ob >> 9) & 1) << 5)); }
__device__ __forceinline__ void stage_rc(int b, int& R, int& C) { const int st = b / 1024, sb = b % 1024, swz = sb ^ (((sb >> 9) & 1) << 5); R = (st >> 1) * 16 + swz / 64; C = (st & 1) * 32 + (swz % 64) / 2; }
__device__ __forceinline__ int perm32(int rho) { const int n = rho >> 4, i = rho & 15; return 8 * (i >> 2) + 4 * n + (i & 3); }
struct AO { unsigned h0p0, h0p1, h1p0, h1p1; };
template <class Src, class Epi>
__device__ __forceinline__ void gemm_phase(const int tid, PG8_LAS unsigned char* lds, const int K, const Src& S, const Epi& E) {
    const int wid = __builtin_amdgcn_readfirstlane(tid >> 6), lane = tid & 63, wr = wid >> 2, wc = wid & 3, fr = lane & 15, fq = lane >> 4;
    const int nt = K / BK;
    int R0, C0, R1, C1; stage_rc(tid * 16, R0, C0); stage_rc(tid * 16 + 8192, R1, C1);
    unsigned voffB[2];
    { const int Rb0 = Epi::PERM ? ((R0 & ~31) + perm32(R0 & 31)) : R0, Rb1 = Epi::PERM ? ((R1 & ~31) + perm32(R1 & 31)) : R1;
      voffB[0] = (unsigned)(Rb0 * K + C0) * 2u; voffB[1] = (unsigned)(Rb1 * K + C1) * 2u; }
    const size_t kstep = (size_t)(BK * 2);
    const size_t hstepB = (size_t)HALF * K * 2;
    const unsigned ldsw = (unsigned)wid * 1024u;
    const int aoff = lds_byte(wr * 64 + fr, fq * 8), boff = lds_byte(wc * 32 + fr, fq * 8);
#define PG8_SA(b, h) (((b) * 2 + (h)) * HTB)
#define PG8_SB(b, h) ((4 + (b) * 2 + (h)) * HTB)
#define PG8_STAGE2(bufoff, gbase, o0, o1) do { \
        __builtin_amdgcn_global_load_lds((const unsigned*)((const char*)(gbase) + (o0)), (PG8_LAS unsigned*)(lds + (bufoff) + ldsw), 16, 0, 0); \
        __builtin_amdgcn_global_load_lds((const unsigned*)((const char*)(gbase) + (o1)), (PG8_LAS unsigned*)(lds + (bufoff) + ldsw + 8192), 16, 0, 0); } while (0)
#define PG8_STAGEB(bufoff, gbase) PG8_STAGE2(bufoff, gbase, voffB[0], voffB[1])
#define PG8_STAGEA0(bufoff, gbase, AOV) PG8_STAGE2(bufoff, gbase, AOV.h0p0, AOV.h0p1)
#define PG8_STAGEA1(bufoff, gbase, AOV) PG8_STAGE2(bufoff, gbase, AOV.h1p0, AOV.h1p1)
#define PG8_LDA(dst, b, h) do { _Pragma("unroll") for (int m = 0; m < 4; ++m) _Pragma("unroll") for (int k = 0; k < 2; ++k) dst[m][k] = *(const PG8_LAS bf16x8*)(lds + PG8_SA(b, h) + aoff + m * 2048 + k * 1024); } while (0)
#define PG8_LDB(dst, b, h) do { _Pragma("unroll") for (int n = 0; n < 2; ++n) _Pragma("unroll") for (int k = 0; k < 2; ++k) dst[n][k] = *(const PG8_LAS bf16x8*)(lds + PG8_SB(b, h) + boff + n * 2048 + k * 1024); } while (0)
#define PG8_MMA(ai, bj, At, Bt) do { __builtin_amdgcn_s_setprio(1); _Pragma("unroll") for (int m = 0; m < 4; ++m) _Pragma("unroll") for (int n = 0; n < 2; ++n) _Pragma("unroll") for (int k = 0; k < 2; ++k) \
        acc[ai][bj][m][n] = __builtin_amdgcn_mfma_f32_16x16x32_bf16(Bt[n][k], At[m][k], acc[ai][bj][m][n], 0, 0, 0); __builtin_amdgcn_s_setprio(0); } while (0)
#define PG8_WAIT_V(n) asm volatile("s_waitcnt vmcnt(" #n ")" ::: "memory")
#define PG8_WAIT_L(n) asm volatile("s_waitcnt lgkmcnt(" #n ")" ::: "memory")
#define PG8_BAR __builtin_amdgcn_s_barrier()
#define PG8_SCHED __builtin_amdgcn_sched_barrier(0)
    typename Src::Unit cur, nxt; int ui = 0;
    if (!S.next(0, cur)) return;
    f32x4 acc[2][2][4][2];
#pragma unroll
    for (int a = 0; a < 2; ++a)
#pragma unroll
        for (int b = 0; b < 2; ++b)
#pragma unroll
            for (int m = 0; m < 4; ++m)
#pragma unroll
                for (int n = 0; n < 2; ++n) acc[a][b][m][n] = (f32x4){0.f, 0.f, 0.f, 0.f};
    bf16x8 At[4][2], B0[2][2], B1[2][2];
    AO aoC, aoN;
    S.a_off(cur, R0, C0, R1, C1, aoC);
    const char* cB = S.b_base(cur);
    PG8_STAGEB(PG8_SB(0, 0), cB); PG8_STAGEA0(PG8_SA(0, 0), S.a_base(cur, 0), aoC); PG8_STAGEB(PG8_SB(0, 1), cB + hstepB); PG8_STAGEA1(PG8_SA(0, 1), S.a_base(cur, 0), aoC);
    if (wr == 1) PG8_BAR;
    PG8_WAIT_V(4); PG8_BAR;
    PG8_STAGEB(PG8_SB(1, 0), cB + kstep); PG8_STAGEA0(PG8_SA(1, 0), S.a_base(cur, 1), aoC); PG8_STAGEB(PG8_SB(1, 1), cB + hstepB + kstep);
    PG8_WAIT_V(6); PG8_BAR;
    for (;;) {
        const bool has_next = S.next(ui + 1, nxt);
        const char* nB = cB;
        if (has_next) { S.a_off(nxt, R0, C0, R1, C1, aoN); nB = S.b_base(nxt); }
        else aoN = aoC;
        for (int t = 0; t < nt; t += 2) {
            const bool last = (t == nt - 2);
            const char* a1 = S.a_base(cur, t + 1);
            const char* a2 = last ? S.a_base(has_next ? nxt : cur, 0) : S.a_base(cur, t + 2);
            const char* a3 = last ? S.a_base(has_next ? nxt : cur, 1) : S.a_base(cur, t + 3);
            const char* b2 = last ? nB : cB + (size_t)(t + 2) * kstep; const char* b3 = b2 + kstep;
            const AO ao2 = last ? aoN : aoC;
            PG8_LDB(B0, 0, 0); PG8_SCHED; PG8_LDA(At, 0, 0); PG8_STAGEA1(PG8_SA(1, 1), a1, aoC);
            PG8_WAIT_L(8); PG8_BAR; PG8_WAIT_L(0); PG8_MMA(0, 0, At, B0); PG8_BAR; PG8_SCHED;
            PG8_LDB(B1, 0, 1); PG8_STAGEB(PG8_SB(0, 0), b2);
            PG8_BAR; PG8_WAIT_L(0); PG8_MMA(0, 1, At, B1); PG8_BAR;
            PG8_LDA(At, 0, 1); PG8_STAGEA0(PG8_SA(0, 0), a2, ao2);
            PG8_BAR; PG8_WAIT_L(0); PG8_MMA(1, 0, At, B0); PG8_BAR; PG8_SCHED;
            PG8_STAGEB(PG8_SB(0, 1), b2 + hstepB);
            PG8_WAIT_V(6); PG8_BAR; PG8_MMA(1, 1, At, B1); PG8_BAR;
            PG8_LDB(B0, 1, 0); PG8_SCHED; PG8_LDA(At, 1, 0); PG8_STAGEA1(PG8_SA(0, 1), a2, ao2);
            PG8_WAIT_L(8); PG8_BAR; PG8_WAIT_L(0); PG8_MMA(0, 0, At, B0); PG8_BAR; PG8_SCHED;
            PG8_LDB(B1, 1, 1); PG8_STAGEB(PG8_SB(1, 0), b3);
            PG8_BAR; PG8_WAIT_L(0); PG8_MMA(0, 1, At, B1); PG8_BAR;
            PG8_LDA(At, 1, 1); PG8_STAGEA0(PG8_SA(1, 0), a3, ao2);
            PG8_BAR; PG8_WAIT_L(0); PG8_MMA(1, 0, At, B0); PG8_BAR; PG8_SCHED;
            PG8_STAGEB(PG8_SB(1, 1), b3 + hstepB);
            PG8_WAIT_V(6); PG8_BAR; PG8_MMA(1, 1, At, B1); PG8_BAR;
        }
        E(acc, cur, wr, wc, fr, fq);
        if (!has_next) break;
#pragma unroll
        for (int a = 0; a < 2; ++a)
#pragma unroll
            for (int b = 0; b < 2; ++b)
#pragma unroll
                for (int m = 0; m < 4; ++m)
#pragma unroll
                    for (int n = 0; n < 2; ++n) acc[a][b][m][n] = (f32x4){0.f, 0.f, 0.f, 0.f};
        cur = nxt; cB = nB; ++ui; aoC = aoN;
    }
    PG8_WAIT_V(0);
    if (wr == 0) PG8_BAR;
    PG8_BAR;
#undef PG8_SA
#undef PG8_SB
#undef PG8_STAGE2
#undef PG8_STAGEB
#undef PG8_STAGEA0
#undef PG8_STAGEA1
#undef PG8_LDA
#undef PG8_LDB
#undef PG8_MMA
#undef PG8_WAIT_V
#undef PG8_WAIT_L
#undef PG8_BAR
#undef PG8_SCHED
}
struct DenseSrc {
    struct Unit { int pm, pn; };
    const char* A0; const char* A1; const char* Bt; int lda, K, nM, nN, G, c, ksplit;
    __device__ __forceinline__ bool next(int i, Unit& u) const {
        const int nwg = nM * nN; const long L = (long)i * G + c; if (L >= nwg) return false;
        int wgid = (int)L; { const int q = nwg / 8, r = nwg % 8, xcd = wgid % 8, off = wgid / 8; wgid = (xcd < r ? xcd * (q + 1) : r * (q + 1) + (xcd - r) * q) + off; }
        const int nig = 8 * nN, gid = wgid / nig, fm = gid * 8, gsz = (nM - fm) < 8 ? (nM - fm) : 8;
        u.pm = fm + ((wgid % nig) % gsz); u.pn = (wgid % nig) / gsz; return true;
    }
    __device__ __forceinline__ void a_off(const Unit& u, int R0, int C0, int R1, int C1, AO& ao) const {
        ao.h0p0 = (unsigned)(((u.pm * 256 + R0) * lda + C0) * 2); ao.h0p1 = (unsigned)(((u.pm * 256 + R1) * lda + C1) * 2);
        ao.h1p0 = (unsigned)(((u.pm * 256 + 128 + R0) * lda + C0) * 2); ao.h1p1 = (unsigned)(((u.pm * 256 + 128 + R1) * lda + C1) * 2);
    }
    __device__ __forceinline__ const char* a_base(const Unit&, int kt) const { return (kt < ksplit) ? A0 + (size_t)kt * 128 : A1 + (size_t)(kt - ksplit) * 128; }
    __device__ __forceinline__ const char* b_base(const Unit& u) const { return Bt + (size_t)u.pn * 256 * K * 2; }
};
}

struct EpiProj {
    static constexpr bool PERM = true;
    bf16_t* O; int ldc;
    __device__ __forceinline__ void operator()(const f32x4 (&acc)[2][2][4][2], const pg8::DenseSrc::Unit& u, int wr, int wc, int fr, int fq) const {
        const int row0 = u.pm * 256 + wr * 64 + fr, col0 = u.pn * 256 + wc * 32 + 8 * fq;
#pragma unroll
        for (int ai = 0; ai < 2; ++ai)
#pragma unroll
            for (int m = 0; m < 4; ++m) { bf16_t* rowp = O + (size_t)(row0 + ai * 128 + m * 16) * ldc + col0;
#pragma unroll
                for (int bj = 0; bj < 2; ++bj) { const f32x4 v0 = acc[ai][bj][m][0], v1 = acc[ai][bj][m][1];
                    *(uint4*)(rowp + bj * 128) = make_uint4(pack2(v0[0], v0[1]), pack2(v0[2], v0[3]), pack2(v1[0], v1[1]), pack2(v1[2], v1[3])); } }
    }
};
__device__ __forceinline__ void ph_gemm1(const P& p, char* smem) {
    const int tid = tid_opaque();
    pg8::DenseSrc S; S.A0 = (const char*)p.out; S.A1 = S.A0; S.Bt = (const char*)(p.ws + WS_WIN); S.lda = ND; S.K = ND; S.nM = NTOK / 256; S.nN = NPROJ / 256; S.G = gridDim.x; S.c = blockIdx.x; S.ksplit = ND / 64;
    EpiProj E; E.O = (bf16_t*)(p.ws + WS_PROJ); E.ldc = NPROJ;
    pg8::gemm_phase(tid, (PG8_LAS unsigned char*)smem, ND, S, E);
}

__device__ __forceinline__ void ph_post(const P& p, char* smem) {
    const int tid = tid_opaque();
    float* sW = (float*)smem;
    {
        f32x4 t[8];
#pragma unroll
        for (int i = 0; i < 8; ++i) t[i] = *(const f32x4*)(p.w_kv_up + (size_t)(tid + i * NTHREADS) * 4);
#pragma unroll
        for (int i = 0; i < 8; ++i) *(f32x4*)(sW + (size_t)(tid + i * NTHREADS) * 4) = t[i];
    }
    __syncthreads();
    const int lane = tid & 63, wave = tid >> 6;
    float* skv = (float*)(smem + 128 * 128 * 4) + wave * 128;
    const bf16_t* proj = (const bf16_t*)(p.ws + WS_PROJ);
    bf16_t* qn = (bf16_t*)(p.ws + WS_QN); bf16_t* Kb = (bf16_t*)(p.ws + WS_K); bf16_t* kib = (bf16_t*)(p.ws + WS_KI);
    float* wi = (float*)(p.ws + WS_WI); float* dbeta = (float*)(p.ws + WS_DBG); float* dg = dbeta + NTOK * 4;
    bf16_t* dq = (bf16_t*)(p.ws + WS_DQ); bf16_t* dk = (bf16_t*)(p.ws + WS_DK); bf16_t* dkT = (bf16_t*)(p.ws + WS_DKT); bf16_t* dvT = (bf16_t*)(p.ws + WS_DVT);
    bf16_t* Vt = (bf16_t*)(p.ws + WS_VT);
    {
        const int g = blockIdx.x * NTHREADS + tid;
        if (g < NB * 64) { int mn = 0x7fffffff, mx = -0x7fffffff; for (int i = 0; i < 32; ++i) { const int v = p.pos[g * 32 + i]; mn = min(mn, v); mx = max(mx, v); } int* pm = (int*)(p.ws + WS_POSMM); pm[g * 2] = mn; pm[g * 2 + 1] = mx; }
    }
    for (int tg = blockIdx.x * NWAVES + wave; tg < NTOK / 8; tg += gridDim.x * NWAVES) {
        const int tok0 = tg * 8, t0 = tok0 % NT, bb = tok0 / NT;
        uint4 rq[8]; unsigned rkv[8]; unsigned rms[8];
#pragma unroll
        for (int ti = 0; ti < 8; ++ti) {
            const bf16_t* pr = proj + (size_t)(tok0 + ti) * NPROJ;
            rq[ti] = *(const uint4*)(pr + PC_QATT + lane * 8);
            rkv[ti] = *(const unsigned*)(pr + PC_KVLAT + lane * 2);
            rms[ti] = (lane < 48) ? (unsigned)pr[PC_KIDX + lane] : 0u;
        }
        float vall[8];
#pragma unroll
        for (int ti = 0; ti < 8; ++ti) {
            const int tok = tok0 + ti;
            {
                const unsigned w[4] = {rq[ti].x, rq[ti].y, rq[ti].z, rq[ti].w};
                float v[8]; float ss = 0.f;
#pragma unroll
                for (int j = 0; j < 4; ++j) { v[2 * j] = __uint_as_float(w[j] << 16); v[2 * j + 1] = __uint_as_float(w[j] & 0xffff0000u); }
#pragma unroll
                for (int j = 0; j < 8; ++j) ss += v[j] * v[j];
                ss += dpp_f<0xB1>(ss); ss += dpp_f<0x4E>(ss); ss += dpp_f<0x141>(ss);
                const float rs = rsqrtf(ss * (1.f / 64.f) + EPS) * (0.125f * LOG2E);
                const int d0 = (lane & 7) * 8;
                unsigned o[4];
#pragma unroll
                for (int j = 0; j < 4; ++j) o[j] = pack2(v[2 * j] * rs * p.q_norm_g[d0 + 2 * j], v[2 * j + 1] * rs * p.q_norm_g[d0 + 2 * j + 1]);
                *(uint4*)(qn + (size_t)tok * 512 + lane * 8) = make_uint4(o[0], o[1], o[2], o[3]);
            }
            {
                float a0 = __uint_as_float(rkv[ti] << 16), a1 = __uint_as_float(rkv[ti] & 0xffff0000u);
                float ss = wave_sum(a0 * a0 + a1 * a1);
                const float rs = rsqrtf(ss * (1.f / 128.f) + EPS);
                a0 *= rs * p.kv_norm_g[lane * 2]; a1 *= rs * p.kv_norm_g[lane * 2 + 1];
                *(float2*)(skv + lane * 2) = make_float2(a0, a1);
                __threadfence_block();
                float k = 0.f, v = 0.f, k2 = 0.f, v2 = 0.f;
#pragma unroll 4
                for (int i4 = 0; i4 < 32; ++i4) {
                    const f32x4 x = *(const f32x4*)(skv + 4 * i4);
                    const float* w = sW + (4 * i4) * 128 + lane;
                    k += x[0] * w[0] + x[2] * w[256]; k2 += x[1] * w[128] + x[3] * w[384];
                    v += x[0] * w[64] + x[2] * w[320]; v2 += x[1] * w[192] + x[3] * w[448];
                }
                k += k2; v += v2;
                __threadfence_block();
                const float ks = wave_sum(k * k);
                k *= rsqrtf(ks * (1.f / 64.f) + EPS) * p.k_norm_g[lane];
                Kb[(size_t)tok * 64 + lane] = f2bf(k);
                vall[ti] = v;
            }
            {
                const float raw = bf2f((bf16_t)rms[ti]);
                float a = (lane < 32) ? raw : 0.f;
                const float ss = wave_sum(a * a);
                a *= rsqrtf(ss * (1.f / 32.f) + EPS);
                if (lane < 32) kib[(size_t)tok * 32 + lane] = f2bf(a * p.idx_k_norm_g[lane]);
                else if (lane < 40) wi[(size_t)tok * 8 + lane - 32] = raw * 0.35355339059327373f * 0.17677669529663687f;
                else if (lane < 44) dbeta[(size_t)tok * 4 + lane - 40] = sigmoid_f(raw);
                else if (lane < 48) {
                    const float z = raw + p.dt_bias[lane - 44];
                    const float sp = (z > 20.f) ? z : log1pf(__expf(z));
                    dg[(size_t)tok * 4 + lane - 44] = -__expf(p.a_log[lane - 44]) * sp;
                }
            }
        }
        *(uint4*)(Vt + ((size_t)bb * 64 + lane) * NT + t0) = make_uint4(pack2(vall[0], vall[1]), pack2(vall[2], vall[3]), pack2(vall[4], vall[5]), pack2(vall[6], vall[7]));
#pragma unroll 1
        for (int jg = 0; jg < 4; ++jg) {
            unsigned raw[3][11];
#pragma unroll
            for (int jj = 0; jj < 3; ++jj)
#pragma unroll
                for (int i = 0; i < 11; ++i) {
                    raw[jj][i] = 0u;
                    if (t0 - 3 + i >= 0) raw[jj][i] = *(const unsigned*)(proj + (size_t)(tok0 - 3 + i) * NPROJ + PC_DNQKV + (jg * 3 + jj) * 128 + lane * 2);
                }
#pragma unroll
            for (int jj = 0; jj < 3; ++jj) {
                const int j = jg * 3 + jj;
                const int ch = j * 128 + lane * 2;
                float c0[4], c1[4];
#pragma unroll
                for (int tap = 0; tap < 4; ++tap) { c0[tap] = p.conv_w[tap * 1536 + ch]; c1[tap] = p.conv_w[tap * 1536 + ch + 1]; }
                float y0[8], y1[8];
#pragma unroll
                for (int i = 0; i < 8; ++i) {
                    float a0 = 0.f, a1 = 0.f;
#pragma unroll
                    for (int tap = 0; tap < 4; ++tap) { a0 += c0[tap] * __uint_as_float(raw[jj][i + tap] << 16); a1 += c1[tap] * __uint_as_float(raw[jj][i + tap] & 0xffff0000u); }
                    y0[i] = silu_f(a0); y1[i] = silu_f(a1);
                    if (j < 8) {
                        const float ss = wave_sum(y0[i] * y0[i] + y1[i] * y1[i]);
                        float rs = rsqrtf(ss + EPS);
                        if (j < 4) rs *= 0.08838834764831845f;
                        y0[i] *= rs; y1[i] *= rs;
                    }
                }
                if (j < 8) {
                    bf16_t* dst = (j < 4) ? dq : dk;
#pragma unroll
                    for (int i = 0; i < 8; ++i) *(unsigned*)(dst + (size_t)(tok0 + i) * 512 + (j & 3) * 128 + lane * 2) = pack2(y0[i], y1[i]);
                }
                if (j >= 4) {
                    bf16_t* dstT = ((j < 8) ? dkT : dvT) + ((size_t)(bb * 4 + (j & 3)) * 128 + lane * 2) * NT + t0;
                    *(uint4*)dstT = make_uint4(pack2(y0[0], y0[1]), pack2(y0[2], y0[3]), pack2(y0[4], y0[5]), pack2(y0[6], y0[7]));
                    *(uint4*)(dstT + NT) = make_uint4(pack2(y1[0], y1[1]), pack2(y1[2], y1[3]), pack2(y1[4], y1[5]), pack2(y1[6], y1[7]));
                }
            }
        }
    }
}

__device__ __forceinline__ unsigned f2sortable(float f) { const unsigned u = __float_as_uint(f); return (u & 0x80000000u) ? ~u : (u | 0x80000000u); }
__device__ __forceinline__ float sum8_f(float v) { v += dpp_f<0xB1>(v); v += dpp_f<0x4E>(v); v += dpp_f<0x141>(v); return v; }
__device__ __forceinline__ int sum16_i(int v) { v += dpp_i<0xB1>(v); v += dpp_i<0x4E>(v); v += dpp_i<0x141>(v); v += __shfl_xor(v, 32); return v; }
__device__ __forceinline__ int pi32(int r) { return (r & 0x13) | ((r & 4) << 1) | ((r & 8) >> 1); }
__device__ __forceinline__ constexpr int key_of_reg(int r) { return (r & 3) + 4 * ((r >> 2) & 1) + 16 * (r >> 3); }
struct KiFrag { bf16x8 a0, a1; };
__device__ __forceinline__ float xhalf_sum(float v) { auto rr = __builtin_amdgcn_permlane32_swap(__float_as_uint(v), __float_as_uint(v), false, false); return __uint_as_float(rr[0]) + __uint_as_float(rr[1]); }
__device__ __forceinline__ void idx_scores4(float (&sc)[4], const KiFrag& f, bf16x8 qi0, bf16x8 qi1, const float* wvp) {
    f32x4 wq[4];
#pragma unroll
    for (int q = 0; q < 4; ++q) wq[q] = *(const f32x4*)(wvp + 4 * q);
    f32x16 z;
#pragma unroll
    for (int r = 0; r < 16; ++r) z[r] = 0.f;
    z = __builtin_amdgcn_mfma_f32_32x32x16_bf16(qi0, f.a0, z, 0, 0, 0);
    z = __builtin_amdgcn_mfma_f32_32x32x16_bf16(qi1, f.a1, z, 0, 0, 0);
#pragma unroll
    for (int q = 0; q < 4; ++q) {
        float a = wq[q][0] * relu_f(z[4 * q]);
        a += wq[q][1] * relu_f(z[4 * q + 1]);
        a += wq[q][2] * relu_f(z[4 * q + 2]);
        a += wq[q][3] * relu_f(z[4 * q + 3]);
        sc[q] = xhalf_sum(a);
    }
}
constexpr int AT_SBL = 0, AT_POSMAX = 4352, AT_ITEM = 6400, AT_WV = 6656, AT_BUF = 7680;
constexpr int AT_KI_ROW = 80, AT_P1_BUF = 256 * AT_KI_ROW;
constexpr int AT2_K = 0, AT2_VT = 128 * 144, AT2_KI = AT2_VT + 64 * 272, AT2_PK = AT2_KI + 128 * AT_KI_ROW, AT2_BUF = AT2_PK + 512;
constexpr int ATTM_LDS = AT_BUF + 2 * (AT_P1_BUF > AT2_BUF ? AT_P1_BUF : AT2_BUF);
__device__ __forceinline__ KiFrag ki_lds(const char* buf, int row, int hf) {
    KiFrag f; const char* r = buf + row * AT_KI_ROW + 16 * hf;
    f.a0 = *(const bf16x8*)r; f.a1 = *(const bf16x8*)(r + 32); return f;
}
struct SelQ { float tau[4]; int cut[4]; };
struct IdxOps { bf16x8 qi0, qi1; const float* wvp; };
__device__ __forceinline__ IdxOps idx_ops(const P& p, char* smem, int b, int t0, int lane) {
    const int hf = lane >> 5, cq = (lane & 31) >> 3, ch = lane & 7;
    const int tok = b * NT + t0 + cq;
    const bf16_t* proj = (const bf16_t*)(p.ws + WS_PROJ);
    IdxOps o;
    o.qi0 = *(const bf16x8*)(proj + (size_t)tok * NPROJ + PC_QIDX + ch * 32 + 8 * hf);
    o.qi1 = *(const bf16x8*)(proj + (size_t)tok * NPROJ + PC_QIDX + ch * 32 + 16 + 8 * hf);
    float* wslot = (float*)(smem + AT_WV) + (lane >> 6) * 0;
    const float* wi = (const float*)(p.ws + WS_WI) + (size_t)(b * NT + t0) * 8;
    if ((lane & 31) < 16) { const int r = lane & 15; wslot[hf * 16 + r] = wi[(r >> 2) * 8 + 4 * hf + (r & 3)]; }
    __threadfence_block();
    o.wvp = wslot + hf * 16;
    return o;
}
__device__ __forceinline__ void attn_pass1(const P& p, char* smem, int b, int tb, int tid, SelQ& sel) {
    const int lane = tid & 63, wave = tid >> 6;
    const int hf = lane >> 5, l31 = lane & 31;
    const int t0 = tb * 32 + wave * 4;
    const bf16_t* ki_b = (const bf16_t*)(p.ws + WS_KI) + (size_t)b * NT * 32;
    const IdxOps io = idx_ops(p, smem + wave * 128, b, t0, lane);
    char* bufs = smem + AT_BUF;
    unsigned u[32][4];
#pragma unroll
    for (int s = 0; s < 32; ++s)
#pragma unroll
        for (int q = 0; q < 4; ++q) u[s][q] = 0x007fffffu;
    {
#pragma unroll
        for (int i = 0; i < 2; ++i) { const int x = tid + 512 * i; *(uint4*)(bufs + (x >> 2) * AT_KI_ROW + (x & 3) * 16) = *(const uint4*)(ki_b + (size_t)(x >> 2) * 32 + (x & 3) * 8); }
    }
    __syncthreads();
#pragma unroll
    for (int g = 0; g < 8; ++g) {
        if (g * 8 <= tb) {
            const bool more = (g + 1) * 8 <= tb;
            uint4 n0 = make_uint4(0, 0, 0, 0), n1 = n0;
            if (more) {
                n0 = *(const uint4*)(ki_b + (size_t)((g + 1) * 256 + (tid >> 2)) * 32 + (tid & 3) * 8);
                n1 = *(const uint4*)(ki_b + (size_t)((g + 1) * 256 + 128 + (tid >> 2)) * 32 + (tid & 3) * 8);
            }
            const char* buf = bufs + (g & 1) * AT_P1_BUF;
#pragma unroll
            for (int kk = 0; kk < 8; ++kk) {
                const int kt = g * 8 + kk;
                if (kt <= tb) {
                    const KiFrag f = ki_lds(buf, kk * 32 + l31, hf);
                    float sc[4];
                    idx_scores4(sc, f, io.qi0, io.qi1, io.wvp);
                    if (kt == tb) {
#pragma unroll
                        for (int q = 0; q < 4; ++q) sc[q] = (kt * 32 + l31 <= t0 + q) ? sc[q] : -INFINITY;
                    }
#pragma unroll
                    for (int q = 0; q < 4; ++q) u[kt >> 1][q] = (hf == (kt & 1)) ? f2sortable(sc[q]) : u[kt >> 1][q];
                    __builtin_amdgcn_sched_barrier(0);
                }
            }
            if (more) {
                char* nb = bufs + ((g + 1) & 1) * AT_P1_BUF;
                *(uint4*)(nb + (tid >> 2) * AT_KI_ROW + (tid & 3) * 16) = n0;
                *(uint4*)(nb + (128 + (tid >> 2)) * AT_KI_ROW + (tid & 3) * 16) = n1;
            }
            __syncthreads();
        }
    }
    unsigned prefix[4] = {0u, 0u, 0u, 0u}; bool exact[4] = {false, false, false, false};
    for (int bit = 31; bit >= 0; --bit) {
        unsigned cand[4];
#pragma unroll
        for (int q = 0; q < 4; ++q) cand[q] = prefix[q] | (1u << bit);
        int c0 = 0, c1 = 0, c2 = 0, c3 = 0;
#pragma unroll
        for (int g8 = 0; g8 < 4; ++g8) {
            if (g8 * 16 <= tb) {
#pragma unroll
                for (int s = g8 * 8; s < g8 * 8 + 8; ++s)
                    asm volatile("v_cmp_ge_u32_e64 s[70:71], %4, %8\n\tv_cmp_ge_u32_e64 s[72:73], %5, %9\n\tv_cmp_ge_u32_e64 s[74:75], %6, %10\n\tv_cmp_ge_u32_e64 s[76:77], %7, %11\n\t"
                                 "v_addc_co_u32_e64 %0, s[70:71], 0, %0, s[70:71]\n\tv_addc_co_u32_e64 %1, s[72:73], 0, %1, s[72:73]\n\tv_addc_co_u32_e64 %2, s[74:75], 0, %2, s[74:75]\n\tv_addc_co_u32_e64 %3, s[76:77], 0, %3, s[76:77]"
                                 : "+v"(c0), "+v"(c1), "+v"(c2), "+v"(c3)
                                 : "v"(u[s][0]), "v"(u[s][1]), "v"(u[s][2]), "v"(u[s][3]), "s"(cand[0]), "s"(cand[1]), "s"(cand[2]), "s"(cand[3])
                                 : "s70", "s71", "s72", "s73", "s74", "s75", "s76", "s77");
            }
        }
        int cnt[4] = {c0, c1, c2, c3};
#pragma unroll
        for (int q = 0; q < 4; ++q) { int v = cnt[q]; v += dpp_i<0xB1>(v); v += dpp_i<0x4E>(v); v += dpp_i<0x141>(v); v += dpp_i<0x140>(v);
            v += __builtin_amdgcn_update_dpp(0, v, 0x142, 0xA, 0xF, false); v += __builtin_amdgcn_update_dpp(0, v, 0x143, 0xC, 0xF, false); cnt[q] = __builtin_amdgcn_readlane(v, 63); }
#pragma unroll
        for (int q = 0; q < 4; ++q) {
            const int cq_ = cnt[q];
            if (!exact[q] && cq_ >= 256) { prefix[q] = cand[q]; if (cq_ == 256) exact[q] = true; }
        }
        if (exact[0] && exact[1] && exact[2] && exact[3]) break;
    }
#pragma unroll
    for (int q = 0; q < 4; ++q) {
        int cutq = 0x7fffffff;
        if (!exact[q]) {
            const unsigned pf = prefix[q];
            int ngt = 0, neq = 0;
#pragma unroll
            for (int s = 0; s < 32; ++s)
                { ngt += __builtin_popcountll(__ballot(u[s][q] > pf)); neq += __builtin_popcountll(__ballot(u[s][q] == pf)); }
            const int need = 256 - ngt;
            if (need < neq) {
                int lo = 0, hi = NT - 1;
                for (int it = 0; it < 11; ++it) {
                    const int mid = (lo + hi) >> 1;
                    int cnt = 0;
#pragma unroll
                    for (int s = 0; s < 32; ++s)
                        cnt += __builtin_popcountll(__ballot(u[s][q] == pf && ((2 * s + hf) * 32 + l31) <= mid));
                    if (cnt >= need) hi = mid; else lo = mid + 1;
                }
                cutq = lo;
            }
        }
        sel.tau[q] = __uint_as_float((prefix[q] & 0x80000000u) ? (prefix[q] & 0x7fffffffu) : ~prefix[q]);
        sel.cut[q] = cutq;
    }
}
__device__ __forceinline__ float xhalf_max(float v) { auto rr = __builtin_amdgcn_permlane32_swap(__float_as_uint(v), __float_as_uint(v), false, false); return fmaxf(__uint_as_float(rr[0]), __uint_as_float(rr[1])); }
__device__ __forceinline__ void attn_pass2(const P& p, char* smem, int b, int tb, int tid, const SelQ& sel) {
    const int lane = tid & 63, wave = tid >> 6;
    const int hf = lane >> 5, l31 = lane & 31, cq = l31 >> 3, ch = lane & 7, prow = pi32(l31);
    const int t0 = tb * 32 + wave * 4, tq = t0 + cq, tok = b * NT + tq;
    const bf16_t* proj = (const bf16_t*)(p.ws + WS_PROJ);
    bf16_t* qn = (bf16_t*)(p.ws + WS_QN);
    const bf16_t* ki_b = (const bf16_t*)(p.ws + WS_KI) + (size_t)b * NT * 32;
    const bf16_t* K_b = (const bf16_t*)(p.ws + WS_K) + (size_t)b * NT * 64;
    const bf16_t* Vt_b = (const bf16_t*)(p.ws + WS_VT) + (size_t)b * 64 * NT;
    const float* sbl = (const float*)(smem + AT_SBL); const int* posmax = (const int*)(smem + AT_POSMAX) + b * 64;
    char* bufs = smem + AT_BUF;
    const IdxOps io = idx_ops(p, smem + wave * 128, b, t0, lane);
    bf16x8 qb[4];
#pragma unroll
    for (int ks = 0; ks < 4; ++ks) qb[ks] = *(const bf16x8*)(qn + (size_t)tok * 512 + ch * 64 + ks * 16 + 8 * hf);
    const int pq = p.pos[tok];
    int pqmin = pq;
    pqmin = min(pqmin, __shfl_xor(pqmin, 8)); pqmin = min(pqmin, __shfl_xor(pqmin, 16));
    pqmin = __builtin_amdgcn_readfirstlane(pqmin);
    const float bias_far = sbl[128 * 8 + ch];
    const bool anycut = (sel.cut[0] & sel.cut[1] & sel.cut[2] & sel.cut[3]) != 0x7fffffff;
    f32x16 o0, o1;
#pragma unroll
    for (int r = 0; r < 16; ++r) { o0[r] = 0.f; o1[r] = 0.f; }
    float m = -1.0e30f, l = 0.f;
    bf16x8 selB;
    { union { uint4 u; bf16x8 f; } cv; const unsigned one = 0x3F80u;
      cv.u = make_uint4((hf == 0 && cq == 0) ? one : ((hf == 0 && cq == 1) ? (one << 16) : 0u), (hf == 0 && cq == 2) ? one : ((hf == 0 && cq == 3) ? (one << 16) : 0u), 0u, 0u); selB = cv.f; }
    const int nt128 = (tb + 4) >> 2;
    uint4 rk0, rk1, rv0, rv1, rki; int rpos = 0;
#define AT_LOAD(j) { const int kb_ = (j) * 128; \
        rk0 = *(const uint4*)(K_b + (size_t)(kb_ + (tid >> 3)) * 64 + (tid & 7) * 8); rk1 = *(const uint4*)(K_b + (size_t)(kb_ + 64 + (tid >> 3)) * 64 + (tid & 7) * 8); \
        rv0 = *(const uint4*)(Vt_b + (size_t)(tid >> 4) * NT + kb_ + (tid & 15) * 8); rv1 = *(const uint4*)(Vt_b + (size_t)(32 + (tid >> 4)) * NT + kb_ + (tid & 15) * 8); \
        rki = *(const uint4*)(ki_b + (size_t)(kb_ + (tid >> 2)) * 32 + (tid & 3) * 8); \
        if (tid < 128) rpos = p.pos[b * NT + kb_ + tid]; }
#define AT_STORE(bp) { char* sb_ = (bp); \
        *(uint4*)(sb_ + AT2_K + (tid >> 3) * 144 + (tid & 7) * 16) = rk0; *(uint4*)(sb_ + AT2_K + (64 + (tid >> 3)) * 144 + (tid & 7) * 16) = rk1; \
        *(uint4*)(sb_ + AT2_VT + (tid >> 4) * 272 + (tid & 15) * 16) = rv0; *(uint4*)(sb_ + AT2_VT + (32 + (tid >> 4)) * 272 + (tid & 15) * 16) = rv1; \
        *(uint4*)(sb_ + AT2_KI + (tid >> 2) * AT_KI_ROW + (tid & 3) * 16) = rki; \
        if (tid < 128) ((int*)(sb_ + AT2_PK))[tid] = rpos; }
    AT_LOAD(0) AT_STORE(bufs)
    __syncthreads();
#pragma unroll 1
    for (int j = 0; j < nt128; ++j) {
        if (j + 1 < nt128) AT_LOAD(j + 1)
        const char* buf = bufs + (j & 1) * AT2_BUF;
#pragma unroll
        for (int st = 0; st < 2; ++st) {
            const int kt0 = 4 * j + 2 * st;
            if (kt0 <= tb) {
                const bool have1 = (kt0 + 1 <= tb);
                const int krow = st * 64;
                f32x16 s0, s1;
                float sc0[4], sc1[4];
                idx_scores4(sc0, ki_lds(buf + AT2_KI, krow + prow, hf), io.qi0, io.qi1, io.wvp);
                const bool far0 = (pqmin - posmax[kt0] >= 128);
                const int key0 = kt0 * 32 + prow, key1 = key0 + 32;
                const bool diag = (kt0 + 1 >= tb);
                bf16x8 am0, am1;
                {
                    unsigned a01 = 0u, a23 = 0u, b01 = 0u, b23 = 0u;
#pragma unroll
                    for (int q = 0; q < 4; ++q) {
                        bool ok0 = anycut ? ((sc0[q] > sel.tau[q]) || (sc0[q] == sel.tau[q] && key0 <= sel.cut[q])) : (sc0[q] >= sel.tau[q]);
                        if (diag) ok0 = ok0 && (key0 <= t0 + q);
                        const unsigned v0 = ok0 ? 0u : 0xC6EAu;
                        if (q == 0) a01 |= v0; else if (q == 1) a01 |= v0 << 16; else if (q == 2) a23 |= v0; else a23 |= v0 << 16;
                    }
                    if (hf) { a01 = 0u; a23 = 0u; }
                    union { uint4 u; bf16x8 f; } cv; cv.u = make_uint4(a01, a23, 0u, 0u); am0 = cv.f;
                    (void)b01; (void)b23;
                }
#pragma unroll
                for (int r = 0; r < 16; ++r) s0[r] = far0 ? bias_far : 0.f;
                s0 = __builtin_amdgcn_mfma_f32_32x32x16_bf16(am0, selB, s0, 0, 0, 0);
                {
                    const char* kr = buf + AT2_K + (krow + prow) * 144 + 16 * hf;
#pragma unroll
                    for (int ks = 0; ks < 4; ++ks) s0 = __builtin_amdgcn_mfma_f32_32x32x16_bf16(*(const bf16x8*)(kr + ks * 32), qb[ks], s0, 0, 0, 0);
                }
                bool far1 = true;
                if (have1) {
                    idx_scores4(sc1, ki_lds(buf + AT2_KI, krow + 32 + prow, hf), io.qi0, io.qi1, io.wvp);
                    far1 = (pqmin - posmax[kt0 + 1] >= 128);
                    unsigned a01 = 0u, a23 = 0u;
#pragma unroll
                    for (int q = 0; q < 4; ++q) {
                        bool ok1 = anycut ? ((sc1[q] > sel.tau[q]) || (sc1[q] == sel.tau[q] && key1 <= sel.cut[q])) : (sc1[q] >= sel.tau[q]);
                        if (diag) ok1 = ok1 && (key1 <= t0 + q);
                        const unsigned v1 = ok1 ? 0u : 0xC6EAu;
                        if (q == 0) a01 |= v1; else if (q == 1) a01 |= v1 << 16; else if (q == 2) a23 |= v1; else a23 |= v1 << 16;
                    }
                    if (hf) { a01 = 0u; a23 = 0u; }
                    union { uint4 u; bf16x8 f; } cv; cv.u = make_uint4(a01, a23, 0u, 0u); am1 = cv.f;
#pragma unroll
                    for (int r = 0; r < 16; ++r) s1[r] = far1 ? bias_far : 0.f;
                    s1 = __builtin_amdgcn_mfma_f32_32x32x16_bf16(am1, selB, s1, 0, 0, 0);
                    const char* kr = buf + AT2_K + (krow + 32 + prow) * 144 + 16 * hf;
#pragma unroll
                    for (int ks = 0; ks < 4; ++ks) s1 = __builtin_amdgcn_mfma_f32_32x32x16_bf16(*(const bf16x8*)(kr + ks * 32), qb[ks], s1, 0, 0, 0);
                } else {
#pragma unroll
                    for (int r = 0; r < 16; ++r) s1[r] = -60000.f;
                }
                if (!far0) {
                    const int* pk = (const int*)(buf + AT2_PK) + krow + 8 * hf;
#pragma unroll
                    for (int r = 0; r < 16; ++r) { int n = pq - pk[key_of_reg(r)]; n = n < 0 ? 0 : (n > 128 ? 128 : n); s0[r] += sbl[n * 8 + ch]; }
                }
                if (!far1) {
                    const int* pk = (const int*)(buf + AT2_PK) + krow + 32 + 8 * hf;
#pragma unroll
                    for (int r = 0; r < 16; ++r) { int n = pq - pk[key_of_reg(r)]; n = n < 0 ? 0 : (n > 128 ? 128 : n); s1[r] += sbl[n * 8 + ch]; }
                }
                float mx = fmaxf(s0[0], s1[0]);
#pragma unroll
                for (int r = 1; r < 16; ++r) mx = fmaxf(mx, fmaxf(s0[r], s1[r]));
                mx = xhalf_max(mx);
                if (!__all(mx - m <= 8.f)) {
                    const float mnew = fmaxf(m, mx);
                    const float alpha = __builtin_amdgcn_exp2f(m - mnew);
                    m = mnew; l *= alpha;
#pragma unroll
                    for (int r = 0; r < 16; ++r) { o0[r] *= alpha; o1[r] *= alpha; }
                }
                const float mref = m;
                float ps = 0.f;
#pragma unroll
                for (int r = 0; r < 16; ++r) { s0[r] = __builtin_amdgcn_exp2f(s0[r] - mref); s1[r] = __builtin_amdgcn_exp2f(s1[r] - mref); ps += s0[r] + s1[r]; }
                l += ps;
                union { uint4 u; bf16x8 f; } pb0, pb1, pb2, pb3;
                pb0.u = make_uint4(pack2(s0[0], s0[1]), pack2(s0[2], s0[3]), pack2(s0[4], s0[5]), pack2(s0[6], s0[7]));
                pb1.u = make_uint4(pack2(s0[8], s0[9]), pack2(s0[10], s0[11]), pack2(s0[12], s0[13]), pack2(s0[14], s0[15]));
                pb2.u = make_uint4(pack2(s1[0], s1[1]), pack2(s1[2], s1[3]), pack2(s1[4], s1[5]), pack2(s1[6], s1[7]));
                pb3.u = make_uint4(pack2(s1[8], s1[9]), pack2(s1[10], s1[11]), pack2(s1[12], s1[13]), pack2(s1[14], s1[15]));
                const char* vr = buf + AT2_VT + l31 * 272 + st * 128 + 16 * hf;
                o0 = __builtin_amdgcn_mfma_f32_32x32x16_bf16(*(const bf16x8*)vr, pb0.f, o0, 0, 0, 0);
                o1 = __builtin_amdgcn_mfma_f32_32x32x16_bf16(*(const bf16x8*)(vr + 32 * 272), pb0.f, o1, 0, 0, 0);
                o0 = __builtin_amdgcn_mfma_f32_32x32x16_bf16(*(const bf16x8*)(vr + 32), pb1.f, o0, 0, 0, 0);
                o1 = __builtin_amdgcn_mfma_f32_32x32x16_bf16(*(const bf16x8*)(vr + 32 * 272 + 32), pb1.f, o1, 0, 0, 0);
                o0 = __builtin_amdgcn_mfma_f32_32x32x16_bf16(*(const bf16x8*)(vr + 64), pb2.f, o0, 0, 0, 0);
                o1 = __builtin_amdgcn_mfma_f32_32x32x16_bf16(*(const bf16x8*)(vr + 32 * 272 + 64), pb2.f, o1, 0, 0, 0);
                o0 = __builtin_amdgcn_mfma_f32_32x32x16_bf16(*(const bf16x8*)(vr + 96), pb3.f, o0, 0, 0, 0);
                o1 = __builtin_amdgcn_mfma_f32_32x32x16_bf16(*(const bf16x8*)(vr + 32 * 272 + 96), pb3.f, o1, 0, 0, 0);
            }
        }
        if (j + 1 < nt128) AT_STORE(bufs + ((j + 1) & 1) * AT2_BUF)
        __syncthreads();
    }
#undef AT_LOAD
#undef AT_STORE
    l += __shfl_xor(l, 32);
    const float inv = 1.f / l;
    bf16_t* orow = qn + (size_t)tok * 512 + ch * 64;
#pragma unroll
    for (int gq = 0; gq < 4; ++gq) {
        *(uint2*)(orow + gq * 8 + 4 * hf) = make_uint2(pack2(o0[gq * 4] * inv, o0[gq * 4 + 1] * inv), pack2(o0[gq * 4 + 2] * inv, o0[gq * 4 + 3] * inv));
        *(uint2*)(orow + 32 + gq * 8 + 4 * hf) = make_uint2(pack2(o1[gq * 4] * inv, o1[gq * 4 + 1] * inv), pack2(o1[gq * 4 + 2] * inv, o1[gq * 4 + 3] * inv));
    }
}
__device__ __forceinline__ void dn_scan_block(const P& p, char* smem, int bh, int tid);
template <int MODE>
__device__ __forceinline__ void ph_attn_mfma(const P& p, char* smem) {
    const int tid = tid_opaque();
    float* sbl = (float*)(smem + AT_SBL);
    for (int i = tid; i < 129 * 8; i += NTHREADS) {
        const int n = i >> 3, h = i & 7; int bk;
        if (n < 16) bk = n;
        else { const float v = logf((float)n / 16.f) / 2.0794415416798357f * 16.f; bk = 16 + (int)v; if (bk > 31) bk = 31; }
        sbl[i] = p.rel_bias[bk * 8 + h] * LOG2E;
    }
    ((int*)(smem + AT_POSMAX))[tid] = ((const int*)(p.ws + WS_POSMM))[tid * 2 + 1];
    __syncthreads();
    if (MODE != 2 && blockIdx.x < NB * 4) {
        int tid0 = tid; asm volatile("" : "+v"(tid0));
        dn_scan_block(p, smem + AT_BUF, blockIdx.x, tid0);
        __syncthreads();
    }
    int* qctr = (int*)(p.ws + WS_CTL) + 64;
    if (MODE != 1) for (;;) {
        int tid1 = tid; asm volatile("" : "+v"(tid1));
        if (tid1 == 0) *(int*)(smem + AT_ITEM) = atomicAdd(qctr, 1);
        __syncthreads();
        const int item = *(const int*)(smem + AT_ITEM);
        if (item >= NB * 64) break;
        const int b = item & 7, tb = 63 - (item >> 3);
        SelQ sel;
#pragma unroll
        for (int q = 0; q < 4; ++q) { sel.tau[q] = -INFINITY; sel.cut[q] = 0x7fffffff; }
        if (tb >= 8) attn_pass1(p, smem, b, tb, tid1, sel);
        int tid2 = tid; asm volatile("" : "+v"(tid2));
        attn_pass2(p, smem, b, tb, tid2, sel);
    }
}

__device__ __forceinline__ constexpr int sig16(int x) { return (x & ~12) | ((x & 4) << 1) | ((x & 8) >> 1); }
constexpr int PREP_WAVE_LDS = 2 * 64 * 72 * 2 + 4 * 64 * 4;
constexpr int PREP_LDS = NWAVES * PREP_WAVE_LDS;
__device__ __forceinline__ void ph_dn_prep(const P& p, char* smem) {
    const int tid = tid_opaque();
    const int wave = tid >> 6;
    char* wl = smem + wave * PREP_WAVE_LDS;
    float* sA = (float*)wl;
    bf16_t* sTw = (bf16_t*)wl; bf16_t* sTu = sTw + 64 * 72;
    float* sG = (float*)(wl + 2 * 64 * 72 * 2); float* sB = sG + 64; float* sE = sB + 64; float* sL = sE + 64;
    const bf16_t* dq = (const bf16_t*)(p.ws + WS_DQ); const bf16_t* dk = (const bf16_t*)(p.ws + WS_DK);
    const bf16_t* dkT = (const bf16_t*)(p.ws + WS_DKT); const bf16_t* dvT = (const bf16_t*)(p.ws + WS_DVT);
    const float* dbeta = (const float*)(p.ws + WS_DBG); const float* dg = dbeta + NTOK * 4;
    unsigned char* dob = (unsigned char*)p.out;
    bf16_t* PPg = (bf16_t*)(dob + DO_PP); float* GCg = (float*)(dob + DO_GC); float* EGg = (float*)(dob + DO_EG); float* LLg = (float*)(dob + DO_LL);
    for (int item = blockIdx.x * NWAVES + wave; item < NB * 4 * 32; item += gridDim.x * NWAVES) {
        int lane = tid & 63; asm volatile("" : "+v"(lane));
        const int hf = lane >> 5, l31 = lane & 31;
        const int bh = item >> 5, c = item & 31, b = bh >> 2, hh = bh & 3;
        const int tok0 = b * NT + c * 64;
        bf16_t* WN = (bf16_t*)(dob + DO_WN) + (size_t)item * 64 * 128; bf16_t* Ug = (bf16_t*)(dob + DO_U) + (size_t)item * 64 * 128;
        bf16_t* PP = PPg + (size_t)item * 64 * 64;
        float G, beta, eG;
        {
            const float g = dg[(size_t)(tok0 + lane) * 4 + hh];
            beta = dbeta[(size_t)(tok0 + lane) * 4 + hh];
            G = g;
#pragma unroll
            for (int o = 1; o < 64; o <<= 1) { const float n = __shfl_up(G, o); if (lane >= o) G += n; }
            const float Gl = __shfl(G, 63);
            eG = __expf(G);
            sG[lane] = G; sB[lane] = beta; sE[lane] = eG; sL[lane] = __expf(Gl - G);
            EGg[item * 64 + lane] = eG; LLg[item * 64 + lane] = __expf(Gl - G);
            if (lane == 0) GCg[item] = __expf(Gl);
        }
        f32x16 kk00, kk10, kk11, qk00, qk10, qk11;
#pragma unroll
        for (int r = 0; r < 16; ++r) { kk00[r] = 0.f; kk10[r] = 0.f; kk11[r] = 0.f; qk00[r] = 0.f; qk10[r] = 0.f; qk11[r] = 0.f; }
        {
            const bf16_t* kr0 = dk + (size_t)(tok0 + l31) * 512 + hh * 128 + 8 * hf; const bf16_t* kr1 = kr0 + 32 * 512;
            const bf16_t* qr0 = dq + (size_t)(tok0 + l31) * 512 + hh * 128 + 8 * hf; const bf16_t* qr1 = qr0 + 32 * 512;
#pragma unroll
            for (int s = 0; s < 8; ++s) {
                const bf16x8 k0 = *(const bf16x8*)(kr0 + s * 16), k1 = *(const bf16x8*)(kr1 + s * 16), q0 = *(const bf16x8*)(qr0 + s * 16), q1 = *(const bf16x8*)(qr1 + s * 16);
                kk00 = __builtin_amdgcn_mfma_f32_32x32x16_bf16(k0, k0, kk00, 0, 0, 0);
                kk10 = __builtin_amdgcn_mfma_f32_32x32x16_bf16(k1, k0, kk10, 0, 0, 0);
                kk11 = __builtin_amdgcn_mfma_f32_32x32x16_bf16(k1, k1, kk11, 0, 0, 0);
                qk00 = __builtin_amdgcn_mfma_f32_32x32x16_bf16(q0, k0, qk00, 0, 0, 0);
                qk10 = __builtin_amdgcn_mfma_f32_32x32x16_bf16(q1, k0, qk10, 0, 0, 0);
                qk11 = __builtin_amdgcn_mfma_f32_32x32x16_bf16(q1, k1, qk11, 0, 0, 0);
            }
        }
        __threadfence_block();
        {
            const float Gc0 = sG[l31], Gc1 = sG[32 + l31];
            float* sA0 = sA + (4 * hf) * 64 + l31;
            bf16_t* PP0 = PP + (4 * hf) * 64 + sig16(l31);
            const float* sGr = sG + 4 * hf; const float* sBr = sB + 4 * hf;
            const int jrel = l31 - 4 * hf;
#pragma unroll
            for (int r = 0; r < 16; ++r) {
                const int ro = (r & 3) + 8 * (r >> 2);
                const float Gi0 = sGr[ro], Gi1 = sGr[32 + ro], Bi0 = sBr[ro], Bi1 = sBr[32 + ro];
                {
                    const float dec = (jrel <= ro) ? __expf(Gi0 - Gc0) : 0.f;
                    sA0[ro * 64] = (jrel < ro) ? Bi0 * kk00[r] * dec : 0.f;
                    PP0[ro * 64] = f2bf(qk00[r] * dec);
                    PP0[ro * 64 + 32] = 0;
                }
                {
                    const float dec = __expf(Gi1 - Gc0);
                    sA0[(32 + ro) * 64] = Bi1 * kk10[r] * dec;
                    PP0[(32 + ro) * 64] = f2bf(qk10[r] * dec);
                }
                {
                    const float dec = (jrel <= ro) ? __expf(Gi1 - Gc1) : 0.f;
                    sA0[(32 + ro) * 64 + 32] = (jrel < ro) ? Bi1 * kk11[r] * dec : 0.f;
                    PP0[(32 + ro) * 64 + 32] = f2bf(qk11[r] * dec);
                }
            }
        }
        __threadfence_block();
        float x[64];
#pragma unroll
        for (int i = 0; i < 64; ++i) x[i] = (i == lane) ? 1.f : 0.f;
#pragma unroll
        for (int i = 1; i < 64; ++i) {
            float acc = x[i];
#pragma unroll
            for (int m4 = 0; m4 < i; m4 += 4) {
                const f32x4 a = *(const f32x4*)(sA + i * 64 + m4);
                acc -= a[0] * x[m4];
                if (m4 + 1 < i) acc -= a[1] * x[m4 + 1];
                if (m4 + 2 < i) acc -= a[2] * x[m4 + 2];
                if (m4 + 3 < i) acc -= a[3] * x[m4 + 3];
            }
            x[i] = acc;
            __builtin_amdgcn_sched_barrier(0);
        }
        __threadfence_block();
        {
            const float sw = beta * eG;
#pragma unroll
            for (int i = 0; i < 64; ++i) { sTw[i * 72 + lane] = f2bf(x[i] * sw); sTu[i * 72 + lane] = f2bf(x[i] * beta); }
        }
        __threadfence_block();
        {
            bf16x8 tw[2][4], tu[2][4];
#pragma unroll
            for (int mt = 0; mt < 2; ++mt)
#pragma unroll
                for (int s = 0; s < 4; ++s) { tw[mt][s] = *(const bf16x8*)(sTw + (mt * 32 + l31) * 72 + s * 16 + 8 * hf); tu[mt][s] = *(const bf16x8*)(sTu + (mt * 32 + l31) * 72 + s * 16 + 8 * hf); }
            const bf16_t* kTb = dkT + ((size_t)bh * 128 + l31) * NT + c * 64 + 8 * hf;
            const bf16_t* vTb = dvT + ((size_t)bh * 128 + l31) * NT + c * 64 + 8 * hf;
#pragma unroll 1
            for (int nt = 0; nt < 4; ++nt) {
                f32x16 w0, w1, u0, u1;
#pragma unroll
                for (int r = 0; r < 16; ++r) { w0[r] = 0.f; w1[r] = 0.f; u0[r] = 0.f; u1[r] = 0.f; }
#pragma unroll
                for (int s = 0; s < 4; ++s) {
                    const bf16x8 kb = *(const bf16x8*)(kTb + (size_t)nt * 32 * NT + s * 16), vb = *(const bf16x8*)(vTb + (size_t)nt * 32 * NT + s * 16);
                    w0 = __builtin_amdgcn_mfma_f32_32x32x16_bf16(tw[0][s], kb, w0, 0, 0, 0);
                    w1 = __builtin_amdgcn_mfma_f32_32x32x16_bf16(tw[1][s], kb, w1, 0, 0, 0);
                    u0 = __builtin_amdgcn_mfma_f32_32x32x16_bf16(tu[0][s], vb, u0, 0, 0, 0);
                    u1 = __builtin_amdgcn_mfma_f32_32x32x16_bf16(tu[1][s], vb, u1, 0, 0, 0);
                }
                bf16_t* WN0 = WN + (4 * hf) * 128 + nt * 32 + sig16(l31); bf16_t* U0 = Ug + (4 * hf) * 128 + nt * 32 + l31;
#pragma unroll
                for (int r = 0; r < 16; ++r) {
                    const int ro = (r & 3) + 8 * (r >> 2);
                    WN0[ro * 128] = f2bf(-w0[r]); WN0[(32 + ro) * 128] = f2bf(-w1[r]);
                    U0[ro * 128] = f2bf(u0[r]); U0[(32 + ro) * 128] = f2bf(u1[r]);
                }
            }
        }
        __threadfence_block();
    }
}

__device__ __forceinline__ bf16x8 pack_frag(const f32x16& t, int s) {
    bf16x8 f;
#pragma unroll
    for (int j = 0; j < 8; ++j) f[j] = (short)f2bf(t[8 * s + j]);
    return f;
}
__device__ __forceinline__ bf16x8 pack_frag_scaled(const f32x16& t, int s, const f32x4& sc0, const f32x4& sc1) {
    bf16x8 f;
#pragma unroll
    for (int j = 0; j < 4; ++j) { f[j] = (short)f2bf(t[8 * s + j] * sc0[j]); f[4 + j] = (short)f2bf(t[8 * s + 4 + j] * sc1[j]); }
    return f;
}
__device__ __forceinline__ bf16x8 load_perm_frag(const bf16_t* ptr) {
    const uint2 lo = *(const uint2*)ptr, hi = *(const uint2*)(ptr + 8);
    union { uint4 u; bf16x8 f; } cv; cv.u = make_uint4(lo.x, lo.y, hi.x, hi.y); return cv.f;
}
constexpr int SC_WN = 0, SC_Q = 16384, SC_KT = 32768, SC_PP = SC_KT + 128 * 144, SC_U = SC_PP + 64 * 144, SC_EG = SC_U + 16384, SC_LL = SC_EG + 256, SC_GC = SC_LL + 256, SC_BYTES = SC_GC + 16;
constexpr int SCAN_LDS = 2 * SC_BYTES;
#define SCAN_DECL uint4 wn0, wn1, wn2, wn3, q0, q1, q2, q3, kt0, kt1, kt2, kt3, pp0, pp1, u0, u1, u2, u3; float egv = 0.f, gcv = 0.f;
#define SCAN_LD4(i, WNR, UR, QR, KTR) { const int x = hl + 256 * (i); WNR = WNp[x]; UR = Up[x]; \
        QR = *(const uint4*)(dqb + (size_t)(x >> 4) * 512 + (x & 15) * 8); \
        KTR = *(const uint4*)(ktb + (size_t)(x >> 3) * NT + (x & 7) * 8); }
#define SCAN_LOAD(c) { const int ci = bh * 32 + (c); \
        const uint4* WNp = (const uint4*)(dob + DO_WN + (size_t)ci * 16384); const uint4* Up = (const uint4*)(dob + DO_U + (size_t)ci * 16384); const uint4* PPp = (const uint4*)(dob + DO_PP + (size_t)ci * 8192); \
        const bf16_t* dqb = dqh + (size_t)(c) * 64 * 512; const bf16_t* ktb = dkTh + (c) * 64; \
        SCAN_LD4(0, wn0, u0, q0, kt0) SCAN_LD4(1, wn1, u1, q1, kt1) SCAN_LD4(2, wn2, u2, q2, kt2) SCAN_LD4(3, wn3, u3, q3, kt3) \
        pp0 = PPp[hl]; pp1 = PPp[hl + 256]; \
        if (hl < 64) egv = ((const float*)(dob + DO_EG))[ci * 64 + hl]; else if (hl < 128) egv = ((const float*)(dob + DO_LL))[ci * 64 + hl - 64]; \
        if (hl == 128) gcv = ((const float*)(dob + DO_GC))[ci]; }
#define SCAN_ST4(i, WNR, UR, QR, KTR) { const int x = hl + 256 * (i); \
        { const int r = x >> 4, cc = x & 15; *(uint4*)(sbuf + SC_WN + r * 256 + ((cc ^ (r & 15)) << 4)) = WNR; } \
        *(uint4*)(sbuf + SC_U + x * 16) = UR; \
        { const int r = x >> 4, cc = x & 15, a = cc >> 1, g = cc & 1; char* row = sbuf + SC_Q + r * 256; \
          *(uint2*)(row + (((2 * a) ^ (r & 15)) << 4) + g * 8) = make_uint2(QR.x, QR.y); \
          *(uint2*)(row + (((2 * a + 1) ^ (r & 15)) << 4) + g * 8) = make_uint2(QR.z, QR.w); } \
        { const int d = x >> 3, cc = x & 7, a = cc >> 1, g = cc & 1; char* row = sbuf + SC_KT + d * 144; \
          *(uint2*)(row + (2 * a) * 16 + g * 8) = make_uint2(KTR.x, KTR.y); \
          *(uint2*)(row + (2 * a + 1) * 16 + g * 8) = make_uint2(KTR.z, KTR.w); } }
#define SCAN_STORE(bufptr) { char* sbuf = (bufptr); \
        SCAN_ST4(0, wn0, u0, q0, kt0) SCAN_ST4(1, wn1, u1, q1, kt1) SCAN_ST4(2, wn2, u2, q2, kt2) SCAN_ST4(3, wn3, u3, q3, kt3) \
        *(uint4*)(sbuf + SC_PP + (hl >> 3) * 144 + (hl & 7) * 16) = pp0; \
        *(uint4*)(sbuf + SC_PP + ((hl + 256) >> 3) * 144 + (hl & 7) * 16) = pp1; \
        if (hl < 128) ((float*)(sbuf + SC_EG))[hl] = egv; \
        if (hl == 128) *(float*)(sbuf + SC_GC) = gcv; }
__device__ __forceinline__ void dn_scan_block(const P& p, char* smem, int bh, int tid) {
    const int wave = tid >> 6, lane = tid & 63;
    const int hf = lane >> 5, l31 = lane & 31;
    const int b = bh >> 2, hh = bh & 3;
    const bool helper = wave >= 4;
    const int hl = tid - 256, sl = wave;
    bf16_t* dno = (bf16_t*)((unsigned char*)p.out + DO_DNO);
    if (helper) {
        const unsigned char* dob = (const unsigned char*)p.out;
        const bf16_t* dqh = (const bf16_t*)(p.ws + WS_DQ) + (size_t)b * NT * 512 + hh * 128; const bf16_t* dkTh = (const bf16_t*)(p.ws + WS_DKT) + (size_t)bh * 128 * NT;
        SCAN_DECL
        SCAN_LOAD(0) SCAN_STORE(smem) SCAN_LOAD(1)
        __syncthreads();
#pragma unroll 1
        for (int c = 0; c < NT / 64; ++c) {
            if (c + 1 < NT / 64) SCAN_STORE(smem + ((c + 1) & 1) * SC_BYTES)
            if (c + 2 < NT / 64) SCAN_LOAD(c + 2)
            __syncthreads();
        }
        return;
    }
    f32x16 S[4];
#pragma unroll
    for (int T = 0; T < 4; ++T)
#pragma unroll
        for (int r = 0; r < 16; ++r) S[T][r] = 0.f;
    __syncthreads();
#pragma unroll 1
    for (int c = 0; c < NT / 64; ++c) {
        char* buf = smem + (c & 1) * SC_BYTES;
        {
            const int tok0 = b * NT + c * 64;
            const int sw = l31 & 15;
            const char* wnr = buf + SC_WN + l31 * 256; const char* qr = buf + SC_Q + l31 * 256;
            const char* ktr = buf + SC_KT + l31 * 144 + 16 * hf; const char* ppr = buf + SC_PP + l31 * 144 + 16 * hf;
            const bf16_t* ur = (const bf16_t*)(buf + SC_U) + sl * 32 + l31;
            const float* egs = (const float*)(buf + SC_EG); const float* lls = (const float*)(buf + SC_LL);
            const float gc = *(const float*)(buf + SC_GC);
            bf16x8 SB[4][2];
#pragma unroll
            for (int T = 0; T < 4; ++T) { SB[T][0] = pack_frag(S[T], 0); SB[T][1] = pack_frag(S[T], 1); }
            f32x16 D[2], O[2];
#pragma unroll
            for (int mt = 0; mt < 2; ++mt)
#pragma unroll
                for (int r = 0; r < 16; ++r) { D[mt][r] = bf2f(ur[(mt * 32 + (r & 3) + 8 * (r >> 2) + 4 * hf) * 128]); O[mt][r] = 0.f; }
#pragma unroll
            for (int mt = 0; mt < 2; ++mt)
#pragma unroll
                for (int T = 0; T < 4; ++T)
#pragma unroll
                    for (int s = 0; s < 2; ++s) {
                        const int co = (((2 * (2 * T + s) + hf) ^ sw) << 4) + mt * 32 * 256;
                        const bf16x8 wa = *(const bf16x8*)(wnr + co);
                        const bf16x8 qa = *(const bf16x8*)(qr + co);
                        D[mt] = __builtin_amdgcn_mfma_f32_32x32x16_bf16(wa, SB[T][s], D[mt], 0, 0, 0);
                        O[mt] = __builtin_amdgcn_mfma_f32_32x32x16_bf16(qa, SB[T][s], O[mt], 0, 0, 0);
                    }
            __builtin_amdgcn_sched_barrier(0);
            bf16x8 DB[2][2], DL[2][2];
#pragma unroll
            for (int mt = 0; mt < 2; ++mt) {
#pragma unroll
                for (int g4 = 0; g4 < 4; ++g4) {
                    const f32x4 eg = *(const f32x4*)(egs + mt * 32 + g4 * 8 + 4 * hf);
#pragma unroll
                    for (int j = 0; j < 4; ++j) O[mt][g4 * 4 + j] *= eg[j];
                }
                const f32x4 l0 = *(const f32x4*)(lls + mt * 32 + 0 + 4 * hf), l1 = *(const f32x4*)(lls + mt * 32 + 8 + 4 * hf);
                const f32x4 l2 = *(const f32x4*)(lls + mt * 32 + 16 + 4 * hf), l3 = *(const f32x4*)(lls + mt * 32 + 24 + 4 * hf);
                DB[mt][0] = pack_frag(D[mt], 0); DB[mt][1] = pack_frag(D[mt], 1);
                DL[mt][0] = pack_frag_scaled(D[mt], 0, l0, l1); DL[mt][1] = pack_frag_scaled(D[mt], 1, l2, l3);
            }
#pragma unroll
            for (int mt = 0; mt < 2; ++mt)
#pragma unroll
                for (int ks = 0; ks < 4; ++ks) {
                    const bf16x8 pa = *(const bf16x8*)(ppr + mt * 32 * 144 + ks * 32);
                    O[mt] = __builtin_amdgcn_mfma_f32_32x32x16_bf16(pa, DB[ks >> 1][ks & 1], O[mt], 0, 0, 0);
                }
            __builtin_amdgcn_sched_barrier(0);
            {
                bf16_t* orow = dno + (size_t)tok0 * 512 + hh * 128 + sl * 32 + l31;
#pragma unroll
                for (int mt = 0; mt < 2; ++mt)
#pragma unroll
                    for (int r = 0; r < 16; ++r) orow[(size_t)(mt * 32 + (r & 3) + 8 * (r >> 2) + 4 * hf) * 512] = f2bf(O[mt][r]);
            }
#pragma unroll
            for (int T = 0; T < 4; ++T) {
#pragma unroll
                for (int r = 0; r < 16; ++r) S[T][r] *= gc;
#pragma unroll
                for (int ks = 0; ks < 4; ++ks) {
                    const bf16x8 ka = *(const bf16x8*)(ktr + T * 32 * 144 + ks * 32);
                    S[T] = __builtin_amdgcn_mfma_f32_32x32x16_bf16(ka, DL[ks >> 1][ks & 1], S[T], 0, 0, 0);
                }
            }
        }
        __syncthreads();
    }
}

__device__ __forceinline__ void ph_dn_gate(const P& p) {
    const int tid = tid_opaque();
    const int lane = tid & 63, wave = tid >> 6;
    const bf16_t* dno = (const bf16_t*)((const unsigned char*)p.out + DO_DNO); const bf16_t* proj = (const bf16_t*)(p.ws + WS_PROJ); bf16_t* dnn = (bf16_t*)(p.ws + WS_DK);
    for (int tok = blockIdx.x * NWAVES + wave; tok < NTOK; tok += gridDim.x * NWAVES) {
#pragma unroll
        for (int hh = 0; hh < 4; ++hh) {
            const unsigned orw = *(const unsigned*)(dno + (size_t)tok * 512 + hh * 128 + lane * 2);
            const float o0 = __uint_as_float(orw << 16), o1 = __uint_as_float(orw & 0xffff0000u);
            const float ss = wave_sum(o0 * o0 + o1 * o1);
            const float rs = rsqrtf(ss * (1.f / 128.f) + EPS);
            const unsigned zr = *(const unsigned*)(proj + (size_t)tok * NPROJ + PC_DNZ + hh * 128 + lane * 2);
            const float z0 = __uint_as_float(zr << 16), z1 = __uint_as_float(zr & 0xffff0000u);
            *(unsigned*)(dnn + (size_t)tok * 512 + hh * 128 + lane * 2) = pack2(o0 * rs * p.dn_norm_g[lane * 2] * silu_f(z0), o1 * rs * p.dn_norm_g[lane * 2 + 1] * silu_f(z1));
        }
    }
}

struct EpiOut {
    static constexpr bool PERM = false;
    const float* x; float* out; const float* modf;
    __device__ __forceinline__ void operator()(const f32x4 (&acc)[2][2][4][2], const pg8::DenseSrc::Unit& u, int wr, int wc, int fr, int fq) const {
        const int row0 = u.pm * 256 + wr * 64 + fr, col0 = u.pn * 256 + wc * 32 + 4 * fq;
        const float* gate = modf + (size_t)((u.pm * 256) / NT) * (6 * ND) + 2 * ND;
        f32x4 gv[2][2];
#pragma unroll
        for (int bj = 0; bj < 2; ++bj)
#pragma unroll
            for (int n = 0; n < 2; ++n) gv[bj][n] = *(const f32x4*)(gate + col0 + bj * 128 + n * 16);
#pragma unroll
        for (int ai = 0; ai < 2; ++ai)
#pragma unroll
            for (int m = 0; m < 4; ++m) { const size_t ro = (size_t)(row0 + ai * 128 + m * 16) * ND + col0;
#pragma unroll
                for (int bj = 0; bj < 2; ++bj)
#pragma unroll
                    for (int n = 0; n < 2; ++n) { const f32x4 xv = *(const f32x4*)(x + ro + bj * 128 + n * 16); *(f32x4*)(out + ro + bj * 128 + n * 16) = xv + gv[bj][n] * acc[ai][bj][m][n]; } }
    }
};
__device__ __forceinline__ void ph_gemm_out(const P& p, char* smem) {
    const int tid = tid_opaque();
    pg8::DenseSrc S; S.A0 = (const char*)(p.ws + WS_QN); S.A1 = (const char*)(p.ws + WS_DK); S.Bt = (const char*)(p.ws + WS_WOUT); S.lda = 512; S.K = ND; S.nM = NTOK / 256; S.nN = ND / 256; S.G = gridDim.x; S.c = blockIdx.x; S.ksplit = 8;
    EpiOut E; E.x = p.x; E.out = p.out; E.modf = (const float*)(p.ws + WS_MODF);
    pg8::gemm_phase(tid, (PG8_LAS unsigned char*)smem, ND, S, E);
}

constexpr int ROUTE_LDS = 1024 * 37 * 4 + 2 * 1024 * 4 + 2048;
__device__ __forceinline__ void ph_route(const P& p, char* smem) {
    const int tid = tid_opaque();
    float* sW = (float*)smem;
    float* sA = sW + 1024 * 37; float* sB = sA + 1024;
    int* s_cnt = (int*)(sB + 1024);
    int* s_base = s_cnt + 32; int* s_tok = s_base + 32;
    const int lane = tid & 63, wave = tid >> 6;
    {
        f32x4 tg[2], te[16];
#pragma unroll
        for (int i = 0; i < 2; ++i) tg[i] = *(const f32x4*)(p.rg_w + (size_t)(tid + i * NTHREADS) * 4);
#pragma unroll
        for (int i = 0; i < 16; ++i) te[i] = *(const f32x4*)(p.re_w + (size_t)(tid + i * NTHREADS) * 4);
#pragma unroll
        for (int i = 0; i < 2; ++i) { float* d = sW + (tid + i * NTHREADS) * 37; d[0] = tg[i][0]; d[1] = tg[i][1]; d[2] = tg[i][2]; d[3] = tg[i][3]; }
#pragma unroll
        for (int i = 0; i < 16; ++i) { const int x = tid + i * NTHREADS; float* d = sW + (x >> 3) * 37 + 4 + (x & 7) * 4; d[0] = te[i][0]; d[1] = te[i][1]; d[2] = te[i][2]; d[3] = te[i][3]; }
    }
    bf16_t* h2 = (bf16_t*)(p.ws + WS_H2);
    int* cnt = (int*)(p.ws + WS_CTL); int* list = (int*)(p.ws + WS_LIST); int* tokinfo = (int*)(p.ws + WS_TOKINFO);
    int curb = -1;
    for (int tile = blockIdx.x; tile < NTOK / 64; tile += gridDim.x) {
        const int b = tile / (NT / 64);
        __syncthreads();
        if (b != curb) {
            { const float* mf = (const float*)(p.ws + WS_MODF) + (size_t)b * (6 * ND); for (int d = tid; d < ND; d += NTHREADS) { sA[d] = p.norm2_g[d] * (1.f + mf[4 * ND + d]); sB[d] = mf[3 * ND + d]; } }
            curb = b;
        }
        if (tid < 32) s_cnt[tid] = 0;
        __syncthreads();
        for (int i2 = 0; i2 < 4; ++i2) {
            const int tokA = tile * 64 + wave * 8 + i2 * 2, tokB = tokA + 1;
            const float* xa = p.out + (size_t)tokA * ND; const float* xb = xa + ND;
            float va[16], vb[16]; float sa = 0.f, sb = 0.f;
#pragma unroll
            for (int j = 0; j < 16; ++j) { va[j] = xa[j * 64 + lane]; vb[j] = xb[j * 64 + lane]; sa += va[j] * va[j]; sb += vb[j] * vb[j]; }
            sa = wave_sum(sa); sb = wave_sum(sb);
            const float ra = rsqrtf(sa * (1.f / ND) + EPS), rb = rsqrtf(sb * (1.f / ND) + EPS);
#pragma unroll
            for (int j = 0; j < 16; ++j) {
                const int d = j * 64 + lane;
                va[j] = va[j] * ra * sA[d] + sB[d]; vb[j] = vb[j] * rb * sA[d] + sB[d];
                h2[(size_t)tokA * ND + d] = f2bf(va[j]); h2[(size_t)tokB * ND + d] = f2bf(vb[j]);
            }
            float la = 0.f, lb = 0.f;
#pragma unroll 4
            for (int o = 0; o < 36; ++o) {
                float a = 0.f, c = 0.f;
#pragma unroll
                for (int j = 0; j < 16; ++j) { const float w = sW[(j * 64 + lane) * 37 + o]; a += va[j] * w; c += vb[j] * w; }
                a = wave_sum(a); c = wave_sum(c);
                if (lane == o) { la = a; lb = c; }
            }
            const float bias = (lane < 4) ? p.rg_b[lane] : ((lane < 36) ? p.re_b[lane - 4] : 0.f);
            la += bias; lb += bias;
#pragma unroll
            for (int which = 0; which < 2; ++which) {
                const float mylogit = which ? lb : la; const int tok = which ? tokB : tokA;
                float gl[4];
#pragma unroll
                for (int j = 0; j < 4; ++j) gl[j] = __shfl(mylogit, j);
                int gsel = 0; float gm = gl[0];
#pragma unroll
                for (int j = 1; j < 4; ++j) if (gl[j] > gm) { gm = gl[j]; gsel = j; }
                float gs = 0.f;
#pragma unroll
                for (int j = 0; j < 4; ++j) gs += __expf(gl[j] - gm);
                const float gtop = 1.f / gs;
                float el[8];
#pragma unroll
                for (int j = 0; j < 8; ++j) el[j] = __shfl(mylogit, 4 + gsel * 8 + j);
                int e1 = 0; float m1 = el[0];
#pragma unroll
                for (int j = 1; j < 8; ++j) if (el[j] > m1) { m1 = el[j]; e1 = j; }
                int e2 = -1; float m2 = -INFINITY;
#pragma unroll
                for (int j = 0; j < 8; ++j) if (j != e1 && el[j] > m2) { m2 = el[j]; e2 = j; }
                const float r2 = __expf(m2 - m1);
                const float w1v = gtop / (1.f + r2), w2v = gtop * r2 / (1.f + r2);
                if (lane == 0) {
                    const int ea = gsel * 8 + e1, eb = gsel * 8 + e2;
                    const int pa = atomicAdd(&s_cnt[ea], 1), pb = atomicAdd(&s_cnt[eb], 1);
                    int* st = s_tok + (tok & 63) * 4; st[0] = ea; st[1] = pa; st[2] = eb; st[3] = pb;
                    int* ti = tokinfo + (size_t)tok * 8; ti[4] = __float_as_int(w1v); ti[5] = __float_as_int(w2v);
                }
            }
        }
        __syncthreads();
        if (tid < 32) s_base[tid] = atomicAdd(&cnt[tid], s_cnt[tid]);
        __syncthreads();
        if (tid < 64) {
            const int tok = tile * 64 + tid; const int* st = s_tok + tid * 4;
            const int ea = st[0], pa = s_base[ea] + st[1], eb = st[2], pb = s_base[eb] + st[3];
            list[ea * NTOK + pa] = tok; list[eb * NTOK + pb] = tok;
            int* ti = tokinfo + (size_t)tok * 8; ti[0] = ea; ti[1] = pa; ti[2] = eb; ti[3] = pb;
        }
    }
}

struct MoeIdx { int rowoff[NE + 1]; int tileoff[NE + 1]; };
__device__ __forceinline__ void moe_index(const int tid, const P& p, MoeIdx* mi) {
    if (tid == 0) {
        const int* cnt = (const int*)(p.ws + WS_CTL);
        int r = 0, t = 0;
        for (int e = 0; e < NE; ++e) { mi->rowoff[e] = r; mi->tileoff[e] = t; const int c = cnt[e]; r += c; t += (c + 255) >> 8; }
        mi->rowoff[NE] = r; mi->tileoff[NE] = t;
    }
    __syncthreads();
}
struct MoeSrc {
    struct Unit { int e, ml, pn, nrows, row0; };
    const MoeIdx* mi; const int* list; const char* Ab; const char* Bt; size_t bstride; int K, G, c; bool gather;
    __device__ __forceinline__ bool next(int i, Unit& u) const {
        const int L = i * G + c; if (L >= mi->tileoff[NE] * 4) return false;
        const int mt = L >> 2; u.pn = L & 3;
        int e = 0; while (mi->tileoff[e + 1] <= mt) ++e;
        u.e = e; u.ml = mt - mi->tileoff[e]; u.row0 = mi->rowoff[e] + u.ml * 256;
        u.nrows = min(256, mi->rowoff[e + 1] - u.row0);
        return true;
    }
    __device__ __forceinline__ unsigned one(const Unit& u, int r, int C) const {
        const int rr = min(r, u.nrows - 1);
        const int arow = gather ? list[u.e * NTOK + u.ml * 256 + rr] : (u.row0 + rr);
        return (unsigned)((arow * K + C) * 2);
    }
    __device__ __forceinline__ void a_off(const Unit& u, int R0, int C0, int R1, int C1, pg8::AO& ao) const {
        ao.h0p0 = one(u, R0, C0); ao.h0p1 = one(u, R1, C1); ao.h1p0 = one(u, 128 + R0, C0); ao.h1p1 = one(u, 128 + R1, C1);
    }
    __device__ __forceinline__ const char* a_base(const Unit&, int kt) const { return Ab + (size_t)kt * 128; }
    __device__ __forceinline__ const char* b_base(const Unit& u) const { return Bt + (size_t)u.e * bstride + (size_t)u.pn * 256 * K * 2; }
};
constexpr int L_MOE = pg8::STAGE_BYTES + (int)sizeof(MoeIdx) + 16;

struct EpiUp {
    static constexpr bool PERM = true;
    bf16_t* act;
    __device__ __forceinline__ void operator()(const f32x4 (&acc)[2][2][4][2], const MoeSrc::Unit& u, int wr, int wc, int fr, int fq) const {
        const int col0 = u.pn * 128 + wc * 32 + 8 * fq;
#pragma unroll
        for (int ai = 0; ai < 2; ++ai)
#pragma unroll
            for (int m = 0; m < 4; ++m) {
                const int r = ai * 128 + wr * 64 + m * 16 + fr;
                if (r < u.nrows) {
                    const f32x4 g0 = acc[ai][0][m][0], g1 = acc[ai][0][m][1], u0 = acc[ai][1][m][0], u1 = acc[ai][1][m][1];
                    *(uint4*)(act + (size_t)(u.row0 + r) * EFF + col0) = make_uint4(pack2(silu_f(g0[0]) * u0[0], silu_f(g0[1]) * u0[1]), pack2(silu_f(g0[2]) * u0[2], silu_f(g0[3]) * u0[3]),
                                                                                     pack2(silu_f(g1[0]) * u1[0], silu_f(g1[1]) * u1[1]), pack2(silu_f(g1[2]) * u1[2], silu_f(g1[3]) * u1[3]));
                }
            }
    }
};
__device__ __forceinline__ void ph_moe_up(const P& p, char* smem) {
    const int tid = tid_opaque();
    MoeIdx* mi = (MoeIdx*)(smem + pg8::STAGE_BYTES);
    moe_index(tid, p, mi);
    MoeSrc S; S.mi = mi; S.list = (const int*)(p.ws + WS_LIST); S.Ab = (const char*)(p.ws + WS_H2); S.Bt = (const char*)(p.ws + WS_W13); S.bstride = (size_t)1024 * ND * 2; S.K = ND; S.G = gridDim.x; S.c = blockIdx.x; S.gather = true;
    EpiUp E; E.act = (bf16_t*)(p.ws + WS_ACT);
    pg8::gemm_phase(tid, (PG8_LAS unsigned char*)smem, ND, S, E);
}

struct EpiDown {
    static constexpr bool PERM = true;
    bf16_t* yb;
    __device__ __forceinline__ void operator()(const f32x4 (&acc)[2][2][4][2], const MoeSrc::Unit& u, int wr, int wc, int fr, int fq) const {
        const int col0 = u.pn * 256 + wc * 32 + 8 * fq;
#pragma unroll
        for (int ai = 0; ai < 2; ++ai)
#pragma unroll
            for (int m = 0; m < 4; ++m) {
                const int r = ai * 128 + wr * 64 + m * 16 + fr;
                if (r < u.nrows) {
#pragma unroll
                    for (int bj = 0; bj < 2; ++bj) { const f32x4 v0 = acc[ai][bj][m][0], v1 = acc[ai][bj][m][1];
                        *(uint4*)(yb + (size_t)(u.row0 + r) * ND + col0 + bj * 128) = make_uint4(pack2(v0[0], v0[1]), pack2(v0[2], v0[3]), pack2(v1[0], v1[1]), pack2(v1[2], v1[3])); }
                }
            }
    }
};
__device__ __forceinline__ void ph_moe_down(const P& p, char* smem) {
    const int tid = tid_opaque();
    MoeIdx* mi = (MoeIdx*)(smem + pg8::STAGE_BYTES);
    moe_index(tid, p, mi);
    MoeSrc S; S.mi = mi; S.list = nullptr; S.Ab = (const char*)(p.ws + WS_ACT); S.Bt = (const char*)(p.ws + WS_W2); S.bstride = (size_t)ND * EFF * 2; S.K = EFF; S.G = gridDim.x; S.c = blockIdx.x; S.gather = false;
    EpiDown E; E.yb = (bf16_t*)(p.ws + WS_YBUF);
    pg8::gemm_phase(tid, (PG8_LAS unsigned char*)smem, EFF, S, E);
}

__device__ __forceinline__ void ph_combine(const P& p, char* smem) {
    const int tid = tid_opaque();
    MoeIdx* mi = (MoeIdx*)smem;
    float* sG = (float*)(mi + 1);
    moe_index(tid, p, mi);
    const int lane = tid & 63, wave = tid >> 6;
    const bf16_t* yb = (const bf16_t*)(p.ws + WS_YBUF); const int* tokinfo = (const int*)(p.ws + WS_TOKINFO);
    int curb = -1;
    for (int tile = blockIdx.x; tile < NTOK / 64; tile += gridDim.x) {
        const int b = tile / (NT / 64);
        if (b != curb) {
            __syncthreads();
            { const float* mf = (const float*)(p.ws + WS_MODF) + (size_t)b * (6 * ND) + 5 * ND; for (int d = tid; d < ND; d += NTHREADS) sG[d] = mf[d]; }
            __syncthreads();
            curb = b;
        }
        for (int i = 0; i < 8; ++i) {
            const int tok = tile * 64 + wave * 8 + i;
            const int* ti = tokinfo + (size_t)tok * 8;
            const int ra = mi->rowoff[ti[0]] + ti[1], rb = mi->rowoff[ti[2]] + ti[3];
            const float wa = __int_as_float(ti[4]), wb = __int_as_float(ti[5]);
#pragma unroll
            for (int j = 0; j < 4; ++j) {
                const int d = j * 256 + lane * 4;
                const uint2 ya = *(const uint2*)(yb + (size_t)ra * ND + d), ybv = *(const uint2*)(yb + (size_t)rb * ND + d);
                f32x4 xv = *(const f32x4*)(p.out + (size_t)tok * ND + d);
                xv[0] += sG[d] * (wa * __uint_as_float(ya.x << 16) + wb * __uint_as_float(ybv.x << 16));
                xv[1] += sG[d + 1] * (wa * __uint_as_float(ya.x & 0xffff0000u) + wb * __uint_as_float(ybv.x & 0xffff0000u));
                xv[2] += sG[d + 2] * (wa * __uint_as_float(ya.y << 16) + wb * __uint_as_float(ybv.y << 16));
                xv[3] += sG[d + 3] * (wa * __uint_as_float(ya.y & 0xffff0000u) + wb * __uint_as_float(ybv.y & 0xffff0000u));
                *(f32x4*)(p.out + (size_t)tok * ND + d) = xv;
            }
        }
    }
}

#define XB_TMO      128
#define XB_XCNT(j)  (256  + 64 * (j))
#define XB_XSUB(j)  (1280 + 64 * (j))
#define XB_XGEN(j)  (2304 + 64 * (j))
#define XB_TOP      3328
#define XB_TOPGEN   3392
#define XCD_BAR_WORDS 3456
#define XB_SPIN_CAP (1u << 20)
#define LAS __attribute__((address_space(3)))
__device__ __forceinline__ unsigned xb_ld(unsigned* p)              { return __hip_atomic_load(p, __ATOMIC_RELAXED, __HIP_MEMORY_SCOPE_AGENT); }
__device__ __forceinline__ unsigned xb_add(unsigned* p, unsigned v) { return __hip_atomic_fetch_add(p, v, __ATOMIC_RELAXED, __HIP_MEMORY_SCOPE_AGENT); }
__device__ __forceinline__ unsigned xb_xcc_id() { return (unsigned)__builtin_amdgcn_s_getreg((3 << 11) | 20) & 0xFu; }
#define XB_SPIN(cond, bar) do { unsigned _sp = 0; while (cond) { __builtin_amdgcn_s_sleep(1); \
    if ((++_sp & 255u) == 0u) { if (xb_ld(&(bar)[XB_TMO])) break; if (_sp > XB_SPIN_CAP) { atomicAdd(&(bar)[XB_TMO], 1u); break; } } } } while (0)
struct XcdBarrier { unsigned* bar; unsigned x; volatile LAS unsigned* st; };
__device__ __forceinline__ XcdBarrier xcd_barrier_post(unsigned* bar, volatile LAS unsigned* st) {
    XcdBarrier b; b.bar = bar; b.x = xb_xcc_id(); b.st = st;
    if (threadIdx.x == 0) (void)xb_add(&bar[XB_XCNT(b.x)], 1u);
    return b;
}
__device__ __forceinline__ void xcd_barrier_complete(unsigned* bar, unsigned x, unsigned& nloc, unsigned& nx) {
    const unsigned G = gridDim.x * gridDim.y * gridDim.z;
    unsigned sum, cnt, mine, sp = 0u;
    for (;;) {
        sum = 0u; cnt = 0u; mine = 0u;
#pragma unroll
        for (unsigned j = 0; j < 16; ++j) { const unsigned c = xb_ld(&bar[XB_XCNT(j)]); sum += c; cnt += (c > 0u) ? 1u : 0u; mine = (j == x) ? c : mine; }
        if (sum == G) break;
        __builtin_amdgcn_s_sleep(1);
        if ((++sp & 255u) == 0u) { if (xb_ld(&bar[XB_TMO])) break; if (sp > XB_SPIN_CAP) { atomicAdd(&bar[XB_TMO], 1u); break; } }
    }
    nloc = mine > 0u ? mine : 1u; nx = cnt > 0u ? cnt : 1u;
}
__device__ __forceinline__ void xcd_barrier(const XcdBarrier& b) {
    asm volatile("s_waitcnt vmcnt(0)" ::: "memory");
    __syncthreads();
    if (threadIdx.x == 0) {
        unsigned* bar = b.bar;
        __builtin_amdgcn_s_waitcnt(0);
        unsigned nloc = b.st[0], nx = b.st[1];
        if (nloc == 0u) { xcd_barrier_complete(bar, b.x, nloc, nx); b.st[0] = nloc; b.st[1] = nx; }
        const unsigned old = xb_add(&bar[XB_XSUB(b.x)], 1u);
        const unsigned gen = old / nloc;
        if (old + 1u == (gen + 1u) * nloc) {
            __builtin_amdgcn_fence(__ATOMIC_RELEASE, "agent");
            asm volatile("s_waitcnt vmcnt(0)" ::: "memory");
            const unsigned og = xb_add(&bar[XB_TOP], 1u);
            const unsigned tg = og / nx;
            if (og + 1u == (tg + 1u) * nx) xb_add(&bar[XB_TOPGEN], 1u);
            else XB_SPIN(xb_ld(&bar[XB_TOPGEN]) == tg, bar);
            __builtin_amdgcn_fence(__ATOMIC_ACQUIRE, "agent");
            xb_add(&bar[XB_XGEN(b.x)], 1u);
            asm volatile("s_waitcnt vmcnt(0)" ::: "memory");
        } else {
            XB_SPIN(xb_ld(&bar[XB_XGEN(b.x)]) == gen, bar);
            __builtin_amdgcn_fence(__ATOMIC_ACQUIRE, "agent");
            asm volatile("s_waitcnt vmcnt(0)" ::: "memory");
        }
    }
    __syncthreads();
}

namespace cg = cooperative_groups;
extern __shared__ __attribute__((aligned(16))) char dyn_smem[];
constexpr int cmax(int a, int b) { return a > b ? a : b; }
constexpr int L_G1 = pg8::STAGE_BYTES;
constexpr int MEGA_LDS = cmax(cmax(cmax(ROUTE_LDS, PREP_LDS), cmax(cmax(AT_BUF + SCAN_LDS, ATTM_LDS), L_G1)), L_MOE);
typedef const unsigned long long __attribute__((address_space(4)))* kargp_t;
__device__ __forceinline__ void load_params(P& p, kargp_t ka) {
    asm volatile("" : "+s"(ka));
    typedef __attribute__((address_space(1))) char* gptr_t;
    const void** d = (const void**)&p;
#pragma unroll
    for (int i = 0; i < (int)(sizeof(P) / 8); ++i) d[i] = (const void*)(gptr_t)ka[i];
}
#define PHASE(call) do { P p; load_params(p, ka); call; } while (0)
#ifndef PROBE_MODE
#define PROBE_MODE 0
#endif
#ifndef PROBE_K
#define PROBE_K -1
#endif
template <int KMAX>
__device__ __forceinline__ void run_phases(cg::grid_group& grid, const XcdBarrier& xb, kargp_t ka, char* smem) {
    if constexpr (KMAX >= 0) { PHASE(ph_mod_partial(p, smem)); PHASE(ph_convert(p, smem)); xcd_barrier(xb); }
    if constexpr (KMAX >= 1) { PHASE(ph_norm1(p, smem)); xcd_barrier(xb); }
    if constexpr (KMAX >= 2) { PHASE(ph_gemm1(p, smem)); xcd_barrier(xb); }
    if constexpr (KMAX >= 3) { PHASE(ph_post(p, smem)); xcd_barrier(xb); }
    if constexpr (KMAX >= 4) { PHASE(ph_dn_prep(p, smem)); xcd_barrier(xb); }
    if constexpr (KMAX >= 5) { PHASE(ph_attn_mfma<(KMAX == 5 ? PROBE_MODE : 0)>(p, smem)); xcd_barrier(xb); }
    if constexpr (KMAX >= 6) { PHASE(ph_dn_gate(p)); xcd_barrier(xb); }
    if constexpr (KMAX >= 7) { PHASE(ph_gemm_out(p, smem)); xcd_barrier(xb); }
    if constexpr (KMAX >= 8) { PHASE(ph_route(p, smem)); xcd_barrier(xb); }
    if constexpr (KMAX >= 9) { PHASE(ph_moe_up(p, smem)); xcd_barrier(xb); }
    if constexpr (KMAX >= 10) { PHASE(ph_moe_down(p, smem)); xcd_barrier(xb); }
    if constexpr (KMAX >= 11) { PHASE(ph_combine(p, smem)); }
}
__global__ void __launch_bounds__(NTHREADS) mega(P p_arg) {
    cg::grid_group grid = cg::this_grid();
    char* smem = dyn_smem;
    kargp_t ka = (kargp_t)__builtin_amdgcn_kernarg_segment_ptr();
    volatile LAS unsigned* xst = (volatile LAS unsigned*)(smem + MEGA_LDS);
    if (threadIdx.x < 4) xst[threadIdx.x] = 0u;
    __syncthreads();
    XcdBarrier xb;
    { P p; load_params(p, ka); xb = xcd_barrier_post((unsigned*)(p.ws + WS_BAR), xst);
      if (p.ws == nullptr) grid.sync(); }
    if constexpr (PROBE_K >= 0) {
        run_phases<PROBE_K>(grid, xb, ka, smem);
        if (PROBE_MODE == 20) { for (int i = 0; i < 20; ++i) xcd_barrier(xb); }
        P p; load_params(p, ka);
        if (blockIdx.x == 0 && threadIdx.x < 256) ((int*)(p.ws + WS_CTL))[threadIdx.x] = 0;
        xcd_barrier(xb);
    }
    run_phases<99>(grid, xb, ka, smem);
}

extern "C" void kernel_launch(void* const* d_in, const int* in_sizes, int n_in, void* d_out, int out_size, void* d_ws, size_t ws_size, hipStream_t stream) {
    if (n_in != 26 || out_size != NTOK * ND || ws_size < WS_END) { fprintf(stderr, "kernel_launch: unexpected shapes (n_in %d out %d ws %zu need %zu)\n", n_in, out_size, ws_size, (size_t)WS_END); return; }
    static int grid_blocks = 0;
    if (!grid_blocks) {
        int dev = 0, cus = 0, per_cu = 0;
        (void)hipGetDevice(&dev);
        (void)hipDeviceGetAttribute(&cus, hipDeviceAttributeMultiprocessorCount, dev);
        (void)hipFuncSetAttribute((const void*)mega, hipFuncAttributeMaxDynamicSharedMemorySize, MEGA_LDS + 16);
        (void)hipOccupancyMaxActiveBlocksPerMultiprocessor(&per_cu, (const void*)mega, NTHREADS, MEGA_LDS + 16);
        if (per_cu < 1) { fprintf(stderr, "kernel_launch: occupancy query says %d blocks/CU\n", per_cu); per_cu = 1; }
        grid_blocks = cus * per_cu;
    }
    P p{};
    const float** fp = (const float**)&p;
    for (int i = 0; i < 26; ++i) fp[i] = (const float*)d_in[i];
    p.pos = (const int*)d_in[2];
    p.out = (float*)d_out; p.ws = (unsigned char*)d_ws;
    (void)hipMemsetAsync((char*)d_ws + WS_CTL, 0, 32768, stream);
    void* args[] = {&p};
    hipError_t e = hipLaunchCooperativeKernel((const void*)mega, dim3(grid_blocks), dim3(NTHREADS), args, MEGA_LDS + 16, stream);
    if (e != hipSuccess) fprintf(stderr, "cooperative launch failed: %s (grid %d)\n", hipGetErrorString(e), grid_blocks);
}
```

```cpp
#include <hip/hip_runtime.h>
#include <hip/hip_cooperative_groups.h>
#include <cstdio>
#include <cstdint>

typedef unsigned short bf16_t;
typedef short bf16x8 __attribute__((ext_vector_type(8)));
typedef float f32x16 __attribute__((ext_vector_type(16)));
typedef float f32x4 __attribute__((ext_vector_type(4)));

constexpr int NB = 8, NT = 2048, ND = 1024, NTOK = NB * NT;
constexpr int NPROJ = 3072;
constexpr int PC_QATT = 0, PC_KVLAT = 512, PC_QIDX = 640, PC_DNQKV = 896, PC_DNZ = 2432, PC_KIDX = 2944, PC_WIDX = 2976, PC_BETA = 2984, PC_A = 2988;
constexpr int W_IN_SRC = 2992;
constexpr int NE = 32, EFF = 512;
constexpr int KSPLIT = 16;
constexpr int NTHREADS = 512, NWAVES = 8;
constexpr float EPS = 1e-6f;
constexpr float LOG2E = 1.4426950408889634f;

constexpr size_t MiB = 1ull << 20;
constexpr size_t WS_CTL = 0;
constexpr size_t WS_BAR = WS_CTL + 16 * 1024;
constexpr size_t WS_MODF = WS_CTL + 256 * 1024;
constexpr size_t WS_MODP = WS_CTL + 1 * MiB;
constexpr size_t WS_WIN = WS_MODP + 3 * MiB;
constexpr size_t WS_WOUT = WS_WIN + 6 * MiB;
constexpr size_t WS_W13 = WS_WOUT + 2 * MiB;
constexpr size_t WS_W2 = WS_W13 + 64 * MiB;
constexpr size_t WS_PROJ = WS_W2 + 32 * MiB;
constexpr size_t WS_ACT = WS_PROJ;
constexpr size_t WS_YBUF = WS_PROJ + 32 * MiB;
constexpr size_t WS_QN = WS_PROJ + 96 * MiB;
constexpr size_t WS_K = WS_QN + 16 * MiB;
constexpr size_t WS_KI = WS_K + 2 * MiB;
constexpr size_t WS_WI = WS_KI + 1 * MiB;
constexpr size_t WS_DBG = WS_WI + 512 * 1024;
constexpr size_t WS_DQ = WS_DBG + 512 * 1024;
constexpr size_t WS_DK = WS_DQ + 16 * MiB;
constexpr size_t WS_H2 = WS_DQ;
constexpr size_t WS_DKT = WS_DK + 16 * MiB;
constexpr size_t WS_DVT = WS_DKT + 16 * MiB;
constexpr size_t WS_END = WS_DVT + 16 * MiB;
constexpr size_t WS_LIST = WS_K;
constexpr size_t WS_TOKINFO = WS_KI;
constexpr size_t WS_VT = WS_WIN;
constexpr size_t WS_POSMM = WS_WIN + 2 * MiB;
constexpr size_t DO_WN = 0, DO_U = 16 * MiB, DO_DNO = 32 * MiB, DO_PP = 48 * MiB, DO_EG = 56 * MiB, DO_LL = DO_EG + 256 * 1024, DO_GC = DO_LL + 256 * 1024;

struct P {
    const float* x; const float* c; const int* pos; const float* ada_w; const float* ada_b; const float* norm1_g; const float* norm2_g;
    const float* w_in; const float* q_norm_g; const float* k_norm_g; const float* kv_norm_g; const float* w_kv_up; const float* idx_k_norm_g;
    const float* rel_bias; const float* conv_w; const float* a_log; const float* dt_bias; const float* dn_norm_g; const float* w_out;
    const float* rg_w; const float* rg_b; const float* re_w; const float* re_b; const float* w1; const float* w3; const float* w2;
    float* out; unsigned char* ws;
};

__device__ __forceinline__ float bf2f(bf16_t h) { return __uint_as_float(((unsigned)h) << 16); }
__device__ __forceinline__ bf16_t f2bf(float f) { unsigned u = __float_as_uint(f); u += 0x7fffu + ((u >> 16) & 1u); return (bf16_t)(u >> 16); }
__device__ __forceinline__ unsigned pack2(float a, float b) { unsigned r; asm volatile("v_cvt_pk_bf16_f32 %0, %1, %2" : "=v"(r) : "v"(a), "v"(b)); return r; }
template <int CTRL> __device__ __forceinline__ float dpp_f(float v) { return __int_as_float(__builtin_amdgcn_update_dpp(0, __float_as_int(v), CTRL, 0xF, 0xF, false)); }
template <int CTRL> __device__ __forceinline__ int dpp_i(int v) { return __builtin_amdgcn_update_dpp(0, v, CTRL, 0xF, 0xF, false); }
__device__ __forceinline__ float wave_sum(float v) {
    v += dpp_f<0xB1>(v); v += dpp_f<0x4E>(v); v += dpp_f<0x141>(v); v += dpp_f<0x140>(v);
    v += __int_as_float(__builtin_amdgcn_update_dpp(0, __float_as_int(v), 0x142, 0xA, 0xF, false));
    v += __int_as_float(__builtin_amdgcn_update_dpp(0, __float_as_int(v), 0x143, 0xC, 0xF, false));
    return __int_as_float(__builtin_amdgcn_readlane(__float_as_int(v), 63));
}
__device__ __forceinline__ float wave_max(float v) {
#pragma unroll
    for (int o = 32; o >= 1; o >>= 1) v = fmaxf(v, __shfl_xor(v, o));
    return v;
}
__device__ __forceinline__ int wave_isum(int v) {
#pragma unroll
    for (int o = 32; o >= 1; o >>= 1) v += __shfl_xor(v, o);
    return v;
}
__device__ __forceinline__ int tid_opaque() { int t = threadIdx.x; asm volatile("" : "+v"(t)); return t; }
__device__ __forceinline__ float relu_f(float x) { return __builtin_amdgcn_fmed3f(x, 0.f, __builtin_inff()); }
__device__ __forceinline__ float silu_f(float x) { return x / (1.f + __expf(-x)); }
__device__ __forceinline__ float sigmoid_f(float x) { return 1.f / (1.f + __expf(-x)); }
__device__ __forceinline__ float mod_val(const P& p, int b, int which, int d) {
    const float* mp = (const float*)(p.ws + WS_MODP);
    const int col = which * ND + d;
    float s = p.ada_b[col];
#pragma unroll
    for (int ks = 0; ks < KSPLIT; ++ks) s += mp[(size_t)(ks * NB + b) * (6 * ND) + col];
    return s;
}

__device__ __forceinline__ void ph_mod_partial(const P& p, char* smem) {
    const int tid = tid_opaque();
    const int lane = tid & 63, wave = tid >> 6;
    float* sc = (float*)smem;
    for (int i = tid; i < NB * ND; i += NTHREADS) sc[i] = silu_f(p.c[i]);
    __syncthreads();
    float* mp = (float*)(p.ws + WS_MODP);
    const int nitem = 96 * KSPLIT;
    for (int it = blockIdx.x * NWAVES + wave; it < nitem; it += gridDim.x * NWAVES) {
        const int cg = it % 96, ks = it / 96;
        const int col = cg * 64 + lane;
        float acc[NB];
#pragma unroll
        for (int b = 0; b < NB; ++b) acc[b] = 0.f;
#pragma unroll 32
        for (int kk = 0; kk < ND / KSPLIT; ++kk) {
            const int k = ks * (ND / KSPLIT) + kk;
            const float w = p.ada_w[(size_t)k * (6 * ND) + col];
#pragma unroll
            for (int b = 0; b < NB; ++b) acc[b] += sc[b * ND + k] * w;
        }
#pragma unroll
        for (int b = 0; b < NB; ++b) mp[(size_t)(ks * NB + b) * (6 * ND) + col] = acc[b];
    }
    __syncthreads();
}

__device__ __forceinline__ int win_src_col(int n) {
    if (n < 896) return n;
    if (n < 2944) return n + 40;
    if (n < 2976) return n - 2944 + 896;
    if (n < 2984) return n - 2976 + 928;
    if (n < 2992) return n;
    return -1;
}
__device__ __forceinline__ void conv_tile_wave(const int lane, float* tile, const float* src0, int nsrc, int mode, int n0, int k0, bf16_t* dst, int K, int sc0) {
    if (mode == 1) {
        const int col = win_src_col(n0 + lane);
#pragma unroll 8
        for (int k = 0; k < 64; ++k) tile[k * 65 + lane] = (col >= 0) ? src0[(size_t)(k0 + k) * nsrc + col] : 0.f;
    } else {
        const int kr = lane >> 4, c4 = lane & 15;
        const float* src = src0; const int col = sc0 + c4 * 4;
        f32x4 v[16];
#pragma unroll
        for (int i = 0; i < 16; ++i) v[i] = *(const f32x4*)(src + (size_t)(k0 + i * 4 + kr) * nsrc + col);
#pragma unroll
        for (int i = 0; i < 16; ++i) { float* t = tile + (i * 4 + kr) * 65 + c4 * 4; t[0] = v[i][0]; t[1] = v[i][1]; t[2] = v[i][2]; t[3] = v[i][3]; }
    }
    __threadfence_block();
    {
        const int kc = lane & 7, nr = lane >> 3;
#pragma unroll
        for (int i = 0; i < 8; ++i) {
            const int n = i * 8 + nr;
            unsigned w[4];
#pragma unroll
            for (int j = 0; j < 4; ++j) w[j] = pack2(tile[(kc * 8 + 2 * j) * 65 + n], tile[(kc * 8 + 2 * j + 1) * 65 + n]);
            *(uint4*)(dst + (size_t)(n0 + n) * K + k0 + kc * 8) = make_uint4(w[0], w[1], w[2], w[3]);
        }
    }
    __threadfence_block();
}
__device__ __forceinline__ void ph_convert(const P& p, char* smem) {
    const int tid = tid_opaque();
    const int lane = tid & 63, wave = tid >> 6;
    float* tile = (float*)smem + wave * (64 * 65);
    bf16_t* Wt_in = (bf16_t*)(p.ws + WS_WIN); bf16_t* Wt_out = (bf16_t*)(p.ws + WS_WOUT);
    bf16_t* Wt13 = (bf16_t*)(p.ws + WS_W13); bf16_t* Wt2 = (bf16_t*)(p.ws + WS_W2);
    const int T0 = 48 * 16, T1 = 16 * 16, T2 = NE * 256, T3 = NE * 128;
    const int total = T0 + T1 + T2 + T3;
    for (int t = blockIdx.x * NWAVES + wave; t < total; t += gridDim.x * NWAVES) {
        if (t < T0) { const int nt = t / 16, kt = t % 16; conv_tile_wave(lane, tile, p.w_in, W_IN_SRC, 1, nt * 64, kt * 64, Wt_in, ND, 0); }
        else if (t < T0 + T1) { const int u = t - T0; const int nt = u / 16, kt = u % 16; conv_tile_wave(lane, tile, p.w_out, ND, 0, nt * 64, kt * 64, Wt_out, ND, nt * 64); }
        else if (t < T0 + T1 + T2) { const int u = t - T0 - T1; const int e = u / 256, v = u % 256; const int kt = v / 16, j16 = v % 16;
            const int nt = ((j16 & 7) >> 1) * 4 + (j16 >> 3) * 2 + (j16 & 1);
            const int pn = nt >> 2, within = nt & 3;
            const float* srcw = ((within >= 2) ? p.w3 : p.w1) + (size_t)e * ND * EFF;
            conv_tile_wave(lane, tile, srcw, EFF, 0, nt * 64, kt * 64, Wt13 + (size_t)e * 1024 * ND, ND, pn * 128 + (within & 1) * 64); }
        else { const int u = t - T0 - T1 - T2; const int e = u / 128, v = u % 128; const int kt = v / 16, nt = v % 16;
            conv_tile_wave(lane, tile, p.w2 + (size_t)e * EFF * ND, ND, 0, nt * 64, kt * 64, Wt2 + (size_t)e * ND * EFF, EFF, nt * 64); }
    }
}

__device__ __forceinline__ void ph_norm1(const P& p, char* smem) {
    const int tid = tid_opaque();
    float* sA = (float*)smem; float* sB = sA + ND;
    const int lane = tid & 63, wave = tid >> 6;
    bf16_t* h = (bf16_t*)p.out;
    {
        float* mf = (float*)(p.ws + WS_MODF);
        for (int i = blockIdx.x * NTHREADS + tid; i < NB * 6 * ND; i += gridDim.x * NTHREADS) mf[i] = mod_val(p, i / (6 * ND), (i % (6 * ND)) / ND, i % ND);
    }
    int curb = -1;
    for (int tile = blockIdx.x; tile < NTOK / 64; tile += gridDim.x) {
        const int b = tile / (NT / 64);
        if (b != curb) {
            __syncthreads();
            for (int d = tid; d < ND; d += NTHREADS) { sA[d] = p.norm1_g[d] * (1.f + mod_val(p, b, 1, d)); sB[d] = mod_val(p, b, 0, d); }
            __syncthreads();
            curb = b;
        }
        for (int i4 = 0; i4 < 2; ++i4) {
            const int tokb = tile * 64 + wave * 8 + i4 * 4;
            f32x4 v[4][4];
#pragma unroll
            for (int q = 0; q < 4; ++q)
#pragma unroll
                for (int j = 0; j < 4; ++j) v[q][j] = *(const f32x4*)(p.x + (size_t)(tokb + q) * ND + j * 256 + lane * 4);
#pragma unroll
            for (int q = 0; q < 4; ++q) {
                float ss = 0.f;
#pragma unroll
                for (int j = 0; j < 4; ++j) ss += v[q][j][0] * v[q][j][0] + v[q][j][1] * v[q][j][1] + v[q][j][2] * v[q][j][2] + v[q][j][3] * v[q][j][3];
                ss = wave_sum(ss);
                const float rstd = rsqrtf(ss * (1.f / ND) + EPS);
#pragma unroll
                for (int j = 0; j < 4; ++j) {
                    const int d = j * 256 + lane * 4;
                    const float o0 = v[q][j][0] * rstd * sA[d] + sB[d], o1 = v[q][j][1] * rstd * sA[d + 1] + sB[d + 1], o2 = v[q][j][2] * rstd * sA[d + 2] + sB[d + 2], o3 = v[q][j][3] * rstd * sA[d + 3] + sB[d + 3];
                    *(uint2*)(h + (size_t)(tokb + q) * ND + d) = make_uint2(pack2(o0, o1), pack2(o2, o3));
                }
            }
        }
    }
}

namespace pg8 {
#define PG8_LAS __attribute__((address_space(3)))
typedef unsigned u32x4 __attribute__((ext_vector_type(4)));
constexpr int BM = 256, BK = 64, HALF = 128, HTB = HALF * BK * 2  , STAGE_BYTES = 8 * HTB;
__device__ __forceinline__ int lds_byte(int r, int c) { const int st = (r >> 4) * 2 + (c >> 5), rr = r & 15, cc = c & 31, ob = rr * 64 + cc * 2; return st * 1024 + (ob ^ (((ob >> 9) & 1) << 5)); }
__device__ __forceinline__ void stage_rc(int b, int& R, int& C) { const int st = b / 1024, sb = b % 1024, swz = sb ^ (((sb >> 9) & 1) << 5); R = (st >> 1) * 16 + swz / 64; C = (st & 1) * 32 + (swz % 64) / 2; }
__device__ __forceinline__ int perm32(int rho) { const int n = rho >> 4, i = rho & 15; return 8 * (i >> 2) + 4 * n + (i & 3); }
struct AO { unsigned h0p0, h0p1, h1p0, h1p1; };
template <class Src, class Epi>
__device__ __forceinline__ void gemm_phase(const int tid, PG8_LAS unsigned char* lds, const int K, const Src& S, const Epi& E) {
    const int wid = __builtin_amdgcn_readfirstlane(tid >> 6), lane = tid & 63, wr = wid >> 2, wc = wid & 3, fr = lane & 15, fq = lane >> 4;
    const int nt = K / BK;
    int R0, C0, R1, C1; stage_rc(tid * 16, R0, C0); stage_rc(tid * 16 + 8192, R1, C1);
    unsigned voffB[2];
    { const int Rb0 = Epi::PERM ? ((R0 & ~31) + perm32(R0 & 31)) : R0, Rb1 = Epi::PERM ? ((R1 & ~31) + perm32(R1 & 31)) : R1;
      voffB[0] = (unsigned)(Rb0 * K + C0) * 2u; voffB[1] = (unsigned)(Rb1 * K + C1) * 2u; }
    const size_t kstep = (size_t)(BK * 2);
    const size_t hstepB = (size_t)HALF * K * 2;
    const unsigned ldsw = (unsigned)wid * 1024u;
    const int aoff = lds_byte(wr * 64 + fr, fq * 8), boff = lds_byte(wc * 32 + fr, fq * 8);
#define PG8_SA(b, h) (((b) * 2 + (h)) * HTB)
#define PG8_SB(b, h) ((4 + (b) * 2 + (h)) * HTB)
#define PG8_STAGE2(bufoff, gbase, o0, o1) do { \
        __builtin_amdgcn_global_load_lds((const unsigned*)((const char*)(gbase) + (o0)), (PG8_LAS unsigned*)(lds + (bufoff) + ldsw), 16, 0, 0); \
        __builtin_amdgcn_global_load_lds((const unsigned*)((const char*)(gbase) + (o1)), (PG8_LAS unsigned*)(lds + (bufoff) + ldsw + 8192), 16, 0, 0); } while (0)
#define PG8_STAGEB(bufoff, gbase) PG8_STAGE2(bufoff, gbase, voffB[0], voffB[1])
#define PG8_STAGEA0(bufoff, gbase, AOV) PG8_STAGE2(bufoff, gbase, AOV.h0p0, AOV.h0p1)
#define PG8_STAGEA1(bufoff, gbase, AOV) PG8_STAGE2(bufoff, gbase, AOV.h1p0, AOV.h1p1)
#define PG8_LDA(dst, b, h) do { _Pragma("unroll") for (int m = 0; m < 4; ++m) _Pragma("unroll") for (int k = 0; k < 2; ++k) dst[m][k] = *(const PG8_LAS bf16x8*)(lds + PG8_SA(b, h) + aoff + m * 2048 + k * 1024); } while (0)
#define PG8_LDB(dst, b, h) do { _Pragma("unroll") for (int n = 0; n < 2; ++n) _Pragma("unroll") for (int k = 0; k < 2; ++k) dst[n][k] = *(const PG8_LAS bf16x8*)(lds + PG8_SB(b, h) + boff + n * 2048 + k * 1024); } while (0)
#define PG8_MMA(ai, bj, At, Bt) do { __builtin_amdgcn_s_setprio(1); _Pragma("unroll") for (int m = 0; m < 4; ++m) _Pragma("unroll") for (int n = 0; n < 2; ++n) _Pragma("unroll") for (int k = 0; k < 2; ++k) \
        acc[ai][bj][m][n] = __builtin_amdgcn_mfma_f32_16x16x32_bf16(Bt[n][k], At[m][k], acc[ai][bj][m][n], 0, 0, 0); __builtin_amdgcn_s_setprio(0); } while (0)
#define PG8_WAIT_V(n) asm volatile("s_waitcnt vmcnt(" #n ")" ::: "memory")
#define PG8_WAIT_L(n) asm volatile("s_waitcnt lgkmcnt(" #n ")" ::: "memory")
#define PG8_BAR __builtin_amdgcn_s_barrier()
#define PG8_SCHED __builtin_amdgcn_sched_barrier(0)
    typename Src::Unit cur, nxt; int ui = 0;
    if (!S.next(0, cur)) return;
    f32x4 acc[2][2][4][2];
#pragma unroll
    for (int a = 0; a < 2; ++a)
#pragma unroll
        for (int b = 0; b < 2; ++b)
#pragma unroll
            for (int m = 0; m < 4; ++m)
#pragma unroll
                for (int n = 0; n < 2; ++n) acc[a][b][m][n] = (f32x4){0.f, 0.f, 0.f, 0.f};
    bf16x8 At[4][2], B0[2][2], B1[2][2];
    AO aoC, aoN;
    S.a_off(cur, R0, C0, R1, C1, aoC);
    const char* cB = S.b_base(cur);
    PG8_STAGEB(PG8_SB(0, 0), cB); PG8_STAGEA0(PG8_SA(0, 0), S.a_base(cur, 0), aoC); PG8_STAGEB(PG8_SB(0, 1), cB + hstepB); PG8_STAGEA1(PG8_SA(0, 1), S.a_base(cur, 0), aoC);
    if (wr == 1) PG8_BAR;
    PG8_WAIT_V(4); PG8_BAR;
    PG8_STAGEB(PG8_SB(1, 0), cB + kstep); PG8_STAGEA0(PG8_SA(1, 0), S.a_base(cur, 1), aoC); PG8_STAGEB(PG8_SB(1, 1), cB + hstepB + kstep);
    PG8_WAIT_V(6); PG8_BAR;
    for (;;) {
        const bool has_next = S.next(ui + 1, nxt);
        const char* nB = cB;
        if (has_next) { S.a_off(nxt, R0, C0, R1, C1, aoN); nB = S.b_base(nxt); }
        else aoN = aoC;
        for (int t = 0; t < nt; t += 2) {
            const bool last = (t == nt - 2);
            const char* a1 = S.a_base(cur, t + 1);
            const char* a2 = last ? S.a_base(has_next ? nxt : cur, 0) : S.a_base(cur, t + 2);
            const char* a3 = last ? S.a_base(has_next ? nxt : cur, 1) : S.a_base(cur, t + 3);
            const char* b2 = last ? nB : cB + (size_t)(t + 2) * kstep; const char* b3 = b2 + kstep;
            const AO ao2 = last ? aoN : aoC;
            PG8_LDB(B0, 0, 0); PG8_SCHED; PG8_LDA(At, 0, 0); PG8_STAGEA1(PG8_SA(1, 1), a1, aoC);
            PG8_WAIT_L(8); PG8_BAR; PG8_WAIT_L(0); PG8_MMA(0, 0, At, B0); PG8_BAR; PG8_SCHED;
            PG8_LDB(B1, 0, 1); PG8_STAGEB(PG8_SB(0, 0), b2);
            PG8_BAR; PG8_WAIT_L(0); PG8_MMA(0, 1, At, B1); PG8_BAR;
            PG8_LDA(At, 0, 1); PG8_STAGEA0(PG8_SA(0, 0), a2, ao2);
            PG8_BAR; PG8_WAIT_L(0); PG8_MMA(1, 0, At, B0); PG8_BAR; PG8_SCHED;
            PG8_STAGEB(PG8_SB(0, 1), b2 + hstepB);
            PG8_WAIT_V(6); PG8_BAR; PG8_MMA(1, 1, At, B1); PG8_BAR;
            PG8_LDB(B0, 1, 0); PG8_SCHED; PG8_LDA(At, 1, 0); PG8_STAGEA1(PG8_SA(0, 1), a2, ao2);
            PG8_WAIT_L(8); PG8_BAR; PG8_WAIT_L(0); PG8_MMA(0, 0, At, B0); PG8_BAR; PG8_SCHED;
            PG8_LDB(B1, 1, 1); PG8_STAGEB(PG8_SB(1, 0), b3);
            PG8_BAR; PG8_WAIT_L(0); PG8_MMA(0, 1, At, B1); PG8_BAR;
            PG8_LDA(At, 1, 1); PG8_STAGEA0(PG8_SA(1, 0), a3, ao2);
            PG8_BAR; PG8_WAIT_L(0); PG8_MMA(1, 0, At, B0); PG8_BAR; PG8_SCHED;
            PG8_STAGEB(PG8_SB(1, 1), b3 + hstepB);
            PG8_WAIT_V(6); PG8_BAR; PG8_MMA(1, 1, At, B1); PG8_BAR;
        }
        E(acc, cur, wr, wc, fr, fq);
        if (!has_next) break;
#pragma unroll
        for (int a = 0; a < 2; ++a)
#pragma unroll
            for (int b = 0; b < 2; ++b)
#pragma unroll
                for (int m = 0; m < 4; ++m)
#pragma unroll
                    for (int n = 0; n < 2; ++n) acc[a][b][m][n] = (f32x4){0.f, 0.f, 0.f, 0.f};
        cur = nxt; cB = nB; ++ui; aoC = aoN;
    }
    PG8_WAIT_V(0);
    if (wr == 0) PG8_BAR;
    PG8_BAR;
#undef PG8_SA
#undef PG8_SB
#undef PG8_STAGE2
#undef PG8_STAGEB
#undef PG8_STAGEA0
#undef PG8_STAGEA1
#undef PG8_LDA
#undef PG8_LDB
#undef PG8_MMA
#undef PG8_WAIT_V
#undef PG8_WAIT_L
#undef PG8_BAR
#undef PG8_SCHED
}
struct DenseSrc {
    struct Unit { int pm, pn; };
    const char* A0; const char* A1; const char* Bt; int lda, K, nM, nN, G, c, ksplit;
    __device__ __forceinline__ bool next(int i, Unit& u) const {
        const int nwg = nM * nN; const long L = (long)i * G + c; if (L >= nwg) return false;
        int wgid = (int)L; { const int q = nwg / 8, r = nwg % 8, xcd = wgid % 8, off = wgid / 8; wgid = (xcd < r ? xcd * (q + 1) : r * (q + 1) + (xcd - r) * q) + off; }
        const int nig = 8 * nN, gid = wgid / nig, fm = gid * 8, gsz = (nM - fm) < 8 ? (nM - fm) : 8;
        u.pm = fm + ((wgid % nig) % gsz); u.pn = (wgid % nig) / gsz; return true;
    }
    __device__ __forceinline__ void a_off(const Unit& u, int R0, int C0, int R1, int C1, AO& ao) const {
        ao.h0p0 = (unsigned)(((u.pm * 256 + R0) * lda + C0) * 2); ao.h0p1 = (unsigned)(((u.pm * 256 + R1) * lda + C1) * 2);
        ao.h1p0 = (unsigned)(((u.pm * 256 + 128 + R0) * lda + C0) * 2); ao.h1p1 = (unsigned)(((u.pm * 256 + 128 + R1) * lda + C1) * 2);
    }
    __device__ __forceinline__ const char* a_base(const Unit&, int kt) const { return (kt < ksplit) ? A0 + (size_t)kt * 128 : A1 + (size_t)(kt - ksplit) * 128; }
    __device__ __forceinline__ const char* b_base(const Unit& u) const { return Bt + (size_t)u.pn * 256 * K * 2; }
};
}

struct EpiProj {
    static constexpr bool PERM = true;
    bf16_t* O; int ldc;
    __device__ __forceinline__ void operator()(const f32x4 (&acc)[2][2][4][2], const pg8::DenseSrc::Unit& u, int wr, int wc, int fr, int fq) const {
        const int row0 = u.pm * 256 + wr * 64 + fr, col0 = u.pn * 256 + wc * 32 + 8 * fq;
#pragma unroll
        for (int ai = 0; ai < 2; ++ai)
#pragma unroll
            for (int m = 0; m < 4; ++m) { bf16_t* rowp = O + (size_t)(row0 + ai * 128 + m * 16) * ldc + col0;
#pragma unroll
                for (int bj = 0; bj < 2; ++bj) { const f32x4 v0 = acc[ai][bj][m][0], v1 = acc[ai][bj][m][1];
                    *(uint4*)(rowp + bj * 128) = make_uint4(pack2(v0[0], v0[1]), pack2(v0[2], v0[3]), pack2(v1[0], v1[1]), pack2(v1[2], v1[3])); } }
    }
};
__device__ __forceinline__ void ph_gemm1(const P& p, char* smem) {
    const int tid = tid_opaque();
    pg8::DenseSrc S; S.A0 = (const char*)p.out; S.A1 = S.A0; S.Bt = (const char*)(p.ws + WS_WIN); S.lda = ND; S.K = ND; S.nM = NTOK / 256; S.nN = NPROJ / 256; S.G = gridDim.x; S.c = blockIdx.x; S.ksplit = ND / 64;
    EpiProj E; E.O = (bf16_t*)(p.ws + WS_PROJ); E.ldc = NPROJ;
    pg8::gemm_phase(tid, (PG8_LAS unsigned char*)smem, ND, S, E);
}

__device__ __forceinline__ void ph_post(const P& p, char* smem) {
    const int tid = tid_opaque();
    float* sW = (float*)smem;
    {
        f32x4 t[8];
#pragma unroll
        for (int i = 0; i < 8; ++i) t[i] = *(const f32x4*)(p.w_kv_up + (size_t)(tid + i * NTHREADS) * 4);
#pragma unroll
        for (int i = 0; i < 8; ++i) *(f32x4*)(sW + (size_t)(tid + i * NTHREADS) * 4) = t[i];
    }
    __syncthreads();
    const int lane = tid & 63, wave = tid >> 6;
    float* skv = (float*)(smem + 128 * 128 * 4) + wave * 128;
    const bf16_t* proj = (const bf16_t*)(p.ws + WS_PROJ);
    bf16_t* qn = (bf16_t*)(p.ws + WS_QN); bf16_t* Kb = (bf16_t*)(p.ws + WS_K); bf16_t* kib = (bf16_t*)(p.ws + WS_KI);
    float* wi = (float*)(p.ws + WS_WI); float* dbeta = (float*)(p.ws + WS_DBG); float* dg = dbeta + NTOK * 4;
    bf16_t* dq = (bf16_t*)(p.ws + WS_DQ); bf16_t* dk = (bf16_t*)(p.ws + WS_DK); bf16_t* dkT = (bf16_t*)(p.ws + WS_DKT); bf16_t* dvT = (bf16_t*)(p.ws + WS_DVT);
    bf16_t* Vt = (bf16_t*)(p.ws + WS_VT);
    {
        const int g = blockIdx.x * NTHREADS + tid;
        if (g < NB * 64) { int mn = 0x7fffffff, mx = -0x7fffffff; for (int i = 0; i < 32; ++i) { const int v = p.pos[g * 32 + i]; mn = min(mn, v); mx = max(mx, v); } int* pm = (int*)(p.ws + WS_POSMM); pm[g * 2] = mn; pm[g * 2 + 1] = mx; }
    }
    for (int tg = blockIdx.x * NWAVES + wave; tg < NTOK / 8; tg += gridDim.x * NWAVES) {
        const int tok0 = tg * 8, t0 = tok0 % NT, bb = tok0 / NT;
        uint4 rq[8]; unsigned rkv[8]; unsigned rms[8];
#pragma unroll
        for (int ti = 0; ti < 8; ++ti) {
            const bf16_t* pr = proj + (size_t)(tok0 + ti) * NPROJ;
            rq[ti] = *(const uint4*)(pr + PC_QATT + lane * 8);
            rkv[ti] = *(const unsigned*)(pr + PC_KVLAT + lane * 2);
            rms[ti] = (lane < 48) ? (unsigned)pr[PC_KIDX + lane] : 0u;
        }
        float vall[8];
#pragma unroll
        for (int ti = 0; ti < 8; ++ti) {
            const int tok = tok0 + ti;
            {
                const unsigned w[4] = {rq[ti].x, rq[ti].y, rq[ti].z, rq[ti].w};
                float v[8]; float ss = 0.f;
#pragma unroll
                for (int j = 0; j < 4; ++j) { v[2 * j] = __uint_as_float(w[j] << 16); v[2 * j + 1] = __uint_as_float(w[j] & 0xffff0000u); }
#pragma unroll
                for (int j = 0; j < 8; ++j) ss += v[j] * v[j];
                ss += dpp_f<0xB1>(ss); ss += dpp_f<0x4E>(ss); ss += dpp_f<0x141>(ss);
                const float rs = rsqrtf(ss * (1.f / 64.f) + EPS) * (0.125f * LOG2E);
                const int d0 = (lane & 7) * 8;
                unsigned o[4];
#pragma unroll
                for (int j = 0; j < 4; ++j) o[j] = pack2(v[2 * j] * rs * p.q_norm_g[d0 + 2 * j], v[2 * j + 1] * rs * p.q_norm_g[d0 + 2 * j + 1]);
                *(uint4*)(qn + (size_t)tok * 512 + lane * 8) = make_uint4(o[0], o[1], o[2], o[3]);
            }
            {
                float a0 = __uint_as_float(rkv[ti] << 16), a1 = __uint_as_float(rkv[ti] & 0xffff0000u);
                float ss = wave_sum(a0 * a0 + a1 * a1);
                const float rs = rsqrtf(ss * (1.f / 128.f) + EPS);
                a0 *= rs * p.kv_norm_g[lane * 2]; a1 *= rs * p.kv_norm_g[lane * 2 + 1];
                *(float2*)(skv + lane * 2) = make_float2(a0, a1);
                __threadfence_block();
                float k = 0.f, v = 0.f, k2 = 0.f, v2 = 0.f;
#pragma unroll 4
                for (int i4 = 0; i4 < 32; ++i4) {
                    const f32x4 x = *(const f32x4*)(skv + 4 * i4);
                    const float* w = sW + (4 * i4) * 128 + lane;
                    k += x[0] * w[0] + x[2] * w[256]; k2 += x[1] * w[128] + x[3] * w[384];
                    v += x[0] * w[64] + x[2] * w[320]; v2 += x[1] * w[192] + x[3] * w[448];
                }
                k += k2; v += v2;
                __threadfence_block();
                const float ks = wave_sum(k * k);
                k *= rsqrtf(ks * (1.f / 64.f) + EPS) * p.k_norm_g[lane];
                Kb[(size_t)tok * 64 + lane] = f2bf(k);
                vall[ti] = v;
            }
            {
                const float raw = bf2f((bf16_t)rms[ti]);
                float a = (lane < 32) ? raw : 0.f;
                const float ss = wave_sum(a * a);
                a *= rsqrtf(ss * (1.f / 32.f) + EPS);
                if (lane < 32) kib[(size_t)tok * 32 + lane] = f2bf(a * p.idx_k_norm_g[lane]);
                else if (lane < 40) wi[(size_t)tok * 8 + lane - 32] = raw * 0.35355339059327373f * 0.17677669529663687f;
                else if (lane < 44) dbeta[(size_t)tok * 4 + lane - 40] = sigmoid_f(raw);
                else if (lane < 48) {
                    const float z = raw + p.dt_bias[lane - 44];
                    const float sp = (z > 20.f) ? z : log1pf(__expf(z));
                    dg[(size_t)tok * 4 + lane - 44] = -__expf(p.a_log[lane - 44]) * sp;
                }
            }
        }
        *(uint4*)(Vt + ((size_t)bb * 64 + lane) * NT + t0) = make_uint4(pack2(vall[0], vall[1]), pack2(vall[2], vall[3]), pack2(vall[4], vall[5]), pack2(vall[6], vall[7]));
#pragma unroll 1
        for (int jg = 0; jg < 4; ++jg) {
            unsigned raw[3][11];
#pragma unroll
            for (int jj = 0; jj < 3; ++jj)
#pragma unroll
                for (int i = 0; i < 11; ++i) {
                    raw[jj][i] = 0u;
                    if (t0 - 3 + i >= 0) raw[jj][i] = *(const unsigned*)(proj + (size_t)(tok0 - 3 + i) * NPROJ + PC_DNQKV + (jg * 3 + jj) * 128 + lane * 2);
                }
#pragma unroll
            for (int jj = 0; jj < 3; ++jj) {
                const int j = jg * 3 + jj;
                const int ch = j * 128 + lane * 2;
                float c0[4], c1[4];
#pragma unroll
                for (int tap = 0; tap < 4; ++tap) { c0[tap] = p.conv_w[tap * 1536 + ch]; c1[tap] = p.conv_w[tap * 1536 + ch + 1]; }
                float y0[8], y1[8];
#pragma unroll
                for (int i = 0; i < 8; ++i) {
                    float a0 = 0.f, a1 = 0.f;
#pragma unroll
                    for (int tap = 0; tap < 4; ++tap) { a0 += c0[tap] * __uint_as_float(raw[jj][i + tap] << 16); a1 += c1[tap] * __uint_as_float(raw[jj][i + tap] & 0xffff0000u); }
                    y0[i] = silu_f(a0); y1[i] = silu_f(a1);
                    if (j < 8) {
                        const float ss = wave_sum(y0[i] * y0[i] + y1[i] * y1[i]);
                        float rs = rsqrtf(ss + EPS);
                        if (j < 4) rs *= 0.08838834764831845f;
                        y0[i] *= rs; y1[i] *= rs;
                    }
                }
                if (j < 8) {
                    bf16_t* dst = (j < 4) ? dq : dk;
#pragma unroll
                    for (int i = 0; i < 8; ++i) *(unsigned*)(dst + (size_t)(tok0 + i) * 512 + (j & 3) * 128 + lane * 2) = pack2(y0[i], y1[i]);
                }
                if (j >= 4) {
                    bf16_t* dstT = ((j < 8) ? dkT : dvT) + ((size_t)(bb * 4 + (j & 3)) * 128 + lane * 2) * NT + t0;
                    *(uint4*)dstT = make_uint4(pack2(y0[0], y0[1]), pack2(y0[2], y0[3]), pack2(y0[4], y0[5]), pack2(y0[6], y0[7]));
                    *(uint4*)(dstT + NT) = make_uint4(pack2(y1[0], y1[1]), pack2(y1[2], y1[3]), pack2(y1[4], y1[5]), pack2(y1[6], y1[7]));
                }
            }
        }
    }
}

__device__ __forceinline__ unsigned f2sortable(float f) { const unsigned u = __float_as_uint(f); return (u & 0x80000000u) ? ~u : (u | 0x80000000u); }
__device__ __forceinline__ float sum8_f(float v) { v += dpp_f<0xB1>(v); v += dpp_f<0x4E>(v); v += dpp_f<0x141>(v); return v; }
__device__ __forceinline__ int sum16_i(int v) { v += dpp_i<0xB1>(v); v += dpp_i<0x4E>(v); v += dpp_i<0x141>(v); v += __shfl_xor(v, 32); return v; }
__device__ __forceinline__ int pi32(int r) { return (r & 0x13) | ((r & 4) << 1) | ((r & 8) >> 1); }
__device__ __forceinline__ constexpr int key_of_reg(int r) { return (r & 3) + 4 * ((r >> 2) & 1) + 16 * (r >> 3); }
struct KiFrag { bf16x8 a0, a1; };
__device__ __forceinline__ float xhalf_sum(float v) { auto rr = __builtin_amdgcn_permlane32_swap(__float_as_uint(v), __float_as_uint(v), false, false); return __uint_as_float(rr[0]) + __uint_as_float(rr[1]); }
__device__ __forceinline__ void idx_scores4(float (&sc)[4], const KiFrag& f, bf16x8 qi0, bf16x8 qi1, const float* wvp) {
    f32x4 wq[4];
#pragma unroll
    for (int q = 0; q < 4; ++q) wq[q] = *(const f32x4*)(wvp + 4 * q);
    f32x16 z;
#pragma unroll
    for (int r = 0; r < 16; ++r) z[r] = 0.f;
    z = __builtin_amdgcn_mfma_f32_32x32x16_bf16(qi0, f.a0, z, 0, 0, 0);
    z = __builtin_amdgcn_mfma_f32_32x32x16_bf16(qi1, f.a1, z, 0, 0, 0);
#pragma unroll
    for (int q = 0; q < 4; ++q) {
        float a = wq[q][0] * relu_f(z[4 * q]);
        a += wq[q][1] * relu_f(z[4 * q + 1]);
        a += wq[q][2] * relu_f(z[4 * q + 2]);
        a += wq[q][3] * relu_f(z[4 * q + 3]);
        sc[q] = xhalf_sum(a);
    }
}
constexpr int AT_SBL = 0, AT_POSMAX = 4352, AT_ITEM = 6400, AT_WV = 6656, AT_BUF = 7680;
constexpr int AT_KI_ROW = 80, AT_P1_BUF = 256 * AT_KI_ROW;
constexpr int AT2_K = 0, AT2_VT = 128 * 144, AT2_KI = AT2_VT + 64 * 272, AT2_PK = AT2_KI + 128 * AT_KI_ROW, AT2_BUF = AT2_PK + 512;
constexpr int ATTM_LDS = AT_BUF + 2 * (AT_P1_BUF > AT2_BUF ? AT_P1_BUF : AT2_BUF);
__device__ __forceinline__ KiFrag ki_lds(const char* buf, int row, int hf) {
    KiFrag f; const char* r = buf + row * AT_KI_ROW + 16 * hf;
    f.a0 = *(const bf16x8*)r; f.a1 = *(const bf16x8*)(r + 32); return f;
}
struct SelQ { float tau[4]; int cut[4]; };
struct IdxOps { bf16x8 qi0, qi1; const float* wvp; };
__device__ __forceinline__ IdxOps idx_ops(const P& p, char* smem, int b, int t0, int lane) {
    const int hf = lane >> 5, cq = (lane & 31) >> 3, ch = lane & 7;
    const int tok = b * NT + t0 + cq;
    const bf16_t* proj = (const bf16_t*)(p.ws + WS_PROJ);
    IdxOps o;
    o.qi0 = *(const bf16x8*)(proj + (size_t)tok * NPROJ + PC_QIDX + ch * 32 + 8 * hf);
    o.qi1 = *(const bf16x8*)(proj + (size_t)tok * NPROJ + PC_QIDX + ch * 32 + 16 + 8 * hf);
    float* wslot = (float*)(smem + AT_WV) + (lane >> 6) * 0;
    const float* wi = (const float*)(p.ws + WS_WI) + (size_t)(b * NT + t0) * 8;
    if ((lane & 31) < 16) { const int r = lane & 15; wslot[hf * 16 + r] = wi[(r >> 2) * 8 + 4 * hf + (r & 3)]; }
    __threadfence_block();
    o.wvp = wslot + hf * 16;
    return o;
}
__device__ __forceinline__ void attn_pass1(const P& p, char* smem, int b, int tb, int tid, SelQ& sel) {
    const int lane = tid & 63, wave = tid >> 6;
    const int hf = lane >> 5, l31 = lane & 31;
    const int t0 = tb * 32 + wave * 4;
    const bf16_t* ki_b = (const bf16_t*)(p.ws + WS_KI) + (size_t)b * NT * 32;
    const IdxOps io = idx_ops(p, smem + wave * 128, b, t0, lane);
    char* bufs = smem + AT_BUF;
    unsigned u[32][4];
#pragma unroll
    for (int s = 0; s < 32; ++s)
#pragma unroll
        for (int q = 0; q < 4; ++q) u[s][q] = 0x007fffffu;
    {
#pragma unroll
        for (int i = 0; i < 2; ++i) { const int x = tid + 512 * i; *(uint4*)(bufs + (x >> 2) * AT_KI_ROW + (x & 3) * 16) = *(const uint4*)(ki_b + (size_t)(x >> 2) * 32 + (x & 3) * 8); }
    }
    __syncthreads();
#pragma unroll
    for (int g = 0; g < 8; ++g) {
        if (g * 8 <= tb) {
            const bool more = (g + 1) * 8 <= tb;
            uint4 n0 = make_uint4(0, 0, 0, 0), n1 = n0;
            if (more) {
                n0 = *(const uint4*)(ki_b + (size_t)((g + 1) * 256 + (tid >> 2)) * 32 + (tid & 3) * 8);
                n1 = *(const uint4*)(ki_b + (size_t)((g + 1) * 256 + 128 + (tid >> 2)) * 32 + (tid & 3) * 8);
            }
            const char* buf = bufs + (g & 1) * AT_P1_BUF;
#pragma unroll
            for (int kk = 0; kk < 8; ++kk) {
                const int kt = g * 8 + kk;
                if (kt <= tb) {
                    const KiFrag f = ki_lds(buf, kk * 32 + l31, hf);
                    float sc[4];
                    idx_scores4(sc, f, io.qi0, io.qi1, io.wvp);
                    if (kt == tb) {
#pragma unroll
                        for (int q = 0; q < 4; ++q) sc[q] = (kt * 32 + l31 <= t0 + q) ? sc[q] : -INFINITY;
                    }
#pragma unroll
                    for (int q = 0; q < 4; ++q) u[kt >> 1][q] = (hf == (kt & 1)) ? f2sortable(sc[q]) : u[kt >> 1][q];
                    __builtin_amdgcn_sched_barrier(0);
                }
            }
            if (more) {
                char* nb = bufs + ((g + 1) & 1) * AT_P1_BUF;
                *(uint4*)(nb + (tid >> 2) * AT_KI_ROW + (tid & 3) * 16) = n0;
                *(uint4*)(nb + (128 + (tid >> 2)) * AT_KI_ROW + (tid & 3) * 16) = n1;
            }
            __syncthreads();
        }
    }
    unsigned prefix[4] = {0u, 0u, 0u, 0u}; bool exact[4] = {false, false, false, false};
    for (int bit = 31; bit >= 0; --bit) {
        unsigned cand[4];
#pragma unroll
        for (int q = 0; q < 4; ++q) cand[q] = prefix[q] | (1u << bit);
        int c0 = 0, c1 = 0, c2 = 0, c3 = 0;
#pragma unroll
        for (int g8 = 0; g8 < 4; ++g8) {
            if (g8 * 16 <= tb) {
#pragma unroll
                for (int s = g8 * 8; s < g8 * 8 + 8; ++s)
                    asm volatile("v_cmp_ge_u32_e64 s[70:71], %4, %8\n\tv_cmp_ge_u32_e64 s[72:73], %5, %9\n\tv_cmp_ge_u32_e64 s[74:75], %6, %10\n\tv_cmp_ge_u32_e64 s[76:77], %7, %11\n\t"
                                 "v_addc_co_u32_e64 %0, s[70:71], 0, %0, s[70:71]\n\tv_addc_co_u32_e64 %1, s[72:73], 0, %1, s[72:73]\n\tv_addc_co_u32_e64 %2, s[74:75], 0, %2, s[74:75]\n\tv_addc_co_u32_e64 %3, s[76:77], 0, %3, s[76:77]"
                                 : "+v"(c0), "+v"(c1), "+v"(c2), "+v"(c3)
                                 : "v"(u[s][0]), "v"(u[s][1]), "v"(u[s][2]), "v"(u[s][3]), "s"(cand[0]), "s"(cand[1]), "s"(cand[2]), "s"(cand[3])
                                 : "s70", "s71", "s72", "s73", "s74", "s75", "s76", "s77");
            }
        }
        int cnt[4] = {c0, c1, c2, c3};
#pragma unroll
        for (int q = 0; q < 4; ++q) { int v = cnt[q]; v += dpp_i<0xB1>(v); v += dpp_i<0x4E>(v); v += dpp_i<0x141>(v); v += dpp_i<0x140>(v);
            v += __builtin_amdgcn_update_dpp(0, v, 0x142, 0xA, 0xF, false); v += __builtin_amdgcn_update_dpp(0, v, 0x143, 0xC, 0xF, false); cnt[q] = __builtin_amdgcn_readlane(v, 63); }
#pragma unroll
        for (int q = 0; q < 4; ++q) {
            const int cq_ = cnt[q];
            if (!exact[q] && cq_ >= 256) { prefix[q] = cand[q]; if (cq_ == 256) exact[q] = true; }
        }
        if (exact[0] && exact[1] && exact[2] && exact[3]) break;
    }
#pragma unroll
    for (int q = 0; q < 4; ++q) {
        int cutq = 0x7fffffff;
        if (!exact[q]) {
            const unsigned pf = prefix[q];
            int ngt = 0, neq = 0;
#pragma unroll
            for (int s = 0; s < 32; ++s)
                { ngt += __builtin_popcountll(__ballot(u[s][q] > pf)); neq += __builtin_popcountll(__ballot(u[s][q] == pf)); }
            const int need = 256 - ngt;
            if (need < neq) {
                int lo = 0, hi = NT - 1;
                for (int it = 0; it < 11; ++it) {
                    const int mid = (lo + hi) >> 1;
                    int cnt = 0;
#pragma unroll
                    for (int s = 0; s < 32; ++s)
                        cnt += __builtin_popcountll(__ballot(u[s][q] == pf && ((2 * s + hf) * 32 + l31) <= mid));
                    if (cnt >= need) hi = mid; else lo = mid + 1;
                }
                cutq = lo;
            }
        }
        sel.tau[q] = __uint_as_float((prefix[q] & 0x80000000u) ? (prefix[q] & 0x7fffffffu) : ~prefix[q]);
        sel.cut[q] = cutq;
    }
}
__device__ __forceinline__ float xhalf_max(float v) { auto rr = __builtin_amdgcn_permlane32_swap(__float_as_uint(v), __float_as_uint(v), false, false); return fmaxf(__uint_as_float(rr[0]), __uint_as_float(rr[1])); }
__device__ __forceinline__ void attn_pass2(const P& p, char* smem, int b, int tb, int tid, const SelQ& sel) {
    const int lane = tid & 63, wave = tid >> 6;
    const int hf = lane >> 5, l31 = lane & 31, cq = l31 >> 3, ch = lane & 7, prow = pi32(l31);
    const int t0 = tb * 32 + wave * 4, tq = t0 + cq, tok = b * NT + tq;
    const bf16_t* proj = (const bf16_t*)(p.ws + WS_PROJ);
    bf16_t* qn = (bf16_t*)(p.ws + WS_QN);
    const bf16_t* ki_b = (const bf16_t*)(p.ws + WS_KI) + (size_t)b * NT * 32;
    const bf16_t* K_b = (const bf16_t*)(p.ws + WS_K) + (size_t)b * NT * 64;
    const bf16_t* Vt_b = (const bf16_t*)(p.ws + WS_VT) + (size_t)b * 64 * NT;
    const float* sbl = (const float*)(smem + AT_SBL); const int* posmax = (const int*)(smem + AT_POSMAX) + b * 64;
    char* bufs = smem + AT_BUF;
    const IdxOps io = idx_ops(p, smem + wave * 128, b, t0, lane);
    bf16x8 qb[4];
#pragma unroll
    for (int ks = 0; ks < 4; ++ks) qb[ks] = *(const bf16x8*)(qn + (size_t)tok * 512 + ch * 64 + ks * 16 + 8 * hf);
    const int pq = p.pos[tok];
    int pqmin = pq;
    pqmin = min(pqmin, __shfl_xor(pqmin, 8)); pqmin = min(pqmin, __shfl_xor(pqmin, 16));
    pqmin = __builtin_amdgcn_readfirstlane(pqmin);
    const float bias_far = sbl[128 * 8 + ch];
    const bool anycut = (sel.cut[0] & sel.cut[1] & sel.cut[2] & sel.cut[3]) != 0x7fffffff;
    f32x16 o0, o1;
#pragma unroll
    for (int r = 0; r < 16; ++r) { o0[r] = 0.f; o1[r] = 0.f; }
    float m = -1.0e30f, l = 0.f;
    bf16x8 selB;
    { union { uint4 u; bf16x8 f; } cv; const unsigned one = 0x3F80u;
      cv.u = make_uint4((hf == 0 && cq == 0) ? one : ((hf == 0 && cq == 1) ? (one << 16) : 0u), (hf == 0 && cq == 2) ? one : ((hf == 0 && cq == 3) ? (one << 16) : 0u), 0u, 0u); selB = cv.f; }
    const int nt128 = (tb + 4) >> 2;
    uint4 rk0, rk1, rv0, rv1, rki; int rpos = 0;
#define AT_LOAD(j) { const int kb_ = (j) * 128; \
        rk0 = *(const uint4*)(K_b + (size_t)(kb_ + (tid >> 3)) * 64 + (tid & 7) * 8); rk1 = *(const uint4*)(K_b + (size_t)(kb_ + 64 + (tid >> 3)) * 64 + (tid & 7) * 8); \
        rv0 = *(const uint4*)(Vt_b + (size_t)(tid >> 4) * NT + kb_ + (tid & 15) * 8); rv1 = *(const uint4*)(Vt_b + (size_t)(32 + (tid >> 4)) * NT + kb_ + (tid & 15) * 8); \
        rki = *(const uint4*)(ki_b + (size_t)(kb_ + (tid >> 2)) * 32 + (tid & 3) * 8); \
        if (tid < 128) rpos = p.pos[b * NT + kb_ + tid]; }
#define AT_STORE(bp) { char* sb_ = (bp); \
        *(uint4*)(sb_ + AT2_K + (tid >> 3) * 144 + (tid & 7) * 16) = rk0; *(uint4*)(sb_ + AT2_K + (64 + (tid >> 3)) * 144 + (tid & 7) * 16) = rk1; \
        *(uint4*)(sb_ + AT2_VT + (tid >> 4) * 272 + (tid & 15) * 16) = rv0; *(uint4*)(sb_ + AT2_VT + (32 + (tid >> 4)) * 272 + (tid & 15) * 16) = rv1; \
        *(uint4*)(sb_ + AT2_KI + (tid >> 2) * AT_KI_ROW + (tid & 3) * 16) = rki; \
        if (tid < 128) ((int*)(sb_ + AT2_PK))[tid] = rpos; }
    AT_LOAD(0) AT_STORE(bufs)
    __syncthreads();
#pragma unroll 1
    for (int j = 0; j < nt128; ++j) {
        if (j + 1 < nt128) AT_LOAD(j + 1)
        const char* buf = bufs + (j & 1) * AT2_BUF;
#pragma unroll
        for (int st = 0; st < 2; ++st) {
            const int kt0 = 4 * j + 2 * st;
            if (kt0 <= tb) {
                const bool have1 = (kt0 + 1 <= tb);
                const int krow = st * 64;
                f32x16 s0, s1;
                float sc0[4], sc1[4];
                idx_scores4(sc0, ki_lds(buf + AT2_KI, krow + prow, hf), io.qi0, io.qi1, io.wvp);
                const bool far0 = (pqmin - posmax[kt0] >= 128);
                const int key0 = kt0 * 32 + prow, key1 = key0 + 32;
                const bool diag = (kt0 + 1 >= tb);
                bf16x8 am0, am1;
                {
                    unsigned a01 = 0u, a23 = 0u, b01 = 0u, b23 = 0u;
#pragma unroll
                    for (int q = 0; q < 4; ++q) {
                        bool ok0 = anycut ? ((sc0[q] > sel.tau[q]) || (sc0[q] == sel.tau[q] && key0 <= sel.cut[q])) : (sc0[q] >= sel.tau[q]);
                        if (diag) ok0 = ok0 && (key0 <= t0 + q);
                        const unsigned v0 = ok0 ? 0u : 0xC6EAu;
                        if (q == 0) a01 |= v0; else if (q == 1) a01 |= v0 << 16; else if (q == 2) a23 |= v0; else a23 |= v0 << 16;
                    }
                    if (hf) { a01 = 0u; a23 = 0u; }
                    union { uint4 u; bf16x8 f; } cv; cv.u = make_uint4(a01, a23, 0u, 0u); am0 = cv.f;
                    (void)b01; (void)b23;
                }
#pragma unroll
                for (int r = 0; r < 16; ++r) s0[r] = far0 ? bias_far : 0.f;
                s0 = __builtin_amdgcn_mfma_f32_32x32x16_bf16(am0, selB, s0, 0, 0, 0);
                {
                    const char* kr = buf + AT2_K + (krow + prow) * 144 + 16 * hf;
#pragma unroll
                    for (int ks = 0; ks < 4; ++ks) s0 = __builtin_amdgcn_mfma_f32_32x32x16_bf16(*(const bf16x8*)(kr + ks * 32), qb[ks], s0, 0, 0, 0);
                }
                bool far1 = true;
                if (have1) {
                    idx_scores4(sc1, ki_lds(buf + AT2_KI, krow + 32 + prow, hf), io.qi0, io.qi1, io.wvp);
                    far1 = (pqmin - posmax[kt0 + 1] >= 128);
                    unsigned a01 = 0u, a23 = 0u;
#pragma unroll
                    for (int q = 0; q < 4; ++q) {
                        bool ok1 = anycut ? ((sc1[q] > sel.tau[q]) || (sc1[q] == sel.tau[q] && key1 <= sel.cut[q])) : (sc1[q] >= sel.tau[q]);
                        if (diag) ok1 = ok1 && (key1 <= t0 + q);
                        const unsigned v1 = ok1 ? 0u : 0xC6EAu;
                        if (q == 0) a01 |= v1; else if (q == 1) a01 |= v1 << 16; else if (q == 2) a23 |= v1; else a23 |= v1 << 16;
                    }
                    if (hf) { a01 = 0u; a23 = 0u; }
                    union { uint4 u; bf16x8 f; } cv; cv.u = make_uint4(a01, a23, 0u, 0u); am1 = cv.f;
#pragma unroll
                    for (int r = 0; r < 16; ++r) s1[r] = far1 ? bias_far : 0.f;
                    s1 = __builtin_amdgcn_mfma_f32_32x32x16_bf16(am1, selB, s1, 0, 0, 0);
                    const char* kr = buf + AT2_K + (krow + 32 + prow) * 144 + 16 * hf;
#pragma unroll
                    for (int ks = 0; ks < 4; ++ks) s1 = __builtin_amdgcn_mfma_f32_32x32x16_bf16(*(const bf16x8*)(kr + ks * 32), qb[ks], s1, 0, 0, 0);
                } else {
#pragma unroll
                    for (int r = 0; r < 16; ++r) s1[r] = -60000.f;
                }
                if (!far0) {
                    const int* pk = (const int*)(buf + AT2_PK) + krow + 8 * hf;
#pragma unroll
                    for (int r = 0; r < 16; ++r) { int n = pq - pk[key_of_reg(r)]; n = n < 0 ? 0 : (n > 128 ? 128 : n); s0[r] += sbl[n * 8 + ch]; }
                }
                if (!far1) {
                    const int* pk = (const int*)(buf + AT2_PK) + krow + 32 + 8 * hf;
#pragma unroll
                    for (int r = 0; r < 16; ++r) { int n = pq - pk[key_of_reg(r)]; n = n < 0 ? 0 : (n > 128 ? 128 : n); s1[r] += sbl[n * 8 + ch]; }
                }
                float mx = fmaxf(s0[0], s1[0]);
#pragma unroll
                for (int r = 1; r < 16; ++r) mx = fmaxf(mx, fmaxf(s0[r], s1[r]));
                mx = xhalf_max(mx);
                if (!__all(mx - m <= 8.f)) {
                    const float mnew = fmaxf(m, mx);
                    const float alpha = __builtin_amdgcn_exp2f(m - mnew);
                    m = mnew; l *= alpha;
#pragma unroll
                    for (int r = 0; r < 16; ++r) { o0[r] *= alpha; o1[r] *= alpha; }
                }
                const float mref = m;
                float ps = 0.f;
#pragma unroll
                for (int r = 0; r < 16; ++r) { s0[r] = __builtin_amdgcn_exp2f(s0[r] - mref); s1[r] = __builtin_amdgcn_exp2f(s1[r] - mref); ps += s0[r] + s1[r]; }
                l += ps;
                union { uint4 u; bf16x8 f; } pb0, pb1, pb2, pb3;
                pb0.u = make_uint4(pack2(s0[0], s0[1]), pack2(s0[2], s0[3]), pack2(s0[4], s0[5]), pack2(s0[6], s0[7]));
                pb1.u = make_uint4(pack2(s0[8], s0[9]), pack2(s0[10], s0[11]), pack2(s0[12], s0[13]), pack2(s0[14], s0[15]));
                pb2.u = make_uint4(pack2(s1[0], s1[1]), pack2(s1[2], s1[3]), pack2(s1[4], s1[5]), pack2(s1[6], s1[7]));
                pb3.u = make_uint4(pack2(s1[8], s1[9]), pack2(s1[10], s1[11]), pack2(s1[12], s1[13]), pack2(s1[14], s1[15]));
                const char* vr = buf + AT2_VT + l31 * 272 + st * 128 + 16 * hf;
                o0 = __builtin_amdgcn_mfma_f32_32x32x16_bf16(*(const bf16x8*)vr, pb0.f, o0, 0, 0, 0);
                o1 = __builtin_amdgcn_mfma_f32_32x32x16_bf16(*(const bf16x8*)(vr + 32 * 272), pb0.f, o1, 0, 0, 0);
                o0 = __builtin_amdgcn_mfma_f32_32x32x16_bf16(*(const bf16x8*)(vr + 32), pb1.f, o0, 0, 0, 0);
                o1 = __builtin_amdgcn_mfma_f32_32x32x16_bf16(*(const bf16x8*)(vr + 32 * 272 + 32), pb1.f, o1, 0, 0, 0);
                o0 = __builtin_amdgcn_mfma_f32_32x32x16_bf16(*(const bf16x8*)(vr + 64), pb2.f, o0, 0, 0, 0);
                o1 = __builtin_amdgcn_mfma_f32_32x32x16_bf16(*(const bf16x8*)(vr + 32 * 272 + 64), pb2.f, o1, 0, 0, 0);
                o0 = __builtin_amdgcn_mfma_f32_32x32x16_bf16(*(const bf16x8*)(vr + 96), pb3.f, o0, 0, 0, 0);
                o1 = __builtin_amdgcn_mfma_f32_32x32x16_bf16(*(const bf16x8*)(vr + 32 * 272 + 96), pb3.f, o1, 0, 0, 0);
            }
        }
        if (j + 1 < nt128) AT_STORE(bufs + ((j + 1) & 1) * AT2_BUF)
        __syncthreads();
    }
#undef AT_LOAD
#undef AT_STORE
    l += __shfl_xor(l, 32);
    const float inv = 1.f / l;
    bf16_t* orow = qn + (size_t)tok * 512 + ch * 64;
#pragma unroll
    for (int gq = 0; gq < 4; ++gq) {
        *(uint2*)(orow + gq * 8 + 4 * hf) = make_uint2(pack2(o0[gq * 4] * inv, o0[gq * 4 + 1] * inv), pack2(o0[gq * 4 + 2] * inv, o0[gq * 4 + 3] * inv));
        *(uint2*)(orow + 32 + gq * 8 + 4 * hf) = make_uint2(pack2(o1[gq * 4] * inv, o1[gq * 4 + 1] * inv), pack2(o1[gq * 4 + 2] * inv, o1[gq * 4 + 3] * inv));
    }
}
__device__ __forceinline__ void dn_scan_block(const P& p, char* smem, int bh, int tid);
template <int MODE>
__device__ __forceinline__ void ph_attn_mfma(const P& p, char* smem) {
    const int tid = tid_opaque();
    float* sbl = (float*)(smem + AT_SBL);
    for (int i = tid; i < 129 * 8; i += NTHREADS) {
        const int n = i >> 3, h = i & 7; int bk;
        if (n < 16) bk = n;
        else { const float v = logf((float)n / 16.f) / 2.0794415416798357f * 16.f; bk = 16 + (int)v; if (bk > 31) bk = 31; }
        sbl[i] = p.rel_bias[bk * 8 + h] * LOG2E;
    }
    ((int*)(smem + AT_POSMAX))[tid] = ((const int*)(p.ws + WS_POSMM))[tid * 2 + 1];
    __syncthreads();
    if (MODE != 2 && blockIdx.x < NB * 4) {
        int tid0 = tid; asm volatile("" : "+v"(tid0));
        dn_scan_block(p, smem + AT_BUF, blockIdx.x, tid0);
        __syncthreads();
    }
    int* qctr = (int*)(p.ws + WS_CTL) + 64;
    if (MODE != 1) for (;;) {
        int tid1 = tid; asm volatile("" : "+v"(tid1));
        if (tid1 == 0) *(int*)(smem + AT_ITEM) = atomicAdd(qctr, 1);
        __syncthreads();
        const int item = *(const int*)(smem + AT_ITEM);
        if (item >= NB * 64) break;
        const int b = item & 7, tb = 63 - (item >> 3);
        SelQ sel;
#pragma unroll
        for (int q = 0; q < 4; ++q) { sel.tau[q] = -INFINITY; sel.cut[q] = 0x7fffffff; }
        if (tb >= 8) attn_pass1(p, smem, b, tb, tid1, sel);
        int tid2 = tid; asm volatile("" : "+v"(tid2));
        attn_pass2(p, smem, b, tb, tid2, sel);
    }
}

__device__ __forceinline__ constexpr int sig16(int x) { return (x & ~12) | ((x & 4) << 1) | ((x & 8) >> 1); }
constexpr int PREP_WAVE_LDS = 2 * 64 * 72 * 2 + 4 * 64 * 4;
constexpr int PREP_LDS = NWAVES * PREP_WAVE_LDS;
__device__ __forceinline__ void ph_dn_prep(const P& p, char* smem) {
    const int tid = tid_opaque();
    const int wave = tid >> 6;
    char* wl = smem + wave * PREP_WAVE_LDS;
    float* sA = (float*)wl;
    bf16_t* sTw = (bf16_t*)wl; bf16_t* sTu = sTw + 64 * 72;
    float* sG = (float*)(wl + 2 * 64 * 72 * 2); float* sB = sG + 64; float* sE = sB + 64; float* sL = sE + 64;
    const bf16_t* dq = (const bf16_t*)(p.ws + WS_DQ); const bf16_t* dk = (const bf16_t*)(p.ws + WS_DK);
    const bf16_t* dkT = (const bf16_t*)(p.ws + WS_DKT); const bf16_t* dvT = (const bf16_t*)(p.ws + WS_DVT);
    const float* dbeta = (const float*)(p.ws + WS_DBG); const float* dg = dbeta + NTOK * 4;
    unsigned char* dob = (unsigned char*)p.out;
    bf16_t* PPg = (bf16_t*)(dob + DO_PP); float* GCg = (float*)(dob + DO_GC); float* EGg = (float*)(dob + DO_EG); float* LLg = (float*)(dob + DO_LL);
    for (int item = blockIdx.x * NWAVES + wave; item < NB * 4 * 32; item += gridDim.x * NWAVES) {
        int lane = tid & 63; asm volatile("" : "+v"(lane));
        const int hf = lane >> 5, l31 = lane & 31;
        const int bh = item >> 5, c = item & 31, b = bh >> 2, hh = bh & 3;
        const int tok0 = b * NT + c * 64;
        bf16_t* WN = (bf16_t*)(dob + DO_WN) + (size_t)item * 64 * 128; bf16_t* Ug = (bf16_t*)(dob + DO_U) + (size_t)item * 64 * 128;
        bf16_t* PP = PPg + (size_t)item * 64 * 64;
        float G, beta, eG;
        {
            const float g = dg[(size_t)(tok0 + lane) * 4 + hh];
            beta = dbeta[(size_t)(tok0 + lane) * 4 + hh];
            G = g;
#pragma unroll
            for (int o = 1; o < 64; o <<= 1) { const float n = __shfl_up(G, o); if (lane >= o) G += n; }
            const float Gl = __shfl(G, 63);
            eG = __expf(G);
            sG[lane] = G; sB[lane] = beta; sE[lane] = eG; sL[lane] = __expf(Gl - G);
            EGg[item * 64 + lane] = eG; LLg[item * 64 + lane] = __expf(Gl - G);
            if (lane == 0) GCg[item] = __expf(Gl);
        }
        f32x16 kk00, kk10, kk11, qk00, qk10, qk11;
#pragma unroll
        for (int r = 0; r < 16; ++r) { kk00[r] = 0.f; kk10[r] = 0.f; kk11[r] = 0.f; qk00[r] = 0.f; qk10[r] = 0.f; qk11[r] = 0.f; }
        {
            const bf16_t* kr0 = dk + (size_t)(tok0 + l31) * 512 + hh * 128 + 8 * hf; const bf16_t* kr1 = kr0 + 32 * 512;
            const bf16_t* qr0 = dq + (size_t)(tok0 + l31) * 512 + hh * 128 + 8 * hf; const bf16_t* qr1 = qr0 + 32 * 512;
#pragma unroll
            for (int s = 0; s < 8; ++s) {
                const bf16x8 k0 = *(const bf16x8*)(kr0 + s * 16), k1 = *(const bf16x8*)(kr1 + s * 16), q0 = *(const bf16x8*)(qr0 + s * 16), q1 = *(const bf16x8*)(qr1 + s * 16);
                kk00 = __builtin_amdgcn_mfma_f32_32x32x16_bf16(k0, k0, kk00, 0, 0, 0);
                kk10 = __builtin_amdgcn_mfma_f32_32x32x16_bf16(k1, k0, kk10, 0, 0, 0);
                kk11 = __builtin_amdgcn_mfma_f32_32x32x16_bf16(k1, k1, kk11, 0, 0, 0);
                qk00 = __builtin_amdgcn_mfma_f32_32x32x16_bf16(q0, k0, qk00, 0, 0, 0);
                qk10 = __builtin_amdgcn_mfma_f32_32x32x16_bf16(q1, k0, qk10, 0, 0, 0);
                qk11 = __builtin_amdgcn_mfma_f32_32x32x16_bf16(q1, k1, qk11, 0, 0, 0);
            }
        }
        __threadfence_block();
        {
            const float Gc0 = sG[l31], Gc1 = sG[32 + l31];
            float* sA0 = sA + (4 * hf) * 64 + l31;
            bf16_t* PP0 = PP + (4 * hf) * 64 + sig16(l31);
            const float* sGr = sG + 4 * hf; const float* sBr = sB + 4 * hf;
            const int jrel = l31 - 4 * hf;
#pragma unroll
            for (int r = 0; r < 16; ++r) {
                const int ro = (r & 3) + 8 * (r >> 2);
                const float Gi0 = sGr[ro], Gi1 = sGr[32 + ro], Bi0 = sBr[ro], Bi1 = sBr[32 + ro];
                {
                    const float dec = (jrel <= ro) ? __expf(Gi0 - Gc0) : 0.f;
                    sA0[ro * 64] = (jrel < ro) ? Bi0 * kk00[r] * dec : 0.f;
                    PP0[ro * 64] = f2bf(qk00[r] * dec);
                    PP0[ro * 64 + 32] = 0;
                }
                {
                    const float dec = __expf(Gi1 - Gc0);
                    sA0[(32 + ro) * 64] = Bi1 * kk10[r] * dec;
                    PP0[(32 + ro) * 64] = f2bf(qk10[r] * dec);
                }
                {
                    const float dec = (jrel <= ro) ? __expf(Gi1 - Gc1) : 0.f;
                    sA0[(32 + ro) * 64 + 32] = (jrel < ro) ? Bi1 * kk11[r] * dec : 0.f;
                    PP0[(32 + ro) * 64 + 32] = f2bf(qk11[r] * dec);
                }
            }
        }
        __threadfence_block();
        float x[64];
#pragma unroll
        for (int i = 0; i < 64; ++i) x[i] = (i == lane) ? 1.f : 0.f;
#pragma unroll
        for (int i = 1; i < 64; ++i) {
            float acc = x[i];
#pragma unroll
            for (int m4 = 0; m4 < i; m4 += 4) {
                const f32x4 a = *(const f32x4*)(sA + i * 64 + m4);
                acc -= a[0] * x[m4];
                if (m4 + 1 < i) acc -= a[1] * x[m4 + 1];
                if (m4 + 2 < i) acc -= a[2] * x[m4 + 2];
                if (m4 + 3 < i) acc -= a[3] * x[m4 + 3];
            }
            x[i] = acc;
            __builtin_amdgcn_sched_barrier(0);
        }
        __threadfence_block();
        {
            const float sw = beta * eG;
#pragma unroll
            for (int i = 0; i < 64; ++i) { sTw[i * 72 + lane] = f2bf(x[i] * sw); sTu[i * 72 + lane] = f2bf(x[i] * beta); }
        }
        __threadfence_block();
        {
            bf16x8 tw[2][4], tu[2][4];
#pragma unroll
            for (int mt = 0; mt < 2; ++mt)
#pragma unroll
                for (int s = 0; s < 4; ++s) { tw[mt][s] = *(const bf16x8*)(sTw + (mt * 32 + l31) * 72 + s * 16 + 8 * hf); tu[mt][s] = *(const bf16x8*)(sTu + (mt * 32 + l31) * 72 + s * 16 + 8 * hf); }
            const bf16_t* kTb = dkT + ((size_t)bh * 128 + l31) * NT + c * 64 + 8 * hf;
            const bf16_t* vTb = dvT + ((size_t)bh * 128 + l31) * NT + c * 64 + 8 * hf;
#pragma unroll 1
            for (int nt = 0; nt < 4; ++nt) {
                f32x16 w0, w1, u0, u1;
#pragma unroll
                for (int r = 0; r < 16; ++r) { w0[r] = 0.f; w1[r] = 0.f; u0[r] = 0.f; u1[r] = 0.f; }
#pragma unroll
                for (int s = 0; s < 4; ++s) {
                    const bf16x8 kb = *(const bf16x8*)(kTb + (size_t)nt * 32 * NT + s * 16), vb = *(const bf16x8*)(vTb + (size_t)nt * 32 * NT + s * 16);
                    w0 = __builtin_amdgcn_mfma_f32_32x32x16_bf16(tw[0][s], kb, w0, 0, 0, 0);
                    w1 = __builtin_amdgcn_mfma_f32_32x32x16_bf16(tw[1][s], kb, w1, 0, 0, 0);
                    u0 = __builtin_amdgcn_mfma_f32_32x32x16_bf16(tu[0][s], vb, u0, 0, 0, 0);
                    u1 = __builtin_amdgcn_mfma_f32_32x32x16_bf16(tu[1][s], vb, u1, 0, 0, 0);
                }
                bf16_t* WN0 = WN + (4 * hf) * 128 + nt * 32 + sig16(l31); bf16_t* U0 = Ug + (4 * hf) * 128 + nt * 32 + l31;
#pragma unroll
                for (int r = 0; r < 16; ++r) {
                    const int ro = (r & 3) + 8 * (r >> 2);
                    WN0[ro * 128] = f2bf(-w0[r]); WN0[(32 + ro) * 128] = f2bf(-w1[r]);
                    U0[ro * 128] = f2bf(u0[r]); U0[(32 + ro) * 128] = f2bf(u1[r]);
                }
            }
        }
        __threadfence_block();
    }
}

__device__ __forceinline__ bf16x8 pack_frag(const f32x16& t, int s) {
    bf16x8 f;
#pragma unroll
    for (int j = 0; j < 8; ++j) f[j] = (short)f2bf(t[8 * s + j]);
    return f;
}
__device__ __forceinline__ bf16x8 pack_frag_scaled(const f32x16& t, int s, const f32x4& sc0, const f32x4& sc1) {
    bf16x8 f;
#pragma unroll
    for (int j = 0; j < 4; ++j) { f[j] = (short)f2bf(t[8 * s + j] * sc0[j]); f[4 + j] = (short)f2bf(t[8 * s + 4 + j] * sc1[j]); }
    return f;
}
__device__ __forceinline__ bf16x8 load_perm_frag(const bf16_t* ptr) {
    const uint2 lo = *(const uint2*)ptr, hi = *(const uint2*)(ptr + 8);
    union { uint4 u; bf16x8 f; } cv; cv.u = make_uint4(lo.x, lo.y, hi.x, hi.y); return cv.f;
}
constexpr int SC_WN = 0, SC_Q = 16384, SC_KT = 32768, SC_PP = SC_KT + 128 * 144, SC_U = SC_PP + 64 * 144, SC_EG = SC_U + 16384, SC_LL = SC_EG + 256, SC_GC = SC_LL + 256, SC_BYTES = SC_GC + 16;
constexpr int SCAN_LDS = 2 * SC_BYTES;
#define SCAN_DECL uint4 wn0, wn1, wn2, wn3, q0, q1, q2, q3, kt0, kt1, kt2, kt3, pp0, pp1, u0, u1, u2, u3; float egv = 0.f, gcv = 0.f;
#define SCAN_LD4(i, WNR, UR, QR, KTR) { const int x = hl + 256 * (i); WNR = WNp[x]; UR = Up[x]; \
        QR = *(const uint4*)(dqb + (size_t)(x >> 4) * 512 + (x & 15) * 8); \
        KTR = *(const uint4*)(ktb + (size_t)(x >> 3) * NT + (x & 7) * 8); }
#define SCAN_LOAD(c) { const int ci = bh * 32 + (c); \
        const uint4* WNp = (const uint4*)(dob + DO_WN + (size_t)ci * 16384); const uint4* Up = (const uint4*)(dob + DO_U + (size_t)ci * 16384); const uint4* PPp = (const uint4*)(dob + DO_PP + (size_t)ci * 8192); \
        const bf16_t* dqb = dqh + (size_t)(c) * 64 * 512; const bf16_t* ktb = dkTh + (c) * 64; \
        SCAN_LD4(0, wn0, u0, q0, kt0) SCAN_LD4(1, wn1, u1, q1, kt1) SCAN_LD4(2, wn2, u2, q2, kt2) SCAN_LD4(3, wn3, u3, q3, kt3) \
        pp0 = PPp[hl]; pp1 = PPp[hl + 256]; \
        if (hl < 64) egv = ((const float*)(dob + DO_EG))[ci * 64 + hl]; else if (hl < 128) egv = ((const float*)(dob + DO_LL))[ci * 64 + hl - 64]; \
        if (hl == 128) gcv = ((const float*)(dob + DO_GC))[ci]; }
#define SCAN_ST4(i, WNR, UR, QR, KTR) { const int x = hl + 256 * (i); \
        { const int r = x >> 4, cc = x & 15; *(uint4*)(sbuf + SC_WN + r * 256 + ((cc ^ (r & 15)) << 4)) = WNR; } \
        *(uint4*)(sbuf + SC_U + x * 16) = UR; \
        { const int r = x >> 4, cc = x & 15, a = cc >> 1, g = cc & 1; char* row = sbuf + SC_Q + r * 256; \
          *(uint2*)(row + (((2 * a) ^ (r & 15)) << 4) + g * 8) = make_uint2(QR.x, QR.y); \
          *(uint2*)(row + (((2 * a + 1) ^ (r & 15)) << 4) + g * 8) = make_uint2(QR.z, QR.w); } \
        { const int d = x >> 3, cc = x & 7, a = cc >> 1, g = cc & 1; char* row = sbuf + SC_KT + d * 144; \
          *(uint2*)(row + (2 * a) * 16 + g * 8) = make_uint2(KTR.x, KTR.y); \
          *(uint2*)(row + (2 * a + 1) * 16 + g * 8) = make_uint2(KTR.z, KTR.w); } }
#define SCAN_STORE(bufptr) { char* sbuf = (bufptr); \
        SCAN_ST4(0, wn0, u0, q0, kt0) SCAN_ST4(1, wn1, u1, q1, kt1) SCAN_ST4(2, wn2, u2, q2, kt2) SCAN_ST4(3, wn3, u3, q3, kt3) \
        *(uint4*)(sbuf + SC_PP + (hl >> 3) * 144 + (hl & 7) * 16) = pp0; \
        *(uint4*)(sbuf + SC_PP + ((hl + 256) >> 3) * 144 + (hl & 7) * 16) = pp1; \
        if (hl < 128) ((float*)(sbuf + SC_EG))[hl] = egv; \
        if (hl == 128) *(float*)(sbuf + SC_GC) = gcv; }
__device__ __forceinline__ void dn_scan_block(const P& p, char* smem, int bh, int tid) {
    const int wave = tid >> 6, lane = tid & 63;
    const int hf = lane >> 5, l31 = lane & 31;
    const int b = bh >> 2, hh = bh & 3;
    const bool helper = wave >= 4;
    const int hl = tid - 256, sl = wave;
    bf16_t* dno = (bf16_t*)((unsigned char*)p.out + DO_DNO);
    if (helper) {
        const unsigned char* dob = (const unsigned char*)p.out;
        const bf16_t* dqh = (const bf16_t*)(p.ws + WS_DQ) + (size_t)b * NT * 512 + hh * 128; const bf16_t* dkTh = (const bf16_t*)(p.ws + WS_DKT) + (size_t)bh * 128 * NT;
        SCAN_DECL
        const bf16_t* dnoh = (const bf16_t*)(dob + DO_DNO) + (size_t)b * NT * 512 + hh * 128 + (hl & 3) * 32;
        const bf16_t* zh = (const bf16_t*)(p.ws + WS_PROJ) + (size_t)b * NT * NPROJ + PC_DNZ + hh * 128 + (hl & 3) * 32;
        bf16_t* dnnh = (bf16_t*)(p.ws + WS_DK) + (size_t)b * NT * 512 + hh * 128 + (hl & 3) * 32;
        const float* gnh = p.dn_norm_g + (hl & 3) * 32;
#define SCAN_GATE(c) { const int trow = (c) * 64 + (hl >> 2); \
            const uint4* op_ = (const uint4*)(dnoh + (size_t)trow * 512); const uint4* zp_ = (const uint4*)(zh + (size_t)trow * NPROJ); uint4* dp_ = (uint4*)(dnnh + (size_t)trow * 512); \
            uint4 ov_[4], zv_[4]; _Pragma("unroll") for (int i_ = 0; i_ < 4; ++i_) { ov_[i_] = op_[i_]; zv_[i_] = zp_[i_]; } \
            float ss_ = 0.f; _Pragma("unroll") for (int i_ = 0; i_ < 4; ++i_) { const unsigned w_[4] = {ov_[i_].x, ov_[i_].y, ov_[i_].z, ov_[i_].w}; \
                _Pragma("unroll") for (int j_ = 0; j_ < 4; ++j_) { const float a_ = __uint_as_float(w_[j_] << 16), b_ = __uint_as_float(w_[j_] & 0xffff0000u); ss_ += a_ * a_ + b_ * b_; } } \
            ss_ += dpp_f<0xB1>(ss_); ss_ += dpp_f<0x4E>(ss_); \
            const float rs_ = rsqrtf(ss_ * (1.f / 128.f) + EPS); \
            _Pragma("unroll") for (int i_ = 0; i_ < 4; ++i_) { const unsigned w_[4] = {ov_[i_].x, ov_[i_].y, ov_[i_].z, ov_[i_].w}; const unsigned y_[4] = {zv_[i_].x, zv_[i_].y, zv_[i_].z, zv_[i_].w}; unsigned r_[4]; \
                _Pragma("unroll") for (int j_ = 0; j_ < 4; ++j_) { const int col_ = i_ * 8 + j_ * 2; \
                    const float a_ = __uint_as_float(w_[j_] << 16), b_ = __uint_as_float(w_[j_] & 0xffff0000u), za_ = __uint_as_float(y_[j_] << 16), zb_ = __uint_as_float(y_[j_] & 0xffff0000u); \
                    r_[j_] = pack2(a_ * rs_ * gnh[col_] * silu_f(za_), b_ * rs_ * gnh[col_ + 1] * silu_f(zb_)); } \
                dp_[i_] = make_uint4(r_[0], r_[1], r_[2], r_[3]); } }
        SCAN_LOAD(0) SCAN_STORE(smem) SCAN_LOAD(1)
        __syncthreads();
#pragma unroll 1
        for (int c = 0; c < NT / 64; ++c) {
            if (c + 1 < NT / 64) SCAN_STORE(smem + ((c + 1) & 1) * SC_BYTES)
            if (c + 2 < NT / 64) SCAN_LOAD(c + 2)
            if (c >= 1) SCAN_GATE(c - 1)
            __syncthreads();
        }
        SCAN_GATE(NT / 64 - 1)
#undef SCAN_GATE
        return;
    }
    f32x16 S[4];
#pragma unroll
    for (int T = 0; T < 4; ++T)
#pragma unroll
        for (int r = 0; r < 16; ++r) S[T][r] = 0.f;
    __syncthreads();
#pragma unroll 1
    for (int c = 0; c < NT / 64; ++c) {
        char* buf = smem + (c & 1) * SC_BYTES;
        {
            const int tok0 = b * NT + c * 64;
            const int sw = l31 & 15;
            const char* wnr = buf + SC_WN + l31 * 256; const char* qr = buf + SC_Q + l31 * 256;
            const char* ktr = buf + SC_KT + l31 * 144 + 16 * hf; const char* ppr = buf + SC_PP + l31 * 144 + 16 * hf;
            const bf16_t* ur = (const bf16_t*)(buf + SC_U) + sl * 32 + l31;
            const float* egs = (const float*)(buf + SC_EG); const float* lls = (const float*)(buf + SC_LL);
            const float gc = *(const float*)(buf + SC_GC);
            bf16x8 SB[4][2];
#pragma unroll
            for (int T = 0; T < 4; ++T) { SB[T][0] = pack_frag(S[T], 0); SB[T][1] = pack_frag(S[T], 1); }
            f32x16 D[2], O[2];
#pragma unroll
            for (int mt = 0; mt < 2; ++mt)
#pragma unroll
                for (int r = 0; r < 16; ++r) { D[mt][r] = bf2f(ur[(mt * 32 + (r & 3) + 8 * (r >> 2) + 4 * hf) * 128]); O[mt][r] = 0.f; }
#pragma unroll
            for (int mt = 0; mt < 2; ++mt)
#pragma unroll
                for (int T = 0; T < 4; ++T)
#pragma unroll
                    for (int s = 0; s < 2; ++s) {
                        const int co = (((2 * (2 * T + s) + hf) ^ sw) << 4) + mt * 32 * 256;
                        const bf16x8 wa = *(const bf16x8*)(wnr + co);
                        const bf16x8 qa = *(const bf16x8*)(qr + co);
                        D[mt] = __builtin_amdgcn_mfma_f32_32x32x16_bf16(wa, SB[T][s], D[mt], 0, 0, 0);
                        O[mt] = __builtin_amdgcn_mfma_f32_32x32x16_bf16(qa, SB[T][s], O[mt], 0, 0, 0);
                    }
            __builtin_amdgcn_sched_barrier(0);
            bf16x8 DB[2][2], DL[2][2];
#pragma unroll
            for (int mt = 0; mt < 2; ++mt) {
#pragma unroll
                for (int g4 = 0; g4 < 4; ++g4) {
                    const f32x4 eg = *(const f32x4*)(egs + mt * 32 + g4 * 8 + 4 * hf);
#pragma unroll
                    for (int j = 0; j < 4; ++j) O[mt][g4 * 4 + j] *= eg[j];
                }
                const f32x4 l0 = *(const f32x4*)(lls + mt * 32 + 0 + 4 * hf), l1 = *(const f32x4*)(lls + mt * 32 + 8 + 4 * hf);
                const f32x4 l2 = *(const f32x4*)(lls + mt * 32 + 16 + 4 * hf), l3 = *(const f32x4*)(lls + mt * 32 + 24 + 4 * hf);
                DB[mt][0] = pack_frag(D[mt], 0); DB[mt][1] = pack_frag(D[mt], 1);
                DL[mt][0] = pack_frag_scaled(D[mt], 0, l0, l1); DL[mt][1] = pack_frag_scaled(D[mt], 1, l2, l3);
            }
#pragma unroll
            for (int mt = 0; mt < 2; ++mt)
#pragma unroll
                for (int ks = 0; ks < 4; ++ks) {
                    const bf16x8 pa = *(const bf16x8*)(ppr + mt * 32 * 144 + ks * 32);
                    O[mt] = __builtin_amdgcn_mfma_f32_32x32x16_bf16(pa, DB[ks >> 1][ks & 1], O[mt], 0, 0, 0);
                }
            __builtin_amdgcn_sched_barrier(0);
            {
                bf16_t* orow = dno + (size_t)tok0 * 512 + hh * 128 + sl * 32 + l31;
#pragma unroll
                for (int mt = 0; mt < 2; ++mt)
#pragma unroll
                    for (int r = 0; r < 16; ++r) orow[(size_t)(mt * 32 + (r & 3) + 8 * (r >> 2) + 4 * hf) * 512] = f2bf(O[mt][r]);
            }
#pragma unroll
            for (int T = 0; T < 4; ++T) {
#pragma unroll
                for (int r = 0; r < 16; ++r) S[T][r] *= gc;
#pragma unroll
                for (int ks = 0; ks < 4; ++ks) {
                    const bf16x8 ka = *(const bf16x8*)(ktr + T * 32 * 144 + ks * 32);
                    S[T] = __builtin_amdgcn_mfma_f32_32x32x16_bf16(ka, DL[ks >> 1][ks & 1], S[T], 0, 0, 0);
                }
            }
        }
        __syncthreads();
    }
}

__device__ __forceinline__ void ph_dn_gate(const P& p) {
    const int tid = tid_opaque();
    const int lane = tid & 63, wave = tid >> 6;
    const bf16_t* dno = (const bf16_t*)((const unsigned char*)p.out + DO_DNO); const bf16_t* proj = (const bf16_t*)(p.ws + WS_PROJ); bf16_t* dnn = (bf16_t*)(p.ws + WS_DK);
    for (int tok = blockIdx.x * NWAVES + wave; tok < NTOK; tok += gridDim.x * NWAVES) {
#pragma unroll
        for (int hh = 0; hh < 4; ++hh) {
            const unsigned orw = *(const unsigned*)(dno + (size_t)tok * 512 + hh * 128 + lane * 2);
            const float o0 = __uint_as_float(orw << 16), o1 = __uint_as_float(orw & 0xffff0000u);
            const float ss = wave_sum(o0 * o0 + o1 * o1);
            const float rs = rsqrtf(ss * (1.f / 128.f) + EPS);
            const unsigned zr = *(const unsigned*)(proj + (size_t)tok * NPROJ + PC_DNZ + hh * 128 + lane * 2);
            const float z0 = __uint_as_float(zr << 16), z1 = __uint_as_float(zr & 0xffff0000u);
            *(unsigned*)(dnn + (size_t)tok * 512 + hh * 128 + lane * 2) = pack2(o0 * rs * p.dn_norm_g[lane * 2] * silu_f(z0), o1 * rs * p.dn_norm_g[lane * 2 + 1] * silu_f(z1));
        }
    }
}

struct EpiOut {
    static constexpr bool PERM = false;
    const float* x; float* out; const float* modf;
    __device__ __forceinline__ void operator()(const f32x4 (&acc)[2][2][4][2], const pg8::DenseSrc::Unit& u, int wr, int wc, int fr, int fq) const {
        const int row0 = u.pm * 256 + wr * 64 + fr, col0 = u.pn * 256 + wc * 32 + 4 * fq;
        const float* gate = modf + (size_t)((u.pm * 256) / NT) * (6 * ND) + 2 * ND;
        f32x4 gv[2][2];
#pragma unroll
        for (int bj = 0; bj < 2; ++bj)
#pragma unroll
            for (int n = 0; n < 2; ++n) gv[bj][n] = *(const f32x4*)(gate + col0 + bj * 128 + n * 16);
#pragma unroll
        for (int ai = 0; ai < 2; ++ai)
#pragma unroll
            for (int m = 0; m < 4; ++m) { const size_t ro = (size_t)(row0 + ai * 128 + m * 16) * ND + col0;
#pragma unroll
                for (int bj = 0; bj < 2; ++bj)
#pragma unroll
                    for (int n = 0; n < 2; ++n) { const f32x4 xv = *(const f32x4*)(x + ro + bj * 128 + n * 16); *(f32x4*)(out + ro + bj * 128 + n * 16) = xv + gv[bj][n] * acc[ai][bj][m][n]; } }
    }
};
__device__ __forceinline__ void ph_gemm_out(const P& p, char* smem) {
    const int tid = tid_opaque();
    pg8::DenseSrc S; S.A0 = (const char*)(p.ws + WS_QN); S.A1 = (const char*)(p.ws + WS_DK); S.Bt = (const char*)(p.ws + WS_WOUT); S.lda = 512; S.K = ND; S.nM = NTOK / 256; S.nN = ND / 256; S.G = gridDim.x; S.c = blockIdx.x; S.ksplit = 8;
    EpiOut E; E.x = p.x; E.out = p.out; E.modf = (const float*)(p.ws + WS_MODF);
    pg8::gemm_phase(tid, (PG8_LAS unsigned char*)smem, ND, S, E);
}

constexpr int ROUTE_LDS = 1024 * 36 * 4 + 2 * 1024 * 4 + 2048 + 8 * 160 * 4;
__device__ __forceinline__ void ph_route(const P& p, char* smem) {
    const int tid = tid_opaque();
    float* sW = (float*)smem;
    float* sA = sW + 1024 * 36; float* sB = sA + 1024;
    int* s_cnt = (int*)(sB + 1024);
    int* s_base = s_cnt + 32; int* s_tok = s_base + 32;
    const int lane = tid & 63, wave = tid >> 6;
    {
        f32x4 tg[2], te[16];
#pragma unroll
        for (int i = 0; i < 2; ++i) tg[i] = *(const f32x4*)(p.rg_w + (size_t)(tid + i * NTHREADS) * 4);
#pragma unroll
        for (int i = 0; i < 16; ++i) te[i] = *(const f32x4*)(p.re_w + (size_t)(tid + i * NTHREADS) * 4);
#pragma unroll
        for (int i = 0; i < 2; ++i) *(f32x4*)(sW + (tid + i * NTHREADS) * 36) = tg[i];
#pragma unroll
        for (int i = 0; i < 16; ++i) { const int x = tid + i * NTHREADS; *(f32x4*)(sW + (x >> 3) * 36 + 4 + (x & 7) * 4) = te[i]; }
    }
    bf16_t* h2 = (bf16_t*)(p.ws + WS_H2);
    int* cnt = (int*)(p.ws + WS_CTL); int* list = (int*)(p.ws + WS_LIST); int* tokinfo = (int*)(p.ws + WS_TOKINFO);
    int curb = -1;
    for (int tile = blockIdx.x; tile < NTOK / 64; tile += gridDim.x) {
        const int b = tile / (NT / 64);
        __syncthreads();
        if (b != curb) {
            { const float* mf = (const float*)(p.ws + WS_MODF) + (size_t)b * (6 * ND); for (int d = tid; d < ND; d += NTHREADS) { sA[d] = p.norm2_g[d] * (1.f + mf[4 * ND + d]); sB[d] = mf[3 * ND + d]; } }
            curb = b;
        }
        if (tid < 32) s_cnt[tid] = 0;
        __syncthreads();
        for (int i4 = 0; i4 < 2; ++i4) {
            const int tok0 = tile * 64 + wave * 8 + i4 * 4;
            float v[4][16];
#pragma unroll
            for (int q = 0; q < 4; ++q)
#pragma unroll
                for (int j = 0; j < 16; ++j) v[q][j] = p.out[(size_t)(tok0 + q) * ND + j * 64 + lane];
#pragma unroll
            for (int q = 0; q < 4; ++q) {
                float ss = 0.f;
#pragma unroll
                for (int j = 0; j < 16; ++j) ss += v[q][j] * v[q][j];
                ss = wave_sum(ss);
                const float rr = rsqrtf(ss * (1.f / ND) + EPS);
#pragma unroll
                for (int j = 0; j < 16; ++j) { const int d = j * 64 + lane; v[q][j] = v[q][j] * rr * sA[d] + sB[d]; h2[(size_t)(tok0 + q) * ND + d] = f2bf(v[q][j]); }
            }
            float* stab = (float*)(s_tok + 64 * 4) + wave * 160;
#pragma unroll 1
            for (int o4 = 0; o4 < 9; ++o4) {
                float a[16];
#pragma unroll
                for (int i = 0; i < 16; ++i) a[i] = 0.f;
#pragma unroll
                for (int j = 0; j < 16; ++j) {
                    const f32x4 w = *(const f32x4*)(sW + (j * 64 + lane) * 36 + o4 * 4);
#pragma unroll
                    for (int q = 0; q < 4; ++q) { a[q * 4 + 0] += v[q][j] * w[0]; a[q * 4 + 1] += v[q][j] * w[1]; a[q * 4 + 2] += v[q][j] * w[2]; a[q * 4 + 3] += v[q][j] * w[3]; }
                }
                float b8[8], c4[4], d2[2];
#pragma unroll
                for (int i = 0; i < 8; ++i) { auto rr = __builtin_amdgcn_permlane32_swap(__float_as_uint(a[2 * i]), __float_as_uint(a[2 * i + 1]), false, false); b8[i] = __uint_as_float(rr[0]) + __uint_as_float(rr[1]); }
#pragma unroll
                for (int i = 0; i < 4; ++i) { auto rr = __builtin_amdgcn_permlane16_swap(__float_as_uint(b8[2 * i]), __float_as_uint(b8[2 * i + 1]), false, false); c4[i] = __uint_as_float(rr[0]) + __uint_as_float(rr[1]); }
#pragma unroll
                for (int i = 0; i < 2; ++i) { const float keep = (lane & 1) ? c4[2 * i + 1] : c4[2 * i], send = (lane & 1) ? c4[2 * i] : c4[2 * i + 1]; d2[i] = keep + dpp_f<0xB1>(send); }
                float e1 = ((lane & 2) ? d2[1] : d2[0]) + dpp_f<0x4E>((lane & 2) ? d2[0] : d2[1]);
                e1 += dpp_f<0x124>(e1);
                e1 += dpp_f<0x128>(e1);
                if ((lane & 12) == 0) {
                    const int vi = ((lane >> 5) & 1) + 2 * ((lane >> 4) & 1) + 4 * (lane & 1) + 8 * ((lane >> 1) & 1);
                    stab[(vi >> 2) * 40 + o4 * 4 + (vi & 3)] = e1;
                }
            }
            __threadfence_block();
            float lg[4];
#pragma unroll
            for (int q = 0; q < 4; ++q) lg[q] = (lane < 36) ? stab[q * 40 + lane] : 0.f;
            __threadfence_block();
            const float bias = (lane < 4) ? p.rg_b[lane] : ((lane < 36) ? p.re_b[lane - 4] : 0.f);
#pragma unroll
            for (int q = 0; q < 4; ++q) {
                const float mylogit = lg[q] + bias; const int tok = tok0 + q;
                float gl[4];
#pragma unroll
                for (int j = 0; j < 4; ++j) gl[j] = __shfl(mylogit, j);
                int gsel = 0; float gm = gl[0];
#pragma unroll
                for (int j = 1; j < 4; ++j) if (gl[j] > gm) { gm = gl[j]; gsel = j; }
                float gs = 0.f;
#pragma unroll
                for (int j = 0; j < 4; ++j) gs += __expf(gl[j] - gm);
                const float gtop = 1.f / gs;
                float el[8];
#pragma unroll
                for (int j = 0; j < 8; ++j) el[j] = __shfl(mylogit, 4 + gsel * 8 + j);
                int e1i = 0; float m1 = el[0];
#pragma unroll
                for (int j = 1; j < 8; ++j) if (el[j] > m1) { m1 = el[j]; e1i = j; }
                int e2i = -1; float m2 = -INFINITY;
#pragma unroll
                for (int j = 0; j < 8; ++j) if (j != e1i && el[j] > m2) { m2 = el[j]; e2i = j; }
                const float r2 = __expf(m2 - m1);
                const float w1v = gtop / (1.f + r2), w2v = gtop * r2 / (1.f + r2);
                if (lane == 0) {
                    const int ea = gsel * 8 + e1i, eb = gsel * 8 + e2i;
                    const int pa = atomicAdd(&s_cnt[ea], 1), pb = atomicAdd(&s_cnt[eb], 1);
                    int* st = s_tok + (tok & 63) * 4; st[0] = ea; st[1] = pa; st[2] = eb; st[3] = pb;
                    int* ti = tokinfo + (size_t)tok * 8; ti[4] = __float_as_int(w1v); ti[5] = __float_as_int(w2v);
                }
            }
        }
        __syncthreads();
        if (tid < 32) s_base[tid] = atomicAdd(&cnt[tid], s_cnt[tid]);
        __syncthreads();
        if (tid < 64) {
            const int tok = tile * 64 + tid; const int* st = s_tok + tid * 4;
            const int ea = st[0], pa = s_base[ea] + st[1], eb = st[2], pb = s_base[eb] + st[3];
            list[ea * NTOK + pa] = tok; list[eb * NTOK + pb] = tok;
            int* ti = tokinfo + (size_t)tok * 8; ti[0] = ea; ti[1] = pa; ti[2] = eb; ti[3] = pb;
        }
    }
}

struct MoeIdx { int rowoff[NE + 1]; int tileoff[NE + 1]; };
__device__ __forceinline__ void moe_index(const int tid, const P& p, MoeIdx* mi) {
    if (tid == 0) {
        const int* cnt = (const int*)(p.ws + WS_CTL);
        int r = 0, t = 0;
        for (int e = 0; e < NE; ++e) { mi->rowoff[e] = r; mi->tileoff[e] = t; const int c = cnt[e]; r += c; t += (c + 255) >> 8; }
        mi->rowoff[NE] = r; mi->tileoff[NE] = t;
    }
    __syncthreads();
}
struct MoeSrc {
    struct Unit { int e, ml, pn, nrows, row0; };
    const MoeIdx* mi; const int* list; const char* Ab; const char* Bt; size_t bstride; int K, G, c; bool gather;
    __device__ __forceinline__ bool next(int i, Unit& u) const {
        const int L = i * G + c; if (L >= mi->tileoff[NE] * 4) return false;
        const int mt = L >> 2; u.pn = L & 3;
        int e = 0; while (mi->tileoff[e + 1] <= mt) ++e;
        u.e = e; u.ml = mt - mi->tileoff[e]; u.row0 = mi->rowoff[e] + u.ml * 256;
        u.nrows = min(256, mi->rowoff[e + 1] - u.row0);
        return true;
    }
    __device__ __forceinline__ unsigned one(const Unit& u, int r, int C) const {
        const int rr = min(r, u.nrows - 1);
        const int arow = gather ? list[u.e * NTOK + u.ml * 256 + rr] : (u.row0 + rr);
        return (unsigned)((arow * K + C) * 2);
    }
    __device__ __forceinline__ void a_off(const Unit& u, int R0, int C0, int R1, int C1, pg8::AO& ao) const {
        ao.h0p0 = one(u, R0, C0); ao.h0p1 = one(u, R1, C1); ao.h1p0 = one(u, 128 + R0, C0); ao.h1p1 = one(u, 128 + R1, C1);
    }
    __device__ __forceinline__ const char* a_base(const Unit&, int kt) const { return Ab + (size_t)kt * 128; }
    __device__ __forceinline__ const char* b_base(const Unit& u) const { return Bt + (size_t)u.e * bstride + (size_t)u.pn * 256 * K * 2; }
};
constexpr int L_MOE = pg8::STAGE_BYTES + (int)sizeof(MoeIdx) + 16;

struct EpiUp {
    static constexpr bool PERM = true;
    bf16_t* act;
    __device__ __forceinline__ void operator()(const f32x4 (&acc)[2][2][4][2], const MoeSrc::Unit& u, int wr, int wc, int fr, int fq) const {
        const int col0 = u.pn * 128 + wc * 32 + 8 * fq;
#pragma unroll
        for (int ai = 0; ai < 2; ++ai)
#pragma unroll
            for (int m = 0; m < 4; ++m) {
                const int r = ai * 128 + wr * 64 + m * 16 + fr;
                if (r < u.nrows) {
                    const f32x4 g0 = acc[ai][0][m][0], g1 = acc[ai][0][m][1], u0 = acc[ai][1][m][0], u1 = acc[ai][1][m][1];
                    *(uint4*)(act + (size_t)(u.row0 + r) * EFF + col0) = make_uint4(pack2(silu_f(g0[0]) * u0[0], silu_f(g0[1]) * u0[1]), pack2(silu_f(g0[2]) * u0[2], silu_f(g0[3]) * u0[3]),
                                                                                     pack2(silu_f(g1[0]) * u1[0], silu_f(g1[1]) * u1[1]), pack2(silu_f(g1[2]) * u1[2], silu_f(g1[3]) * u1[3]));
                }
            }
    }
};
__device__ __forceinline__ void ph_moe_up(const P& p, char* smem) {
    const int tid = tid_opaque();
    MoeIdx* mi = (MoeIdx*)(smem + pg8::STAGE_BYTES);
    moe_index(tid, p, mi);
    MoeSrc S; S.mi = mi; S.list = (const int*)(p.ws + WS_LIST); S.Ab = (const char*)(p.ws + WS_H2); S.Bt = (const char*)(p.ws + WS_W13); S.bstride = (size_t)1024 * ND * 2; S.K = ND; S.G = gridDim.x; S.c = blockIdx.x; S.gather = true;
    EpiUp E; E.act = (bf16_t*)(p.ws + WS_ACT);
    pg8::gemm_phase(tid, (PG8_LAS unsigned char*)smem, ND, S, E);
}

struct EpiDown {
    static constexpr bool PERM = true;
    bf16_t* yb;
    __device__ __forceinline__ void operator()(const f32x4 (&acc)[2][2][4][2], const MoeSrc::Unit& u, int wr, int wc, int fr, int fq) const {
        const int col0 = u.pn * 256 + wc * 32 + 8 * fq;
#pragma unroll
        for (int ai = 0; ai < 2; ++ai)
#pragma unroll
            for (int m = 0; m < 4; ++m) {
                const int r = ai * 128 + wr * 64 + m * 16 + fr;
                if (r < u.nrows) {
#pragma unroll
                    for (int bj = 0; bj < 2; ++bj) { const f32x4 v0 = acc[ai][bj][m][0], v1 = acc[ai][bj][m][1];
                        *(uint4*)(yb + (size_t)(u.row0 + r) * ND + col0 + bj * 128) = make_uint4(pack2(v0[0], v0[1]), pack2(v0[2], v0[3]), pack2(v1[0], v1[1]), pack2(v1[2], v1[3])); }
                }
            }
    }
};
__device__ __forceinline__ void ph_moe_down(const P& p, char* smem) {
    const int tid = tid_opaque();
    MoeIdx* mi = (MoeIdx*)(smem + pg8::STAGE_BYTES);
    moe_index(tid, p, mi);
    MoeSrc S; S.mi = mi; S.list = nullptr; S.Ab = (const char*)(p.ws + WS_ACT); S.Bt = (const char*)(p.ws + WS_W2); S.bstride = (size_t)ND * EFF * 2; S.K = EFF; S.G = gridDim.x; S.c = blockIdx.x; S.gather = false;
    EpiDown E; E.yb = (bf16_t*)(p.ws + WS_YBUF);
    pg8::gemm_phase(tid, (PG8_LAS unsigned char*)smem, EFF, S, E);
}

__device__ __forceinline__ void ph_combine(const P& p, char* smem) {
    const int tid = tid_opaque();
    MoeIdx* mi = (MoeIdx*)smem;
    float* sG = (float*)(mi + 1);
    moe_index(tid, p, mi);
    const int lane = tid & 63, wave = tid >> 6;
    const bf16_t* yb = (const bf16_t*)(p.ws + WS_YBUF); const int* tokinfo = (const int*)(p.ws + WS_TOKINFO);
    int curb = -1;
    for (int tile = blockIdx.x; tile < NTOK / 64; tile += gridDim.x) {
        const int b = tile / (NT / 64);
        if (b != curb) {
            __syncthreads();
            { const float* mf = (const float*)(p.ws + WS_MODF) + (size_t)b * (6 * ND) + 5 * ND; for (int d = tid; d < ND; d += NTHREADS) sG[d] = mf[d]; }
            __syncthreads();
            curb = b;
        }
        for (int i = 0; i < 8; ++i) {
            const int tok = tile * 64 + wave * 8 + i;
            const int* ti = tokinfo + (size_t)tok * 8;
            const int ra = mi->rowoff[ti[0]] + ti[1], rb = mi->rowoff[ti[2]] + ti[3];
            const float wa = __int_as_float(ti[4]), wb = __int_as_float(ti[5]);
#pragma unroll
            for (int j = 0; j < 4; ++j) {
                const int d = j * 256 + lane * 4;
                const uint2 ya = *(const uint2*)(yb + (size_t)ra * ND + d), ybv = *(const uint2*)(yb + (size_t)rb * ND + d);
                f32x4 xv = *(const f32x4*)(p.out + (size_t)tok * ND + d);
                xv[0] += sG[d] * (wa * __uint_as_float(ya.x << 16) + wb * __uint_as_float(ybv.x << 16));
                xv[1] += sG[d + 1] * (wa * __uint_as_float(ya.x & 0xffff0000u) + wb * __uint_as_float(ybv.x & 0xffff0000u));
                xv[2] += sG[d + 2] * (wa * __uint_as_float(ya.y << 16) + wb * __uint_as_float(ybv.y << 16));
                xv[3] += sG[d + 3] * (wa * __uint_as_float(ya.y & 0xffff0000u) + wb * __uint_as_float(ybv.y & 0xffff0000u));
                *(f32x4*)(p.out + (size_t)tok * ND + d) = xv;
            }
        }
    }
}

#define XB_TMO      128
#define XB_XCNT(j)  (256  + 64 * (j))
#define XB_XSUB(j)  (1280 + 64 * (j))
#define XB_XGEN(j)  (2304 + 64 * (j))
#define XB_TOP      3328
#define XB_TOPGEN   3392
#define XCD_BAR_WORDS 3456
#define XB_SPIN_CAP (1u << 20)
#define LAS __attribute__((address_space(3)))
__device__ __forceinline__ unsigned xb_ld(unsigned* p)              { return __hip_atomic_load(p, __ATOMIC_RELAXED, __HIP_MEMORY_SCOPE_AGENT); }
__device__ __forceinline__ unsigned xb_add(unsigned* p, unsigned v) { return __hip_atomic_fetch_add(p, v, __ATOMIC_RELAXED, __HIP_MEMORY_SCOPE_AGENT); }
__device__ __forceinline__ unsigned xb_xcc_id() { return (unsigned)__builtin_amdgcn_s_getreg((3 << 11) | 20) & 0xFu; }
#define XB_SPIN(cond, bar) do { unsigned _sp = 0; while (cond) { __builtin_amdgcn_s_sleep(1); \
    if ((++_sp & 255u) == 0u) { if (xb_ld(&(bar)[XB_TMO])) break; if (_sp > XB_SPIN_CAP) { atomicAdd(&(bar)[XB_TMO], 1u); break; } } } } while (0)
struct XcdBarrier { unsigned* bar; unsigned x; volatile LAS unsigned* st; };
__device__ __forceinline__ XcdBarrier xcd_barrier_post(unsigned* bar, volatile LAS unsigned* st) {
    XcdBarrier b; b.bar = bar; b.x = xb_xcc_id(); b.st = st;
    if (threadIdx.x == 0) (void)xb_add(&bar[XB_XCNT(b.x)], 1u);
    return b;
}
__device__ __forceinline__ void xcd_barrier_complete(unsigned* bar, unsigned x, unsigned& nloc, unsigned& nx) {
    const unsigned G = gridDim.x * gridDim.y * gridDim.z;
    unsigned sum, cnt, mine, sp = 0u;
    for (;;) {
        sum = 0u; cnt = 0u; mine = 0u;
#pragma unroll
        for (unsigned j = 0; j < 16; ++j) { const unsigned c = xb_ld(&bar[XB_XCNT(j)]); sum += c; cnt += (c > 0u) ? 1u : 0u; mine = (j == x) ? c : mine; }
        if (sum == G) break;
        __builtin_amdgcn_s_sleep(1);
        if ((++sp & 255u) == 0u) { if (xb_ld(&bar[XB_TMO])) break; if (sp > XB_SPIN_CAP) { atomicAdd(&bar[XB_TMO], 1u); break; } }
    }
    nloc = mine > 0u ? mine : 1u; nx = cnt > 0u ? cnt : 1u;
}
__device__ __forceinline__ void xcd_barrier(const XcdBarrier& b) {
    asm volatile("s_waitcnt vmcnt(0)" ::: "memory");
    __syncthreads();
    if (threadIdx.x == 0) {
        unsigned* bar = b.bar;
        __builtin_amdgcn_s_waitcnt(0);
        unsigned nloc = b.st[0], nx = b.st[1];
        if (nloc == 0u) { xcd_barrier_complete(bar, b.x, nloc, nx); b.st[0] = nloc; b.st[1] = nx; }
        const unsigned old = xb_add(&bar[XB_XSUB(b.x)], 1u);
        const unsigned gen = old / nloc;
        if (old + 1u == (gen + 1u) * nloc) {
            __builtin_amdgcn_fence(__ATOMIC_RELEASE, "agent");
            asm volatile("s_waitcnt vmcnt(0)" ::: "memory");
            const unsigned og = xb_add(&bar[XB_TOP], 1u);
            const unsigned tg = og / nx;
            if (og + 1u == (tg + 1u) * nx) xb_add(&bar[XB_TOPGEN], 1u);
            else XB_SPIN(xb_ld(&bar[XB_TOPGEN]) == tg, bar);
            __builtin_amdgcn_fence(__ATOMIC_ACQUIRE, "agent");
            xb_add(&bar[XB_XGEN(b.x)], 1u);
            asm volatile("s_waitcnt vmcnt(0)" ::: "memory");
        } else {
            XB_SPIN(xb_ld(&bar[XB_XGEN(b.x)]) == gen, bar);
            __builtin_amdgcn_fence(__ATOMIC_ACQUIRE, "agent");
            asm volatile("s_waitcnt vmcnt(0)" ::: "memory");
        }
    }
    __syncthreads();
}

namespace cg = cooperative_groups;
extern __shared__ __attribute__((aligned(16))) char dyn_smem[];
constexpr int cmax(int a, int b) { return a > b ? a : b; }
constexpr int L_G1 = pg8::STAGE_BYTES;
constexpr int MEGA_LDS = cmax(cmax(cmax(ROUTE_LDS, PREP_LDS), cmax(cmax(AT_BUF + SCAN_LDS, ATTM_LDS), L_G1)), L_MOE);
typedef const unsigned long long __attribute__((address_space(4)))* kargp_t;
__device__ __forceinline__ void load_params(P& p, kargp_t ka) {
    asm volatile("" : "+s"(ka));
    typedef __attribute__((address_space(1))) char* gptr_t;
    const void** d = (const void**)&p;
#pragma unroll
    for (int i = 0; i < (int)(sizeof(P) / 8); ++i) d[i] = (const void*)(gptr_t)ka[i];
}
#define PHASE(call) do { P p; load_params(p, ka); call; } while (0)
#ifndef PROBE_MODE
#define PROBE_MODE 0
#endif
#ifndef PROBE_K
#define PROBE_K -1
#endif
template <int KMAX>
__device__ __forceinline__ void run_phases(cg::grid_group& grid, const XcdBarrier& xb, kargp_t ka, char* smem) {
    if constexpr (KMAX >= 0) { PHASE(ph_mod_partial(p, smem)); PHASE(ph_convert(p, smem)); xcd_barrier(xb); }
    if constexpr (KMAX >= 1) { PHASE(ph_norm1(p, smem)); xcd_barrier(xb); }
    if constexpr (KMAX >= 2) { PHASE(ph_gemm1(p, smem)); xcd_barrier(xb); }
    if constexpr (KMAX >= 3) { PHASE(ph_post(p, smem)); xcd_barrier(xb); }
    if constexpr (KMAX >= 4) { PHASE(ph_dn_prep(p, smem)); xcd_barrier(xb); }
    if constexpr (KMAX >= 5) { PHASE(ph_attn_mfma<(KMAX == 5 ? PROBE_MODE : 0)>(p, smem)); xcd_barrier(xb); }
    if constexpr (KMAX >= 7) { PHASE(ph_gemm_out(p, smem)); xcd_barrier(xb); }
    if constexpr (KMAX >= 8) { PHASE(ph_route(p, smem)); xcd_barrier(xb); }
    if constexpr (KMAX >= 9) { PHASE(ph_moe_up(p, smem)); xcd_barrier(xb); }
    if constexpr (KMAX >= 10) { PHASE(ph_moe_down(p, smem)); xcd_barrier(xb); }
    if constexpr (KMAX >= 11) { PHASE(ph_combine(p, smem)); }
}
__global__ void __launch_bounds__(NTHREADS) mega(P p_arg) {
    cg::grid_group grid = cg::this_grid();
    char* smem = dyn_smem;
    kargp_t ka = (kargp_t)__builtin_amdgcn_kernarg_segment_ptr();
    volatile LAS unsigned* xst = (volatile LAS unsigned*)(smem + MEGA_LDS);
    if (threadIdx.x < 4) xst[threadIdx.x] = 0u;
    __syncthreads();
    XcdBarrier xb;
    { P p; load_params(p, ka); xb = xcd_barrier_post((unsigned*)(p.ws + WS_BAR), xst);
      if (p.ws == nullptr) grid.sync(); }
    if constexpr (PROBE_K >= 0) {
        run_phases<PROBE_K>(grid, xb, ka, smem);
        if (PROBE_MODE == 20) { for (int i = 0; i < 20; ++i) xcd_barrier(xb); }
        P p; load_params(p, ka);
        if (blockIdx.x == 0 && threadIdx.x < 256) ((int*)(p.ws + WS_CTL))[threadIdx.x] = 0;
        xcd_barrier(xb);
    }
    run_phases<99>(grid, xb, ka, smem);
}

extern "C" void kernel_launch(void* const* d_in, const int* in_sizes, int n_in, void* d_out, int out_size, void* d_ws, size_t ws_size, hipStream_t stream) {
    if (n_in != 26 || out_size != NTOK * ND || ws_size < WS_END) { fprintf(stderr, "kernel_launch: unexpected shapes (n_in %d out %d ws %zu need %zu)\n", n_in, out_size, ws_size, (size_t)WS_END); return; }
    static int grid_blocks = 0;
    if (!grid_blocks) {
        int dev = 0, cus = 0, per_cu = 0;
        (void)hipGetDevice(&dev);
        (void)hipDeviceGetAttribute(&cus, hipDeviceAttributeMultiprocessorCount, dev);
        (void)hipFuncSetAttribute((const void*)mega, hipFuncAttributeMaxDynamicSharedMemorySize, MEGA_LDS + 16);
        (void)hipOccupancyMaxActiveBlocksPerMultiprocessor(&per_cu, (const void*)mega, NTHREADS, MEGA_LDS + 16);
        if (per_cu < 1) { fprintf(stderr, "kernel_launch: occupancy query says %d blocks/CU\n", per_cu); per_cu = 1; }
        grid_blocks = cus * per_cu;
    }
    P p{};
    const float** fp = (const float**)&p;
    for (int i = 0; i < 26; ++i) fp[i] = (const float*)d_in[i];
    p.pos = (const int*)d_in[2];
    p.out = (float*)d_out; p.ws = (unsigned char*)d_ws;
    (void)hipMemsetAsync((char*)d_ws + WS_CTL, 0, 32768, stream);
    void* args[] = {&p};
    hipError_t e = hipLaunchCooperativeKernel((const void*)mega, dim3(grid_blocks), dim3(NTHREADS), args, MEGA_LDS + 16, stream);
    if (e != hipSuccess) fprintf(stderr, "cooperative launch failed: %s (grid %d)\n", hipGetErrorString(e), grid_blocks);
}
```

```cpp
#include <hip/hip_runtime.h>
#include <hip/hip_cooperative_groups.h>
#include <cstdio>
#include <cstdint>

typedef unsigned short bf16_t;
typedef short bf16x8 __attribute__((ext_vector_type(8)));
typedef float f32x16 __attribute__((ext_vector_type(16)));
typedef float f32x4 __attribute__((ext_vector_type(4)));

constexpr int NB = 8, NT = 2048, ND = 1024, NTOK = NB * NT;
constexpr int NPROJ = 3072;
constexpr int PC_QATT = 0, PC_KVLAT = 512, PC_QIDX = 640, PC_DNQKV = 896, PC_DNZ = 2432, PC_KIDX = 2944, PC_WIDX = 2976, PC_BETA = 2984, PC_A = 2988;
constexpr int W_IN_SRC = 2992;
constexpr int NE = 32, EFF = 512;
constexpr int KSPLIT = 16;
constexpr int NTHREADS = 512, NWAVES = 8;
constexpr float EPS = 1e-6f;
constexpr float LOG2E = 1.4426950408889634f;

constexpr size_t MiB = 1ull << 20;
constexpr size_t WS_CTL = 0;
constexpr size_t WS_BAR = WS_CTL + 16 * 1024;
constexpr size_t WS_MODF = WS_CTL + 256 * 1024;
constexpr size_t WS_MODP = WS_CTL + 1 * MiB;
constexpr size_t WS_WIN = WS_MODP + 3 * MiB;
constexpr size_t WS_WOUT = WS_WIN + 6 * MiB;
constexpr size_t WS_W13 = WS_WOUT + 2 * MiB;
constexpr size_t WS_W2 = WS_W13 + 64 * MiB;
constexpr size_t WS_PROJ = WS_W2 + 32 * MiB;
constexpr size_t WS_ACT = WS_PROJ;
constexpr size_t WS_YBUF = WS_PROJ + 32 * MiB;
constexpr size_t WS_QN = WS_PROJ + 96 * MiB;
constexpr size_t WS_K = WS_QN + 16 * MiB;
constexpr size_t WS_KI = WS_K + 2 * MiB;
constexpr size_t WS_WI = WS_KI + 1 * MiB;
constexpr size_t WS_DBG = WS_WI + 512 * 1024;
constexpr size_t WS_DQ = WS_DBG + 512 * 1024;
constexpr size_t WS_DK = WS_DQ + 16 * MiB;
constexpr size_t WS_H2 = WS_DQ;
constexpr size_t WS_DKT = WS_DK + 16 * MiB;
constexpr size_t WS_DVT = WS_DKT + 16 * MiB;
constexpr size_t WS_END = WS_DVT + 16 * MiB;
constexpr size_t WS_LIST = WS_K;
constexpr size_t WS_TOKINFO = WS_KI;
constexpr size_t WS_VT = WS_WIN;
constexpr size_t WS_POSMM = WS_WIN + 2 * MiB;
constexpr size_t DO_WN = 0, DO_U = 16 * MiB, DO_DNO = 32 * MiB, DO_PP = 48 * MiB, DO_EG = 56 * MiB, DO_LL = DO_EG + 256 * 1024, DO_GC = DO_LL + 256 * 1024;

struct P {
    const float* x; const float* c; const int* pos; const float* ada_w; const float* ada_b; const float* norm1_g; const float* norm2_g;
    const float* w_in; const float* q_norm_g; const float* k_norm_g; const float* kv_norm_g; const float* w_kv_up; const float* idx_k_norm_g;
    const float* rel_bias; const float* conv_w; const float* a_log; const float* dt_bias; const float* dn_norm_g; const float* w_out;
    const float* rg_w; const float* rg_b; const float* re_w; const float* re_b; const float* w1; const float* w3; const float* w2;
    float* out; unsigned char* ws;
};

__device__ __forceinline__ float bf2f(bf16_t h) { return __uint_as_float(((unsigned)h) << 16); }
__device__ __forceinline__ bf16_t f2bf(float f) { unsigned u = __float_as_uint(f); u += 0x7fffu + ((u >> 16) & 1u); return (bf16_t)(u >> 16); }
__device__ __forceinline__ unsigned pack2(float a, float b) { unsigned r; asm volatile("v_cvt_pk_bf16_f32 %0, %1, %2" : "=v"(r) : "v"(a), "v"(b)); return r; }
template <int CTRL> __device__ __forceinline__ float dpp_f(float v) { return __int_as_float(__builtin_amdgcn_update_dpp(0, __float_as_int(v), CTRL, 0xF, 0xF, false)); }
template <int CTRL> __device__ __forceinline__ int dpp_i(int v) { return __builtin_amdgcn_update_dpp(0, v, CTRL, 0xF, 0xF, false); }
__device__ __forceinline__ float wave_sum(float v) {
    v += dpp_f<0xB1>(v); v += dpp_f<0x4E>(v); v += dpp_f<0x141>(v); v += dpp_f<0x140>(v);
    v += __int_as_float(__builtin_amdgcn_update_dpp(0, __float_as_int(v), 0x142, 0xA, 0xF, false));
    v += __int_as_float(__builtin_amdgcn_update_dpp(0, __float_as_int(v), 0x143, 0xC, 0xF, false));
    return __int_as_float(__builtin_amdgcn_readlane(__float_as_int(v), 63));
}
__device__ __forceinline__ float wave_max(float v) {
#pragma unroll
    for (int o = 32; o >= 1; o >>= 1) v = fmaxf(v, __shfl_xor(v, o));
    return v;
}
__device__ __forceinline__ int wave_isum(int v) {
#pragma unroll
    for (int o = 32; o >= 1; o >>= 1) v += __shfl_xor(v, o);
    return v;
}
__device__ __forceinline__ int tid_opaque() { int t = threadIdx.x; asm volatile("" : "+v"(t)); return t; }
__device__ __forceinline__ float relu_f(float x) { return __builtin_amdgcn_fmed3f(x, 0.f, __builtin_inff()); }
__device__ __forceinline__ float silu_f(float x) { return x * __builtin_amdgcn_rcpf(1.f + __expf(-x)); }
__device__ __forceinline__ float sigmoid_f(float x) { return __builtin_amdgcn_rcpf(1.f + __expf(-x)); }
__device__ __forceinline__ float rsq_f(float x) { return __builtin_amdgcn_rsqf(x); }
__device__ __forceinline__ float mod_val(const P& p, int b, int which, int d) {
    const float* mp = (const float*)(p.ws + WS_MODP);
    const int col = which * ND + d;
    float s = p.ada_b[col];
#pragma unroll
    for (int ks = 0; ks < KSPLIT; ++ks) s += mp[(size_t)(ks * NB + b) * (6 * ND) + col];
    return s;
}

__device__ __forceinline__ int win_src_col(int n) {
    if (n < 896) return n;
    if (n < 2944) return n + 40;
    if (n < 2976) return n - 2944 + 896;
    if (n < 2984) return n - 2976 + 928;
    if (n < 2992) return n;
    return -1;
}
__device__ __forceinline__ f32x4 ldnt4(const float* p_) { return __builtin_nontemporal_load((const f32x4*)p_); }
__device__ __forceinline__ void conv_tile_wave(const int lane, const float* src0, int nsrc, int mode, int n0, int k0, bf16_t* dst, int K, int sc0) {
    const int kb = lane >> 3, c = lane & 7;
    int col0, col1;
    if (mode == 1) { col0 = win_src_col(n0 + c * 4); col1 = win_src_col(n0 + 32 + c * 4); }
    else { col0 = sc0 + c * 4; col1 = col0 + 32; }
    const float* s0 = src0 + (size_t)(k0 + kb * 8) * nsrc;
    f32x4 v0[8], v1[8];
#pragma unroll
    for (int j = 0; j < 8; ++j) {
        v0[j] = (col0 >= 0) ? ldnt4(s0 + (size_t)j * nsrc + col0) : (f32x4){0.f, 0.f, 0.f, 0.f};
        v1[j] = (col1 >= 0) ? ldnt4(s0 + (size_t)j * nsrc + col1) : (f32x4){0.f, 0.f, 0.f, 0.f};
    }
    bf16_t* d0 = dst + (size_t)(n0 + c * 4) * K + k0 + kb * 8;
#pragma unroll
    for (int i = 0; i < 4; ++i) *(uint4*)(d0 + (size_t)i * K) = make_uint4(pack2(v0[0][i], v0[1][i]), pack2(v0[2][i], v0[3][i]), pack2(v0[4][i], v0[5][i]), pack2(v0[6][i], v0[7][i]));
#pragma unroll
    for (int i = 0; i < 4; ++i) *(uint4*)(d0 + (size_t)(32 + i) * K) = make_uint4(pack2(v1[0][i], v1[1][i]), pack2(v1[2][i], v1[3][i]), pack2(v1[4][i], v1[5][i]), pack2(v1[6][i], v1[7][i]));
}
constexpr int CV_T0 = 48 * 16, CV_T1 = 16 * 16, CV_T2 = NE * 256, CV_T3 = NE * 128, CV_TOTAL = CV_T0 + CV_T1 + CV_T2 + CV_T3;
constexpr int CV_PREP = 3072;
constexpr int CV_LATE = (CV_TOTAL - CV_T0 - CV_PREP) / NWAVES;
__device__ __forceinline__ void conv_tile_index(const P& p, const int lane, const int t) {
    bf16_t* Wt_in = (bf16_t*)(p.ws + WS_WIN); bf16_t* Wt_out = (bf16_t*)(p.ws + WS_WOUT);
    bf16_t* Wt13 = (bf16_t*)(p.ws + WS_W13); bf16_t* Wt2 = (bf16_t*)(p.ws + WS_W2);
    const float* srcw; int nsrc, mode = 0, n0, k0, K = ND, sc0; bf16_t* dstw;
    if (t < CV_T0) { const int nt = t / 16, kt = t % 16; srcw = p.w_in; nsrc = W_IN_SRC; mode = 1; n0 = nt * 64; k0 = kt * 64; dstw = Wt_in; sc0 = 0; }
    else if (t < CV_T0 + CV_T1) { const int u = t - CV_T0; const int nt = u / 16, kt = u % 16; srcw = p.w_out; nsrc = ND; n0 = nt * 64; k0 = kt * 64; dstw = Wt_out; sc0 = nt * 64; }
    else if (t < CV_T0 + CV_T1 + CV_T2) { const int u = t - CV_T0 - CV_T1; const int e = u / 256, v = u % 256; const int kt = v / 16, j16 = v % 16;
        const int nt = ((j16 & 7) >> 1) * 4 + (j16 >> 3) * 2 + (j16 & 1);
        const int pn = nt >> 2, within = nt & 3;
        srcw = ((within >= 2) ? p.w3 : p.w1) + (size_t)e * ND * EFF; nsrc = EFF; n0 = nt * 64; k0 = kt * 64; dstw = Wt13 + (size_t)e * 1024 * ND; sc0 = pn * 128 + (within & 1) * 64; }
    else { const int u = t - CV_T0 - CV_T1 - CV_T2; const int e = u / 128, v = u % 128; const int kt = v / 16, nt = v % 16;
        srcw = p.w2 + (size_t)e * EFF * ND; nsrc = ND; n0 = nt * 64; k0 = kt * 64; dstw = Wt2 + (size_t)e * ND * EFF; K = EFF; sc0 = nt * 64; }
    conv_tile_wave(lane, srcw, nsrc, mode, n0, k0, dstw, K, sc0);
}
__device__ __forceinline__ void ph_p0(const P& p, char* smem) {
    const int tid = tid_opaque();
    const int lane = tid & 63, wave = tid >> 6;
    float* sc = (float*)smem;
    int* cnt = (int*)(smem + NB * ND * 4);
    for (int i = tid; i < NB * ND; i += NTHREADS) sc[i] = silu_f(p.c[i]);
    if (tid == 0) *cnt = 0;
    __syncthreads();
    {
        float* mp = (float*)(p.ws + WS_MODP);
        const int nitem = 96 * KSPLIT;
        for (int it = wave * gridDim.x + blockIdx.x; it < nitem; it += gridDim.x * NWAVES) {
            const int cg = it % 96, ks = it / 96;
            const int col = cg * 64 + lane;
            float acc[NB];
#pragma unroll
            for (int b = 0; b < NB; ++b) acc[b] = 0.f;
#pragma unroll 32
            for (int kk = 0; kk < ND / KSPLIT; ++kk) {
                const int k = ks * (ND / KSPLIT) + kk;
                const float w = __builtin_nontemporal_load(p.ada_w + (size_t)k * (6 * ND) + col);
#pragma unroll
                for (int b = 0; b < NB; ++b) acc[b] += sc[b * ND + k] * w;
            }
#pragma unroll
            for (int b = 0; b < NB; ++b) mp[(size_t)(ks * NB + b) * (6 * ND) + col] = acc[b];
        }
    }
    for (;;) {
        int i = 0;
        if (lane == 0) i = atomicAdd(cnt, 1);
        i = __builtin_amdgcn_readfirstlane(i);
        const int t = blockIdx.x + i * gridDim.x;
        if (t >= CV_T0) break;
        conv_tile_index(p, lane, t);
    }
}

__device__ __forceinline__ void ph_norm1(const P& p, char* smem) {
    const int tid = tid_opaque();
    float* sA = (float*)smem; float* sB = sA + ND;
    const int lane = tid & 63, wave = tid >> 6;
    bf16_t* h = (bf16_t*)p.out;
    {
        float* mf = (float*)(p.ws + WS_MODF);
        for (int i = blockIdx.x * NTHREADS + tid; i < NB * 6 * ND; i += gridDim.x * NTHREADS) mf[i] = mod_val(p, i / (6 * ND), (i % (6 * ND)) / ND, i % ND);
    }
    int curb = -1;
    for (int tile = blockIdx.x; tile < NTOK / 64; tile += gridDim.x) {
        const int b = tile / (NT / 64);
        if (b != curb) {
            __syncthreads();
            for (int d = tid; d < ND; d += NTHREADS) { sA[d] = p.norm1_g[d] * (1.f + mod_val(p, b, 1, d)); sB[d] = mod_val(p, b, 0, d); }
            __syncthreads();
            curb = b;
        }
        {
            const int tokb = tile * 64 + wave * 8;
            f32x4 v[8][4];
#pragma unroll
            for (int q = 0; q < 8; ++q)
#pragma unroll
                for (int j = 0; j < 4; ++j) v[q][j] = ldnt4(p.x + (size_t)(tokb + q) * ND + j * 256 + lane * 4);
#pragma unroll
            for (int q = 0; q < 8; ++q) {
                float ss = 0.f;
#pragma unroll
                for (int j = 0; j < 4; ++j) ss += v[q][j][0] * v[q][j][0] + v[q][j][1] * v[q][j][1] + v[q][j][2] * v[q][j][2] + v[q][j][3] * v[q][j][3];
                ss = wave_sum(ss);
                const float rstd = rsq_f(ss * (1.f / ND) + EPS);
#pragma unroll
                for (int j = 0; j < 4; ++j) {
                    const int d = j * 256 + lane * 4;
                    const float o0 = v[q][j][0] * rstd * sA[d] + sB[d], o1 = v[q][j][1] * rstd * sA[d + 1] + sB[d + 1], o2 = v[q][j][2] * rstd * sA[d + 2] + sB[d + 2], o3 = v[q][j][3] * rstd * sA[d + 3] + sB[d + 3];
                    *(uint2*)(h + (size_t)(tokb + q) * ND + d) = make_uint2(pack2(o0, o1), pack2(o2, o3));
                }
            }
        }
    }
}

namespace pg8 {
#define PG8_LAS __attribute__((address_space(3)))
typedef unsigned u32x4 __attribute__((ext_vector_type(4)));
constexpr int BM = 256, BK = 64, HALF = 128, HTB = HALF * BK * 2  , STAGE_BYTES = 8 * HTB;
__device__ __forceinline__ int lds_byte(int r, int c) { const int st = (r >> 4) * 2 + (c >> 5), rr = r & 15, cc = c & 31, ob = rr * 64 + cc * 2; return st * 1024 + (ob ^ (((ob >> 9) & 1) << 5)); }
__device__ __forceinline__ void stage_rc(int b, int& R, int& C) { const int st = b / 1024, sb = b % 1024, swz = sb ^ (((sb >> 9) & 1) << 5); R = (st >> 1) * 16 + swz / 64; C = (st & 1) * 32 + (swz % 64) / 2; }
__device__ __forceinline__ int perm32(int rho) { const int n = rho >> 4, i = rho & 15; return 8 * (i >> 2) + 4 * n + (i & 3); }
struct AO { unsigned h0p0, h0p1, h1p0, h1p1; };
template <class Src, class Epi>
__device__ __forceinline__ void gemm_phase(const int tid, PG8_LAS unsigned char* lds, const int K, const Src& S, const Epi& E) {
    const int wid = __builtin_amdgcn_readfirstlane(tid >> 6), lane = tid & 63, wr = wid >> 2, wc = wid & 3, fr = lane & 15, fq = lane >> 4;
    const int nt = K / BK;
    int R0, C0, R1, C1; stage_rc(tid * 16, R0, C0); stage_rc(tid * 16 + 8192, R1, C1);
    unsigned voffB[2];
    { const int Rb0 = Epi::PERM ? ((R0 & ~31) + perm32(R0 & 31)) : R0, Rb1 = Epi::PERM ? ((R1 & ~31) + perm32(R1 & 31)) : R1;
      voffB[0] = (unsigned)(Rb0 * K + C0) * 2u; voffB[1] = (unsigned)(Rb1 * K + C1) * 2u; }
    const size_t kstep = (size_t)(BK * 2);
    const size_t hstepB = (size_t)HALF * K * 2;
    const unsigned ldsw = (unsigned)wid * 1024u;
    const int aoff = lds_byte(wr * 64 + fr, fq * 8), boff = lds_byte(wc * 32 + fr, fq * 8);
#define PG8_SA(b, h) (((b) * 2 + (h)) * HTB)
#define PG8_SB(b, h) ((4 + (b) * 2 + (h)) * HTB)
#define PG8_STAGE2(bufoff, gbase, o0, o1) do { \
        __builtin_amdgcn_global_load_lds((const unsigned*)((const char*)(gbase) + (o0)), (PG8_LAS unsigned*)(lds + (bufoff) + ldsw), 16, 0, 0); \
        __builtin_amdgcn_global_load_lds((const unsigned*)((const char*)(gbase) + (o1)), (PG8_LAS unsigned*)(lds + (bufoff) + ldsw + 8192), 16, 0, 0); } while (0)
#define PG8_STAGEB(bufoff, gbase) PG8_STAGE2(bufoff, gbase, voffB[0], voffB[1])
#define PG8_STAGEA0(bufoff, gbase, AOV) PG8_STAGE2(bufoff, gbase, AOV.h0p0, AOV.h0p1)
#define PG8_STAGEA1(bufoff, gbase, AOV) PG8_STAGE2(bufoff, gbase, AOV.h1p0, AOV.h1p1)
#define PG8_LDA(dst, b, h) do { _Pragma("unroll") for (int m = 0; m < 4; ++m) _Pragma("unroll") for (int k = 0; k < 2; ++k) dst[m][k] = *(const PG8_LAS bf16x8*)(lds + PG8_SA(b, h) + aoff + m * 2048 + k * 1024); } while (0)
#define PG8_LDB(dst, b, h) do { _Pragma("unroll") for (int n = 0; n < 2; ++n) _Pragma("unroll") for (int k = 0; k < 2; ++k) dst[n][k] = *(const PG8_LAS bf16x8*)(lds + PG8_SB(b, h) + boff + n * 2048 + k * 1024); } while (0)
#define PG8_MMA(ai, bj, At, Bt) do { __builtin_amdgcn_s_setprio(1); _Pragma("unroll") for (int m = 0; m < 4; ++m) _Pragma("unroll") for (int n = 0; n < 2; ++n) _Pragma("unroll") for (int k = 0; k < 2; ++k) \
        acc[ai][bj][m][n] = __builtin_amdgcn_mfma_f32_16x16x32_bf16(Bt[n][k], At[m][k], acc[ai][bj][m][n], 0, 0, 0); __builtin_amdgcn_s_setprio(0); } while (0)
#define PG8_WAIT_V(n) asm volatile("s_waitcnt vmcnt(" #n ")" ::: "memory")
#define PG8_WAIT_L(n) asm volatile("s_waitcnt lgkmcnt(" #n ")" ::: "memory")
#define PG8_BAR __builtin_amdgcn_s_barrier()
#define PG8_SCHED __builtin_amdgcn_sched_barrier(0)
    typename Src::Unit cur, nxt; int ui = 0;
    if (!S.next(0, cur)) return;
    f32x4 acc[2][2][4][2];
#pragma unroll
    for (int a = 0; a < 2; ++a)
#pragma unroll
        for (int b = 0; b < 2; ++b)
#pragma unroll
            for (int m = 0; m < 4; ++m)
#pragma unroll
                for (int n = 0; n < 2; ++n) acc[a][b][m][n] = (f32x4){0.f, 0.f, 0.f, 0.f};
    bf16x8 At[4][2], B0[2][2], B1[2][2];
    AO aoC, aoN;
    S.a_off(cur, R0, C0, R1, C1, aoC);
    const char* cB = S.b_base(cur);
    PG8_STAGEB(PG8_SB(0, 0), cB); PG8_STAGEB(PG8_SB(0, 1), cB + hstepB); PG8_STAGEA0(PG8_SA(0, 0), S.a_base(cur, 0), aoC); PG8_STAGEA1(PG8_SA(0, 1), S.a_base(cur, 0), aoC);
    if (wr == 1) PG8_BAR;
    PG8_WAIT_V(2); PG8_BAR;
    PG8_STAGEB(PG8_SB(1, 0), cB + kstep); PG8_STAGEA0(PG8_SA(1, 0), S.a_base(cur, 1), aoC); PG8_STAGEB(PG8_SB(1, 1), cB + hstepB + kstep);
    PG8_WAIT_V(6); PG8_BAR;
    for (;;) {
        const bool has_next = S.next(ui + 1, nxt);
        const char* nB = cB;
        if (has_next) { S.a_off(nxt, R0, C0, R1, C1, aoN); nB = S.b_base(nxt); }
        else aoN = aoC;
        const bool skip1 = S.lo_only(cur);
        for (int t = 0; t < nt; t += 2) {
            const bool last = (t == nt - 2);
            const char* a1 = S.a_base(cur, t + 1);
            const char* a2 = last ? S.a_base(has_next ? nxt : cur, 0) : S.a_base(cur, t + 2);
            const char* a3 = last ? S.a_base(has_next ? nxt : cur, 1) : S.a_base(cur, t + 3);
            const char* b2 = last ? nB : cB + (size_t)(t + 2) * kstep; const char* b3 = b2 + kstep;
            const AO ao2 = last ? aoN : aoC;
            PG8_LDB(B0, 0, 0); PG8_LDB(B1, 0, 1); PG8_SCHED; PG8_LDA(At, 0, 0); PG8_STAGEA1(PG8_SA(1, 1), a1, aoC);
            PG8_WAIT_V(8); PG8_WAIT_L(0); PG8_BAR; PG8_MMA(0, 0, At, B0); PG8_MMA(0, 1, At, B1); PG8_BAR; PG8_SCHED;
            if (!skip1) PG8_LDA(At, 0, 1); PG8_STAGEB(PG8_SB(0, 0), b2); PG8_STAGEB(PG8_SB(0, 1), b2 + hstepB); PG8_STAGEA0(PG8_SA(0, 0), a2, ao2);
            PG8_WAIT_V(8); PG8_WAIT_L(0); PG8_BAR; if (!skip1) { PG8_MMA(1, 0, At, B0); PG8_MMA(1, 1, At, B1); } PG8_BAR; PG8_SCHED;
            PG8_LDB(B0, 1, 0); PG8_LDB(B1, 1, 1); PG8_SCHED; PG8_LDA(At, 1, 0); PG8_STAGEA1(PG8_SA(0, 1), a2, ao2);
            PG8_WAIT_V(8); PG8_WAIT_L(0); PG8_BAR; PG8_MMA(0, 0, At, B0); PG8_MMA(0, 1, At, B1); PG8_BAR; PG8_SCHED;
            if (!skip1) PG8_LDA(At, 1, 1); PG8_STAGEB(PG8_SB(1, 0), b3); PG8_STAGEB(PG8_SB(1, 1), b3 + hstepB); PG8_STAGEA0(PG8_SA(1, 0), a3, ao2);
            PG8_WAIT_V(8); PG8_WAIT_L(0); PG8_BAR; if (!skip1) { PG8_MMA(1, 0, At, B0); PG8_MMA(1, 1, At, B1); } PG8_BAR; PG8_SCHED;
        }
        if (wr == 0) PG8_BAR;
        E(acc, cur, wr, wc, fr, fq);
        if (!has_next) break;
#pragma unroll
        for (int a = 0; a < 2; ++a)
#pragma unroll
            for (int b = 0; b < 2; ++b)
#pragma unroll
                for (int m = 0; m < 4; ++m)
#pragma unroll
                    for (int n = 0; n < 2; ++n) acc[a][b][m][n] = (f32x4){0.f, 0.f, 0.f, 0.f};
        cur = nxt; cB = nB; ++ui; aoC = aoN;
        if (wr == 1) PG8_BAR;
    }
    PG8_WAIT_V(0);
    PG8_BAR;
#undef PG8_SA
#undef PG8_SB
#undef PG8_STAGE2
#undef PG8_STAGEB
#undef PG8_STAGEA0
#undef PG8_STAGEA1
#undef PG8_LDA
#undef PG8_LDB
#undef PG8_MMA
#undef PG8_WAIT_V
#undef PG8_WAIT_L
#undef PG8_BAR
#undef PG8_SCHED
}
struct DenseSrc {
    struct Unit { int pm, pn; };
    const char* A0; const char* A1; const char* Bt; int lda, K, nM, nN, G, c, ksplit;
    __device__ __forceinline__ bool next(int i, Unit& u) const {
        const int nwg = nM * nN; const long L = (long)i * G + c; if (L >= nwg) return false;
        int wgid = (int)L; { const int q = nwg / 8, r = nwg % 8, xcd = wgid % 8, off = wgid / 8; wgid = (xcd < r ? xcd * (q + 1) : r * (q + 1) + (xcd - r) * q) + off; }
        const int nig = 8 * nN, gid = wgid / nig, fm = gid * 8, gsz = (nM - fm) < 8 ? (nM - fm) : 8;
        u.pm = fm + ((wgid % nig) % gsz); u.pn = (wgid % nig) / gsz; return true;
    }
    __device__ __forceinline__ void a_off(const Unit& u, int R0, int C0, int R1, int C1, AO& ao) const {
        ao.h0p0 = (unsigned)(((u.pm * 256 + R0) * lda + C0) * 2); ao.h0p1 = (unsigned)(((u.pm * 256 + R1) * lda + C1) * 2);
        ao.h1p0 = (unsigned)(((u.pm * 256 + 128 + R0) * lda + C0) * 2); ao.h1p1 = (unsigned)(((u.pm * 256 + 128 + R1) * lda + C1) * 2);
    }
    __device__ __forceinline__ const char* a_base(const Unit&, int kt) const { return (kt < ksplit) ? A0 + (size_t)kt * 128 : A1 + (size_t)(kt - ksplit) * 128; }
    __device__ __forceinline__ const char* b_base(const Unit& u) const { return Bt + (size_t)u.pn * 256 * K * 2; }
    __device__ __forceinline__ bool lo_only(const Unit&) const { return false; }
};
}

struct EpiProj {
    static constexpr bool PERM = true;
    bf16_t* O; int ldc;
    __device__ __forceinline__ void operator()(const f32x4 (&acc)[2][2][4][2], const pg8::DenseSrc::Unit& u, int wr, int wc, int fr, int fq) const {
        const int row0 = u.pm * 256 + wr * 64 + fr, col0 = u.pn * 256 + wc * 32 + 8 * fq;
#pragma unroll
        for (int ai = 0; ai < 2; ++ai)
#pragma unroll
            for (int m = 0; m < 4; ++m) { bf16_t* rowp = O + (size_t)(row0 + ai * 128 + m * 16) * ldc + col0;
#pragma unroll
                for (int bj = 0; bj < 2; ++bj) { const f32x4 v0 = acc[ai][bj][m][0], v1 = acc[ai][bj][m][1];
                    *(uint4*)(rowp + bj * 128) = make_uint4(pack2(v0[0], v0[1]), pack2(v0[2], v0[3]), pack2(v1[0], v1[1]), pack2(v1[2], v1[3])); } }
    }
};
__device__ __forceinline__ void ph_gemm1(const P& p, char* smem) {
    const int tid = tid_opaque();
    pg8::DenseSrc S; S.A0 = (const char*)p.out; S.A1 = S.A0; S.Bt = (const char*)(p.ws + WS_WIN); S.lda = ND; S.K = ND; S.nM = NTOK / 256; S.nN = NPROJ / 256; S.G = gridDim.x; S.c = blockIdx.x; S.ksplit = ND / 64;
    EpiProj E; E.O = (bf16_t*)(p.ws + WS_PROJ); E.ldc = NPROJ;
    pg8::gemm_phase(tid, (PG8_LAS unsigned char*)smem, ND, S, E);
}

__device__ __forceinline__ void ph_post(const P& p, char* smem) {
    const int tid = tid_opaque();
    const int lane = tid & 63, wave = tid >> 6;
    const bf16_t* proj = (const bf16_t*)(p.ws + WS_PROJ);
    uint4 rq[8]; unsigned rkv[8]; unsigned rms[8];
#define DN_LOAD(R, J) { _Pragma("unroll") for (int i = 0; i < 11; ++i) { R[i] = 0u; if (t0 - 3 + i >= 0) R[i] = *(const unsigned*)(proj + (size_t)(tok0 - 3 + i) * NPROJ + PC_DNQKV + (J) * 128 + lane * 2); } }
#define POST_LOADS(TG) { _Pragma("unroll") for (int ti = 0; ti < 8; ++ti) { \
            const bf16_t* pr = proj + (size_t)((TG) * 8 + ti) * NPROJ; \
            rq[ti] = *(const uint4*)(pr + PC_QATT + lane * 8); \
            rkv[ti] = *(const unsigned*)(pr + PC_KVLAT + lane * 2); \
            rms[ti] = (lane < 48) ? (unsigned)pr[PC_KIDX + lane] : 0u;            } }
    {
        f32x4 t[8];
        const int ip = tid >> 5, og = tid & 31;
#pragma unroll
        for (int i = 0; i < 4; ++i) { t[2 * i] = *(const f32x4*)(p.w_kv_up + (size_t)(2 * (ip + 16 * i)) * 128 + og * 4); t[2 * i + 1] = *(const f32x4*)(p.w_kv_up + (size_t)(2 * (ip + 16 * i) + 1) * 128 + og * 4); }
        if (blockIdx.x * NWAVES + wave < NTOK / 8) POST_LOADS(blockIdx.x * NWAVES + wave)
#pragma unroll
        for (int i = 0; i < 4; ++i)
#pragma unroll
            for (int c = 0; c < 4; ++c) *(unsigned*)(smem + (og * 4 + c) * 272 + 4 * (ip + 16 * i)) = pack2(t[2 * i][c], t[2 * i + 1][c]);
    }
    __syncthreads();
    char* skvb = smem + 128 * 272 + wave * (8 * 272);
    bf16_t* qn = (bf16_t*)(p.ws + WS_QN); bf16_t* Kb = (bf16_t*)(p.ws + WS_K); bf16_t* kib = (bf16_t*)(p.ws + WS_KI);
    float* wi = (float*)(p.ws + WS_WI); float* dbeta = (float*)(p.ws + WS_DBG); float* dg = dbeta + NTOK * 4;
    bf16_t* dq = (bf16_t*)(p.ws + WS_DQ); bf16_t* dk = (bf16_t*)(p.ws + WS_DK); bf16_t* dkT = (bf16_t*)(p.ws + WS_DKT); bf16_t* dvT = (bf16_t*)(p.ws + WS_DVT);
    bf16_t* Vt = (bf16_t*)(p.ws + WS_VT);
    {
        const int g = blockIdx.x * NTHREADS + tid;
        if (g < NB * 64) { int mn = 0x7fffffff, mx = -0x7fffffff; for (int i = 0; i < 32; ++i) { const int v = p.pos[g * 32 + i]; mn = min(mn, v); mx = max(mx, v); } int* pm = (int*)(p.ws + WS_POSMM); pm[g * 2] = mn; pm[g * 2 + 1] = mx; }
    }
    for (int tg = blockIdx.x * NWAVES + wave; tg < NTOK / 8; tg += gridDim.x * NWAVES) {
        int lane = tid & 63; asm volatile("" : "+v"(lane));
        const int tok0 = tg * 8, t0 = tok0 % NT, bb = tok0 / NT;
        unsigned r0[11], r1[11], r2[11];
#pragma unroll
        for (int ti = 0; ti < 8; ++ti) {
            const int tok = tok0 + ti;
            {
                const unsigned w[4] = {rq[ti].x, rq[ti].y, rq[ti].z, rq[ti].w};
                float v[8]; float ss = 0.f;
#pragma unroll
                for (int j = 0; j < 4; ++j) { v[2 * j] = __uint_as_float(w[j] << 16); v[2 * j + 1] = __uint_as_float(w[j] & 0xffff0000u); }
#pragma unroll
                for (int j = 0; j < 8; ++j) ss += v[j] * v[j];
                ss += dpp_f<0xB1>(ss); ss += dpp_f<0x4E>(ss); ss += dpp_f<0x141>(ss);
                const float rs = rsq_f(ss * (1.f / 64.f) + EPS) * (0.125f * LOG2E);
                unsigned o[4];
#pragma unroll
                for (int j = 0; j < 4; ++j) o[j] = pack2(v[2 * j] * rs * p.q_norm_g[(lane & 7) * 8 + 2 * j], v[2 * j + 1] * rs * p.q_norm_g[(lane & 7) * 8 + 2 * j + 1]);
                *(uint4*)(qn + (size_t)tok * 512 + lane * 8) = make_uint4(o[0], o[1], o[2], o[3]);
            }
            {
                float a0 = __uint_as_float(rkv[ti] << 16), a1 = __uint_as_float(rkv[ti] & 0xffff0000u);
                float ss = wave_sum(a0 * a0 + a1 * a1);
                const float rs = rsq_f(ss * (1.f / 128.f) + EPS);
                a0 *= rs * p.kv_norm_g[lane * 2]; a1 *= rs * p.kv_norm_g[lane * 2 + 1];
                *(unsigned*)(skvb + ti * 272 + lane * 4) = pack2(a0, a1);
            }
            {
                const float raw = bf2f((bf16_t)rms[ti]);
                float a = (lane < 32) ? raw : 0.f;
                const float ss = wave_sum(a * a);
                a *= rsq_f(ss * (1.f / 32.f) + EPS);
                if (lane < 32) kib[(size_t)tok * 32 + lane] = f2bf(a * p.idx_k_norm_g[lane]);
                else if (lane < 40) wi[(size_t)tok * 8 + lane - 32] = raw * 0.35355339059327373f * 0.17677669529663687f;
                else if (lane < 44) dbeta[(size_t)tok * 4 + lane - 40] = sigmoid_f(raw);
                else if (lane < 48) {
                    const float z = raw + p.dt_bias[lane - 44];
                    const float sp = (z > 20.f) ? z : __builtin_amdgcn_logf(1.f + __expf(z)) * 0.6931471805599453f;
                    dg[(size_t)tok * 4 + lane - 44] = -__expf(p.a_log[lane - 44]) * sp;
                }
            }
            __builtin_amdgcn_sched_barrier(0);
        }
        DN_LOAD(r0, 0) DN_LOAD(r1, 1)
        {
            __threadfence_block();
            const int l31 = lane & 31, hf = lane >> 5;
            f32x16 c0, c1, c2, c3;
#pragma unroll
            for (int r = 0; r < 16; ++r) { c0[r] = 0.f; c1[r] = 0.f; c2[r] = 0.f; c3[r] = 0.f; }
            const char* ar = skvb + (l31 & 7) * 272 + 16 * hf; const char* br = smem + l31 * 272 + 16 * hf;
#pragma unroll
            for (int ks = 0; ks < 8; ++ks) {
                const bf16x8 a = *(const bf16x8*)(ar + ks * 32);
                c0 = __builtin_amdgcn_mfma_f32_32x32x16_bf16(a, *(const bf16x8*)(br + ks * 32), c0, 0, 0, 0);
                c1 = __builtin_amdgcn_mfma_f32_32x32x16_bf16(a, *(const bf16x8*)(br + 32 * 272 + ks * 32), c1, 0, 0, 0);
                c2 = __builtin_amdgcn_mfma_f32_32x32x16_bf16(a, *(const bf16x8*)(br + 64 * 272 + ks * 32), c2, 0, 0, 0);
                c3 = __builtin_amdgcn_mfma_f32_32x32x16_bf16(a, *(const bf16x8*)(br + 96 * 272 + ks * 32), c3, 0, 0, 0);
            }
            __threadfence_block();
            const float kg0 = p.k_norm_g[l31], kg1 = p.k_norm_g[32 + l31];
#pragma unroll
            for (int r = 0; r < 4; ++r) {
                float v = c0[r] * c0[r] + c1[r] * c1[r];
                v += dpp_f<0xB1>(v); v += dpp_f<0x4E>(v); v += dpp_f<0x141>(v); v += dpp_f<0x140>(v);
                v += __int_as_float(__builtin_amdgcn_update_dpp(0, __float_as_int(v), 0x142, 0xA, 0xF, false));
                const float slo = __int_as_float(__builtin_amdgcn_readlane(__float_as_int(v), 31)), shi = __int_as_float(__builtin_amdgcn_readlane(__float_as_int(v), 63));
                const float rs = rsq_f((hf ? shi : slo) * (1.f / 64.f) + EPS);
                bf16_t* kd = Kb + (size_t)(tok0 + 4 * hf + r) * 64 + l31;
                kd[0] = f2bf(c0[r] * rs * kg0); kd[32] = f2bf(c1[r] * rs * kg1);
            }
            unsigned pv[4];
#pragma unroll
            for (int r = 0; r < 4; r += 2) {
                auto x0 = __builtin_amdgcn_permlane32_swap(__float_as_uint(c2[r]), __float_as_uint(c2[r]), false, false); auto x1 = __builtin_amdgcn_permlane32_swap(__float_as_uint(c2[r + 1]), __float_as_uint(c2[r + 1]), false, false);
                auto y0 = __builtin_amdgcn_permlane32_swap(__float_as_uint(c3[r]), __float_as_uint(c3[r]), false, false); auto y1 = __builtin_amdgcn_permlane32_swap(__float_as_uint(c3[r + 1]), __float_as_uint(c3[r + 1]), false, false);
                pv[r >> 1] = hf ? pack2(__uint_as_float(y0[0]), __uint_as_float(y1[0])) : pack2(__uint_as_float(x0[0]), __uint_as_float(x1[0]));
                pv[2 + (r >> 1)] = hf ? pack2(__uint_as_float(y0[1]), __uint_as_float(y1[1])) : pack2(__uint_as_float(x0[1]), __uint_as_float(x1[1]));
            }
            *(uint4*)(Vt + ((size_t)bb * 64 + 32 * hf + l31) * NT + t0) = make_uint4(pv[0], pv[1], pv[2], pv[3]);
        }
#define DN_COMP(R, J) { \
            const int j = (J); const int ch = j * 128 + lane * 2; \
            float c0[4], c1[4]; \
            _Pragma("unroll") for (int tap = 0; tap < 4; ++tap) { c0[tap] = p.conv_w[tap * 1536 + ch]; c1[tap] = p.conv_w[tap * 1536 + ch + 1]; } \
            float y0[8], y1[8]; \
            _Pragma("unroll") for (int i = 0; i < 8; ++i) { \
                float a0 = 0.f, a1 = 0.f; \
                _Pragma("unroll") for (int tap = 0; tap < 4; ++tap) { a0 += c0[tap] * __uint_as_float(R[i + tap] << 16); a1 += c1[tap] * __uint_as_float(R[i + tap] & 0xffff0000u); } \
                y0[i] = silu_f(a0); y1[i] = silu_f(a1); \
                if (j < 8) { \
                    const float ss = wave_sum(y0[i] * y0[i] + y1[i] * y1[i]); \
                    float rs = rsq_f(ss + EPS); \
                    if (j < 4) rs *= 0.08838834764831845f;      \
                    y0[i] *= rs; y1[i] *= rs; \
                } \
            } \
            if (j < 8) { \
                bf16_t* dst = (j < 4) ? dq : dk; \
                _Pragma("unroll") for (int i = 0; i < 8; ++i) *(unsigned*)(dst + (size_t)(tok0 + i) * 512 + (j & 3) * 128 + lane * 2) = pack2(y0[i], y1[i]); \
            } \
            if (j >= 4) { \
                bf16_t* dstT = ((j < 8) ? dkT : dvT) + ((size_t)(bb * 4 + (j & 3)) * 128 + lane * 2) * NT + t0; \
                *(uint4*)dstT = make_uint4(pack2(y0[0], y0[1]), pack2(y0[2], y0[3]), pack2(y0[4], y0[5]), pack2(y0[6], y0[7])); \
                *(uint4*)(dstT + NT) = make_uint4(pack2(y1[0], y1[1]), pack2(y1[2], y1[3]), pack2(y1[4], y1[5]), pack2(y1[6], y1[7])); \
            } }
        {
#pragma unroll 1
            for (int jg = 0; jg < 4; ++jg) {
                DN_LOAD(r2, jg * 3 + 2) DN_COMP(r0, jg * 3)
                if (jg < 3) DN_LOAD(r0, jg * 3 + 3)
                DN_COMP(r1, jg * 3 + 1)
                if (jg < 3) DN_LOAD(r1, jg * 3 + 4)
                DN_COMP(r2, jg * 3 + 2)
            }
        }
        if (tg + gridDim.x * NWAVES < NTOK / 8) POST_LOADS(tg + gridDim.x * NWAVES)
    }
#undef DN_LOAD
#undef DN_COMP
#undef POST_LOADS
}

__device__ __forceinline__ unsigned f2sortable(float f) { const unsigned u = __float_as_uint(f); return (u & 0x80000000u) ? ~u : (u | 0x80000000u); }
__device__ __forceinline__ float sum8_f(float v) { v += dpp_f<0xB1>(v); v += dpp_f<0x4E>(v); v += dpp_f<0x141>(v); return v; }
__device__ __forceinline__ int sum16_i(int v) { v += dpp_i<0xB1>(v); v += dpp_i<0x4E>(v); v += dpp_i<0x141>(v); v += __shfl_xor(v, 32); return v; }
__device__ __forceinline__ int pi32(int r) { return (r & 0x13) | ((r & 4) << 1) | ((r & 8) >> 1); }
__device__ __forceinline__ constexpr int key_of_reg(int r) { return (r & 3) + 4 * ((r >> 2) & 1) + 16 * (r >> 3); }
struct KiFrag { bf16x8 a0, a1; };
__device__ __forceinline__ float xhalf_sum(float v) { auto rr = __builtin_amdgcn_permlane32_swap(__float_as_uint(v), __float_as_uint(v), false, false); return __uint_as_float(rr[0]) + __uint_as_float(rr[1]); }
__device__ __forceinline__ void idx_scores4(float (&sc)[4], const KiFrag& f, bf16x8 qi0, bf16x8 qi1, const float* wvp) {
    f32x4 wq[4];
#pragma unroll
    for (int q = 0; q < 4; ++q) wq[q] = *(const f32x4*)(wvp + 4 * q);
    f32x16 z;
#pragma unroll
    for (int r = 0; r < 16; ++r) z[r] = 0.f;
    z = __builtin_amdgcn_mfma_f32_32x32x16_bf16(qi0, f.a0, z, 0, 0, 0);
    z = __builtin_amdgcn_mfma_f32_32x32x16_bf16(qi1, f.a1, z, 0, 0, 0);
#pragma unroll
    for (int q = 0; q < 4; ++q) {
        float a = wq[q][0] * relu_f(z[4 * q]);
        a += wq[q][1] * relu_f(z[4 * q + 1]);
        a += wq[q][2] * relu_f(z[4 * q + 2]);
        a += wq[q][3] * relu_f(z[4 * q + 3]);
        sc[q] = xhalf_sum(a);
    }
}
constexpr int AT_SBL = 0, AT_POSMAX = 4352, AT_ITEM = 6400, AT_WV = 6656, AT_BUF = 7680;
constexpr int AT_KI_ROW = 80, AT_P1_BUF = 256 * AT_KI_ROW;
constexpr int AT2_K = 0, AT2_VT = 128 * 144, AT2_KI = AT2_VT + 64 * 272, AT2_PK = AT2_KI + 128 * AT_KI_ROW, AT2_BUF = AT2_PK + 512;
constexpr int AT_MASK = AT_BUF + 2 * (AT_P1_BUF > AT2_BUF ? AT_P1_BUF : AT2_BUF);
constexpr int ATTM_LDS = AT_MASK + NWAVES * 1024;
__device__ __forceinline__ KiFrag ki_lds(const char* buf, int row, int hf) {
    KiFrag f; const char* r = buf + row * AT_KI_ROW + 16 * hf;
    f.a0 = *(const bf16x8*)r; f.a1 = *(const bf16x8*)(r + 32); return f;
}
struct SelQ { float tau[4]; int cut[4]; };
struct IdxOps { bf16x8 qi0, qi1; const float* wvp; };
__device__ __forceinline__ IdxOps idx_ops(const P& p, char* smem, int b, int t0, int lane) {
    const int hf = lane >> 5, cq = (lane & 31) >> 3, ch = lane & 7;
    const int tok = b * NT + t0 + cq;
    const bf16_t* proj = (const bf16_t*)(p.ws + WS_PROJ);
    IdxOps o;
    o.qi0 = *(const bf16x8*)(proj + (size_t)tok * NPROJ + PC_QIDX + ch * 32 + 8 * hf);
    o.qi1 = *(const bf16x8*)(proj + (size_t)tok * NPROJ + PC_QIDX + ch * 32 + 16 + 8 * hf);
    float* wslot = (float*)(smem + AT_WV) + (lane >> 6) * 0;
    const float* wi = (const float*)(p.ws + WS_WI) + (size_t)(b * NT + t0) * 8;
    if ((lane & 31) < 16) { const int r = lane & 15; wslot[hf * 16 + r] = wi[(r >> 2) * 8 + 4 * hf + (r & 3)]; }
    __threadfence_block();
    o.wvp = wslot + hf * 16;
    return o;
}
__device__ __forceinline__ void attn_pass1(const P& p, char* smem, int b, int tb, int tid, SelQ& sel) {
    const int lane = tid & 63, wave = tid >> 6;
    const int hf = lane >> 5, l31 = lane & 31;
    const int t0 = tb * 32 + wave * 4;
    const bf16_t* ki_b = (const bf16_t*)(p.ws + WS_KI) + (size_t)b * NT * 32;
    const IdxOps io = idx_ops(p, smem + wave * 128, b, t0, lane);
    char* bufs = smem + AT_BUF;
    unsigned u[32][4];
#pragma unroll
    for (int s = 0; s < 32; ++s)
#pragma unroll
        for (int q = 0; q < 4; ++q) u[s][q] = 0x007fffffu;
    {
#pragma unroll
        for (int i = 0; i < 2; ++i) { const int x = tid + 512 * i; *(uint4*)(bufs + (x >> 2) * AT_KI_ROW + (x & 3) * 16) = *(const uint4*)(ki_b + (size_t)(x >> 2) * 32 + (x & 3) * 8); }
    }
    __syncthreads();
#pragma unroll
    for (int g = 0; g < 8; ++g) {
        if (g * 8 <= tb) {
            const bool more = (g + 1) * 8 <= tb;
            uint4 n0 = make_uint4(0, 0, 0, 0), n1 = n0;
            if (more) {
                n0 = *(const uint4*)(ki_b + (size_t)((g + 1) * 256 + (tid >> 2)) * 32 + (tid & 3) * 8);
                n1 = *(const uint4*)(ki_b + (size_t)((g + 1) * 256 + 128 + (tid >> 2)) * 32 + (tid & 3) * 8);
            }
            const char* buf = bufs + (g & 1) * AT_P1_BUF;
#pragma unroll
            for (int kk = 0; kk < 8; ++kk) {
                const int kt = g * 8 + kk;
                if (kt <= tb) {
                    const KiFrag f = ki_lds(buf, kk * 32 + l31, hf);
                    float sc[4];
                    idx_scores4(sc, f, io.qi0, io.qi1, io.wvp);
                    if (kt == tb) {
#pragma unroll
                        for (int q = 0; q < 4; ++q) sc[q] = (kt * 32 + l31 <= t0 + q) ? sc[q] : -INFINITY;
                    }
#pragma unroll
                    for (int q = 0; q < 4; ++q) u[kt >> 1][q] = (hf == (kt & 1)) ? f2sortable(sc[q]) : u[kt >> 1][q];
                    __builtin_amdgcn_sched_barrier(0);
                }
            }
            if (more) {
                char* nb = bufs + ((g + 1) & 1) * AT_P1_BUF;
                *(uint4*)(nb + (tid >> 2) * AT_KI_ROW + (tid & 3) * 16) = n0;
                *(uint4*)(nb + (128 + (tid >> 2)) * AT_KI_ROW + (tid & 3) * 16) = n1;
            }
            __syncthreads();
        }
    }
    unsigned prefix[4] = {0u, 0u, 0u, 0u}; bool exact[4] = {false, false, false, false};
    for (int bit = 31; bit >= 0; --bit) {
        unsigned cand[4];
#pragma unroll
        for (int q = 0; q < 4; ++q) cand[q] = prefix[q] | (1u << bit);
        int c0 = 0, c1 = 0, c2 = 0, c3 = 0;
#pragma unroll
        for (int g8 = 0; g8 < 4; ++g8) {
            if (g8 * 16 <= tb) {
#pragma unroll
                for (int s = g8 * 8; s < g8 * 8 + 8; ++s)
                    asm volatile("v_cmp_ge_u32_e64 s[70:71], %4, %8\n\tv_cmp_ge_u32_e64 s[72:73], %5, %9\n\tv_cmp_ge_u32_e64 s[74:75], %6, %10\n\tv_cmp_ge_u32_e64 s[76:77], %7, %11\n\t"
                                 "v_addc_co_u32_e64 %0, s[70:71], 0, %0, s[70:71]\n\tv_addc_co_u32_e64 %1, s[72:73], 0, %1, s[72:73]\n\tv_addc_co_u32_e64 %2, s[74:75], 0, %2, s[74:75]\n\tv_addc_co_u32_e64 %3, s[76:77], 0, %3, s[76:77]"
                                 : "+v"(c0), "+v"(c1), "+v"(c2), "+v"(c3)
                                 : "v"(u[s][0]), "v"(u[s][1]), "v"(u[s][2]), "v"(u[s][3]), "s"(cand[0]), "s"(cand[1]), "s"(cand[2]), "s"(cand[3])
                                 : "s70", "s71", "s72", "s73", "s74", "s75", "s76", "s77");
            }
        }
        int cnt[4] = {c0, c1, c2, c3};
#pragma unroll
        for (int q = 0; q < 4; ++q) { int v = cnt[q]; v += dpp_i<0xB1>(v); v += dpp_i<0x4E>(v); v += dpp_i<0x141>(v); v += dpp_i<0x140>(v);
            v += __builtin_amdgcn_update_dpp(0, v, 0x142, 0xA, 0xF, false); v += __builtin_amdgcn_update_dpp(0, v, 0x143, 0xC, 0xF, false); cnt[q] = __builtin_amdgcn_readlane(v, 63); }
#pragma unroll
        for (int q = 0; q < 4; ++q) {
            const int cq_ = cnt[q];
            if (!exact[q] && cq_ >= 256) { prefix[q] = cand[q]; if (cq_ == 256) exact[q] = true; }
        }
        if (exact[0] && exact[1] && exact[2] && exact[3]) break;
    }
#pragma unroll
    for (int q = 0; q < 4; ++q) {
        int cutq = 0x7fffffff;
        if (!exact[q]) {
            const unsigned pf = prefix[q];
            int ngt = 0, neq = 0;
#pragma unroll
            for (int s = 0; s < 32; ++s)
                { ngt += __builtin_popcountll(__ballot(u[s][q] > pf)); neq += __builtin_popcountll(__ballot(u[s][q] == pf)); }
            const int need = 256 - ngt;
            if (need < neq) {
                int lo = 0, hi = NT - 1;
                for (int it = 0; it < 11; ++it) {
                    const int mid = (lo + hi) >> 1;
                    int cnt = 0;
#pragma unroll
                    for (int s = 0; s < 32; ++s)
                        cnt += __builtin_popcountll(__ballot(u[s][q] == pf && ((2 * s + hf) * 32 + l31) <= mid));
                    if (cnt >= need) hi = mid; else lo = mid + 1;
                }
                cutq = lo;
            }
        }
        sel.tau[q] = __uint_as_float((prefix[q] & 0x80000000u) ? (prefix[q] & 0x7fffffffu) : ~prefix[q]);
        sel.cut[q] = cutq;
    }
    {
        unsigned* mw = (unsigned*)(smem + AT_MASK) + wave * 256;
        int mv[4] = {0, 0, 0, 0};
        int cutu[4], t0u = __builtin_amdgcn_readfirstlane(t0);
#pragma unroll
        for (int q = 0; q < 4; ++q) cutu[q] = __builtin_amdgcn_readfirstlane(sel.cut[q]);
#pragma unroll
        for (int g8 = 0; g8 < 4; ++g8) {
            if (g8 * 16 <= tb) {
#pragma unroll
                for (int s = g8 * 8; s < g8 * 8 + 8; ++s)
#pragma unroll
                    for (int q = 0; q < 4; ++q) {
                        const unsigned uu = u[s][q];
                        const int xc = cutu[q] - s * 64, xt = t0u + q - s * 64;
                        const unsigned long long lc = (xc >= 63) ? ~0ull : ((xc < 0) ? 0ull : ((2ull << xc) - 1ull)), ca = (xt >= 63) ? ~0ull : ((xt < 0) ? 0ull : ((2ull << xt) - 1ull));
                        unsigned long long nb;
                        if (xc >= 63 && xt >= 63) nb = ~__ballot(uu >= prefix[q]);
                        else nb = ~((__ballot(uu > prefix[q]) | (__ballot(uu == prefix[q]) & lc)) & ca);
                        asm volatile("s_nop 1\n\tv_writelane_b32 %0, %1, %3\n\tv_writelane_b32 %0, %2, %4" : "+v"(mv[g8]) : "s"((unsigned)nb), "s"((unsigned)(nb >> 32)), "n"((s & 7) * 8 + q), "n"((s & 7) * 8 + 4 + q));
                    }
                mw[g8 * 64 + lane] = (unsigned)mv[g8];
            }
        }
    }
}
__device__ __forceinline__ float xhalf_max(float v) { auto rr = __builtin_amdgcn_permlane32_swap(__float_as_uint(v), __float_as_uint(v), false, false); return fmaxf(__uint_as_float(rr[0]), __uint_as_float(rr[1])); }
__device__ __forceinline__ void attn_pass2(const P& p, char* smem, int b, int tb, int tid, const SelQ& sel) {
    const int lane = tid & 63, wave = tid >> 6;
    const int hf = lane >> 5, l31 = lane & 31, cq = l31 >> 3, ch = lane & 7, prow = pi32(l31);
    const int t0 = tb * 32 + wave * 4, tq = t0 + cq, tok = b * NT + tq;
    bf16_t* qn = (bf16_t*)(p.ws + WS_QN);
    const bf16_t* ki_b = (const bf16_t*)(p.ws + WS_KI) + (size_t)b * NT * 32;
    const bf16_t* K_b = (const bf16_t*)(p.ws + WS_K) + (size_t)b * NT * 64;
    const bf16_t* Vt_b = (const bf16_t*)(p.ws + WS_VT) + (size_t)b * 64 * NT;
    const float* sbl = (const float*)(smem + AT_SBL); const int* posmax = (const int*)(smem + AT_POSMAX) + b * 64;
    char* bufs = smem + AT_BUF;
    const unsigned* mw = (const unsigned*)(smem + AT_MASK) + wave * 256;
    bf16x8 qb[4];
#pragma unroll
    for (int ks = 0; ks < 4; ++ks) qb[ks] = *(const bf16x8*)(qn + (size_t)tok * 512 + ch * 64 + ks * 16 + 8 * hf);
    const int pq = p.pos[tok];
    int pqmin = pq;
    pqmin = min(pqmin, __shfl_xor(pqmin, 8)); pqmin = min(pqmin, __shfl_xor(pqmin, 16));
    pqmin = __builtin_amdgcn_readfirstlane(pqmin);
    const float bias_far = sbl[128 * 8 + ch];
    f32x16 o0, o1;
#pragma unroll
    for (int r = 0; r < 16; ++r) { o0[r] = 0.f; o1[r] = 0.f; }
    float m = 0.f, l = 0.f;
    const unsigned bh_ = pack2(bias_far, 0.f) & 0xffffu, bl_ = pack2(bias_far - __uint_as_float(bh_ << 16), 0.f) & 0xffffu;
    const unsigned one_ = 0x3F80u;
    const unsigned sbw0 = (hf == 0 && cq == 0) ? one_ : ((hf == 0 && cq == 1) ? (one_ << 16) : 0u), sbw1 = (hf == 0 && cq == 2) ? one_ : ((hf == 0 && cq == 3) ? (one_ << 16) : 0u);
    unsigned sbw2 = hf ? 0u : (bh_ << 16); const unsigned sbw3 = hf ? 0u : bl_;
    const unsigned aw2_near = hf ? 0u : 0x3F80u, aw2_far = hf ? 0u : 0x3F803F80u, aw3_far = hf ? 0u : 0x3F80u;
    f32x16 zero16;
#pragma unroll
    for (int r = 0; r < 16; ++r) zero16[r] = 0.f;
    const int nt128 = (tb + 4) >> 2;
    uint4 rk0, rk1, rv0, rv1; int rpos = 0;
#define AT_LOAD(j) { const int kb_ = (j) * 128; \
        rk0 = *(const uint4*)(K_b + (size_t)(kb_ + (tid >> 3)) * 64 + (tid & 7) * 8); rk1 = *(const uint4*)(K_b + (size_t)(kb_ + 64 + (tid >> 3)) * 64 + (tid & 7) * 8); \
        rv0 = *(const uint4*)(Vt_b + (size_t)(tid >> 4) * NT + kb_ + (tid & 15) * 8); rv1 = *(const uint4*)(Vt_b + (size_t)(32 + (tid >> 4)) * NT + kb_ + (tid & 15) * 8); \
        if (tid < 128) rpos = p.pos[b * NT + kb_ + tid]; }
#define AT_STORE(bp) { char* sb_ = (bp); \
        *(uint4*)(sb_ + AT2_K + (tid >> 3) * 144 + (tid & 7) * 16) = rk0; *(uint4*)(sb_ + AT2_K + (64 + (tid >> 3)) * 144 + (tid & 7) * 16) = rk1; \
        *(uint4*)(sb_ + AT2_VT + (tid >> 4) * 272 + (tid & 15) * 16) = rv0; *(uint4*)(sb_ + AT2_VT + (32 + (tid >> 4)) * 272 + (tid & 15) * 16) = rv1; \
        if (tid < 128) ((int*)(sb_ + AT2_PK))[tid] = rpos; }
    AT_LOAD(0) AT_STORE(bufs)
    __syncthreads();
#pragma unroll 1
    for (int j = 0; j < nt128; ++j) {
        if (j + 1 < nt128) AT_LOAD(j + 1)
        const char* buf = bufs + (j & 1) * AT2_BUF;
#pragma unroll
        for (int st = 0; st < 2; ++st) {
            const int kt0 = 4 * j + 2 * st;
            if (kt0 <= tb) {
                const bool have1 = (kt0 + 1 <= tb);
                const int krow = st * 64;
                f32x16 s0, s1;
                const bool far0 = (pqmin - posmax[kt0] >= 128);
                const uint4 nlo = *(const uint4*)(mw + (kt0 >> 1) * 8), nhi = *(const uint4*)(mw + (kt0 >> 1) * 8 + 4);
                bf16x8 am0, am1;
                {
                    const unsigned v0 = (unsigned)__builtin_amdgcn_sbfe((int)nlo.x, prow, 1) & 0xC6EAu, v1 = (unsigned)__builtin_amdgcn_sbfe((int)nlo.y, prow, 1) & 0xC6EAu;
                    const unsigned v2 = (unsigned)__builtin_amdgcn_sbfe((int)nlo.z, prow, 1) & 0xC6EAu, v3 = (unsigned)__builtin_amdgcn_sbfe((int)nlo.w, prow, 1) & 0xC6EAu;
                    unsigned a01 = v0 | (v1 << 16), a23 = v2 | (v3 << 16);
                    if (hf) { a01 = 0u; a23 = 0u; }
                    union { uint4 u; bf16x8 f; } cv; cv.u = make_uint4(a01, a23, far0 ? aw2_far : aw2_near, far0 ? aw3_far : 0u); am0 = cv.f;
                }
                bf16x8 selB; { union { uint4 u; bf16x8 f; } cv; cv.u = make_uint4(sbw0, sbw1, sbw2, sbw3); selB = cv.f; }
                s0 = __builtin_amdgcn_mfma_f32_32x32x16_bf16(am0, selB, zero16, 0, 0, 0);
                {
                    const char* kr = buf + AT2_K + (krow + prow) * 144 + 16 * hf;
#pragma unroll
                    for (int ks = 0; ks < 4; ++ks) s0 = __builtin_amdgcn_mfma_f32_32x32x16_bf16(*(const bf16x8*)(kr + ks * 32), qb[ks], s0, 0, 0, 0);
                }
                bool far1 = true;
                if (have1) {
                    far1 = (pqmin - posmax[kt0 + 1] >= 128);
                    const unsigned v0 = (unsigned)__builtin_amdgcn_sbfe((int)nhi.x, prow, 1) & 0xC6EAu, v1 = (unsigned)__builtin_amdgcn_sbfe((int)nhi.y, prow, 1) & 0xC6EAu;
                    const unsigned v2 = (unsigned)__builtin_amdgcn_sbfe((int)nhi.z, prow, 1) & 0xC6EAu, v3 = (unsigned)__builtin_amdgcn_sbfe((int)nhi.w, prow, 1) & 0xC6EAu;
                    unsigned a01 = v0 | (v1 << 16), a23 = v2 | (v3 << 16);
                    if (hf) { a01 = 0u; a23 = 0u; }
                    union { uint4 u; bf16x8 f; } cv; cv.u = make_uint4(a01, a23, far1 ? aw2_far : aw2_near, far1 ? aw3_far : 0u); am1 = cv.f;
                    s1 = __builtin_amdgcn_mfma_f32_32x32x16_bf16(am1, selB, zero16, 0, 0, 0);
                    const char* kr = buf + AT2_K + (krow + 32 + prow) * 144 + 16 * hf;
#pragma unroll
                    for (int ks = 0; ks < 4; ++ks) s1 = __builtin_amdgcn_mfma_f32_32x32x16_bf16(*(const bf16x8*)(kr + ks * 32), qb[ks], s1, 0, 0, 0);
                } else {
#pragma unroll
                    for (int r = 0; r < 16; ++r) s1[r] = -60000.f;
                }
                if (!far0) {
                    const int* pk = (const int*)(buf + AT2_PK) + krow + 8 * hf;
#pragma unroll
                    for (int r = 0; r < 16; ++r) { int n = pq - pk[key_of_reg(r)]; n = n < 0 ? 0 : (n > 128 ? 128 : n); s0[r] += sbl[n * 8 + ch]; }
                }
                if (!far1) {
                    const int* pk = (const int*)(buf + AT2_PK) + krow + 32 + 8 * hf;
#pragma unroll
                    for (int r = 0; r < 16; ++r) { int n = pq - pk[key_of_reg(r)]; n = n < 0 ? 0 : (n > 128 ? 128 : n); s1[r] += sbl[n * 8 + ch]; }
                }
                float mx = __builtin_amdgcn_fmed3f(s0[0], s1[0], __builtin_inff());
#pragma unroll
                for (int r = 1; r < 16; ++r) mx = __builtin_amdgcn_fmed3f(mx, __builtin_amdgcn_fmed3f(s0[r], s1[r], __builtin_inff()), __builtin_inff());
                mx = xhalf_max(mx);
                const bool first = (j == 0 && st == 0);
                if (first || !__all(mx <= 8.f)) {
                    const float mtrue = mx + m;
                    float mnew = first ? mtrue : fmaxf(m, mtrue);
                    mnew = __uint_as_float(pack2(mnew, 0.f) << 16);
                    const float alpha = first ? 0.f : __builtin_amdgcn_exp2f(m - mnew);
                    const float dsh = mnew - m;
                    m = mnew; l *= alpha;
#pragma unroll
                    for (int r = 0; r < 16; ++r) { o0[r] *= alpha; o1[r] *= alpha; s0[r] -= dsh; s1[r] -= dsh; }
                    sbw2 = hf ? 0u : (((__float_as_uint(mnew) >> 16) ^ 0x8000u) | (bh_ << 16));
                }
                float ps = 0.f;
#pragma unroll
                for (int r = 0; r < 16; ++r) { s0[r] = __builtin_amdgcn_exp2f(s0[r]); s1[r] = __builtin_amdgcn_exp2f(s1[r]); ps += s0[r] + s1[r]; }
                l += ps;
                union { uint4 u; bf16x8 f; } pb0, pb1, pb2, pb3;
                pb0.u = make_uint4(pack2(s0[0], s0[1]), pack2(s0[2], s0[3]), pack2(s0[4], s0[5]), pack2(s0[6], s0[7]));
                pb1.u = make_uint4(pack2(s0[8], s0[9]), pack2(s0[10], s0[11]), pack2(s0[12], s0[13]), pack2(s0[14], s0[15]));
                pb2.u = make_uint4(pack2(s1[0], s1[1]), pack2(s1[2], s1[3]), pack2(s1[4], s1[5]), pack2(s1[6], s1[7]));
                pb3.u = make_uint4(pack2(s1[8], s1[9]), pack2(s1[10], s1[11]), pack2(s1[12], s1[13]), pack2(s1[14], s1[15]));
                const char* vr = buf + AT2_VT + l31 * 272 + st * 128 + 16 * hf;
                o0 = __builtin_amdgcn_mfma_f32_32x32x16_bf16(*(const bf16x8*)vr, pb0.f, o0, 0, 0, 0);
                o1 = __builtin_amdgcn_mfma_f32_32x32x16_bf16(*(const bf16x8*)(vr + 32 * 272), pb0.f, o1, 0, 0, 0);
                o0 = __builtin_amdgcn_mfma_f32_32x32x16_bf16(*(const bf16x8*)(vr + 32), pb1.f, o0, 0, 0, 0);
                o1 = __builtin_amdgcn_mfma_f32_32x32x16_bf16(*(const bf16x8*)(vr + 32 * 272 + 32), pb1.f, o1, 0, 0, 0);
                o0 = __builtin_amdgcn_mfma_f32_32x32x16_bf16(*(const bf16x8*)(vr + 64), pb2.f, o0, 0, 0, 0);
                o1 = __builtin_amdgcn_mfma_f32_32x32x16_bf16(*(const bf16x8*)(vr + 32 * 272 + 64), pb2.f, o1, 0, 0, 0);
                o0 = __builtin_amdgcn_mfma_f32_32x32x16_bf16(*(const bf16x8*)(vr + 96), pb3.f, o0, 0, 0, 0);
                o1 = __builtin_amdgcn_mfma_f32_32x32x16_bf16(*(const bf16x8*)(vr + 32 * 272 + 96), pb3.f, o1, 0, 0, 0);
            }
        }
        if (j + 1 < nt128) AT_STORE(bufs + ((j + 1) & 1) * AT2_BUF)
        __syncthreads();
    }
#undef AT_LOAD
#undef AT_STORE
    l += __shfl_xor(l, 32);
    const float inv = 1.f / l;
    bf16_t* orow = qn + (size_t)tok * 512 + ch * 64;
#pragma unroll
    for (int gq = 0; gq < 4; ++gq) {
        *(uint2*)(orow + gq * 8 + 4 * hf) = make_uint2(pack2(o0[gq * 4] * inv, o0[gq * 4 + 1] * inv), pack2(o0[gq * 4 + 2] * inv, o0[gq * 4 + 3] * inv));
        *(uint2*)(orow + 32 + gq * 8 + 4 * hf) = make_uint2(pack2(o1[gq * 4] * inv, o1[gq * 4 + 1] * inv), pack2(o1[gq * 4 + 2] * inv, o1[gq * 4 + 3] * inv));
    }
}
__device__ __forceinline__ void dn_scan_block(const P& p, char* smem, int bh, int tid);
template <int MODE>
__device__ __forceinline__ void ph_attn_mfma(const P& p, char* smem) {
    const int tid = tid_opaque();
    float* sbl = (float*)(smem + AT_SBL);
    for (int i = tid; i < 129 * 8; i += NTHREADS) {
        const int n = i >> 3, h = i & 7; int bk;
        if (n < 16) bk = n;
        else { const float v = logf((float)n / 16.f) / 2.0794415416798357f * 16.f; bk = 16 + (int)v; if (bk > 31) bk = 31; }
        sbl[i] = p.rel_bias[bk * 8 + h] * LOG2E;
    }
    ((int*)(smem + AT_POSMAX))[tid] = ((const int*)(p.ws + WS_POSMM))[tid * 2 + 1];
    __syncthreads();
    if (MODE != 2 && blockIdx.x < NB * 4) {
        int tid0 = tid; asm volatile("" : "+v"(tid0));
        dn_scan_block(p, smem + AT_BUF, blockIdx.x, tid0);
        __syncthreads();
        {
            const int bh = blockIdx.x, b = bh >> 2, hh = bh & 3;
            const bf16_t* dnoh = (const bf16_t*)((const unsigned char*)p.out + DO_DNO) + (size_t)b * NT * 512 + hh * 128 + (tid0 & 3) * 32;
            const bf16_t* zh = (const bf16_t*)(p.ws + WS_PROJ) + (size_t)b * NT * NPROJ + PC_DNZ + hh * 128 + (tid0 & 3) * 32;
            bf16_t* dnnh = (bf16_t*)(p.ws + WS_DK) + (size_t)b * NT * 512 + hh * 128 + (tid0 & 3) * 32;
            float gn[32];
#pragma unroll
            for (int i = 0; i < 32; ++i) gn[i] = p.dn_norm_g[(tid0 & 3) * 32 + i];
#pragma unroll 2
            for (int it = 0; it < NT / 128; ++it) {
                const int trow = it * 128 + (tid0 >> 2);
                const uint4* op_ = (const uint4*)(dnoh + (size_t)trow * 512); const uint4* zp_ = (const uint4*)(zh + (size_t)trow * NPROJ); uint4* dp_ = (uint4*)(dnnh + (size_t)trow * 512);
                uint4 ov[4], zv[4];
#pragma unroll
                for (int i = 0; i < 4; ++i) { ov[i] = op_[i]; zv[i] = zp_[i]; }
                float ss = 0.f;
#pragma unroll
                for (int i = 0; i < 4; ++i) { const unsigned w_[4] = {ov[i].x, ov[i].y, ov[i].z, ov[i].w};
#pragma unroll
                    for (int j = 0; j < 4; ++j) { const float a_ = __uint_as_float(w_[j] << 16), b_ = __uint_as_float(w_[j] & 0xffff0000u); ss += a_ * a_ + b_ * b_; } }
                ss += dpp_f<0xB1>(ss); ss += dpp_f<0x4E>(ss);
                const float rs = rsq_f(ss * (1.f / 128.f) + EPS);
#pragma unroll
                for (int i = 0; i < 4; ++i) { const unsigned w_[4] = {ov[i].x, ov[i].y, ov[i].z, ov[i].w}; const unsigned y_[4] = {zv[i].x, zv[i].y, zv[i].z, zv[i].w}; unsigned r_[4];
#pragma unroll
                    for (int j = 0; j < 4; ++j) { const int col = i * 8 + j * 2;
                        const float a_ = __uint_as_float(w_[j] << 16), b_ = __uint_as_float(w_[j] & 0xffff0000u), za_ = __uint_as_float(y_[j] << 16), zb_ = __uint_as_float(y_[j] & 0xffff0000u);
                        r_[j] = pack2(a_ * rs * gn[col] * silu_f(za_), b_ * rs * gn[col + 1] * silu_f(zb_)); }
                    dp_[i] = make_uint4(r_[0], r_[1], r_[2], r_[3]); }
            }
        }
    }
    int* qctr = (int*)(p.ws + WS_CTL) + 64;
    int* cctr = (int*)(p.ws + WS_CTL) + 96;
    if (MODE != 1) for (;;) {
        int tid1 = tid; asm volatile("" : "+v"(tid1));
        if (tid1 == 0) { const int it_ = atomicAdd(qctr, 1); ((int*)(smem + AT_ITEM))[0] = it_; if (it_ < NB * 64) { const int n_ = (it_ < 224) ? 1 : 0;   ((int*)(smem + AT_ITEM))[1] = atomicAdd(cctr, n_); ((int*)(smem + AT_ITEM))[2] = n_; } }
        __syncthreads();
        const int item = ((const int*)(smem + AT_ITEM))[0];
        if (item >= NB * 64) break;
        const int cbase = ((const int*)(smem + AT_ITEM))[1], cnum = ((const int*)(smem + AT_ITEM))[2];
        const int b = item & 7, tb = 63 - (item >> 3);
        SelQ sel;
#pragma unroll
        for (int q = 0; q < 4; ++q) { sel.tau[q] = -INFINITY; sel.cut[q] = 0x7fffffff; }
        if (tb >= 8) attn_pass1(p, smem, b, tb, tid1, sel);
        else {
            const int lane_ = tid1 & 63, wave_ = tid1 >> 6, t0_ = tb * 32 + wave_ * 4;
            unsigned* mw = (unsigned*)(smem + AT_MASK) + wave_ * 256;
            const int s_ = lane_ >> 3, hq = lane_ & 7, xt = t0_ + (hq & 3) - s_ * 64 - (hq >> 2) * 32;
            mw[lane_] = (xt >= 31) ? 0u : ((xt < 0) ? ~0u : ~((2u << xt) - 1u));
        }
        int tid2 = tid; asm volatile("" : "+v"(tid2));
        attn_pass2(p, smem, b, tb, tid2, sel);
        {
            int tid3 = tid; asm volatile("" : "+v"(tid3));
#pragma unroll 1
            for (int r = 0; r < cnum; ++r) if (cbase + r < CV_LATE) conv_tile_index(p, tid3 & 63, CV_T0 + CV_PREP + (cbase + r) * NWAVES + (tid3 >> 6));
        }
    }
    for (;;) {
        int tid1 = tid; asm volatile("" : "+v"(tid1));
        __syncthreads();
        if (tid1 == 0) ((int*)(smem + AT_ITEM))[1] = atomicAdd(cctr, 1);
        __syncthreads();
        const int ci = ((const int*)(smem + AT_ITEM))[1];
        if (ci >= CV_LATE) break;
        conv_tile_index(p, tid1 & 63, CV_T0 + CV_PREP + ci * NWAVES + (tid1 >> 6));
    }
}

__device__ __forceinline__ constexpr int sig16(int x) { return (x & ~12) | ((x & 4) << 1) | ((x & 8) >> 1); }
constexpr int PREP_WAVE_LDS = 2 * 64 * 72 * 2 + 4 * 64 * 4;
constexpr int PREP_LDS = NWAVES * PREP_WAVE_LDS;
__device__ __forceinline__ void ph_dn_prep(const P& p, char* smem) {
    const int tid = tid_opaque();
    const int wave = tid >> 6;
    char* wl = smem + wave * PREP_WAVE_LDS;
    float* sA = (float*)wl;
    bf16_t* sTw = (bf16_t*)wl; bf16_t* sTu = sTw + 64 * 72;
    float* sG = (float*)(wl + 2 * 64 * 72 * 2); float* sB = sG + 64; float* sE = sB + 64; float* sL = sE + 64;
    const bf16_t* dq = (const bf16_t*)(p.ws + WS_DQ); const bf16_t* dk = (const bf16_t*)(p.ws + WS_DK);
    const bf16_t* dkT = (const bf16_t*)(p.ws + WS_DKT); const bf16_t* dvT = (const bf16_t*)(p.ws + WS_DVT);
    const float* dbeta = (const float*)(p.ws + WS_DBG); const float* dg = dbeta + NTOK * 4;
    unsigned char* dob = (unsigned char*)p.out;
    bf16_t* PPg = (bf16_t*)(dob + DO_PP); float* GCg = (float*)(dob + DO_GC); float* EGg = (float*)(dob + DO_EG); float* LLg = (float*)(dob + DO_LL);
    if (wave >= 4) {
        int lane = tid & 63; asm volatile("" : "+v"(lane));
#pragma unroll 1
        for (int i = blockIdx.x * 4 + (wave - 4); i < CV_PREP; i += gridDim.x * 4) conv_tile_index(p, lane, CV_T0 + i);
    }
    for (int blk = blockIdx.x; blk < NB * 32 && wave < 4; blk += gridDim.x) {
        const int item = ((blk >> 5) * 4 + wave) * 32 + (blk & 31);
        int lane = tid & 63; asm volatile("" : "+v"(lane));
        const int hf = lane >> 5, l31 = lane & 31;
        const int bh = item >> 5, c = item & 31, b = bh >> 2, hh = bh & 3;
        const int tok0 = b * NT + c * 64;
        bf16_t* WN = (bf16_t*)(dob + DO_WN) + (size_t)item * 64 * 128; bf16_t* Ug = (bf16_t*)(dob + DO_U) + (size_t)item * 64 * 128;
        bf16_t* PP = PPg + (size_t)item * 64 * 64;
        float G, beta, eG;
        {
            const float g = dg[(size_t)(tok0 + lane) * 4 + hh];
            beta = dbeta[(size_t)(tok0 + lane) * 4 + hh];
            G = g;
#pragma unroll
            for (int o = 1; o < 64; o <<= 1) { const float n = __shfl_up(G, o); if (lane >= o) G += n; }
            const float Gl = __shfl(G, 63);
            eG = __expf(G);
            sG[lane] = G; sB[lane] = beta; sE[lane] = eG; sL[lane] = __expf(Gl - G);
            EGg[item * 64 + lane] = eG; LLg[item * 64 + lane] = __expf(Gl - G);
            if (lane == 0) GCg[item] = __expf(Gl);
        }
        f32x16 kk00, kk10, kk11, qk00, qk10, qk11;
#pragma unroll
        for (int r = 0; r < 16; ++r) { kk00[r] = 0.f; kk10[r] = 0.f; kk11[r] = 0.f; qk00[r] = 0.f; qk10[r] = 0.f; qk11[r] = 0.f; }
        {
            const bf16_t* kr0 = dk + (size_t)(tok0 + l31) * 512 + hh * 128 + 8 * hf; const bf16_t* kr1 = kr0 + 32 * 512;
            const bf16_t* qr0 = dq + (size_t)(tok0 + l31) * 512 + hh * 128 + 8 * hf; const bf16_t* qr1 = qr0 + 32 * 512;
#pragma unroll
            for (int s = 0; s < 8; ++s) {
                const bf16x8 k0 = *(const bf16x8*)(kr0 + s * 16), k1 = *(const bf16x8*)(kr1 + s * 16), q0 = *(const bf16x8*)(qr0 + s * 16), q1 = *(const bf16x8*)(qr1 + s * 16);
                kk00 = __builtin_amdgcn_mfma_f32_32x32x16_bf16(k0, k0, kk00, 0, 0, 0);
                kk10 = __builtin_amdgcn_mfma_f32_32x32x16_bf16(k1, k0, kk10, 0, 0, 0);
                kk11 = __builtin_amdgcn_mfma_f32_32x32x16_bf16(k1, k1, kk11, 0, 0, 0);
                qk00 = __builtin_amdgcn_mfma_f32_32x32x16_bf16(q0, k0, qk00, 0, 0, 0);
                qk10 = __builtin_amdgcn_mfma_f32_32x32x16_bf16(q1, k0, qk10, 0, 0, 0);
                qk11 = __builtin_amdgcn_mfma_f32_32x32x16_bf16(q1, k1, qk11, 0, 0, 0);
            }
        }
        __threadfence_block();
        {
            const float Gc0 = sG[l31], Gc1 = sG[32 + l31];
            float* sA0 = sA + (4 * hf) * 64 + l31;
            const float* sGr = sG + 4 * hf; const float* sBr = sB + 4 * hf;
            const int jrel = l31 - 4 * hf;
#pragma unroll
            for (int r = 0; r < 16; ++r) {
                const int ro = (r & 3) + 8 * (r >> 2);
                const float Gi0 = sGr[ro], Gi1 = sGr[32 + ro], Bi0 = sBr[ro], Bi1 = sBr[32 + ro];
                {
                    const float dec = (jrel <= ro) ? __expf(Gi0 - Gc0) : 0.f;
                    sA0[ro * 64] = (jrel < ro) ? Bi0 * kk00[r] * dec : 0.f;
                    qk00[r] *= dec;
                }
                {
                    const float dec = __expf(Gi1 - Gc0);
                    sA0[(32 + ro) * 64] = Bi1 * kk10[r] * dec;
                    qk10[r] *= dec;
                }
                {
                    const float dec = (jrel <= ro) ? __expf(Gi1 - Gc1) : 0.f;
                    sA0[(32 + ro) * 64 + 32] = (jrel < ro) ? Bi1 * kk11[r] * dec : 0.f;
                    qk11[r] *= dec;
                }
            }
        }
        __threadfence_block();
        float x[64];
#pragma unroll
        for (int i = 0; i < 64; ++i) x[i] = (i == lane) ? 1.f : 0.f;
#pragma unroll
        for (int i = 1; i < 64; ++i) {
            float acc = x[i], acc1 = 0.f, acc2 = 0.f, acc3 = 0.f;
#pragma unroll
            for (int m4 = 0; m4 < i; m4 += 4) {
                const f32x4 a = *(const f32x4*)(sA + i * 64 + m4);
                acc -= a[0] * x[m4];
                if (m4 + 1 < i) acc1 -= a[1] * x[m4 + 1];
                if (m4 + 2 < i) acc2 -= a[2] * x[m4 + 2];
                if (m4 + 3 < i) acc3 -= a[3] * x[m4 + 3];
            }
            x[i] = (acc + acc1) + (acc2 + acc3);
            __builtin_amdgcn_sched_barrier(0);
        }
        __threadfence_block();
        {
            const float sw = beta * eG;
#pragma unroll
            for (int i = 0; i < 64; ++i) { sTw[i * 72 + lane] = f2bf(x[i] * sw); sTu[i * 72 + lane] = f2bf(x[i] * beta); }
        }
        __threadfence_block();
        {
            bf16x8 tw[2][4], tu[2][4];
#pragma unroll
            for (int mt = 0; mt < 2; ++mt)
#pragma unroll
                for (int s = 0; s < 4; ++s) { tw[mt][s] = *(const bf16x8*)(sTw + (mt * 32 + l31) * 72 + s * 16 + 8 * hf); tu[mt][s] = *(const bf16x8*)(sTu + (mt * 32 + l31) * 72 + s * 16 + 8 * hf); }
            const bf16_t* kTb = dkT + ((size_t)bh * 128 + l31) * NT + c * 64 + 8 * hf;
            const bf16_t* vTb = dvT + ((size_t)bh * 128 + l31) * NT + c * 64 + 8 * hf;
            __threadfence_block();
            bf16_t* img = (bf16_t*)wl;
            {
                bf16_t* i0 = img + (4 * hf) * 64 + sig16(l31);
#pragma unroll
                for (int r = 0; r < 16; ++r) {
                    const int ro = (r & 3) + 8 * (r >> 2);
                    i0[ro * 64] = f2bf(qk00[r]); i0[ro * 64 + 32] = 0; i0[(32 + ro) * 64] = f2bf(qk10[r]); i0[(32 + ro) * 64 + 32] = f2bf(qk11[r]);
                }
                __threadfence_block();
#pragma unroll
                for (int i = 0; i < 8; ++i) ((uint4*)PP)[lane + 64 * i] = ((const uint4*)img)[lane + 64 * i];
                __threadfence_block();
            }
#pragma unroll 1
            for (int nt = 0; nt < 4; ++nt) {
                f32x16 w0, w1;
#pragma unroll
                for (int r = 0; r < 16; ++r) { w0[r] = 0.f; w1[r] = 0.f; }
#pragma unroll
                for (int s = 0; s < 4; ++s) {
                    const bf16x8 kb = *(const bf16x8*)(kTb + (size_t)nt * 32 * NT + s * 16);
                    w0 = __builtin_amdgcn_mfma_f32_32x32x16_bf16(tw[0][s], kb, w0, 0, 0, 0);
                    w1 = __builtin_amdgcn_mfma_f32_32x32x16_bf16(tw[1][s], kb, w1, 0, 0, 0);
                }
                bf16_t* i0 = img + (4 * hf) * 128 + nt * 32 + sig16(l31);
#pragma unroll
                for (int r = 0; r < 16; ++r) { const int ro = (r & 3) + 8 * (r >> 2); i0[ro * 128] = f2bf(-w0[r]); i0[(32 + ro) * 128] = f2bf(-w1[r]); }
            }
            __threadfence_block();
#pragma unroll
            for (int i = 0; i < 16; ++i) ((uint4*)WN)[lane + 64 * i] = ((const uint4*)img)[lane + 64 * i];
            __threadfence_block();
#pragma unroll 1
            for (int nt = 0; nt < 4; ++nt) {
                f32x16 u0, u1;
#pragma unroll
                for (int r = 0; r < 16; ++r) { u0[r] = 0.f; u1[r] = 0.f; }
#pragma unroll
                for (int s = 0; s < 4; ++s) {
                    const bf16x8 vb = *(const bf16x8*)(vTb + (size_t)nt * 32 * NT + s * 16);
                    u0 = __builtin_amdgcn_mfma_f32_32x32x16_bf16(tu[0][s], vb, u0, 0, 0, 0);
                    u1 = __builtin_amdgcn_mfma_f32_32x32x16_bf16(tu[1][s], vb, u1, 0, 0, 0);
                }
                bf16_t* i0 = img + (4 * hf) * 128 + nt * 32 + l31;
#pragma unroll
                for (int r = 0; r < 16; ++r) { const int ro = (r & 3) + 8 * (r >> 2); i0[ro * 128] = f2bf(u0[r]); i0[(32 + ro) * 128] = f2bf(u1[r]); }
            }
            __threadfence_block();
#pragma unroll
            for (int i = 0; i < 16; ++i) ((uint4*)Ug)[lane + 64 * i] = ((const uint4*)img)[lane + 64 * i];
        }
        __threadfence_block();
    }
}

__device__ __forceinline__ bf16x8 pack_frag(const f32x16& t, int s) {
    bf16x8 f;
#pragma unroll
    for (int j = 0; j < 8; ++j) f[j] = (short)f2bf(t[8 * s + j]);
    return f;
}
__device__ __forceinline__ bf16x8 pack_frag_scaled(const f32x16& t, int s, const f32x4& sc0, const f32x4& sc1) {
    bf16x8 f;
#pragma unroll
    for (int j = 0; j < 4; ++j) { f[j] = (short)f2bf(t[8 * s + j] * sc0[j]); f[4 + j] = (short)f2bf(t[8 * s + 4 + j] * sc1[j]); }
    return f;
}
__device__ __forceinline__ bf16x8 load_perm_frag(const bf16_t* ptr) {
    const uint2 lo = *(const uint2*)ptr, hi = *(const uint2*)(ptr + 8);
    union { uint4 u; bf16x8 f; } cv; cv.u = make_uint4(lo.x, lo.y, hi.x, hi.y); return cv.f;
}
constexpr int SC_WN = 0, SC_Q = 16384, SC_KT = 32768, SC_PP = SC_KT + 128 * 144, SC_U = SC_PP + 64 * 144, SC_EG = SC_U + 16384, SC_LL = SC_EG + 256, SC_GC = SC_LL + 256, SC_BYTES = SC_GC + 16;
constexpr int SCAN_LDS = 2 * SC_BYTES;
#define SCAN_DECL uint4 wn0, wn1, wn2, wn3, q0, q1, q2, q3, kt0, kt1, kt2, kt3, pp0, pp1, u0, u1, u2, u3; float egv = 0.f, gcv = 0.f;
#define SCAN_LD4(i, WNR, UR, QR, KTR) { const int x = hl + 256 * (i); WNR = WNp[x]; UR = Up[x]; \
        QR = *(const uint4*)(dqb + (size_t)(x >> 4) * 512 + (x & 15) * 8); \
        KTR = *(const uint4*)(ktb + (size_t)(x >> 3) * NT + (x & 7) * 8); }
#define SCAN_LOAD(c) { const int ci = bh * 32 + (c); \
        const uint4* WNp = (const uint4*)(dob + DO_WN + (size_t)ci * 16384); const uint4* Up = (const uint4*)(dob + DO_U + (size_t)ci * 16384); const uint4* PPp = (const uint4*)(dob + DO_PP + (size_t)ci * 8192); \
        const bf16_t* dqb = dqh + (size_t)(c) * 64 * 512; const bf16_t* ktb = dkTh + (c) * 64; \
        SCAN_LD4(0, wn0, u0, q0, kt0) SCAN_LD4(1, wn1, u1, q1, kt1) SCAN_LD4(2, wn2, u2, q2, kt2) SCAN_LD4(3, wn3, u3, q3, kt3) \
        pp0 = PPp[hl]; pp1 = PPp[hl + 256]; \
        if (hl < 64) egv = ((const float*)(dob + DO_EG))[ci * 64 + hl]; else if (hl < 128) egv = ((const float*)(dob + DO_LL))[ci * 64 + hl - 64]; \
        if (hl == 128) gcv = ((const float*)(dob + DO_GC))[ci]; }
#define SCAN_ST4(i, WNR, UR, QR, KTR) { const int x = hl + 256 * (i); \
        { const int r = x >> 4, cc = x & 15; *(uint4*)(sbuf + SC_WN + r * 256 + ((cc ^ (r & 15)) << 4)) = WNR; } \
        *(uint4*)(sbuf + SC_U + x * 16) = UR; \
        { const int r = x >> 4, cc = x & 15, a = cc >> 1, g = cc & 1; char* row = sbuf + SC_Q + r * 256; \
          *(uint2*)(row + (((2 * a) ^ (r & 15)) << 4) + g * 8) = make_uint2(QR.x, QR.y); \
          *(uint2*)(row + (((2 * a + 1) ^ (r & 15)) << 4) + g * 8) = make_uint2(QR.z, QR.w); } \
        { const int d = x >> 3, cc = x & 7, a = cc >> 1, g = cc & 1; char* row = sbuf + SC_KT + d * 144; \
          *(uint2*)(row + (2 * a) * 16 + g * 8) = make_uint2(KTR.x, KTR.y); \
          *(uint2*)(row + (2 * a + 1) * 16 + g * 8) = make_uint2(KTR.z, KTR.w); } }
#define SCAN_STORE(bufptr) { char* sbuf = (bufptr); \
        SCAN_ST4(0, wn0, u0, q0, kt0) SCAN_ST4(1, wn1, u1, q1, kt1) SCAN_ST4(2, wn2, u2, q2, kt2) SCAN_ST4(3, wn3, u3, q3, kt3) \
        *(uint4*)(sbuf + SC_PP + (hl >> 3) * 144 + (hl & 7) * 16) = pp0; \
        *(uint4*)(sbuf + SC_PP + ((hl + 256) >> 3) * 144 + (hl & 7) * 16) = pp1; \
        if (hl < 128) ((float*)(sbuf + SC_EG))[hl] = egv; \
        if (hl == 128) *(float*)(sbuf + SC_GC) = gcv; }
__device__ __forceinline__ void dn_scan_block(const P& p, char* smem, int bh, int tid) {
    const int wave = tid >> 6, lane = tid & 63;
    const int hf = lane >> 5, l31 = lane & 31;
    const int b = bh >> 2, hh = bh & 3;
    const bool helper = wave >= 4;
    const int hl = tid - 256, sl = wave;
    bf16_t* dno = (bf16_t*)((unsigned char*)p.out + DO_DNO);
    if (helper) {
        const unsigned char* dob = (const unsigned char*)p.out;
        const bf16_t* dqh = (const bf16_t*)(p.ws + WS_DQ) + (size_t)b * NT * 512 + hh * 128; const bf16_t* dkTh = (const bf16_t*)(p.ws + WS_DKT) + (size_t)bh * 128 * NT;
        SCAN_DECL
        SCAN_LOAD(0) SCAN_STORE(smem) SCAN_LOAD(1)
        __syncthreads();
#pragma unroll 1
        for (int c = 0; c < NT / 64; ++c) {
            if (c + 1 < NT / 64) SCAN_STORE(smem + ((c + 1) & 1) * SC_BYTES)
            if (c + 2 < NT / 64) SCAN_LOAD(c + 2)
            __syncthreads();
        }
        return;
    }
    f32x16 S[4];
#pragma unroll
    for (int T = 0; T < 4; ++T)
#pragma unroll
        for (int r = 0; r < 16; ++r) S[T][r] = 0.f;
    __syncthreads();
#pragma unroll 1
    for (int c = 0; c < NT / 64; ++c) {
        char* buf = smem + (c & 1) * SC_BYTES;
        {
            const int tok0 = b * NT + c * 64;
            const int sw = l31 & 15;
            const char* wnr = buf + SC_WN + l31 * 256; const char* qr = buf + SC_Q + l31 * 256;
            const char* ktr = buf + SC_KT + l31 * 144 + 16 * hf; const char* ppr = buf + SC_PP + l31 * 144 + 16 * hf;
            const bf16_t* ur = (const bf16_t*)(buf + SC_U) + sl * 32 + l31;
            const float* egs = (const float*)(buf + SC_EG); const float* lls = (const float*)(buf + SC_LL);
            const float gc = *(const float*)(buf + SC_GC);
            bf16x8 SB[4][2];
#pragma unroll
            for (int T = 0; T < 4; ++T) { SB[T][0] = pack_frag(S[T], 0); SB[T][1] = pack_frag(S[T], 1); }
            f32x16 D[2], O[2];
#pragma unroll
            for (int mt = 0; mt < 2; ++mt)
#pragma unroll
                for (int r = 0; r < 16; ++r) { D[mt][r] = bf2f(ur[(mt * 32 + (r & 3) + 8 * (r >> 2) + 4 * hf) * 128]); O[mt][r] = 0.f; }
#pragma unroll
            for (int mt = 0; mt < 2; ++mt)
#pragma unroll
                for (int T = 0; T < 4; ++T)
#pragma unroll
                    for (int s = 0; s < 2; ++s) {
                        const int co = (((2 * (2 * T + s) + hf) ^ sw) << 4) + mt * 32 * 256;
                        const bf16x8 wa = *(const bf16x8*)(wnr + co);
                        const bf16x8 qa = *(const bf16x8*)(qr + co);
                        D[mt] = __builtin_amdgcn_mfma_f32_32x32x16_bf16(wa, SB[T][s], D[mt], 0, 0, 0);
                        O[mt] = __builtin_amdgcn_mfma_f32_32x32x16_bf16(qa, SB[T][s], O[mt], 0, 0, 0);
                    }
            __builtin_amdgcn_sched_barrier(0);
            bf16x8 DB[2][2], DL[2][2];
#pragma unroll
            for (int mt = 0; mt < 2; ++mt) {
#pragma unroll
                for (int g4 = 0; g4 < 4; ++g4) {
                    const f32x4 eg = *(const f32x4*)(egs + mt * 32 + g4 * 8 + 4 * hf);
#pragma unroll
                    for (int j = 0; j < 4; ++j) O[mt][g4 * 4 + j] *= eg[j];
                }
                const f32x4 l0 = *(const f32x4*)(lls + mt * 32 + 0 + 4 * hf), l1 = *(const f32x4*)(lls + mt * 32 + 8 + 4 * hf);
                const f32x4 l2 = *(const f32x4*)(lls + mt * 32 + 16 + 4 * hf), l3 = *(const f32x4*)(lls + mt * 32 + 24 + 4 * hf);
                DB[mt][0] = pack_frag(D[mt], 0); DB[mt][1] = pack_frag(D[mt], 1);
                DL[mt][0] = pack_frag_scaled(D[mt], 0, l0, l1); DL[mt][1] = pack_frag_scaled(D[mt], 1, l2, l3);
            }
#pragma unroll
            for (int mt = 0; mt < 2; ++mt)
#pragma unroll
                for (int ks = 0; ks < 4; ++ks) {
                    const bf16x8 pa = *(const bf16x8*)(ppr + mt * 32 * 144 + ks * 32);
                    O[mt] = __builtin_amdgcn_mfma_f32_32x32x16_bf16(pa, DB[ks >> 1][ks & 1], O[mt], 0, 0, 0);
                }
            __builtin_amdgcn_sched_barrier(0);
            {
                bf16_t* orow = dno + (size_t)tok0 * 512 + hh * 128 + sl * 32 + l31;
#pragma unroll
                for (int mt = 0; mt < 2; ++mt)
#pragma unroll
                    for (int r = 0; r < 16; ++r) orow[(size_t)(mt * 32 + (r & 3) + 8 * (r >> 2) + 4 * hf) * 512] = f2bf(O[mt][r]);
            }
#pragma unroll
            for (int T = 0; T < 4; ++T) {
#pragma unroll
                for (int r = 0; r < 16; ++r) S[T][r] *= gc;
#pragma unroll
                for (int ks = 0; ks < 4; ++ks) {
                    const bf16x8 ka = *(const bf16x8*)(ktr + T * 32 * 144 + ks * 32);
                    S[T] = __builtin_amdgcn_mfma_f32_32x32x16_bf16(ka, DL[ks >> 1][ks & 1], S[T], 0, 0, 0);
                }
            }
        }
        __syncthreads();
    }
}

__device__ __forceinline__ void ph_dn_gate(const P& p) {
    const int tid = tid_opaque();
    const int lane = tid & 63, wave = tid >> 6;
    const bf16_t* dno = (const bf16_t*)((const unsigned char*)p.out + DO_DNO); const bf16_t* proj = (const bf16_t*)(p.ws + WS_PROJ); bf16_t* dnn = (bf16_t*)(p.ws + WS_DK);
    for (int tok = blockIdx.x * NWAVES + wave; tok < NTOK; tok += gridDim.x * NWAVES) {
#pragma unroll
        for (int hh = 0; hh < 4; ++hh) {
            const unsigned orw = *(const unsigned*)(dno + (size_t)tok * 512 + hh * 128 + lane * 2);
            const float o0 = __uint_as_float(orw << 16), o1 = __uint_as_float(orw & 0xffff0000u);
            const float ss = wave_sum(o0 * o0 + o1 * o1);
            const float rs = rsq_f(ss * (1.f / 128.f) + EPS);
            const unsigned zr = *(const unsigned*)(proj + (size_t)tok * NPROJ + PC_DNZ + hh * 128 + lane * 2);
            const float z0 = __uint_as_float(zr << 16), z1 = __uint_as_float(zr & 0xffff0000u);
            *(unsigned*)(dnn + (size_t)tok * 512 + hh * 128 + lane * 2) = pack2(o0 * rs * p.dn_norm_g[lane * 2] * silu_f(z0), o1 * rs * p.dn_norm_g[lane * 2 + 1] * silu_f(z1));
        }
    }
}

struct EpiOut {
    static constexpr bool PERM = false;
    const float* x; float* out; const float* modf;
    __device__ __forceinline__ void operator()(const f32x4 (&acc)[2][2][4][2], const pg8::DenseSrc::Unit& u, int wr, int wc, int fr, int fq) const {
        const int row0 = u.pm * 256 + wr * 64 + fr, col0 = u.pn * 256 + wc * 32 + 4 * fq;
        const float* gate = modf + (size_t)((u.pm * 256) / NT) * (6 * ND) + 2 * ND;
        f32x4 gv[2][2];
#pragma unroll
        for (int bj = 0; bj < 2; ++bj)
#pragma unroll
            for (int n = 0; n < 2; ++n) gv[bj][n] = *(const f32x4*)(gate + col0 + bj * 128 + n * 16);
#pragma unroll
        for (int ai = 0; ai < 2; ++ai)
#pragma unroll
            for (int m = 0; m < 4; ++m) { const size_t ro = (size_t)(row0 + ai * 128 + m * 16) * ND + col0;
#pragma unroll
                for (int bj = 0; bj < 2; ++bj)
#pragma unroll
                    for (int n = 0; n < 2; ++n) { const f32x4 xv = *(const f32x4*)(x + ro + bj * 128 + n * 16); *(f32x4*)(out + ro + bj * 128 + n * 16) = xv + gv[bj][n] * acc[ai][bj][m][n]; } }
    }
};
__device__ __forceinline__ void ph_gemm_out(const P& p, char* smem) {
    const int tid = tid_opaque();
    pg8::DenseSrc S; S.A0 = (const char*)(p.ws + WS_QN); S.A1 = (const char*)(p.ws + WS_DK); S.Bt = (const char*)(p.ws + WS_WOUT); S.lda = 512; S.K = ND; S.nM = NTOK / 256; S.nN = ND / 256; S.G = gridDim.x; S.c = blockIdx.x; S.ksplit = 8;
    EpiOut E; E.x = p.x; E.out = p.out; E.modf = (const float*)(p.ws + WS_MODF);
    pg8::gemm_phase(tid, (PG8_LAS unsigned char*)smem, ND, S, E);
}

constexpr int ROUTE_LDS = 1024 * 36 * 4 + 2 * 1024 * 4 + 2048 + 8 * 160 * 4;
__device__ __forceinline__ void ph_route(const P& p, char* smem) {
    const int tid = tid_opaque();
    float* sW = (float*)smem;
    float* sA = sW + 1024 * 36; float* sB = sA + 1024;
    int* s_cnt = (int*)(sB + 1024);
    int* s_base = s_cnt + 32; int* s_tok = s_base + 32;
    const int wave = tid >> 6;
    {
        f32x4 tg[2], te[16];
#pragma unroll
        for (int i = 0; i < 2; ++i) tg[i] = *(const f32x4*)(p.rg_w + (size_t)(tid + i * NTHREADS) * 4);
#pragma unroll
        for (int i = 0; i < 16; ++i) te[i] = *(const f32x4*)(p.re_w + (size_t)(tid + i * NTHREADS) * 4);
#pragma unroll
        for (int i = 0; i < 2; ++i) *(f32x4*)(sW + (tid + i * NTHREADS) * 36) = tg[i];
#pragma unroll
        for (int i = 0; i < 16; ++i) { const int x = tid + i * NTHREADS; *(f32x4*)(sW + (x >> 3) * 36 + 4 + (x & 7) * 4) = te[i]; }
    }
    bf16_t* h2 = (bf16_t*)(p.ws + WS_H2);
    int* cnt = (int*)(p.ws + WS_CTL); int* list = (int*)(p.ws + WS_LIST); int* tokinfo = (int*)(p.ws + WS_TOKINFO);
    int curb = -1;
    for (int tile = blockIdx.x; tile < NTOK / 64; tile += gridDim.x) {
        const int b = tile / (NT / 64);
        __syncthreads();
        if (b != curb) {
            { const float* mf = (const float*)(p.ws + WS_MODF) + (size_t)b * (6 * ND); for (int d = tid; d < ND; d += NTHREADS) { sA[d] = p.norm2_g[d] * (1.f + mf[4 * ND + d]); sB[d] = mf[3 * ND + d]; } }
            curb = b;
        }
        if (tid < 32) s_cnt[tid] = 0;
        __syncthreads();
#pragma unroll 1
        for (int i4 = 0; i4 < 2; ++i4) {
            const int tok0 = tile * 64 + wave * 8 + i4 * 4;
            int lane = tid & 63; asm volatile("" : "+v"(lane));
            float v[4][16];
#pragma unroll
            for (int q = 0; q < 4; ++q)
#pragma unroll
                for (int j = 0; j < 16; ++j) v[q][j] = p.out[(size_t)(tok0 + q) * ND + j * 64 + lane];
#pragma unroll
            for (int q = 0; q < 4; ++q) {
                float ss = 0.f;
#pragma unroll
                for (int j = 0; j < 16; ++j) ss += v[q][j] * v[q][j];
                ss = wave_sum(ss);
                const float rr = rsq_f(ss * (1.f / ND) + EPS);
#pragma unroll
                for (int j = 0; j < 16; ++j) { const int d = j * 64 + lane; v[q][j] = v[q][j] * rr * sA[d] + sB[d]; h2[(size_t)(tok0 + q) * ND + d] = f2bf(v[q][j]); }
            }
            float* stab = (float*)(s_tok + 64 * 4) + wave * 160;
#define TR_REDUCE(A, OFF) { float b8[8], c4[4], d2[2]; \
                _Pragma("unroll") for (int i = 0; i < 8; ++i) { auto rr = __builtin_amdgcn_permlane32_swap(__float_as_uint(A[2 * i]), __float_as_uint(A[2 * i + 1]), false, false); b8[i] = __uint_as_float(rr[0]) + __uint_as_float(rr[1]); } \
                _Pragma("unroll") for (int i = 0; i < 4; ++i) { auto rr = __builtin_amdgcn_permlane16_swap(__float_as_uint(b8[2 * i]), __float_as_uint(b8[2 * i + 1]), false, false); c4[i] = __uint_as_float(rr[0]) + __uint_as_float(rr[1]); } \
                _Pragma("unroll") for (int i = 0; i < 2; ++i) { const float keep = (lane & 1) ? c4[2 * i + 1] : c4[2 * i], send = (lane & 1) ? c4[2 * i] : c4[2 * i + 1]; d2[i] = keep + dpp_f<0xB1>(send); } \
                float e1 = ((lane & 2) ? d2[1] : d2[0]) + dpp_f<0x4E>((lane & 2) ? d2[0] : d2[1]); \
                e1 += dpp_f<0x124>(e1);              \
                e1 += dpp_f<0x128>(e1);              \
                if ((lane & 12) == 0) { \
                    const int vi = ((lane >> 5) & 1) + 2 * ((lane >> 4) & 1) + 4 * (lane & 1) + 8 * ((lane >> 1) & 1); \
                    stab[(vi >> 2) * 40 + (OFF) + (vi & 3)] = e1; \
                } }
            {
                float a[16];
#pragma unroll
                for (int i = 0; i < 16; ++i) a[i] = 0.f;
#pragma unroll
                for (int j = 0; j < 16; ++j) {
                    const f32x4 w = *(const f32x4*)(sW + (j * 64 + lane) * 36);
#pragma unroll
                    for (int q = 0; q < 4; ++q) { a[q * 4 + 0] += v[q][j] * w[0]; a[q * 4 + 1] += v[q][j] * w[1]; a[q * 4 + 2] += v[q][j] * w[2]; a[q * 4 + 3] += v[q][j] * w[3]; }
                }
                TR_REDUCE(a, 0)
            }
            __threadfence_block();
            int gsel[4]; float gtop[4];
            {
                const f32x4 rgb = *(const f32x4*)p.rg_b;
#pragma unroll
                for (int q = 0; q < 4; ++q) {
                    const f32x4 g4 = *(const f32x4*)(stab + q * 40) + rgb;
                    int gs_ = 0; float gm = g4[0];
#pragma unroll
                    for (int j = 1; j < 4; ++j) if (g4[j] > gm) { gm = g4[j]; gs_ = j; }
                    float gs = 0.f;
#pragma unroll
                    for (int j = 0; j < 4; ++j) gs += __expf(g4[j] - gm);
                    gtop[q] = __builtin_amdgcn_rcpf(gs);
                    gsel[q] = __builtin_amdgcn_readfirstlane(gs_);
                }
            }
#pragma unroll 1
            for (int half = 0; half < 2; ++half) {
                float a0[16];
#pragma unroll
                for (int i = 0; i < 16; ++i) a0[i] = 0.f;
                const float* wq0 = sW + lane * 36 + 4 + gsel[0] * 8 + half * 4; const float* wq1 = sW + lane * 36 + 4 + gsel[1] * 8 + half * 4;
                const float* wq2 = sW + lane * 36 + 4 + gsel[2] * 8 + half * 4; const float* wq3 = sW + lane * 36 + 4 + gsel[3] * 8 + half * 4;
#pragma unroll
                for (int j = 0; j < 16; ++j) {
#pragma unroll
                    for (int q = 0; q < 4; ++q) {
                        const f32x4 w0 = *(const f32x4*)((q == 0 ? wq0 : q == 1 ? wq1 : q == 2 ? wq2 : wq3) + j * 64 * 36);
                        a0[q * 4 + 0] += v[q][j] * w0[0]; a0[q * 4 + 1] += v[q][j] * w0[1]; a0[q * 4 + 2] += v[q][j] * w0[2]; a0[q * 4 + 3] += v[q][j] * w0[3];
                    }
                    if ((j & 3) == 3) __builtin_amdgcn_sched_barrier(0);
                }
                TR_REDUCE(a0, 4 + half * 4)
            }
#undef TR_REDUCE
            __threadfence_block();
#pragma unroll
            for (int q = 0; q < 4; ++q) {
                const int tok = tok0 + q;
                const f32x4 e0 = *(const f32x4*)(stab + q * 40 + 4) + *(const f32x4*)(p.re_b + gsel[q] * 8), e1v = *(const f32x4*)(stab + q * 40 + 8) + *(const f32x4*)(p.re_b + gsel[q] * 8 + 4);
                const float el[8] = {e0[0], e0[1], e0[2], e0[3], e1v[0], e1v[1], e1v[2], e1v[3]};
                int e1i = 0; float m1 = el[0];
#pragma unroll
                for (int j = 1; j < 8; ++j) if (el[j] > m1) { m1 = el[j]; e1i = j; }
                int e2i = -1; float m2 = -INFINITY;
#pragma unroll
                for (int j = 0; j < 8; ++j) if (j != e1i && el[j] > m2) { m2 = el[j]; e2i = j; }
                const float r2 = __expf(m2 - m1);
                const float rden = __builtin_amdgcn_rcpf(1.f + r2);
                const float w1v = gtop[q] * rden, w2v = gtop[q] * r2 * rden;
                if (lane == 0) {
                    const int ea = gsel[q] * 8 + e1i, eb = gsel[q] * 8 + e2i;
                    const int pa = atomicAdd(&s_cnt[ea], 1), pb = atomicAdd(&s_cnt[eb], 1);
                    int* st = s_tok + (tok & 63) * 4; st[0] = ea; st[1] = pa; st[2] = eb; st[3] = pb;
                    int* ti = tokinfo + (size_t)tok * 8; ti[4] = __float_as_int(w1v); ti[5] = __float_as_int(w2v);
                }
            }
            __threadfence_block();
        }
        __syncthreads();
        if (tid < 32) s_base[tid] = atomicAdd(&cnt[tid], s_cnt[tid]);
        __syncthreads();
        if (tid < 64) {
            const int tok = tile * 64 + tid; const int* st = s_tok + tid * 4;
            const int ea = st[0], pa = s_base[ea] + st[1], eb = st[2], pb = s_base[eb] + st[3];
            list[ea * NTOK + pa] = tok; list[eb * NTOK + pb] = tok;
            int* ti = tokinfo + (size_t)tok * 8; ti[0] = ea; ti[1] = pa; ti[2] = eb; ti[3] = pb;
        }
    }
}

struct MoeIdx { int rowoff[NE + 1]; int fulloff[NE + 1]; int ptile[NE]; int nfull, ntile; };
__device__ __forceinline__ void moe_index(const int tid, const P& p, MoeIdx* mi) {
    if (tid < 64) {
        const int* cnt = (const int*)(p.ws + WS_CTL);
        const int c = (tid < NE) ? cnt[tid] : 0;
        const int nf = c >> 8, rem = c & 255;
        int r = c, t = nf;
#pragma unroll
        for (int o = 1; o < 32; o <<= 1) { const int rn = __shfl_up(r, o), tn = __shfl_up(t, o); if ((tid & 63) >= o) { r += rn; t += tn; } }
        int rank = 0;
#pragma unroll
        for (int j = 0; j < NE; ++j) { const int rj = __builtin_amdgcn_readlane(rem, j); rank += (rj > rem || (rj == rem && j < tid)) ? 1 : 0; }
        const int npart = __builtin_popcountll(__ballot(tid < NE && rem > 0));
        if (tid < NE) { mi->rowoff[tid] = r - c; mi->fulloff[tid] = t - nf; if (rem > 0) mi->ptile[rank] = tid; }
        if (tid == NE - 1) { mi->rowoff[NE] = r; mi->fulloff[NE] = t; mi->nfull = t; mi->ntile = t + npart; }
    }
    __syncthreads();
}
struct MoeSrc {
    struct Unit { int e, ml, pn, nrows, row0; };
    const MoeIdx* mi; const int* list; const char* Ab; const char* Bt; size_t bstride; int K, G, c; bool gather;
    __device__ __forceinline__ bool next(int i, Unit& u) const {
        const int L = i * G + c; if (L >= mi->ntile * 4) return false;
        const int mt = L >> 2; u.pn = L & 3;
        int e = 0;
        if (mt < mi->nfull) { while (mi->fulloff[e + 1] <= mt) ++e; u.ml = mt - mi->fulloff[e]; }
        else { e = mi->ptile[mt - mi->nfull]; u.ml = mi->fulloff[e + 1] - mi->fulloff[e]; }
        u.e = e; u.row0 = mi->rowoff[e] + u.ml * 256;
        u.nrows = min(256, mi->rowoff[e + 1] - u.row0);
        return true;
    }
    __device__ __forceinline__ unsigned one(const Unit& u, int r, int C) const {
        const int rr = min(r, u.nrows - 1);
        const int arow = gather ? list[u.e * NTOK + u.ml * 256 + rr] : (u.row0 + rr);
        return (unsigned)((arow * K + C) * 2);
    }
    __device__ __forceinline__ void a_off(const Unit& u, int R0, int C0, int R1, int C1, pg8::AO& ao) const {
        ao.h0p0 = one(u, R0, C0); ao.h0p1 = one(u, R1, C1); ao.h1p0 = one(u, 128 + R0, C0); ao.h1p1 = one(u, 128 + R1, C1);
    }
    __device__ __forceinline__ const char* a_base(const Unit&, int kt) const { return Ab + (size_t)kt * 128; }
    __device__ __forceinline__ const char* b_base(const Unit& u) const { return Bt + (size_t)u.e * bstride + (size_t)u.pn * 256 * K * 2; }
    __device__ __forceinline__ bool lo_only(const Unit& u) const { return u.nrows <= 128; }
};
constexpr int L_MOE = pg8::STAGE_BYTES + (int)sizeof(MoeIdx) + 16;

struct EpiUp {
    static constexpr bool PERM = true;
    bf16_t* act;
    __device__ __forceinline__ void operator()(const f32x4 (&acc)[2][2][4][2], const MoeSrc::Unit& u, int wr, int wc, int fr, int fq) const {
        const int col0 = u.pn * 128 + wc * 32 + 8 * fq;
#pragma unroll
        for (int ai = 0; ai < 2; ++ai)
#pragma unroll
            for (int m = 0; m < 4; ++m) {
                const int r = ai * 128 + wr * 64 + m * 16 + fr;
                if (r < u.nrows) {
                    const f32x4 g0 = acc[ai][0][m][0], g1 = acc[ai][0][m][1], u0 = acc[ai][1][m][0], u1 = acc[ai][1][m][1];
                    *(uint4*)(act + (size_t)(u.row0 + r) * EFF + col0) = make_uint4(pack2(silu_f(g0[0]) * u0[0], silu_f(g0[1]) * u0[1]), pack2(silu_f(g0[2]) * u0[2], silu_f(g0[3]) * u0[3]),
                                                                                     pack2(silu_f(g1[0]) * u1[0], silu_f(g1[1]) * u1[1]), pack2(silu_f(g1[2]) * u1[2], silu_f(g1[3]) * u1[3]));
                }
            }
    }
};
__device__ __forceinline__ void ph_moe_up(const P& p, char* smem) {
    const int tid = tid_opaque();
    MoeIdx* mi = (MoeIdx*)(smem + pg8::STAGE_BYTES);
    moe_index(tid, p, mi);
    MoeSrc S; S.mi = mi; S.list = (const int*)(p.ws + WS_LIST); S.Ab = (const char*)(p.ws + WS_H2); S.Bt = (const char*)(p.ws + WS_W13); S.bstride = (size_t)1024 * ND * 2; S.K = ND; S.G = gridDim.x; S.c = blockIdx.x; S.gather = true;
    EpiUp E; E.act = (bf16_t*)(p.ws + WS_ACT);
    pg8::gemm_phase(tid, (PG8_LAS unsigned char*)smem, ND, S, E);
}

struct EpiDown {
    static constexpr bool PERM = true;
    bf16_t* yb;
    __device__ __forceinline__ void operator()(const f32x4 (&acc)[2][2][4][2], const MoeSrc::Unit& u, int wr, int wc, int fr, int fq) const {
        const int col0 = u.pn * 256 + wc * 32 + 8 * fq;
#pragma unroll
        for (int ai = 0; ai < 2; ++ai)
#pragma unroll
            for (int m = 0; m < 4; ++m) {
                const int r = ai * 128 + wr * 64 + m * 16 + fr;
                if (r < u.nrows) {
#pragma unroll
                    for (int bj = 0; bj < 2; ++bj) { const f32x4 v0 = acc[ai][bj][m][0], v1 = acc[ai][bj][m][1];
                        *(uint4*)(yb + (size_t)(u.row0 + r) * ND + col0 + bj * 128) = make_uint4(pack2(v0[0], v0[1]), pack2(v0[2], v0[3]), pack2(v1[0], v1[1]), pack2(v1[2], v1[3])); }
                }
            }
    }
};
__device__ __forceinline__ void ph_moe_down(const P& p, char* smem) {
    const int tid = tid_opaque();
    MoeIdx* mi = (MoeIdx*)(smem + pg8::STAGE_BYTES);
    moe_index(tid, p, mi);
    MoeSrc S; S.mi = mi; S.list = nullptr; S.Ab = (const char*)(p.ws + WS_ACT); S.Bt = (const char*)(p.ws + WS_W2); S.bstride = (size_t)ND * EFF * 2; S.K = EFF; S.G = gridDim.x; S.c = blockIdx.x; S.gather = false;
    EpiDown E; E.yb = (bf16_t*)(p.ws + WS_YBUF);
    pg8::gemm_phase(tid, (PG8_LAS unsigned char*)smem, EFF, S, E);
}

__device__ __forceinline__ void ph_combine(const P& p, char* smem) {
    const int tid = tid_opaque();
    MoeIdx* mi = (MoeIdx*)smem;
    float* sG = (float*)(mi + 1);
    moe_index(tid, p, mi);
    const int lane = tid & 63, wave = tid >> 6;
    const bf16_t* yb = (const bf16_t*)(p.ws + WS_YBUF); const int* tokinfo = (const int*)(p.ws + WS_TOKINFO);
    int curb = -1;
    for (int tile = blockIdx.x; tile < NTOK / 64; tile += gridDim.x) {
        const int b = tile / (NT / 64);
        if (b != curb) {
            __syncthreads();
            { const float* mf = (const float*)(p.ws + WS_MODF) + (size_t)b * (6 * ND) + 5 * ND; for (int d = tid; d < ND; d += NTHREADS) sG[d] = mf[d]; }
            __syncthreads();
            curb = b;
        }
        int ras[8], rbs[8]; float was[8], wbs[8];
#pragma unroll
        for (int i = 0; i < 8; ++i) {
            const int4 t4 = *(const int4*)(tokinfo + (size_t)(tile * 64 + wave * 8 + i) * 8); const int2 w2 = *(const int2*)(tokinfo + (size_t)(tile * 64 + wave * 8 + i) * 8 + 4);
            ras[i] = mi->rowoff[t4.x] + t4.y; rbs[i] = mi->rowoff[t4.z] + t4.w; was[i] = __int_as_float(w2.x); wbs[i] = __int_as_float(w2.y);
        }
#pragma unroll 2
        for (int i = 0; i < 8; ++i) {
            const int tok = tile * 64 + wave * 8 + i;
            const int ra = ras[i], rb = rbs[i]; const float wa = was[i], wb = wbs[i];
            uint2 ya[4], ybv[4]; f32x4 xv[4];
#pragma unroll
            for (int j = 0; j < 4; ++j) { const int d = j * 256 + lane * 4; ya[j] = *(const uint2*)(yb + (size_t)ra * ND + d); ybv[j] = *(const uint2*)(yb + (size_t)rb * ND + d); xv[j] = *(const f32x4*)(p.out + (size_t)tok * ND + d); }
#pragma unroll
            for (int j = 0; j < 4; ++j) {
                const int d = j * 256 + lane * 4;
                xv[j][0] += sG[d] * (wa * __uint_as_float(ya[j].x << 16) + wb * __uint_as_float(ybv[j].x << 16));
                xv[j][1] += sG[d + 1] * (wa * __uint_as_float(ya[j].x & 0xffff0000u) + wb * __uint_as_float(ybv[j].x & 0xffff0000u));
                xv[j][2] += sG[d + 2] * (wa * __uint_as_float(ya[j].y << 16) + wb * __uint_as_float(ybv[j].y << 16));
                xv[j][3] += sG[d + 3] * (wa * __uint_as_float(ya[j].y & 0xffff0000u) + wb * __uint_as_float(ybv[j].y & 0xffff0000u));
                *(f32x4*)(p.out + (size_t)tok * ND + d) = xv[j];
            }
        }
    }
}

#define XB_TMO      128
#define XB_XCNT(j)  (256  + 64 * (j))
#define XB_XSUB(j)  (1280 + 64 * (j))
#define XB_XGEN(j)  (2304 + 64 * (j))
#define XB_TOP      3328
#define XB_TOPGEN   3392
#define XCD_BAR_WORDS 3456
#define XB_SPIN_CAP (1u << 20)
#define LAS __attribute__((address_space(3)))
__device__ __forceinline__ unsigned xb_ld(unsigned* p)              { return __hip_atomic_load(p, __ATOMIC_RELAXED, __HIP_MEMORY_SCOPE_AGENT); }
__device__ __forceinline__ unsigned xb_add(unsigned* p, unsigned v) { return __hip_atomic_fetch_add(p, v, __ATOMIC_RELAXED, __HIP_MEMORY_SCOPE_AGENT); }
__device__ __forceinline__ unsigned xb_xcc_id() { return (unsigned)__builtin_amdgcn_s_getreg((3 << 11) | 20) & 0xFu; }
#define XB_SPIN(cond, bar) do { unsigned _sp = 0; while (cond) { __builtin_amdgcn_s_sleep(1); \
    if ((++_sp & 255u) == 0u) { if (xb_ld(&(bar)[XB_TMO])) break; if (_sp > XB_SPIN_CAP) { atomicAdd(&(bar)[XB_TMO], 1u); break; } } } } while (0)
struct XcdBarrier { unsigned* bar; unsigned x; volatile LAS unsigned* st; };
__device__ __forceinline__ XcdBarrier xcd_barrier_post(unsigned* bar, volatile LAS unsigned* st) {
    XcdBarrier b; b.bar = bar; b.x = xb_xcc_id(); b.st = st;
    if (threadIdx.x == 0) (void)xb_add(&bar[XB_XCNT(b.x)], 1u);
    return b;
}
__device__ __forceinline__ void xcd_barrier_complete(unsigned* bar, unsigned x, unsigned& nloc, unsigned& nx) {
    const unsigned G = gridDim.x * gridDim.y * gridDim.z;
    unsigned sum, cnt, mine, sp = 0u;
    for (;;) {
        sum = 0u; cnt = 0u; mine = 0u;
#pragma unroll
        for (unsigned j = 0; j < 16; ++j) { const unsigned c = xb_ld(&bar[XB_XCNT(j)]); sum += c; cnt += (c > 0u) ? 1u : 0u; mine = (j == x) ? c : mine; }
        if (sum == G) break;
        __builtin_amdgcn_s_sleep(1);
        if ((++sp & 255u) == 0u) { if (xb_ld(&bar[XB_TMO])) break; if (sp > XB_SPIN_CAP) { atomicAdd(&bar[XB_TMO], 1u); break; } }
    }
    nloc = mine > 0u ? mine : 1u; nx = cnt > 0u ? cnt : 1u;
}
__device__ __forceinline__ void xcd_barrier(const XcdBarrier& b) {
    asm volatile("s_waitcnt vmcnt(0)" ::: "memory");
    __syncthreads();
    if (threadIdx.x == 0) {
        unsigned* bar = b.bar;
        __builtin_amdgcn_s_waitcnt(0);
        unsigned nloc = b.st[0], nx = b.st[1];
        if (nloc == 0u) { xcd_barrier_complete(bar, b.x, nloc, nx); b.st[0] = nloc; b.st[1] = nx; }
        const unsigned old = xb_add(&bar[XB_XSUB(b.x)], 1u);
        const unsigned gen = old / nloc;
        if (old + 1u == (gen + 1u) * nloc) {
            __builtin_amdgcn_fence(__ATOMIC_RELEASE, "agent");
            asm volatile("s_waitcnt vmcnt(0)" ::: "memory");
            const unsigned og = xb_add(&bar[XB_TOP], 1u);
            const unsigned tg = og / nx;
            if (og + 1u == (tg + 1u) * nx) xb_add(&bar[XB_TOPGEN], 1u);
            else XB_SPIN(xb_ld(&bar[XB_TOPGEN]) == tg, bar);
            __builtin_amdgcn_fence(__ATOMIC_ACQUIRE, "agent");
            xb_add(&bar[XB_XGEN(b.x)], 1u);
            asm volatile("s_waitcnt vmcnt(0)" ::: "memory");
        } else {
            XB_SPIN(xb_ld(&bar[XB_XGEN(b.x)]) == gen, bar);
            __builtin_amdgcn_fence(__ATOMIC_ACQUIRE, "agent");
            asm volatile("s_waitcnt vmcnt(0)" ::: "memory");
        }
    }
    __syncthreads();
}

namespace cg = cooperative_groups;
extern __shared__ __attribute__((aligned(16))) char dyn_smem[];
constexpr int cmax(int a, int b) { return a > b ? a : b; }
constexpr int L_G1 = pg8::STAGE_BYTES;
constexpr int MEGA_LDS = cmax(cmax(cmax(ROUTE_LDS, PREP_LDS), cmax(cmax(AT_BUF + SCAN_LDS, ATTM_LDS), L_G1)), L_MOE);
typedef const unsigned long long __attribute__((address_space(4)))* kargp_t;
__device__ __forceinline__ void load_params(P& p, kargp_t ka) {
    asm volatile("" : "+s"(ka));
    typedef __attribute__((address_space(1))) char* gptr_t;
    const void** d = (const void**)&p;
#pragma unroll
    for (int i = 0; i < (int)(sizeof(P) / 8); ++i) d[i] = (const void*)(gptr_t)ka[i];
}
#define PHASE(call) do { P p; load_params(p, ka); call; } while (0)
#ifndef PROBE_MODE
#define PROBE_MODE 0
#endif
#ifndef PROBE_K
#define PROBE_K -1
#endif
template <int KMAX>
__device__ __forceinline__ void run_phases(cg::grid_group& grid, const XcdBarrier& xb, kargp_t ka, char* smem) {
    if constexpr (KMAX >= 0) { PHASE(ph_p0(p, smem)); xcd_barrier(xb); }
    if constexpr (KMAX >= 1) { PHASE(ph_norm1(p, smem)); xcd_barrier(xb); }
    if constexpr (KMAX >= 2) { PHASE(ph_gemm1(p, smem)); xcd_barrier(xb); }
    if constexpr (KMAX >= 3) { PHASE(ph_post(p, smem)); if constexpr (KMAX == 3) xcd_barrier(xb); }
    if constexpr (KMAX >= 4) { __syncthreads(); PHASE(ph_dn_prep(p, smem)); xcd_barrier(xb); }
    if constexpr (KMAX >= 5) { PHASE(ph_attn_mfma<(KMAX == 5 ? PROBE_MODE : 0)>(p, smem)); xcd_barrier(xb); }
    if constexpr (KMAX >= 7) { PHASE(ph_gemm_out(p, smem)); xcd_barrier(xb); }
    if constexpr (KMAX >= 8) { PHASE(ph_route(p, smem)); xcd_barrier(xb); }
    if constexpr (KMAX >= 9) { PHASE(ph_moe_up(p, smem)); xcd_barrier(xb); }
    if constexpr (KMAX >= 10) { PHASE(ph_moe_down(p, smem)); xcd_barrier(xb); }
    if constexpr (KMAX >= 11) { PHASE(ph_combine(p, smem)); }
}
__global__ void __launch_bounds__(NTHREADS) mega(P p_arg) {
    cg::grid_group grid = cg::this_grid();
    char* smem = dyn_smem;
    kargp_t ka = (kargp_t)__builtin_amdgcn_kernarg_segment_ptr();
    volatile LAS unsigned* xst = (volatile LAS unsigned*)(smem + MEGA_LDS);
    if (threadIdx.x < 4) xst[threadIdx.x] = 0u;
    __syncthreads();
    XcdBarrier xb;
    { P p; load_params(p, ka); xb = xcd_barrier_post((unsigned*)(p.ws + WS_BAR), xst);
      if (p.ws == nullptr) grid.sync(); }
    if constexpr (PROBE_K >= 0) {
        run_phases<PROBE_K>(grid, xb, ka, smem);
        if (PROBE_MODE == 20) { for (int i = 0; i < 20; ++i) xcd_barrier(xb); }
        P p; load_params(p, ka);
        if (blockIdx.x == 0 && threadIdx.x < 256) ((int*)(p.ws + WS_CTL))[threadIdx.x] = 0;
        xcd_barrier(xb);
    }
    run_phases<99>(grid, xb, ka, smem);
}

extern "C" void kernel_launch(void* const* d_in, const int* in_sizes, int n_in, void* d_out, int out_size, void* d_ws, size_t ws_size, hipStream_t stream) {
    if (n_in != 26 || out_size != NTOK * ND || ws_size < WS_END) { fprintf(stderr, "kernel_launch: unexpected shapes (n_in %d out %d ws %zu need %zu)\n", n_in, out_size, ws_size, (size_t)WS_END); return; }
    static int grid_blocks = 0;
    if (!grid_blocks) {
        int dev = 0, cus = 0, per_cu = 0;
        (void)hipGetDevice(&dev);
        (void)hipDeviceGetAttribute(&cus, hipDeviceAttributeMultiprocessorCount, dev);
        (void)hipFuncSetAttribute((const void*)mega, hipFuncAttributeMaxDynamicSharedMemorySize, MEGA_LDS + 16);
        (void)hipOccupancyMaxActiveBlocksPerMultiprocessor(&per_cu, (const void*)mega, NTHREADS, MEGA_LDS + 16);
        if (per_cu < 1) { fprintf(stderr, "kernel_launch: occupancy query says %d blocks/CU\n", per_cu); per_cu = 1; }
        grid_blocks = cus * per_cu;
    }
    P p{};
    const float** fp = (const float**)&p;
    for (int i = 0; i < 26; ++i) fp[i] = (const float*)d_in[i];
    p.pos = (const int*)d_in[2];
    p.out = (float*)d_out; p.ws = (unsigned char*)d_ws;
    (void)hipMemsetAsync((char*)d_ws + WS_CTL, 0, 32768, stream);
    void* args[] = {&p};
    hipError_t e = hipLaunchCooperativeKernel((const void*)mega, dim3(grid_blocks), dim3(NTHREADS), args, MEGA_LDS + 16, stream);
    if (e != hipSuccess) fprintf(stderr, "cooperative launch failed: %s (grid %d)\n", hipGetErrorString(e), grid_blocks);
}
```
